# Optimizing an MI355X kernel written in HIP

```python
import math
import jax, jax.numpy as jnp
from jax import lax
import numpy as np

D_MODEL = 4096
BATCH = 4
SEQ = 2048
DEPTH = 1
DEC_BATCH = 128
DEC_SEQ = 8
PAST_LEN = 16384
PAGE_SIZE = 128

D_LRU = D_MODEL // 2
LRU_HEADS = 16
LRU_BLK = D_LRU // LRU_HEADS
CONV_W = 4
C_RG = 8.0
D_SSM = D_MODEL // 2
SSM_CG = 16
SSM_GROUPS = D_SSM // SSM_CG
SSM_P = 64
D_FF = ((8 * D_MODEL // 3) + 255) // 256 * 256
D_IN = 2 * D_LRU + D_SSM + 2 * D_MODEL
EPS = 1e-6

kernel_name = 'hawk_s5_macaron_sandwich_decode_step'


def _rms_norm(x, g):
    xf = x.astype(jnp.float32)
    y = xf * lax.rsqrt(jnp.mean(xf * xf, axis=-1, keepdims=True) + EPS)
    return (y * g.astype(jnp.float32)).astype(x.dtype)


def _half_ffn(x, pre_g, post_g, w_gate, w_up, w_down):
    h = _rms_norm(x, pre_g)
    f = (jax.nn.silu(h @ w_gate) * (h @ w_up)) @ w_down
    return x + 0.5 * _rms_norm(f, post_g)


def _lin_combine(e1, e2):
    a1, b1 = e1
    a2, b2 = e2
    return a1 * a2, a2 * b1 + b2


def _cplx_combine(e1, e2):
    ar1, ai1, br1, bi1 = e1
    ar2, ai2, br2, bi2 = e2
    return (ar1 * ar2 - ai1 * ai2,
            ar1 * ai2 + ai1 * ar2,
            ar2 * br1 - ai2 * bi1 + br2,
            ar2 * bi1 + ai2 * br1 + bi2)


def _rg_lru_branch(xa, conv_buf, h0, conv_w, conv_b, w_rg, b_rg, w_ig, b_ig, lam):
    n, t, _ = xa.shape
    xp = jnp.concatenate([conv_buf.astype(xa.dtype), xa], axis=1)
    new_buf = xp[:, -(CONV_W - 1):]
    xc = conv_b + xp[:, 0:t] * conv_w[0]
    for k in range(1, CONV_W):
        xc = xc + xp[:, k:k + t] * conv_w[k]
    xh = xc.reshape(n, t, LRU_HEADS, LRU_BLK)
    r = jax.nn.sigmoid((jnp.einsum('nthi,hij->nthj', xh, w_rg).reshape(n, t, D_LRU) + b_rg).astype(jnp.float32))
    i = jax.nn.sigmoid((jnp.einsum('nthi,hij->nthj', xh, w_ig).reshape(n, t, D_LRU) + b_ig).astype(jnp.float32))
    log_a = -C_RG * r * jax.nn.softplus(-lam.astype(jnp.float32))
    a = jnp.exp(log_a)
    mult = jnp.sqrt(-jnp.expm1(2.0 * log_a))
    b = mult * (i * xc.astype(jnp.float32))
    a_t = jnp.swapaxes(a, 0, 1)
    b_t = jnp.swapaxes(b, 0, 1)
    b_t = b_t.at[0].add(a_t[0] * h0.astype(jnp.float32))
    _, h = lax.associative_scan(_lin_combine, (a_t, b_t), axis=0)
    y = jnp.swapaxes(h, 0, 1).astype(xa.dtype)
    return y, h[-1], new_buf


def _s5_branch(u, s_re, s_im, a_re, a_im, log_dt, b_re, b_im, c_re, c_im, d_skip, w_glu, b_glu):
    f32 = jnp.float32
    n, t, _ = u.shape
    a_re = a_re.astype(f32)
    a_im = a_im.astype(f32)
    dt = jnp.exp(log_dt.astype(f32))[:, None]
    mag = jnp.exp(a_re * dt)
    abar_re = mag * jnp.cos(a_im * dt)
    abar_im = mag * jnp.sin(a_im * dt)
    den = a_re * a_re + a_im * a_im
    nr = abar_re - 1.0
    ni = abar_im
    coef_re = ((nr * a_re + ni * a_im) / den)[..., None]
    coef_im = ((ni * a_re - nr * a_im) / den)[..., None]
    b_re = b_re.astype(f32)
    b_im = b_im.astype(f32)
    bb_re = coef_re * b_re - coef_im * b_im
    bb_im = coef_re * b_im + coef_im * b_re
    uf = u.astype(f32)
    ug = uf.reshape(n, t, SSM_GROUPS, SSM_CG)
    bu_re = jnp.einsum('ntgc,gpc->tngp', ug, bb_re)
    bu_im = jnp.einsum('ntgc,gpc->tngp', ug, bb_im)
    h0r = s_re.astype(f32)
    h0i = s_im.astype(f32)
    bu_re = bu_re.at[0].add(abar_re * h0r - abar_im * h0i)
    bu_im = bu_im.at[0].add(abar_re * h0i + abar_im * h0r)
    ar_t = jnp.broadcast_to(abar_re, (t, 1, SSM_GROUPS, SSM_P))
    ai_t = jnp.broadcast_to(abar_im, (t, 1, SSM_GROUPS, SSM_P))
    _, _, h_re, h_im = lax.associative_scan(_cplx_combine, (ar_t, ai_t, bu_re, bu_im), axis=0)
    y = (jnp.einsum('tngp,gcp->ntgc', h_re, c_re.astype(f32))
         - jnp.einsum('tngp,gcp->ntgc', h_im, c_im.astype(f32)))
    y = y.reshape(n, t, D_SSM) + d_skip.astype(f32) * uf
    g = jax.nn.gelu(y)
    out = g * jax.nn.sigmoid(g @ w_glu.astype(f32) + b_glu.astype(f32))
    return out.astype(u.dtype), h_re[-1], h_im[-1]


def _decoder_layer(x, lru_h, conv_buf, ssm_re, ssm_im, p):
    x = _half_ffn(x, p['ffn1_pre_g'], p['ffn1_post_g'], p['ffn1_w_gate'], p['ffn1_w_up'], p['ffn1_w_down'])
    u = _rms_norm(x, p['mix_pre_g'])
    z = u @ p['w_in']
    xa = z[..., :D_LRU]
    ga = z[..., D_LRU:2 * D_LRU]
    xb = z[..., 2 * D_LRU:2 * D_LRU + D_SSM]
    gl = z[..., 2 * D_LRU + D_SSM:]
    ya, new_h, new_buf = _rg_lru_branch(xa, conv_buf, lru_h, p['conv_w'], p['conv_b'], p['w_rg'], p['b_rg'],
                                        p['w_ig'], p['b_ig'], p['lru_lambda'])
    ya = ya * jax.nn.gelu(ga)
    yb, new_re, new_im = _s5_branch(xb, ssm_re, ssm_im, p['ssm_a_re'], p['ssm_a_im'], p['ssm_log_dt'],
                                    p['ssm_b_re'], p['ssm_b_im'], p['ssm_c_re'], p['ssm_c_im'], p['ssm_d'],
                                    p['w_glu'], p['b_glu'])
    gates = jax.nn.sigmoid(gl.astype(jnp.float32)).astype(x.dtype)
    merged = gates[..., :D_MODEL] * (ya @ p['w_out_a']) + gates[..., D_MODEL:] * (yb @ p['w_out_b'])
    x = x + _rms_norm(merged @ p['w_o'], p['mix_post_g'])
    x = _half_ffn(x, p['ffn2_pre_g'], p['ffn2_post_g'], p['ffn2_w_gate'], p['ffn2_w_up'], p['ffn2_w_down'])
    return x, new_h, new_buf, new_re, new_im


def setup_inputs(seed: int = 0) -> dict:
    key = jax.random.key(seed)
    ks = iter(jax.random.split(key, 48))
    L = DEPTH
    f32 = jnp.float32

    def nrm(shape, scale):
        return jax.random.normal(next(ks), shape, f32) * scale

    def gain(shape):
        return 1.0 + 0.05 * jax.random.normal(next(ks), shape, f32)

    d = {}
    d['x_prompt'] = nrm((BATCH, SEQ, D_MODEL), 1.0)
    d['x_sample'] = nrm((DEC_BATCH, DEC_SEQ, D_MODEL), 1.0)
    d['state_lru_h'] = nrm((L, DEC_BATCH, D_LRU), 0.5)
    d['state_conv'] = nrm((L, DEC_BATCH, CONV_W - 1, D_LRU), 1.0)
    d['state_ssm_re'] = nrm((L, DEC_BATCH, SSM_GROUPS, SSM_P), 0.1)
    d['state_ssm_im'] = nrm((L, DEC_BATCH, SSM_GROUPS, SSM_P), 0.1)
    d['ffn1_pre_g'] = gain((L, D_MODEL))
    d['ffn1_post_g'] = gain((L, D_MODEL))
    d['ffn1_w_gate'] = nrm((L, D_MODEL, D_FF), D_MODEL ** -0.5)
    d['ffn1_w_up'] = nrm((L, D_MODEL, D_FF), D_MODEL ** -0.5)
    d['ffn1_w_down'] = nrm((L, D_FF, D_MODEL), D_FF ** -0.5)
    d['mix_pre_g'] = gain((L, D_MODEL))
    d['mix_post_g'] = gain((L, D_MODEL))
    d['w_in'] = nrm((L, D_MODEL, D_IN), D_MODEL ** -0.5)
    d['conv_w'] = nrm((L, CONV_W, D_LRU), CONV_W ** -0.5)
    d['conv_b'] = nrm((L, D_LRU), 0.02)
    d['w_rg'] = nrm((L, LRU_HEADS, LRU_BLK, LRU_BLK), LRU_BLK ** -0.5)
    d['b_rg'] = nrm((L, D_LRU), 0.02)
    d['w_ig'] = nrm((L, LRU_HEADS, LRU_BLK, LRU_BLK), LRU_BLK ** -0.5)
    d['b_ig'] = nrm((L, D_LRU), 0.02)
    a_pow = jax.random.uniform(next(ks), (L, D_LRU), f32, minval=0.9, maxval=0.999)
    s = a_pow ** (1.0 / C_RG)
    d['lru_lambda'] = jnp.log(s) - jnp.log1p(-s)
    d['ssm_a_re'] = -0.5 + 0.01 * jax.random.normal(next(ks), (L, SSM_GROUPS, SSM_P), f32)
    d['ssm_a_im'] = (math.pi * jnp.arange(SSM_P, dtype=f32))[None, None, :] + 0.01 * jax.random.normal(next(ks), (L, SSM_GROUPS, SSM_P), f32)
    d['ssm_log_dt'] = jax.random.uniform(next(ks), (L, SSM_GROUPS), f32, minval=math.log(1e-3), maxval=math.log(1e-1))
    d['ssm_b_re'] = nrm((L, SSM_GROUPS, SSM_P, SSM_CG), (2 * SSM_CG) ** -0.5)
    d['ssm_b_im'] = nrm((L, SSM_GROUPS, SSM_P, SSM_CG), (2 * SSM_CG) ** -0.5)
    d['ssm_c_re'] = nrm((L, SSM_GROUPS, SSM_CG, SSM_P), (2 * SSM_P) ** -0.5)
    d['ssm_c_im'] = nrm((L, SSM_GROUPS, SSM_CG, SSM_P), (2 * SSM_P) ** -0.5)
    d['ssm_d'] = nrm((L, D_SSM), 1.0)
    d['w_glu'] = nrm((L, D_SSM, D_SSM), D_SSM ** -0.5)
    d['b_glu'] = nrm((L, D_SSM), 0.02)
    d['w_out_a'] = nrm((L, D_LRU, D_MODEL), D_LRU ** -0.5)
    d['w_out_b'] = nrm((L, D_SSM, D_MODEL), D_SSM ** -0.5)
    d['w_o'] = nrm((L, D_MODEL, D_MODEL), D_MODEL ** -0.5)
    d['ffn2_pre_g'] = gain((L, D_MODEL))
    d['ffn2_post_g'] = gain((L, D_MODEL))
    d['ffn2_w_gate'] = nrm((L, D_MODEL, D_FF), D_MODEL ** -0.5)
    d['ffn2_w_up'] = nrm((L, D_MODEL, D_FF), D_MODEL ** -0.5)
    d['ffn2_w_down'] = nrm((L, D_FF, D_MODEL), D_FF ** -0.5)
    return d


def reference(x_prompt, x_sample, state_lru_h, state_conv, state_ssm_re, state_ssm_im,
              ffn1_pre_g, ffn1_post_g, ffn1_w_gate, ffn1_w_up, ffn1_w_down,
              mix_pre_g, mix_post_g, w_in, conv_w, conv_b, w_rg, b_rg, w_ig, b_ig, lru_lambda,
              ssm_a_re, ssm_a_im, ssm_log_dt, ssm_b_re, ssm_b_im, ssm_c_re, ssm_c_im, ssm_d,
              w_glu, b_glu, w_out_a, w_out_b, w_o,
              ffn2_pre_g, ffn2_post_g, ffn2_w_gate, ffn2_w_up, ffn2_w_down):
    n_p = x_prompt.shape[0]
    sdt = state_lru_h.dtype
    yp = x_prompt
    ys = x_sample
    p_h, p_c, p_re, p_im = [], [], [], []
    s_h, s_c, s_re, s_im = [], [], [], []
    for l in range(DEPTH):
        p = dict(ffn1_pre_g=ffn1_pre_g[l], ffn1_post_g=ffn1_post_g[l], ffn1_w_gate=ffn1_w_gate[l],
                 ffn1_w_up=ffn1_w_up[l], ffn1_w_down=ffn1_w_down[l],
                 mix_pre_g=mix_pre_g[l], mix_post_g=mix_post_g[l], w_in=w_in[l],
                 conv_w=conv_w[l], conv_b=conv_b[l], w_rg=w_rg[l], b_rg=b_rg[l], w_ig=w_ig[l], b_ig=b_ig[l],
                 lru_lambda=lru_lambda[l], ssm_a_re=ssm_a_re[l], ssm_a_im=ssm_a_im[l], ssm_log_dt=ssm_log_dt[l],
                 ssm_b_re=ssm_b_re[l], ssm_b_im=ssm_b_im[l], ssm_c_re=ssm_c_re[l], ssm_c_im=ssm_c_im[l],
                 ssm_d=ssm_d[l], w_glu=w_glu[l], b_glu=b_glu[l], w_out_a=w_out_a[l], w_out_b=w_out_b[l],
                 w_o=w_o[l], ffn2_pre_g=ffn2_pre_g[l], ffn2_post_g=ffn2_post_g[l], ffn2_w_gate=ffn2_w_gate[l],
                 ffn2_w_up=ffn2_w_up[l], ffn2_w_down=ffn2_w_down[l])
        yp, h1, c1, r1, i1 = _decoder_layer(
            yp, jnp.zeros((n_p, D_LRU), sdt), jnp.zeros((n_p, CONV_W - 1, D_LRU), sdt),
            jnp.zeros((n_p, SSM_GROUPS, SSM_P), sdt), jnp.zeros((n_p, SSM_GROUPS, SSM_P), sdt), p)
        ys, h2, c2, r2, i2 = _decoder_layer(
            ys, state_lru_h[l], state_conv[l], state_ssm_re[l], state_ssm_im[l], p)
        p_h.append(h1.astype(sdt)); p_c.append(c1.astype(sdt)); p_re.append(r1.astype(sdt)); p_im.append(i1.astype(sdt))
        s_h.append(h2.astype(sdt)); s_c.append(c2.astype(sdt)); s_re.append(r2.astype(sdt)); s_im.append(i2.astype(sdt))
    prompt_lru_h = jnp.stack(p_h, axis=0)
    prompt_conv = jnp.stack(p_c, axis=0)
    prompt_ssm_re = jnp.stack(p_re, axis=0)
    prompt_ssm_im = jnp.stack(p_im, axis=0)
    sample_lru_h = jnp.stack(s_h, axis=0)
    sample_conv = jnp.stack(s_c, axis=0)
    sample_ssm_re = jnp.stack(s_re, axis=0)
    sample_ssm_im = jnp.stack(s_im, axis=0)
    return (yp, ys, prompt_lru_h, prompt_conv, prompt_ssm_re, prompt_ssm_im,
            sample_lru_h, sample_conv, sample_ssm_re, sample_ssm_im)
```

```cpp
#include <hip/hip_runtime.h>
#include <cstdio>
#include <cstdint>
namespace pg8 {
#define PG8_LAS __attribute__((address_space(3)))
typedef unsigned short bf16_t;
typedef short bf16x8 __attribute__((ext_vector_type(8)));
typedef float f32x4 __attribute__((ext_vector_type(4)));
typedef unsigned u32x4 __attribute__((ext_vector_type(4)));
constexpr int BM = 256, BK = 64, HALF = 128, HTB = HALF * BK * 2  , STAGE_BYTES = 8 * HTB, NXCD = 8, WGM = 8;

__host__ __device__ __forceinline__ int lds_byte(int r, int c) { const int st = (r >> 4) * 2 + (c >> 5), rr = r & 15, cc = c & 31, ob = rr * 64 + cc * 2; return st * 1024 + (ob ^ (((ob >> 9) & 1) << 5)); }
__host__ __device__ __forceinline__ void stage_rc(int b, int& R, int& C) { const int st = b / 1024, sb = b % 1024, swz = sb ^ (((sb >> 9) & 1) << 5); R = (st >> 1) * 16 + swz / 64; C = (st & 1) * 32 + (swz % 64) / 2; }
__host__ __device__ __forceinline__ int perm32(int rho) { const int n = rho >> 4, i = rho & 15; return 8 * (i >> 2) + 4 * n + (i & 3); }

struct Unit { int pm, pn, seg; };
struct Gemm { const bf16_t* A; const bf16_t* Bt; int M, N, K, ld; };

struct StaticOrder {
    int nM, nN, nwg, G, c;
    __host__ __device__ void init(int M, int N, int G_, int c_) { nM = M / BM; nN = N / BM; nwg = nM * nN; G = G_; c = c_; }
    __host__ __device__ bool next(int i, Unit& u) const {
        const long L = (long)i * G + c; if (L >= nwg) return false;
        int wgid = (int)L; { const int q = nwg / NXCD, r = nwg % NXCD, xcd = wgid % NXCD, off = wgid / NXCD; wgid = (xcd < r ? xcd * (q + 1) : r * (q + 1) + (xcd - r) * q) + off; }
        const int nig = WGM * nN, gid = wgid / nig, fm = gid * WGM, gsz = (nM - fm) < WGM ? (nM - fm) : WGM;
        u.pm = fm + ((wgid % nig) % gsz); u.pn = (wgid % nig) / gsz; u.seg = 0; return true;
    }
    __device__ __forceinline__ void a_ready(const Unit&) const {}
    __device__ __forceinline__ void done(const Unit&) const {}
};
struct SegOrder : StaticOrder {
    __host__ __device__ bool next(int i, Unit& u) const { const bool ok = StaticOrder::next(i >> 1, u); u.seg = i & 1; return ok; }
};

typedef float cvt_f32x2_t __attribute__((ext_vector_type(2)));
typedef __bf16 cvt_bf16x2_t __attribute__((ext_vector_type(2)));
__device__ __forceinline__ unsigned cvt_pk_bf16(float lo, float hi) { const cvt_f32x2_t v = {lo, hi}; const cvt_bf16x2_t b = __builtin_convertvector(v, cvt_bf16x2_t); return __builtin_bit_cast(unsigned, b); }
typedef float f32x2 __attribute__((ext_vector_type(2)));
__device__ __forceinline__ f32x2 gelu_pk(f32x2 v) {
    const f32x2 av = __builtin_elementwise_abs(v), d = av * 0.2316418882f + 1.0f;
    f32x2 t; t.x = __builtin_amdgcn_rcpf(d.x); t.y = __builtin_amdgcn_rcpf(d.y);
    f32x2 q = t * 0.5307027145f + (-0.7265760135f); q = q * t + 0.7107068705f; q = q * t + (-0.142248368f); q = q * t + 0.127414796f; q = q * t;
    const f32x2 s = (v * v) * (-0.72134752044f);
    f32x2 e; e.x = __builtin_amdgcn_exp2f(s.x); e.y = __builtin_amdgcn_exp2f(s.y);
    const f32x2 m = v * (q * e), r = v - m;
    f32x2 o; o.x = v.x < 0.f ? m.x : r.x; o.y = v.y < 0.f ? m.y : r.y; return o;
}


__device__ __forceinline__ float bf_lo(unsigned w) { return __uint_as_float(w << 16); }
__device__ __forceinline__ float bf_hi(unsigned w) { return __uint_as_float(w & 0xffff0000u); }
__device__ __forceinline__ float fast_sigmoid(float x) { return __builtin_amdgcn_rcpf(1.0f + __builtin_amdgcn_exp2f(-1.4426950408889634f * x)); }
__device__ __forceinline__ float silu_f(float x) { return x * fast_sigmoid(x); }
__device__ __forceinline__ float gelu_tanh_f(float x) { const float z = 1.5957691216057308f * (x + 0.044715f * x * x * x); return x * fast_sigmoid(z); }
__device__ __forceinline__ u32x4 pack8(const f32x4& v0, const f32x4& v1) { u32x4 w; w.x = cvt_pk_bf16(v0[0], v0[1]); w.y = cvt_pk_bf16(v0[2], v0[3]); w.z = cvt_pk_bf16(v1[0], v1[1]); w.w = cvt_pk_bf16(v1[2], v1[3]); return w; }

struct EpiSwiglu {
    static constexpr bool PERM = true, AFTER_DRAIN = false, SEG = false;
    bf16_t* O; int ldc;
    __device__ __forceinline__ void operator()(f32x4 (&acc)[2][2][4][2], const Unit& u, int wr, int wc, int fr, int fq) const {
        const int row0 = u.pm * BM + wr * 64 + fr, col0 = u.pn * HALF + wc * 32 + 8 * fq;
#pragma unroll
        for (int ai = 0; ai < 2; ++ai)
#pragma unroll
            for (int m = 0; m < 4; ++m) { bf16_t* rowp = O + (size_t)(row0 + ai * HALF + m * 16) * ldc + col0;
                f32x4 v0, v1;
#pragma unroll
                for (int j = 0; j < 4; ++j) { v0[j] = silu_f(acc[ai][0][m][0][j]) * acc[ai][1][m][0][j]; v1[j] = silu_f(acc[ai][0][m][1][j]) * acc[ai][1][m][1][j]; }
                *(u32x4*)rowp = pack8(v0, v1); }
    }
};
struct EpiF32 {
    static constexpr bool PERM = true, AFTER_DRAIN = false, SEG = false;
    float* C; int ldc;
    __device__ __forceinline__ void operator()(f32x4 (&acc)[2][2][4][2], const Unit& u, int wr, int wc, int fr, int fq) const {
        const int row0 = u.pm * BM + wr * 64 + fr, col0 = u.pn * BM + wc * 32 + 8 * fq;
#pragma unroll
        for (int ai = 0; ai < 2; ++ai)
#pragma unroll
            for (int m = 0; m < 4; ++m) { float* rowp = C + (size_t)(row0 + ai * HALF + m * 16) * ldc + col0;
#pragma unroll
                for (int bj = 0; bj < 2; ++bj)
#pragma unroll
                    for (int n = 0; n < 2; ++n) *(f32x4*)(rowp + bj * HALF + n * 4) = acc[ai][bj][m][n]; }
    }
};
struct EpiWin {
    static constexpr bool PERM = true, AFTER_DRAIN = false, SEG = false;
    float* XA; bf16_t* GA; bf16_t* XB; bf16_t* G;
    __device__ __forceinline__ void operator()(f32x4 (&acc)[2][2][4][2], const Unit& u, int wr, int wc, int fr, int fq) const {
        const int row0 = u.pm * BM + wr * 64 + fr, cw = wc * 32 + 8 * fq;
        if (u.pn < 8) {
            const int col0 = u.pn * BM + cw;
#pragma unroll
            for (int ai = 0; ai < 2; ++ai)
#pragma unroll
                for (int m = 0; m < 4; ++m) { float* rowp = XA + (size_t)(row0 + ai * HALF + m * 16) * 2048 + col0;
#pragma unroll
                    for (int bj = 0; bj < 2; ++bj)
#pragma unroll
                        for (int n = 0; n < 2; ++n) *(f32x4*)(rowp + bj * HALF + n * 4) = acc[ai][bj][m][n]; }
        } else if (u.pn < 16) {
            const int col0 = (u.pn - 8) * BM + cw;
#pragma unroll
            for (int ai = 0; ai < 2; ++ai)
#pragma unroll
                for (int m = 0; m < 4; ++m) { bf16_t* rowp = GA + (size_t)(row0 + ai * HALF + m * 16) * 2048 + col0;
#pragma unroll
                    for (int bj = 0; bj < 2; ++bj) { f32x4 v0, v1;
#pragma unroll
                        for (int j = 0; j < 4; ++j) { v0[j] = gelu_tanh_f(acc[ai][bj][m][0][j]); v1[j] = gelu_tanh_f(acc[ai][bj][m][1][j]); }
                        *(u32x4*)(rowp + bj * HALF) = pack8(v0, v1); } }
        } else if (u.pn < 24) {
            const int col0 = (u.pn - 16) * BM + cw;
#pragma unroll
            for (int ai = 0; ai < 2; ++ai)
#pragma unroll
                for (int m = 0; m < 4; ++m) { bf16_t* rowp = XB + (size_t)(row0 + ai * HALF + m * 16) * 2048 + col0;
#pragma unroll
                    for (int bj = 0; bj < 2; ++bj) *(u32x4*)(rowp + bj * HALF) = pack8(acc[ai][bj][m][0], acc[ai][bj][m][1]); }
        } else {
            const int col0 = (u.pn - 24) * BM + cw;
#pragma unroll
            for (int ai = 0; ai < 2; ++ai)
#pragma unroll
                for (int m = 0; m < 4; ++m) { bf16_t* rowp = G + (size_t)(row0 + ai * HALF + m * 16) * 8192 + col0;
#pragma unroll
                    for (int bj = 0; bj < 2; ++bj) { f32x4 v0, v1;
#pragma unroll
                        for (int j = 0; j < 4; ++j) { v0[j] = fast_sigmoid(acc[ai][bj][m][0][j]); v1[j] = fast_sigmoid(acc[ai][bj][m][1][j]); }
                        *(u32x4*)(rowp + bj * HALF) = pack8(v0, v1); } }
        }
    }
};
struct EpiGlu {
    static constexpr bool PERM = true, AFTER_DRAIN = false, SEG = false;
    const bf16_t* G2; const float* bias; bf16_t* O;
    __device__ __forceinline__ void operator()(f32x4 (&acc)[2][2][4][2], const Unit& u, int wr, int wc, int fr, int fq) const {
        const int row0 = u.pm * BM + wr * 64 + fr, col0 = u.pn * BM + wc * 32 + 8 * fq;
        f32x4 bv[2][2];
#pragma unroll
        for (int bj = 0; bj < 2; ++bj)
#pragma unroll
            for (int n = 0; n < 2; ++n) bv[bj][n] = *(const f32x4*)(bias + col0 + bj * HALF + 4 * n);
#pragma unroll
        for (int ai = 0; ai < 2; ++ai)
#pragma unroll
            for (int m = 0; m < 4; ++m) { const size_t r = (size_t)(row0 + ai * HALF + m * 16);
#pragma unroll
                for (int bj = 0; bj < 2; ++bj) { const u32x4 gw = *(const u32x4*)(G2 + r * 2048 + col0 + bj * HALF);
                    const f32x4 a0 = acc[ai][bj][m][0] + bv[bj][0], a1 = acc[ai][bj][m][1] + bv[bj][1]; f32x4 v0, v1;
                    v0[0] = bf_lo(gw.x) * fast_sigmoid(a0[0]); v0[1] = bf_hi(gw.x) * fast_sigmoid(a0[1]); v0[2] = bf_lo(gw.y) * fast_sigmoid(a0[2]); v0[3] = bf_hi(gw.y) * fast_sigmoid(a0[3]);
                    v1[0] = bf_lo(gw.z) * fast_sigmoid(a1[0]); v1[1] = bf_hi(gw.z) * fast_sigmoid(a1[1]); v1[2] = bf_lo(gw.w) * fast_sigmoid(a1[2]); v1[3] = bf_hi(gw.w) * fast_sigmoid(a1[3]);
                    *(u32x4*)(O + r * 4096 + col0 + bj * HALF) = pack8(v0, v1); } }
    }
};
struct EpiOut {
    static constexpr bool PERM = true, AFTER_DRAIN = false, SEG = true;
    const bf16_t* G; bf16_t* O;
    __device__ __forceinline__ void seg0(f32x4 (&acc)[2][2][4][2], const Unit& u, int wr, int wc, int fr, int fq) const {
        const int row0 = u.pm * BM + wr * 64 + fr, col0 = u.pn * BM + wc * 32 + 8 * fq;
#pragma unroll
        for (int ai = 0; ai < 2; ++ai)
#pragma unroll
            for (int m = 0; m < 4; ++m) { const bf16_t* gp = G + (size_t)(row0 + ai * HALF + m * 16) * 8192 + col0;
#pragma unroll
                for (int bj = 0; bj < 2; ++bj) { const u32x4 a = *(const u32x4*)(gp + bj * HALF), b = *(const u32x4*)(gp + 4096 + bj * HALF);
                    f32x4 r0, r1;
                    r0[0] = bf_lo(a.x) * __builtin_amdgcn_rcpf(fmaxf(bf_lo(b.x), 1e-30f)); r0[1] = bf_hi(a.x) * __builtin_amdgcn_rcpf(fmaxf(bf_hi(b.x), 1e-30f));
                    r0[2] = bf_lo(a.y) * __builtin_amdgcn_rcpf(fmaxf(bf_lo(b.y), 1e-30f)); r0[3] = bf_hi(a.y) * __builtin_amdgcn_rcpf(fmaxf(bf_hi(b.y), 1e-30f));
                    r1[0] = bf_lo(a.z) * __builtin_amdgcn_rcpf(fmaxf(bf_lo(b.z), 1e-30f)); r1[1] = bf_hi(a.z) * __builtin_amdgcn_rcpf(fmaxf(bf_hi(b.z), 1e-30f));
                    r1[2] = bf_lo(a.w) * __builtin_amdgcn_rcpf(fmaxf(bf_lo(b.w), 1e-30f)); r1[3] = bf_hi(a.w) * __builtin_amdgcn_rcpf(fmaxf(bf_hi(b.w), 1e-30f));
                    acc[ai][bj][m][0] = acc[ai][bj][m][0] * r0; acc[ai][bj][m][1] = acc[ai][bj][m][1] * r1; }
                asm volatile("" ::: "memory"); }
    }
    __device__ __forceinline__ void operator()(f32x4 (&acc)[2][2][4][2], const Unit& u, int wr, int wc, int fr, int fq) const { if (u.seg == 0) seg0(acc, u, wr, wc, fr, fq); else seg1(acc, u, wr, wc, fr, fq); }
    __device__ __forceinline__ void seg1(const f32x4 (&acc)[2][2][4][2], const Unit& u, int wr, int wc, int fr, int fq) const {
        const int row0 = u.pm * BM + wr * 64 + fr, col0 = u.pn * BM + wc * 32 + 8 * fq;
#pragma unroll
        for (int ai = 0; ai < 2; ++ai)
#pragma unroll
            for (int m = 0; m < 4; ++m) { const size_t r = (size_t)(row0 + ai * HALF + m * 16);
#pragma unroll
                for (int bj = 0; bj < 2; ++bj) { const u32x4 b = *(const u32x4*)(G + r * 8192 + 4096 + col0 + bj * HALF);
                    f32x4 g0, g1;
                    g0[0] = fmaxf(bf_lo(b.x), 1e-30f); g0[1] = fmaxf(bf_hi(b.x), 1e-30f); g0[2] = fmaxf(bf_lo(b.y), 1e-30f); g0[3] = fmaxf(bf_hi(b.y), 1e-30f);
                    g1[0] = fmaxf(bf_lo(b.z), 1e-30f); g1[1] = fmaxf(bf_hi(b.z), 1e-30f); g1[2] = fmaxf(bf_lo(b.w), 1e-30f); g1[3] = fmaxf(bf_hi(b.w), 1e-30f);
                    *(u32x4*)(O + r * 4096 + col0 + bj * HALF) = pack8(acc[ai][bj][m][0] * g0, acc[ai][bj][m][1] * g1); } }
    }
};

template <class Epi, class Sched, bool ALIGN_EPI = false, bool SP2 = false>
__device__ __forceinline__ void gemm_phase(PG8_LAS unsigned char* lds, const Gemm g, const Sched& S, const Epi& E) {
    const int tid = threadIdx.x, wid = __builtin_amdgcn_readfirstlane(tid >> 6), lane = tid & 63, wr = wid >> 2, wc = wid & 3, fr = lane & 15, fq = lane >> 4;
    const int K = g.K, nt = K / BK, LD = g.ld;
    unsigned voffA[2], voffB[2];
#pragma unroll
    for (int i = 0; i < 2; ++i) { int R, C; stage_rc(tid * 16 + i * 8192, R, C); const int Rb = Epi::PERM ? ((R & ~31) + perm32(R & 31)) : R;
        voffA[i] = (unsigned)(R * LD + C) * 2u; voffB[i] = (unsigned)(Rb * LD + C) * 2u; }
    const size_t kstep = (size_t)(BK * 2);
    const size_t hstep = (size_t)HALF * LD * 2;
    const size_t tstep = 2 * hstep;
    const unsigned ldsw = (unsigned)wid * 1024u;
    const int aoff = lds_byte(wr * 64 + fr, fq * 8), boff = lds_byte(wc * 32 + fr, fq * 8);
#define PG8_SA(b, h) (((b) * 2 + (h)) * HTB)
#define PG8_SB(b, h) ((4 + (b) * 2 + (h)) * HTB)
#define PG8_STAGE(bufoff, gbase, voff) do { _Pragma("unroll") for (int _i = 0; _i < 2; ++_i) \
        __builtin_amdgcn_global_load_lds((const unsigned*)((const char*)(gbase) + (voff)[_i]), (PG8_LAS unsigned*)(lds + (bufoff) + ldsw + _i * 8192), 16, 0, 0); } while (0)
#define PG8_LDA(dst, b, h) do { _Pragma("unroll") for (int m = 0; m < 4; ++m) _Pragma("unroll") for (int k = 0; k < 2; ++k) dst[m][k] = *(const PG8_LAS bf16x8*)(lds + PG8_SA(b, h) + aoff + m * 2048 + k * 1024); } while (0)
#define PG8_LDB(dst, b, h) do { _Pragma("unroll") for (int n = 0; n < 2; ++n) _Pragma("unroll") for (int k = 0; k < 2; ++k) dst[n][k] = *(const PG8_LAS bf16x8*)(lds + PG8_SB(b, h) + boff + n * 2048 + k * 1024); } while (0)
#define PG8_MMA(ai, bj, At, Bt) do { __builtin_amdgcn_s_setprio(1); _Pragma("unroll") for (int m = 0; m < 4; ++m) _Pragma("unroll") for (int n = 0; n < 2; ++n) _Pragma("unroll") for (int k = 0; k < 2; ++k) \
        acc[ai][bj][m][n] = __builtin_amdgcn_mfma_f32_16x16x32_bf16(Bt[n][k], At[m][k], acc[ai][bj][m][n], 0, 0, 0); __builtin_amdgcn_s_setprio(0); } while (0)
#define PG8_WAIT_V(n) asm volatile("s_waitcnt vmcnt(" #n ")" ::: "memory")
#define PG8_WAIT_L(n) asm volatile("s_waitcnt lgkmcnt(" #n ")" ::: "memory")
#define PG8_BAR __builtin_amdgcn_s_barrier()
#define PG8_SCHED __builtin_amdgcn_sched_barrier(0)
    Unit cur, nxt; int ui = 0;
    if (!S.next(0, cur)) return;
    f32x4 acc[2][2][4][2];
#pragma unroll
    for (int a = 0; a < 2; ++a)
#pragma unroll
        for (int b = 0; b < 2; ++b)
#pragma unroll
            for (int m = 0; m < 4; ++m)
#pragma unroll
                for (int n = 0; n < 2; ++n) acc[a][b][m][n] = (f32x4){0.f, 0.f, 0.f, 0.f};
    bf16x8 At[4][2], B0[2][2], B1[2][2];
    const size_t sstep = (size_t)K * 2;
    const char* cA = (const char*)g.A + (size_t)cur.pm * tstep + (size_t)cur.seg * sstep; const char* cB = (const char*)g.Bt + (size_t)cur.pn * tstep + (size_t)cur.seg * sstep;
    S.a_ready(cur);
    if constexpr (SP2) {
        PG8_STAGE(PG8_SB(0, 0), cB, voffB); PG8_STAGE(PG8_SB(0, 1), cB + hstep, voffB); PG8_STAGE(PG8_SA(0, 0), cA, voffA); PG8_STAGE(PG8_SA(0, 1), cA + hstep, voffA);
        if (wr == 1) PG8_BAR;
        PG8_WAIT_V(2); PG8_BAR;
        PG8_STAGE(PG8_SB(1, 0), cB + kstep, voffB); PG8_STAGE(PG8_SA(1, 0), cA + kstep, voffA); PG8_STAGE(PG8_SB(1, 1), cB + hstep + kstep, voffB);
        PG8_WAIT_V(6); PG8_BAR;
    } else {
        PG8_STAGE(PG8_SB(0, 0), cB, voffB); PG8_STAGE(PG8_SA(0, 0), cA, voffA); PG8_STAGE(PG8_SB(0, 1), cB + hstep, voffB); PG8_STAGE(PG8_SA(0, 1), cA + hstep, voffA);
        if (wr == 1) PG8_BAR;
        PG8_WAIT_V(4); PG8_BAR;
        PG8_STAGE(PG8_SB(1, 0), cB + kstep, voffB); PG8_STAGE(PG8_SA(1, 0), cA + kstep, voffA); PG8_STAGE(PG8_SB(1, 1), cB + hstep + kstep, voffB);
        PG8_WAIT_V(6); PG8_BAR;
    }
    for (;;) {
        const bool has_next = S.next(ui + 1, nxt);
        const char* nA = has_next ? (const char*)g.A + (size_t)nxt.pm * tstep + (size_t)nxt.seg * sstep : cA; const char* nB = has_next ? (const char*)g.Bt + (size_t)nxt.pn * tstep + (size_t)nxt.seg * sstep : cB;
        for (int t = 0; t < nt; t += 2) {
            const bool last = (t == nt - 2);
            const char* a1 = cA + (size_t)(t + 1) * kstep;
            const char* a2 = last ? nA : cA + (size_t)(t + 2) * kstep; const char* b2 = last ? nB : cB + (size_t)(t + 2) * kstep;
            const char* a3 = a2 + kstep; const char* b3 = b2 + kstep;
            if (last && has_next) S.a_ready(nxt);
            if constexpr (SP2) {
            PG8_LDB(B0, 0, 0); PG8_LDB(B1, 0, 1); PG8_SCHED; PG8_LDA(At, 0, 0); PG8_STAGE(PG8_SA(1, 1), a1 + hstep, voffA);
            PG8_WAIT_V(8); PG8_WAIT_L(0); PG8_BAR; PG8_MMA(0, 0, At, B0); PG8_MMA(0, 1, At, B1); PG8_BAR; PG8_SCHED;
            PG8_LDA(At, 0, 1); PG8_STAGE(PG8_SB(0, 0), b2, voffB); PG8_STAGE(PG8_SB(0, 1), b2 + hstep, voffB); PG8_STAGE(PG8_SA(0, 0), a2, voffA);
            PG8_WAIT_V(8); PG8_WAIT_L(0); PG8_BAR; PG8_MMA(1, 0, At, B0); PG8_MMA(1, 1, At, B1); PG8_BAR; PG8_SCHED;
            PG8_LDB(B0, 1, 0); PG8_LDB(B1, 1, 1); PG8_SCHED; PG8_LDA(At, 1, 0); PG8_STAGE(PG8_SA(0, 1), a2 + hstep, voffA);
            PG8_WAIT_V(8); PG8_WAIT_L(0); PG8_BAR; PG8_MMA(0, 0, At, B0); PG8_MMA(0, 1, At, B1); PG8_BAR; PG8_SCHED;
            PG8_LDA(At, 1, 1); PG8_STAGE(PG8_SB(1, 0), b3, voffB); PG8_STAGE(PG8_SB(1, 1), b3 + hstep, voffB); PG8_STAGE(PG8_SA(1, 0), a3, voffA);
            PG8_WAIT_V(8); PG8_WAIT_L(0); PG8_BAR; PG8_MMA(1, 0, At, B0); PG8_MMA(1, 1, At, B1); PG8_BAR; PG8_SCHED;
            } else {
            PG8_LDB(B0, 0, 0); PG8_SCHED; PG8_LDA(At, 0, 0); PG8_STAGE(PG8_SA(1, 1), a1 + hstep, voffA);
            PG8_WAIT_L(8); PG8_BAR; PG8_WAIT_L(0); PG8_MMA(0, 0, At, B0); PG8_BAR; PG8_SCHED;
            PG8_LDB(B1, 0, 1); PG8_STAGE(PG8_SB(0, 0), b2, voffB);
            PG8_BAR; PG8_WAIT_L(0); PG8_MMA(0, 1, At, B1); PG8_BAR;
            PG8_LDA(At, 0, 1); PG8_STAGE(PG8_SA(0, 0), a2, voffA);
            PG8_BAR; PG8_WAIT_L(0); PG8_MMA(1, 0, At, B0); PG8_BAR; PG8_SCHED;
            PG8_STAGE(PG8_SB(0, 1), b2 + hstep, voffB);
            PG8_WAIT_V(6); PG8_BAR; PG8_MMA(1, 1, At, B1); PG8_BAR;
            PG8_LDB(B0, 1, 0); PG8_SCHED; PG8_LDA(At, 1, 0); PG8_STAGE(PG8_SA(0, 1), a2 + hstep, voffA);
            PG8_WAIT_L(8); PG8_BAR; PG8_WAIT_L(0); PG8_MMA(0, 0, At, B0); PG8_BAR; PG8_SCHED;
            PG8_LDB(B1, 1, 1); PG8_STAGE(PG8_SB(1, 0), b3, voffB);
            PG8_BAR; PG8_WAIT_L(0); PG8_MMA(0, 1, At, B1); PG8_BAR;
            PG8_LDA(At, 1, 1); PG8_STAGE(PG8_SA(1, 0), a3, voffA);
            PG8_BAR; PG8_WAIT_L(0); PG8_MMA(1, 0, At, B0); PG8_BAR; PG8_SCHED;
            PG8_STAGE(PG8_SB(1, 1), b3 + hstep, voffB);
            PG8_WAIT_V(6); PG8_BAR; PG8_MMA(1, 1, At, B1); PG8_BAR;
            }
        }
        if constexpr (ALIGN_EPI) { if (wr == 0) PG8_BAR; }
        if constexpr (!Epi::AFTER_DRAIN) { E(acc, cur, wr, wc, fr, fq); S.done(cur); }
        if (!has_next) break;
        if (!Epi::SEG || nxt.seg == 0) {
#pragma unroll
        for (int a = 0; a < 2; ++a)
#pragma unroll
            for (int b = 0; b < 2; ++b)
#pragma unroll
                for (int m = 0; m < 4; ++m)
#pragma unroll
                    for (int n = 0; n < 2; ++n) acc[a][b][m][n] = (f32x4){0.f, 0.f, 0.f, 0.f};
        }
        cur = nxt; cA = nA; cB = nB; ++ui;
        if constexpr (ALIGN_EPI) { if (wr == 1) PG8_BAR; }
    }
    PG8_WAIT_V(0);
    if constexpr (!ALIGN_EPI) { if (wr == 0) PG8_BAR; }
    PG8_BAR;
    if constexpr (Epi::AFTER_DRAIN) { E.fused(acc, cur, wr, wc, fr, fq, lds, wid, lane); S.done(cur); }
#undef PG8_SA
#undef PG8_SB
#undef PG8_STAGE
#undef PG8_LDA
#undef PG8_LDB
#undef PG8_MMA
#undef PG8_WAIT_V
#undef PG8_WAIT_L
#undef PG8_BAR
#undef PG8_SCHED
}
}

#ifndef PG8_SP2
#define PG8_SP2 true
#endif
#ifndef PG8_ALIGN
#define PG8_ALIGN true
#endif

constexpr int NWAVES = 8;
#ifndef MK_N_LAUNCHES
#define MK_N_LAUNCHES 1
#endif
constexpr int N_PHASES = 13;
constexpr int N_LAUNCHES = MK_N_LAUNCHES;

constexpr int D = 4096, DFF = 11008, DLRU = 2048, DSSM = 2048, DIN = 14336;
constexpr int NP = 4, TP = 2048, NS = 128, TS = 8;
constexpr int MP = NP * TP, MS = NS * TS, M = MP + MS;
constexpr int NGRP = 128, SP = 64, SCG = 16;
constexpr float EPS = 1e-6f;

constexpr size_t MiB = 1u << 20;
constexpr size_t WS_CTL = 0, CTL_ZERO_BYTES = 1 * MiB;
constexpr size_t WS_ABAR = 2 * MiB;
constexpr size_t WS_BB = 3 * MiB;
constexpr size_t WS_CC = 4 * MiB;
constexpr size_t WS_WG = 5 * MiB;
constexpr size_t WS_WGU1 = 8 * MiB, WS_WD1 = 180 * MiB, WS_WIN = 266 * MiB, WS_WGLU = 378 * MiB, WS_WOUT = 386 * MiB, WS_WO = 418 * MiB, WS_WGU2 = 450 * MiB, WS_WD2 = 622 * MiB;
constexpr size_t WS_XN = 708 * MiB;
constexpr size_t WS_HID = 780 * MiB;
constexpr size_t WS_XA = WS_HID, WS_GA = WS_HID + 72 * MiB, WS_XB = WS_HID + 108 * MiB, WS_G2 = WS_HID + 144 * MiB;
constexpr size_t WS_F = 974 * MiB;
constexpr size_t WS_G = WS_F;
constexpr size_t WS_YAB = 1118 * MiB, WS_END = 1190 * MiB;
static_assert(WS_WGU1 + (size_t)2 * DFF * D * 2 <= WS_WD1 && WS_WD1 + (size_t)D * DFF * 2 <= WS_WIN && WS_WIN + (size_t)DIN * D * 2 <= WS_WGLU && WS_WGLU + (size_t)DSSM * DSSM * 2 <= WS_WOUT, "ws map 1");
static_assert(WS_WOUT + (size_t)D * D * 2 <= WS_WO && WS_WO + (size_t)D * D * 2 <= WS_WGU2 && WS_WGU2 + (size_t)2 * DFF * D * 2 <= WS_WD2 && WS_WD2 + (size_t)D * DFF * 2 <= WS_XN, "ws map 2");
static_assert(WS_XN + (size_t)M * D * 2 <= WS_HID && WS_HID + (size_t)M * DFF * 2 <= WS_F && WS_G2 + (size_t)M * DSSM * 2 <= WS_F && WS_F + (size_t)M * D * 4 <= WS_YAB && WS_YAB + (size_t)M * D * 2 <= WS_END, "ws map 3");
constexpr int CW_TMO = 0, CW_CODE = 1;
constexpr int CW_BAR = 4096;

constexpr int RING_OFF = 0, RING_BYTES = 131072;
constexpr int LDSCTL_OFF = RING_BYTES, MISC_OFF = LDSCTL_OFF + 320;
constexpr int LDS_BYTES = 147456;
static_assert(MISC_OFF + 128 <= LDS_BYTES, "LDS map");

#define GAS __attribute__((address_space(1)))
#define LAS __attribute__((address_space(3)))
typedef unsigned short bf16;
typedef unsigned v4u __attribute__((ext_vector_type(4)));
typedef unsigned v2u __attribute__((ext_vector_type(2)));
typedef float f32x4 __attribute__((ext_vector_type(4)));
typedef float f32x2 __attribute__((ext_vector_type(2)));
typedef short bf16x8 __attribute__((ext_vector_type(8)));
typedef GAS unsigned gu32;
typedef GAS unsigned long long gu64;
#define RLX_AGENT __ATOMIC_RELAXED, __HIP_MEMORY_SCOPE_AGENT
#define LDS_WAIT() asm volatile("s_waitcnt lgkmcnt(0)" ::: "memory")
#define VM_WAIT() asm volatile("s_waitcnt vmcnt(0)" ::: "memory")
__device__ __forceinline__ unsigned f2bf(float f) { unsigned u = __builtin_bit_cast(unsigned, f); return (u + 0x7fffu + ((u >> 16) & 1u)) >> 16; }
__device__ __forceinline__ unsigned pk2(float lo, float hi) { return pg8::cvt_pk_bf16(lo, hi); }
using pg8::bf_lo; using pg8::bf_hi; using pg8::fast_sigmoid; using pg8::gelu_tanh_f;
#define XB_TMO      128
#define XB_XCNT(j)  (256  + 64 * (j))
#define XB_XSUB(j)  (1280 + 64 * (j))
#define XB_XGEN(j)  (2304 + 64 * (j))
#define XB_TOP      3328
#define XB_TOPGEN   3392
#define XCD_BAR_WORDS 3456
#define XB_SPIN_CAP (1u << 18)

__device__ __forceinline__ unsigned xb_ld(unsigned* p)              { return __hip_atomic_load(p, __ATOMIC_RELAXED, __HIP_MEMORY_SCOPE_AGENT); }
__device__ __forceinline__ unsigned xb_add(unsigned* p, unsigned v) { return __hip_atomic_fetch_add(p, v, __ATOMIC_RELAXED, __HIP_MEMORY_SCOPE_AGENT); }
__device__ __forceinline__ unsigned xb_xcc_id() { return (unsigned)__builtin_amdgcn_s_getreg((3 << 11) | 20) & 0xFu; }
#define XB_SPIN(cond, bar) do { unsigned _sp = 0; while (cond) { __builtin_amdgcn_s_sleep(1); \
    if ((++_sp & 255u) == 0u) { if (xb_ld(&(bar)[XB_TMO])) break; if (_sp > XB_SPIN_CAP) { atomicAdd(&(bar)[XB_TMO], 1u); break; } } } } while (0)

struct XcdBarrier {
    unsigned* bar; unsigned x;
    volatile LAS unsigned* st;
};

__device__ __forceinline__ XcdBarrier xcd_barrier_post(unsigned* bar, volatile LAS unsigned* st) {
    XcdBarrier b; b.bar = bar; b.x = xb_xcc_id(); b.st = st;
    if (threadIdx.x == 0) (void)xb_add(&bar[XB_XCNT(b.x)], 1u);
    return b;
}
__device__ __forceinline__ void xcd_barrier_complete(unsigned* bar, unsigned x, unsigned& nloc, unsigned& nx) {
    const unsigned G = gridDim.x * gridDim.y * gridDim.z;
    unsigned sum, cnt, mine, sp = 0u;
    for (;;) {
        sum = 0u; cnt = 0u; mine = 0u;
#pragma unroll
        for (unsigned j = 0; j < 16; ++j) { const unsigned c = xb_ld(&bar[XB_XCNT(j)]); sum += c; cnt += (c > 0u) ? 1u : 0u; mine = (j == x) ? c : mine; }
        if (sum == G) break;
        __builtin_amdgcn_s_sleep(1);
        if ((++sp & 255u) == 0u) { if (xb_ld(&bar[XB_TMO])) break; if (sp > XB_SPIN_CAP) { atomicAdd(&bar[XB_TMO], 1u); break; } }
    }
    nloc = mine > 0u ? mine : 1u; nx = cnt > 0u ? cnt : 1u;
}

__device__ __forceinline__ void xcd_barrier(const XcdBarrier& b) {
    asm volatile("s_waitcnt vmcnt(0)" ::: "memory");
    __syncthreads();
    if (threadIdx.x == 0) {
        unsigned* bar = b.bar;
        __builtin_amdgcn_s_waitcnt(0);
        unsigned nloc = b.st[0], nx = b.st[1];
        if (nloc == 0u) { xcd_barrier_complete(bar, b.x, nloc, nx); b.st[0] = nloc; b.st[1] = nx; }
        const unsigned old = xb_add(&bar[XB_XSUB(b.x)], 1u);
        const unsigned gen = old / nloc;
        if (old + 1u == (gen + 1u) * nloc) {
            __builtin_amdgcn_fence(__ATOMIC_RELEASE, "agent");
            asm volatile("s_waitcnt vmcnt(0)" ::: "memory");
            const unsigned og = xb_add(&bar[XB_TOP], 1u);
            const unsigned tg = og / nx;
            if (og + 1u == (tg + 1u) * nx) xb_add(&bar[XB_TOPGEN], 1u);
            else XB_SPIN(xb_ld(&bar[XB_TOPGEN]) == tg, bar);
            __builtin_amdgcn_fence(__ATOMIC_ACQUIRE, "agent");
            xb_add(&bar[XB_XGEN(b.x)], 1u);
            asm volatile("s_waitcnt vmcnt(0)" ::: "memory");
        } else {
            XB_SPIN(xb_ld(&bar[XB_XGEN(b.x)]) == gen, bar);
            __builtin_amdgcn_fence(__ATOMIC_ACQUIRE, "agent");
            asm volatile("s_waitcnt vmcnt(0)" ::: "memory");
        }
    }
    __syncthreads();
}

__device__ __forceinline__ float wave_sum(float v) {
#pragma unroll
    for (int o = 1; o < 64; o <<= 1) v += __shfl_xor(v, o);
    return v;
}
constexpr size_t O_Y = 0, O_PLRU = (size_t)M * D, O_PCONV = O_PLRU + NP * DLRU, O_PRE = O_PCONV + NP * 3 * DLRU, O_PIM = O_PRE + NP * NGRP * SP, O_SLRU = O_PIM + NP * NGRP * SP,
                 O_SCONV = O_SLRU + NS * DLRU, O_SRE = O_SCONV + NS * 3 * DLRU, O_SIM = O_SRE + NS * NGRP * SP, O_END = O_SIM + NS * NGRP * SP;
static_assert(O_END == 40992768, "output size");

struct Args { const float* in[39]; float* out; unsigned char* ws; int ph_lo, ph_hi, li, pad; };
enum { I_XP = 0, I_XS, I_SLRU, I_SCONV, I_SRE, I_SIM, I_F1PRE, I_F1POST, I_F1G, I_F1U, I_F1D, I_MPRE, I_MPOST, I_WIN, I_CONVW, I_CONVB, I_WRG, I_BRG, I_WIG, I_BIG, I_LAM,
       I_ARE, I_AIM, I_LDT, I_BRE, I_BIM, I_CRE, I_CIM, I_DSK, I_WGLU, I_BGLU, I_WOA, I_WOB, I_WO, I_F2PRE, I_F2POST, I_F2G, I_F2U, I_F2D };

__device__ __forceinline__ void transpose_item(const float* W, int N, bf16* WT, int pitch, int k0, int n0, int drow, int dcol, LAS float* scr, int lane) {
#pragma unroll 8
    for (int i = 0; i < 32; ++i) { const int kk = 2 * i + (lane >> 5); scr[kk * 33 + (lane & 31)] = W[(size_t)(k0 + kk) * N + n0 + (lane & 31)]; }
    LDS_WAIT(); asm volatile("" ::: "memory");
    const int c = lane & 7;
#pragma unroll
    for (int j = 0; j < 4; ++j) { const int n = (lane >> 3) + 8 * j; const LAS float* s = scr + (8 * c) * 33 + n;
        v4u o; o.x = pk2(s[0 * 33], s[1 * 33]); o.y = pk2(s[2 * 33], s[3 * 33]); o.z = pk2(s[4 * 33], s[5 * 33]); o.w = pk2(s[6 * 33], s[7 * 33]);
        *(GAS v4u*)(WT + (size_t)(drow + n) * pitch + dcol + k0 + 8 * c) = o; }
    LDS_WAIT(); asm volatile("" ::: "memory");
}
__device__ __forceinline__ void tr_plain(const float* W, int K, int N, bf16* WT, int pitch, int dcol, int item, LAS float* scr, int lane) {
    const int nblk = N / 32, kb = item / nblk, nb = item - kb * nblk; (void)K;
    transpose_item(W, N, WT, pitch, 64 * kb, 32 * nb, 32 * nb, dcol, scr, lane);
}
__device__ __forceinline__ void tr_gu(const float* W, bf16* WT, int up, int item, LAS float* scr, int lane) {
    const int nblk = DFF / 32, kb = item / nblk, nb = item - kb * nblk, n0 = 32 * nb;
    transpose_item(W, DFF, WT, D, 64 * kb, n0, 256 * (n0 >> 7) + up * 128 + (n0 & 127), 0, scr, lane);
}
constexpr int IT_GU = (D / 64) * (DFF / 32), IT_DN = (DFF / 64) * (D / 32), IT_IN = (D / 64) * (DIN / 32), IT_GLU = (DSSM / 64) * (DSSM / 32), IT_OA = (DLRU / 64) * (D / 32), IT_WO = (D / 64) * (D / 32), IT_RG = 16 * 2 * 4;
constexpr int IT_TOTAL = 4 * IT_GU + 2 * IT_DN + IT_IN + IT_GLU + 2 * IT_OA + IT_WO + 2 * IT_RG;

template <int MODE> __device__ __forceinline__ void thin_rows(const Args& args, int gw, int ngw, int lane);

__device__ __forceinline__ void p0_prologue(const Args& args, LAS unsigned char* lds, int wave, int lane, int gw, int ngw) {
    unsigned char* ws = args.ws;
    LAS float* scr = (LAS float*)(lds + RING_OFF + wave * 16384);
    for (int it = gw; it < IT_TOTAL; it += ngw) {
        int r = it;
        if (r < IT_GU) { tr_gu(args.in[I_F1G], (bf16*)(ws + WS_WGU1), 0, r, scr, lane); continue; } r -= IT_GU;
        if (r < IT_GU) { tr_gu(args.in[I_F1U], (bf16*)(ws + WS_WGU1), 1, r, scr, lane); continue; } r -= IT_GU;
        if (r < IT_DN) { tr_plain(args.in[I_F1D], DFF, D, (bf16*)(ws + WS_WD1), DFF, 0, r, scr, lane); continue; } r -= IT_DN;
        if (r < IT_IN) { tr_plain(args.in[I_WIN], D, DIN, (bf16*)(ws + WS_WIN), D, 0, r, scr, lane); continue; } r -= IT_IN;
        if (r < IT_GLU) { tr_plain(args.in[I_WGLU], DSSM, DSSM, (bf16*)(ws + WS_WGLU), DSSM, 0, r, scr, lane); continue; } r -= IT_GLU;
        if (r < IT_OA) { tr_plain(args.in[I_WOA], DLRU, D, (bf16*)(ws + WS_WOUT), D, 0, r, scr, lane); continue; } r -= IT_OA;
        if (r < IT_OA) { tr_plain(args.in[I_WOB], DSSM, D, (bf16*)(ws + WS_WOUT), D, DLRU, r, scr, lane); continue; } r -= IT_OA;
        if (r < IT_WO) { tr_plain(args.in[I_WO], D, D, (bf16*)(ws + WS_WO), D, 0, r, scr, lane); continue; } r -= IT_WO;
        if (r < IT_GU) { tr_gu(args.in[I_F2G], (bf16*)(ws + WS_WGU2), 0, r, scr, lane); continue; } r -= IT_GU;
        if (r < IT_GU) { tr_gu(args.in[I_F2U], (bf16*)(ws + WS_WGU2), 1, r, scr, lane); continue; } r -= IT_GU;
        if (r < IT_DN) { tr_plain(args.in[I_F2D], DFF, D, (bf16*)(ws + WS_WD2), DFF, 0, r, scr, lane); continue; } r -= IT_DN;
        { const int ig = r >= IT_RG ? 1 : 0; const int q = r - ig * IT_RG, h = q >> 3, sub = q & 7, kb = sub >> 2, nb = sub & 3;
          const float* W = (ig ? args.in[I_WIG] : args.in[I_WRG]) + (size_t)h * 128 * 128;
          transpose_item(W, 128, (bf16*)(ws + WS_WG) + (size_t)h * 256 * 128, 128, 64 * kb, 32 * nb, ig * 128 + 32 * nb, 0, scr, lane); }
    }
    {
        const int gt = gw * 64 + lane;
        if (gt < NGRP * SP) {
            const int g = gt >> 6, p = gt & 63;
            const double dt = exp((double)args.in[I_LDT][g]);
            const double ar = (double)args.in[I_ARE][gt], ai = (double)args.in[I_AIM][gt];
            const double mag = exp(ar * dt);
            double th = ai * dt; th -= 6.283185307179586476925 * rint(th * 0.15915494309189533577);
            const double x = 0.25 * th, x2 = x * x;
            double s = x * (1.0 + x2 * (-1.0 / 6 + x2 * (1.0 / 120 + x2 * (-1.0 / 5040 + x2 * (1.0 / 362880 + x2 * (-1.0 / 39916800 + x2 * (1.0 / 6227020800.0)))))));
            double c = 1.0 + x2 * (-0.5 + x2 * (1.0 / 24 + x2 * (-1.0 / 720 + x2 * (1.0 / 40320 + x2 * (-1.0 / 3628800 + x2 * (1.0 / 479001600.0 + x2 * (-1.0 / 87178291200.0)))))));
            { const double s2 = 2.0 * s * c, c2 = 1.0 - 2.0 * s * s; s = s2; c = c2; }
            { const double s2 = 2.0 * s * c, c2 = 1.0 - 2.0 * s * s; s = s2; c = c2; }
            const double abr = mag * c, abi = mag * s;
            const double den = ar * ar + ai * ai, nr = abr - 1.0, ni = abi;
            const double cre = (nr * ar + ni * ai) / den, cim = (ni * ar - nr * ai) / den;
            float* AB = (float*)(ws + WS_ABAR); AB[2 * gt] = (float)abr; AB[2 * gt + 1] = (float)abi;
            bf16* BB = (bf16*)(ws + WS_BB); bf16* CC = (bf16*)(ws + WS_CC);
            const float* bre = args.in[I_BRE] + (size_t)gt * SCG; const float* bim = args.in[I_BIM] + (size_t)gt * SCG;
#pragma unroll 4
            for (int ch = 0; ch < SCG; ++ch) {
                const double br = (double)bre[ch], bi = (double)bim[ch];
                const float vre = (float)(cre * br - cim * bi), vim = (float)(cre * bi + cim * br);
#pragma unroll
                for (int ri = 0; ri < 2; ++ri) { const int col = 2 * p + ri, j = col >> 4, ln = (col & 15) + 16 * (ch >> 3);
                    BB[((size_t)(g * 8 + j) * 64 + ln) * 8 + (ch & 7)] = (bf16)f2bf(ri ? vim : vre); }
                const float c_re = args.in[I_CRE][((size_t)g * SCG + ch) * SP + p], c_im = args.in[I_CIM][((size_t)g * SCG + ch) * SP + p];
#pragma unroll
                for (int ri = 0; ri < 2; ++ri) { const int k = 2 * p + ri, kk = k >> 5, ln = ch + 16 * ((k & 31) >> 3);
                    CC[((size_t)(g * 4 + kk) * 64 + ln) * 8 + (k & 7)] = (bf16)f2bf(ri ? -c_im : c_re); }
            }
        }
    }
    thin_rows<0>(args, gw, ngw, lane);
}

template <int MODE> __device__ __forceinline__ void thin_rows(const Args& args, int gw, int ngw, int lane) {
    const float* gA = MODE == 1 ? args.in[I_F1POST] : (MODE == 2 ? args.in[I_MPOST] : args.in[I_F2POST]);
    const float* gB = MODE == 0 ? args.in[I_F1PRE] : (MODE == 1 ? args.in[I_MPRE] : args.in[I_F2PRE]);
    const float sc = MODE == 2 ? 1.0f : 0.5f;
    float* Y = args.out + O_Y; const float* Fb = (const float*)(args.ws + WS_F); bf16* XN = (bf16*)(args.ws + WS_XN);
    for (int m = gw; m < M; m += ngw) {
        const float* xin = (MODE <= 1) ? (m < MP ? args.in[I_XP] + (size_t)m * D : args.in[I_XS] + (size_t)(m - MP) * D) : Y + (size_t)m * D;
        const GAS f32x4* xr = (const GAS f32x4*)xin + lane;
        f32x4 v[16];
#pragma unroll
        for (int j = 0; j < 16; ++j) v[j] = xr[64 * j];
        if (MODE >= 1) {
            const GAS f32x4* fr = (const GAS f32x4*)(Fb + (size_t)m * D) + lane;
            f32x4 f[16]; float s = 0.f;
#pragma unroll
            for (int j = 0; j < 16; ++j) { f[j] = fr[64 * j]; s += (f[j].x * f[j].x + f[j].y * f[j].y) + (f[j].z * f[j].z + f[j].w * f[j].w); }
            const float rstd = sc / sqrtf(wave_sum(s) * (1.f / D) + EPS);
            const GAS f32x4* gr = (const GAS f32x4*)gA + lane;
            GAS f32x4* yo = (GAS f32x4*)(Y + (size_t)m * D) + lane;
#pragma unroll
            for (int j = 0; j < 16; ++j) { const f32x4 g = gr[64 * j]; v[j] = v[j] + f[j] * rstd * g; yo[64 * j] = v[j]; }
        }
        if (MODE <= 2) {
            float s = 0.f;
#pragma unroll
            for (int j = 0; j < 16; ++j) s += (v[j].x * v[j].x + v[j].y * v[j].y) + (v[j].z * v[j].z + v[j].w * v[j].w);
            const float rstd = 1.0f / sqrtf(wave_sum(s) * (1.f / D) + EPS);
            const GAS f32x4* gr = (const GAS f32x4*)gB + lane;
            GAS v2u* o8 = (GAS v2u*)(XN + (size_t)m * D) + lane;
#pragma unroll
            for (int j = 0; j < 16; ++j) { const f32x4 g = gr[64 * j]; const f32x4 o = v[j] * rstd * g; v2u w; w.x = pk2(o.x, o.y); w.y = pk2(o.z, o.w); o8[64 * j] = w; }
        }
    }
}

constexpr int L_WSL = 0, L_XCB = 17408, L_XCF = 34816, L_LA = 43264, L_LB = 51712, L_LH = 60160, L_END = 68608;
constexpr int LP = 33;
template <bool SAMPLE> __device__ __forceinline__ void lru_task(const Args& args, LAS unsigned char* lds, int tid, int wave, int lane, int chain, int head, int q) {
    unsigned char* ws = args.ws;
    const float* XA = (const float*)(ws + WS_XA); const bf16* GA = (const bf16*)(ws + WS_GA); bf16* YAB = (bf16*)(ws + WS_YAB);
    const int chb = head * 128;
    { const bf16* WG = (const bf16*)(ws + WS_WG) + (size_t)head * 256 * 128;
      for (int i = tid; i < 1024; i += 512) { const int r = i >> 4, c16 = i & 15; const int srow = (r < 32) ? (32 * q + r) : (128 + 32 * q + (r - 32));
          *(LAS v4u*)(lds + L_WSL + r * 272 + c16 * 16) = *(const GAS v4u*)(WG + (size_t)srow * 128 + c16 * 8); } }
    const int cg = tid & 31, tg = tid >> 5;
    const f32x4 cw0 = *(const f32x4*)(args.in[I_CONVW] + 0 * DLRU + chb + 4 * cg), cw1 = *(const f32x4*)(args.in[I_CONVW] + 1 * DLRU + chb + 4 * cg),
                cw2 = *(const f32x4*)(args.in[I_CONVW] + 2 * DLRU + chb + 4 * cg), cw3 = *(const f32x4*)(args.in[I_CONVW] + 3 * DLRU + chb + 4 * cg),
                cbv = *(const f32x4*)(args.in[I_CONVB] + chb + 4 * cg);
    const int tb = wave & 3, ct = wave >> 2, l15 = lane & 15, lq = lane >> 4;
    const int chg = chb + 32 * q + 16 * ct + l15;
    const float brg = args.in[I_BRG][chg], big = args.in[I_BIG][chg];
    const float lam = args.in[I_LAM][chg];
    const float sp8 = -8.0f * log1pf(expf(-lam));
    float hcar = 0.f;
    const int ntile = SAMPLE ? 1 : 32;
    for (int k = 0; k < ntile; ++k) {
        const size_t rbase = SAMPLE ? (size_t)MP + 64 * chain : (size_t)chain * TP + 64 * k;
        {
            f32x4 v[7];
#pragma unroll
            for (int i = 0; i < 7; ++i) {
                if (SAMPLE) { const int ts = 4 * (tg & 1) - 3 + i, sl = tg >> 1;
                    v[i] = (ts >= 0) ? *(const GAS f32x4*)(XA + (rbase + 8 * sl + ts) * DLRU + chb + 4 * cg)
                                     : *(const GAS f32x4*)(args.in[I_SCONV] + ((size_t)(8 * chain + sl) * 3 + (3 + ts)) * DLRU + chb + 4 * cg);
                } else { const int tt = 4 * tg - 3 + i;
                    v[i] = (k > 0 || tt >= 0) ? *(const GAS f32x4*)(XA + (rbase + tt) * DLRU + chb + 4 * cg) : (f32x4){0.f, 0.f, 0.f, 0.f}; }
            }
#pragma unroll
            for (int o = 0; o < 4; ++o) { const f32x4 xc = cbv + cw0 * v[o] + cw1 * v[o + 1] + cw2 * v[o + 2] + cw3 * v[o + 3];
                v2u w; w.x = pk2(xc.x, xc.y); w.y = pk2(xc.z, xc.w);
                *(LAS v2u*)(lds + L_XCB + (4 * tg + o) * 272 + cg * 8) = w;
                if ((cg >> 3) == q) { LAS float* xf = (LAS float*)(lds + L_XCF) + (4 * tg + o) * LP + 4 * (cg & 7); xf[0] = xc.x; xf[1] = xc.y; xf[2] = xc.z; xf[3] = xc.w; } }
        }
        __syncthreads();
        pg8::f32x4 accr = {0.f, 0.f, 0.f, 0.f}, acci = {0.f, 0.f, 0.f, 0.f};
#pragma unroll
        for (int kk = 0; kk < 4; ++kk) {
            const bf16x8 a = *(const LAS bf16x8*)(lds + L_XCB + (16 * tb + l15) * 272 + kk * 64 + lq * 16);
            const bf16x8 br = *(const LAS bf16x8*)(lds + L_WSL + (16 * ct + l15) * 272 + kk * 64 + lq * 16);
            const bf16x8 bi = *(const LAS bf16x8*)(lds + L_WSL + (32 + 16 * ct + l15) * 272 + kk * 64 + lq * 16);
            accr = __builtin_amdgcn_mfma_f32_16x16x32_bf16(a, br, accr, 0, 0, 0);
            acci = __builtin_amdgcn_mfma_f32_16x16x32_bf16(a, bi, acci, 0, 0, 0);
        }
#pragma unroll
        for (int r = 0; r < 4; ++r) { const int tt = 16 * tb + 4 * lq + r, cl = 16 * ct + l15;
            const float rg = fast_sigmoid(accr[r] + brg), ig = fast_sigmoid(acci[r] + big);
            const float la = sp8 * rg;
            const float a = __builtin_amdgcn_exp2f(la * 1.4426950408889634f);
            const float x2 = 2.0f * la;
            const float em = (x2 > -0.25f) ? -x2 * (1.0f + x2 * (0.5f + x2 * (1.0f / 6 + x2 * (1.0f / 24 + x2 * (1.0f / 120 + x2 * (1.0f / 720))))))
                                           : 1.0f - __builtin_amdgcn_exp2f(x2 * 1.4426950408889634f);
            const float xcv = ((const LAS float*)(lds + L_XCF))[tt * LP + cl];
            ((LAS float*)(lds + L_LA))[tt * LP + cl] = a;
            ((LAS float*)(lds + L_LB))[tt * LP + cl] = sqrtf(em) * ig * xcv; }
        __syncthreads();
        if (tid < 32) {
            const LAS float* la = (const LAS float*)(lds + L_LA) + tid; const LAS float* lb = (const LAS float*)(lds + L_LB) + tid; LAS float* lh = (LAS float*)(lds + L_LH) + tid;
            const int ch = chb + 32 * q + tid;
#pragma unroll 8
            for (int tt = 0; tt < 64; ++tt) {
                if (SAMPLE && (tt & 7) == 0) hcar = args.in[I_SLRU][(size_t)(8 * chain + (tt >> 3)) * DLRU + ch];
                hcar = la[tt * LP] * hcar + lb[tt * LP]; lh[tt * LP] = hcar;
                if (SAMPLE && (tt & 7) == 7) args.out[O_SLRU + (size_t)(8 * chain + (tt >> 3)) * DLRU + ch] = hcar;
            }
            if (!SAMPLE && k == ntile - 1) args.out[O_PLRU + (size_t)chain * DLRU + ch] = hcar;
        }
        __syncthreads();
        { const int t = tid >> 3, c4 = (tid & 7) * 4; const LAS float* lh = (const LAS float*)(lds + L_LH) + t * LP + c4;
          const v2u gw = *(const GAS v2u*)(GA + (rbase + t) * DLRU + chb + 32 * q + c4);
          v2u o; o.x = pk2(lh[0] * bf_lo(gw.x), lh[1] * bf_hi(gw.x)); o.y = pk2(lh[2] * bf_lo(gw.y), lh[3] * bf_hi(gw.y));
          *(GAS v2u*)(YAB + (rbase + t) * D + chb + 32 * q + c4) = o; }
    }
    __syncthreads();
}

constexpr int S5_WAVE_LDS = 12800, S5_BU = 0, S5_HS = 8448;
template <bool SAMPLE> __device__ __forceinline__ void s5_task(const Args& args, LAS unsigned char* wl, int lane, int chain, int g) {
    unsigned char* ws = args.ws;
    const bf16* XB = (const bf16*)(ws + WS_XB); bf16* G2 = (bf16*)(ws + WS_G2);
    const int l15 = lane & 15, lq = lane >> 4;
    const f32x2 ab = *(const GAS f32x2*)((const float*)(ws + WS_ABAR) + 2 * (g * SP + lane));
    bf16x8 bfrag[8], cfrag[4];
#pragma unroll
    for (int j = 0; j < 8; ++j) { bfrag[j] = (bf16x8){0, 0, 0, 0, 0, 0, 0, 0}; if (lane < 32) bfrag[j] = *(const GAS bf16x8*)((const bf16*)(ws + WS_BB) + ((size_t)(g * 8 + j) * 64 + lane) * 8); }
#pragma unroll
    for (int kk = 0; kk < 4; ++kk) cfrag[kk] = *(const GAS bf16x8*)((const bf16*)(ws + WS_CC) + ((size_t)(g * 4 + kk) * 64 + lane) * 8);
    const f32x4 dsk = *(const GAS f32x4*)(args.in[I_DSK] + g * SCG + 4 * lq);
    float hr = 0.f, hi = 0.f;
    const int ntile = SAMPLE ? 1 : 32;
    for (int k = 0; k < ntile; ++k) {
        const size_t rbase = SAMPLE ? (size_t)MP + 64 * chain : (size_t)chain * TP + 64 * k;
#pragma unroll 1
        for (int tb = 0; tb < 4; ++tb) {
            const size_t row0 = rbase + 16 * tb;
            bf16x8 a = (bf16x8){0, 0, 0, 0, 0, 0, 0, 0};
            if (lane < 32) a = *(const GAS bf16x8*)(XB + (row0 + l15) * DSSM + g * SCG + 8 * lq);
#pragma unroll
            for (int j = 0; j < 8; ++j) { const pg8::f32x4 c = __builtin_amdgcn_mfma_f32_16x16x32_bf16(a, bfrag[j], (pg8::f32x4){0.f, 0.f, 0.f, 0.f}, 0, 0, 0);
#pragma unroll
                for (int r = 0; r < 4; ++r) ((LAS float*)(wl + S5_BU))[(4 * lq + r) * 132 + 16 * j + l15] = c[r]; }
            LDS_WAIT();
            f32x2 bu[16];
#pragma unroll
            for (int t = 0; t < 16; ++t) bu[t] = *(const LAS f32x2*)(wl + S5_BU + (t * 132 + 2 * lane) * 4);
#pragma unroll
            for (int t = 0; t < 16; ++t) {
                if (SAMPLE && (t & 7) == 0) { const size_t si = ((size_t)(8 * chain + 2 * tb + (t >> 3)) * NGRP + g) * SP + lane; hr = args.in[I_SRE][si]; hi = args.in[I_SIM][si]; }
                const float nr = ab.x * hr - ab.y * hi + bu[t].x, ni = ab.x * hi + ab.y * hr + bu[t].y; hr = nr; hi = ni;
                *(LAS unsigned*)(wl + S5_HS + t * 272 + 4 * lane) = pk2(hr, hi);
                if (SAMPLE && (t & 7) == 7) { const size_t si = ((size_t)(8 * chain + 2 * tb + (t >> 3)) * NGRP + g) * SP + lane; args.out[O_SRE + si] = hr; args.out[O_SIM + si] = hi; }
            }
            LDS_WAIT();
            pg8::f32x4 y = {0.f, 0.f, 0.f, 0.f};
#pragma unroll
            for (int kk = 0; kk < 4; ++kk) { const bf16x8 hb = *(const LAS bf16x8*)(wl + S5_HS + l15 * 272 + kk * 64 + lq * 16);
                y = __builtin_amdgcn_mfma_f32_16x16x32_bf16(cfrag[kk], hb, y, 0, 0, 0); }
            LDS_WAIT();
            const v2u uw = *(const GAS v2u*)(XB + (row0 + l15) * DSSM + g * SCG + 4 * lq);
            const float y0 = y[0] + dsk.x * bf_lo(uw.x), y1 = y[1] + dsk.y * bf_hi(uw.x), y2 = y[2] + dsk.z * bf_lo(uw.y), y3 = y[3] + dsk.w * bf_hi(uw.y);
            v2u o; o.x = pk2(gelu_tanh_f(y0), gelu_tanh_f(y1)); o.y = pk2(gelu_tanh_f(y2), gelu_tanh_f(y3));
            *(GAS v2u*)(G2 + (row0 + l15) * DSSM + g * SCG + 4 * lq) = o;
        }
    }
    if (!SAMPLE) { const size_t si = ((size_t)chain * NGRP + g) * SP + lane; args.out[O_PRE + si] = hr; args.out[O_PIM + si] = hi; }
}

__device__ __forceinline__ void p5_mixer(const Args& args, LAS unsigned char* lds, int tid, int wave, int lane, int bx, int G) {
    { const float* XA = (const float*)(args.ws + WS_XA);
      const int nv = (NP + NS) * 3 * (DLRU / 4);
      for (int i = bx * 512 + tid; i < nv; i += G * 512) { const int c4 = i % (DLRU / 4), rj = i / (DLRU / 4), s = rj / 3, j = rj % 3;
          if (s < NP) *(GAS f32x4*)(args.out + O_PCONV + ((size_t)s * 3 + j) * DLRU + 4 * c4) = *(const GAS f32x4*)(XA + ((size_t)s * TP + TP - 3 + j) * DLRU + 4 * c4);
          else { const int ss = s - NP; *(GAS f32x4*)(args.out + O_SCONV + ((size_t)ss * 3 + j) * DLRU + 4 * c4) = *(const GAS f32x4*)(XA + ((size_t)MP + 8 * ss + 5 + j) * DLRU + 4 * c4); } } }
#if !defined(SKIP_LRU)
    for (int t = bx; t < NP * 64; t += G) lru_task<false>(args, lds, tid, wave, lane, t >> 6, (t >> 2) & 15, t & 3);
    for (int t = bx; t < 16 * 64; t += G) lru_task<true>(args, lds, tid, wave, lane, t >> 6, (t >> 2) & 15, t & 3);
#endif
#if defined(S5_PROBE)
    { const bf16* CCp = (const bf16*)(args.ws + WS_CC); const bf16* BBp = (const bf16*)(args.ws + WS_BB); const float* ABp = (const float*)(args.ws + WS_ABAR); const bf16* XBp = (const bf16*)(args.ws + WS_XB);
      for (int i = bx * 512 + tid; i < 32768; i += G * 512) { float s = 0.f, s2 = 0.f;
          for (int e = 0; e < 8; ++e) { s += __uint_as_float((unsigned)CCp[(size_t)i * 8 + e] << 16); s2 += __uint_as_float((unsigned)BBp[((size_t)(i >> 5) * 64 + (i & 31)) * 8 + e] << 16); }
          args.out[O_PRE + i] = s; args.out[O_PIM + i] = s2; if (i < 16384) args.out[O_SRE + i] = ABp[i]; }
      for (int i = bx * 512 + tid; i < 1048576; i += G * 512) { float s = 0.f; for (int e = 0; e < 18; ++e) s += __uint_as_float((unsigned)XBp[(size_t)i * 18 + e] << 16); args.out[O_SIM + i] = s; } }
#endif
#if !defined(SKIP_S5)
    LAS unsigned char* wl = lds + wave * S5_WAVE_LDS;
    const int gw = bx * NWAVES + wave, ngw = G * NWAVES;
    if (ngw >= 1024) {
        if (gw < NP * NGRP) s5_task<false>(args, wl, lane, gw >> 7, gw & 127);
        else for (int t = gw - NP * NGRP; t < 16 * NGRP; t += ngw - NP * NGRP) s5_task<true>(args, wl, lane, t >> 7, t & 127);
    } else {
        for (int t = gw; t < NP * NGRP; t += ngw) s5_task<false>(args, wl, lane, t >> 7, t & 127);
        for (int t = gw; t < 16 * NGRP; t += ngw) s5_task<true>(args, wl, lane, t >> 7, t & 127);
    }
#endif
    __syncthreads();
}

__global__ void __launch_bounds__(NWAVES * 64, 2) hawk_fwd(Args args) {
    extern __shared__ __attribute__((aligned(16))) unsigned char lds_raw[];
    LAS unsigned char* lds = (LAS unsigned char*)lds_raw;
    volatile LAS unsigned* MISC = (volatile LAS unsigned*)(lds + MISC_OFF);
    const int tid = threadIdx.x, lane = tid & 63, wave = __builtin_amdgcn_readfirstlane(tid >> 6);
    const int G = gridDim.x, bx = blockIdx.x;
    const int gw = bx * NWAVES + wave, ngw = G * NWAVES;
    unsigned char* ws = args.ws;
    gu32* ctl = (gu32*)(ws + WS_CTL);
    for (int u = tid; u < (LDS_BYTES - LDSCTL_OFF) / 4; u += NWAVES * 64) ((LAS unsigned*)(lds + LDSCTL_OFF))[u] = 0u;
#if defined(XCHK) && XCHK
    for (int u = tid; u < RING_BYTES / 4; u += NWAVES * 64) ((LAS unsigned*)lds)[u] = 0xFFFFFFFFu;
#endif
    __syncthreads();
    XcdBarrier bar = xcd_barrier_post((unsigned*)(ctl + CW_BAR) + args.li * XCD_BAR_WORDS, MISC + 8);
    const int lo = args.ph_lo, hi = args.ph_hi;
#ifndef PHMASK
#define PHMASK 0x1fff
#endif
#define IN(k) ((((PHMASK) >> (k)) & 1) && lo <= (k) && (k) < hi)
#define BOTH(k) (IN(k) && IN((k) + 1))
#define SEAM(k) do { if (BOTH(k)) xcd_barrier(bar); } while (0)
    bf16* XN = (bf16*)(ws + WS_XN); bf16* HID = (bf16*)(ws + WS_HID); float* Fb = (float*)(ws + WS_F); bf16* YAB = (bf16*)(ws + WS_YAB);

#if defined(XCHK) && XCHK
    if (lo == 0) {
        GAS v4u* w4 = (GAS v4u*)(ws + 2 * MiB); const size_t n4 = (WS_END - 2 * MiB) / 16; const v4u q = {0xFFFFFFFFu, 0xFFFFFFFFu, 0xFFFFFFFFu, 0xFFFFFFFFu};
        for (size_t i = (size_t)bx * 512 + tid; i < n4; i += (size_t)G * 512) w4[i] = q;
        GAS v4u* o4 = (GAS v4u*)args.out; const size_t m4 = O_END / 4;
        for (size_t i = (size_t)bx * 512 + tid; i < m4; i += (size_t)G * 512) o4[i] = q;
        if (hi > 1) xcd_barrier(bar);
    }
#endif
    if (IN(0)) { p0_prologue(args, lds, wave, lane, gw, ngw); SEAM(0); }
    if (IN(1)) { pg8::Gemm g{XN, (const bf16*)(ws + WS_WGU1), M, 2 * DFF, D, D}; pg8::StaticOrder S; S.init(M, 2 * DFF, G, bx);
        pg8::EpiSwiglu E{HID, DFF};
        pg8::gemm_phase<pg8::EpiSwiglu, pg8::StaticOrder, PG8_ALIGN, PG8_SP2>(lds + RING_OFF, g, S, E); SEAM(1); }
    if (IN(2)) { pg8::Gemm g{HID, (const bf16*)(ws + WS_WD1), M, D, DFF, DFF}; pg8::StaticOrder S; S.init(M, D, G, bx);
        pg8::EpiF32 E{Fb, D};
        pg8::gemm_phase<pg8::EpiF32, pg8::StaticOrder, PG8_ALIGN, PG8_SP2>(lds + RING_OFF, g, S, E); SEAM(2); }
    if (IN(3)) { thin_rows<1>(args, gw, ngw, lane); SEAM(3); }
    if (IN(4)) { pg8::Gemm g{XN, (const bf16*)(ws + WS_WIN), M, DIN, D, D}; pg8::StaticOrder S; S.init(M, DIN, G, bx);
        pg8::EpiWin E{(float*)(ws + WS_XA), (bf16*)(ws + WS_GA), (bf16*)(ws + WS_XB), (bf16*)(ws + WS_G)};
        pg8::gemm_phase<pg8::EpiWin, pg8::StaticOrder, PG8_ALIGN, PG8_SP2>(lds + RING_OFF, g, S, E); SEAM(4); }
    if (IN(5)) { p5_mixer(args, lds, tid, wave, lane, bx, G); SEAM(5); }
    if (IN(6)) { pg8::Gemm g{(const bf16*)(ws + WS_G2), (const bf16*)(ws + WS_WGLU), M, DSSM, DSSM, DSSM}; pg8::StaticOrder S; S.init(M, DSSM, G, bx);
        pg8::EpiGlu E{(const bf16*)(ws + WS_G2), args.in[I_BGLU], YAB + DLRU};
        pg8::gemm_phase<pg8::EpiGlu, pg8::StaticOrder, PG8_ALIGN, PG8_SP2>(lds + RING_OFF, g, S, E); SEAM(6); }
    if (IN(7)) { pg8::Gemm g{YAB, (const bf16*)(ws + WS_WOUT), M, D, DLRU, D}; pg8::SegOrder S; S.init(M, D, G, bx);
        pg8::EpiOut E{(const bf16*)(ws + WS_G), XN};
        pg8::gemm_phase<pg8::EpiOut, pg8::SegOrder, PG8_ALIGN, PG8_SP2>(lds + RING_OFF, g, S, E); SEAM(7); }
    if (IN(8)) { pg8::Gemm g{XN, (const bf16*)(ws + WS_WO), M, D, D, D}; pg8::StaticOrder S; S.init(M, D, G, bx);
        pg8::EpiF32 E{Fb, D};
        pg8::gemm_phase<pg8::EpiF32, pg8::StaticOrder, PG8_ALIGN, PG8_SP2>(lds + RING_OFF, g, S, E); SEAM(8); }
    if (IN(9)) { thin_rows<2>(args, gw, ngw, lane); SEAM(9); }
    if (IN(10)) { pg8::Gemm g{XN, (const bf16*)(ws + WS_WGU2), M, 2 * DFF, D, D}; pg8::StaticOrder S; S.init(M, 2 * DFF, G, bx);
        pg8::EpiSwiglu E{HID, DFF};
        pg8::gemm_phase<pg8::EpiSwiglu, pg8::StaticOrder, PG8_ALIGN, PG8_SP2>(lds + RING_OFF, g, S, E); SEAM(10); }
    if (IN(11)) { pg8::Gemm g{HID, (const bf16*)(ws + WS_WD2), M, D, DFF, DFF}; pg8::StaticOrder S; S.init(M, D, G, bx);
        pg8::EpiF32 E{Fb, D};
        pg8::gemm_phase<pg8::EpiF32, pg8::StaticOrder, PG8_ALIGN, PG8_SP2>(lds + RING_OFF, g, S, E); SEAM(11); }
    if (IN(12)) { thin_rows<3>(args, gw, ngw, lane); }
#undef IN
#undef BOTH
#undef SEAM
}

extern "C" void kernel_launch(void* const* d_in, const int* in_sizes, int n_in, void* d_out, int out_size, void* d_ws, size_t ws_size, hipStream_t stream) {
    static int grid = 0;
    if (grid == 0) {
        if (n_in != 39 || in_sizes[0] != MP * D || out_size != (int)O_END || ws_size < WS_END) { fprintf(stderr, "kernel_launch: unexpected shapes (n_in %d, in0 %d, out %d, ws %zu); nothing launched\n", n_in, n_in > 0 ? in_sizes[0] : -1, out_size, ws_size); grid = -1; return; }
        int dev = 0, cus = 0, per_cu = 0;
        if (hipGetDevice(&dev) != hipSuccess || hipDeviceGetAttribute(&cus, hipDeviceAttributeMultiprocessorCount, dev) != hipSuccess) { grid = -1; return; }
        if (hipFuncSetAttribute((const void*)hawk_fwd, hipFuncAttributeMaxDynamicSharedMemorySize, LDS_BYTES) != hipSuccess) { fprintf(stderr, "kernel_launch: hipFuncSetAttribute failed\n"); grid = -1; return; }
        if (hipOccupancyMaxActiveBlocksPerMultiprocessor(&per_cu, (const void*)hawk_fwd, NWAVES * 64, LDS_BYTES) != hipSuccess || per_cu < 1)
            fprintf(stderr, "kernel_launch: note: occupancy query reports %d workgroups per CU\n", per_cu);
        (void)hipGetLastError();
        grid = cus;
    }
    if (grid < 0) return;
    if (hipMemsetAsync((char*)d_ws + WS_CTL, 0, CTL_ZERO_BYTES, stream) != hipSuccess) return;
    Args a{};
    for (int i = 0; i < 39; ++i) a.in[i] = (const float*)d_in[i];
    a.out = (float*)d_out; a.ws = (unsigned char*)d_ws;
    static_assert(N_LAUNCHES == 1 || N_LAUNCHES == N_PHASES, "MK_N_LAUNCHES: 1 or one launch per phase");
    for (int li = 0; li < N_LAUNCHES; ++li) {
        a.ph_lo = (N_LAUNCHES == 1) ? 0 : li; a.ph_hi = (N_LAUNCHES == 1) ? N_PHASES : li + 1; a.li = li; a.pad = 0;
        hipLaunchKernelGGL(hawk_fwd, dim3(grid), dim3(NWAVES * 64), LDS_BYTES, stream, a);
        const hipError_t le = hipPeekAtLastError();
        if (le != hipSuccess) { fprintf(stderr, "kernel_launch: launch %d failed: %s\n", li, hipGetErrorName(le)); break; }
    }
}
```

```cpp
#include <hip/hip_runtime.h>
#include <cstdio>
#include <cstdint>
namespace pg8 {
#define PG8_LAS __attribute__((address_space(3)))
typedef unsigned short bf16_t;
typedef short bf16x8 __attribute__((ext_vector_type(8)));
typedef float f32x4 __attribute__((ext_vector_type(4)));
typedef unsigned u32x4 __attribute__((ext_vector_type(4)));
constexpr int BM = 256, BK = 64, HALF = 128, HTB = HALF * BK * 2  , STAGE_BYTES = 8 * HTB, NXCD = 8, WGM = 8;

__host__ __device__ __forceinline__ int lds_byte(int r, int c) { const int st = (r >> 4) * 2 + (c >> 5), rr = r & 15, cc = c & 31, ob = rr * 64 + cc * 2; return st * 1024 + (ob ^ (((ob >> 9) & 1) << 5)); }
__host__ __device__ __forceinline__ void stage_rc(int b, int& R, int& C) { const int st = b / 1024, sb = b % 1024, swz = sb ^ (((sb >> 9) & 1) << 5); R = (st >> 1) * 16 + swz / 64; C = (st & 1) * 32 + (swz % 64) / 2; }
__host__ __device__ __forceinline__ int perm32(int rho) { const int n = rho >> 4, i = rho & 15; return 8 * (i >> 2) + 4 * n + (i & 3); }

struct Unit { int pm, pn, seg, k0, nt, slab; };
struct Gemm { const bf16_t* A; const bf16_t* Bt; int M, N, K, ld; };

struct StaticOrder {
    int nM, nN, nwg, G, c, ntk;
    __host__ __device__ __forceinline__ void init(int M, int N, int K, int G_, int c_) { nM = M / BM; nN = N / BM; nwg = nM * nN; G = G_; c = c_; ntk = K / BK; }
    __host__ __device__ __forceinline__ bool next(int i, Unit& u) const {
        const long L = (long)i * G + c; if (L >= nwg) return false;
        int wgid = (int)L; { const int q = nwg / NXCD, r = nwg % NXCD, xcd = wgid % NXCD, off = wgid / NXCD; wgid = (xcd < r ? xcd * (q + 1) : r * (q + 1) + (xcd - r) * q) + off; }
        const int nig = WGM * nN, gid = wgid / nig, fm = gid * WGM, gsz = (nM - fm) < WGM ? (nM - fm) : WGM;
        u.pm = fm + ((wgid % nig) % gsz); u.pn = (wgid % nig) / gsz; u.seg = 0; u.k0 = 0; u.nt = ntk; u.slab = 0; return true;
    }
    __device__ __forceinline__ void a_ready(const Unit&) const {}
    __device__ __forceinline__ void done(const Unit&) const {}
};
struct SegOrder : StaticOrder {
    __host__ __device__ __forceinline__ bool next(int i, Unit& u) const { const bool ok = StaticOrder::next(i >> 1, u); u.seg = i & 1; u.nt = ntk >> 1; u.k0 = (i & 1) * (ntk >> 1); return ok; }
};
struct TailOrder {
    StaticOrder base; int c, ntk;
    __host__ __device__ __forceinline__ void init(int N, int K, int G_, int c_) { base.init(32 * BM, N, K, G_, c_); c = c_; ntk = K / BK; }
    __host__ __device__ __forceinline__ bool next(int i, Unit& u) const {
        const bool full = i < 2; Unit b; const bool okb = base.next(full ? i : 0, b);
        const int x = c & 7, j = c >> 3, q = j & 3;
        const int qa = ((ntk >> 2) + 1) & ~1, qb = (ntk - 2 * qa) >> 1;
        u.pm = full ? b.pm : 32 + (x >> 1); u.pn = full ? b.pn : 8 * (x & 1) + (j >> 2); u.seg = 0; u.slab = full ? 0 : q;
        u.k0 = full ? 0 : (q < 2 ? q * qa : 2 * qa + (q - 2) * qb); u.nt = full ? ntk : (q < 2 ? qa : qb);
        return full ? okb : (i == 2 && base.G == 256 && base.nN == 16);
    }
    __device__ __forceinline__ void a_ready(const Unit&) const {}
    __device__ __forceinline__ void done(const Unit&) const {}
};

typedef float cvt_f32x2_t __attribute__((ext_vector_type(2)));
typedef __bf16 cvt_bf16x2_t __attribute__((ext_vector_type(2)));
__device__ __forceinline__ unsigned cvt_pk_bf16(float lo, float hi) { const cvt_f32x2_t v = {lo, hi}; const cvt_bf16x2_t b = __builtin_convertvector(v, cvt_bf16x2_t); return __builtin_bit_cast(unsigned, b); }
typedef float f32x2 __attribute__((ext_vector_type(2)));
__device__ __forceinline__ f32x2 gelu_pk(f32x2 v) {
    const f32x2 av = __builtin_elementwise_abs(v), d = av * 0.2316418882f + 1.0f;
    f32x2 t; t.x = __builtin_amdgcn_rcpf(d.x); t.y = __builtin_amdgcn_rcpf(d.y);
    f32x2 q = t * 0.5307027145f + (-0.7265760135f); q = q * t + 0.7107068705f; q = q * t + (-0.142248368f); q = q * t + 0.127414796f; q = q * t;
    const f32x2 s = (v * v) * (-0.72134752044f);
    f32x2 e; e.x = __builtin_amdgcn_exp2f(s.x); e.y = __builtin_amdgcn_exp2f(s.y);
    const f32x2 m = v * (q * e), r = v - m;
    f32x2 o; o.x = v.x < 0.f ? m.x : r.x; o.y = v.y < 0.f ? m.y : r.y; return o;
}


__device__ __forceinline__ float bf_lo(unsigned w) { return __uint_as_float(w << 16); }
__device__ __forceinline__ float bf_hi(unsigned w) { return __uint_as_float(w & 0xffff0000u); }
__device__ __forceinline__ float fast_sigmoid(float x) { return __builtin_amdgcn_rcpf(1.0f + __builtin_amdgcn_exp2f(-1.4426950408889634f * x)); }
__device__ __forceinline__ float silu_f(float x) { return x * fast_sigmoid(x); }
__device__ __forceinline__ float gelu_tanh_f(float x) { const float z = 1.5957691216057308f * (x + 0.044715f * x * x * x); return x * fast_sigmoid(z); }
__device__ __forceinline__ u32x4 pack8(const f32x4& v0, const f32x4& v1) { u32x4 w; w.x = cvt_pk_bf16(v0[0], v0[1]); w.y = cvt_pk_bf16(v0[2], v0[3]); w.z = cvt_pk_bf16(v1[0], v1[1]); w.w = cvt_pk_bf16(v1[2], v1[3]); return w; }

struct EpiSwiglu {
    static constexpr bool PERM = true, AFTER_DRAIN = false, SEG = false;
    bf16_t* O; int ldc;
    __device__ __forceinline__ void operator()(f32x4 (&acc)[2][2][4][2], const Unit& u, int wr, int wc, int fr, int fq) const {
        const int row0 = u.pm * BM + wr * 64 + fr, col0 = u.pn * HALF + wc * 32 + 8 * fq;
#pragma unroll
        for (int ai = 0; ai < 2; ++ai)
#pragma unroll
            for (int m = 0; m < 4; ++m) { bf16_t* rowp = O + (size_t)(row0 + ai * HALF + m * 16) * ldc + col0;
                f32x4 v0, v1;
#pragma unroll
                for (int j = 0; j < 4; ++j) { v0[j] = silu_f(acc[ai][0][m][0][j]) * acc[ai][1][m][0][j]; v1[j] = silu_f(acc[ai][0][m][1][j]) * acc[ai][1][m][1][j]; }
                *(u32x4*)rowp = pack8(v0, v1); }
    }
};
struct EpiF32 {
    static constexpr bool PERM = true, AFTER_DRAIN = false, SEG = false;
    float* C; int ldc; float* S; size_t slab_stride; int slab_row0;
    __device__ __forceinline__ void operator()(f32x4 (&acc)[2][2][4][2], const Unit& u, int wr, int wc, int fr, int fq) const {
        const int row0 = u.pm * BM + wr * 64 + fr, col0 = u.pn * BM + wc * 32 + 8 * fq;
        float* base = u.slab == 0 ? C : S + (size_t)(u.slab - 1) * slab_stride - (size_t)slab_row0 * ldc;
#pragma unroll
        for (int ai = 0; ai < 2; ++ai)
#pragma unroll
            for (int m = 0; m < 4; ++m) { float* rowp = base + (size_t)(row0 + ai * HALF + m * 16) * ldc + col0;
#pragma unroll
                for (int bj = 0; bj < 2; ++bj)
#pragma unroll
                    for (int n = 0; n < 2; ++n) *(f32x4*)(rowp + bj * HALF + n * 4) = acc[ai][bj][m][n]; }
    }
};
struct EpiWin {
    static constexpr bool PERM = true, AFTER_DRAIN = false, SEG = false;
    float* XA; bf16_t* GA; bf16_t* XB; bf16_t* G;
    __device__ __forceinline__ void operator()(f32x4 (&acc)[2][2][4][2], const Unit& u, int wr, int wc, int fr, int fq) const {
        const int row0 = u.pm * BM + wr * 64 + fr, cw = wc * 32 + 8 * fq;
        if (u.pn < 8) {
            const int col0 = u.pn * BM + cw;
#pragma unroll
            for (int ai = 0; ai < 2; ++ai)
#pragma unroll
                for (int m = 0; m < 4; ++m) { float* rowp = XA + (size_t)(row0 + ai * HALF + m * 16) * 2048 + col0;
#pragma unroll
                    for (int bj = 0; bj < 2; ++bj)
#pragma unroll
                        for (int n = 0; n < 2; ++n) *(f32x4*)(rowp + bj * HALF + n * 4) = acc[ai][bj][m][n]; }
        } else if (u.pn < 16) {
            const int col0 = (u.pn - 8) * BM + cw;
#pragma unroll
            for (int ai = 0; ai < 2; ++ai)
#pragma unroll
                for (int m = 0; m < 4; ++m) { bf16_t* rowp = GA + (size_t)(row0 + ai * HALF + m * 16) * 2048 + col0;
#pragma unroll
                    for (int bj = 0; bj < 2; ++bj) { f32x4 v0, v1;
#pragma unroll
                        for (int j = 0; j < 4; ++j) { v0[j] = gelu_tanh_f(acc[ai][bj][m][0][j]); v1[j] = gelu_tanh_f(acc[ai][bj][m][1][j]); }
                        *(u32x4*)(rowp + bj * HALF) = pack8(v0, v1); } }
        } else if (u.pn < 24) {
            const int col0 = (u.pn - 16) * BM + cw;
#pragma unroll
            for (int ai = 0; ai < 2; ++ai)
#pragma unroll
                for (int m = 0; m < 4; ++m) { bf16_t* rowp = XB + (size_t)(row0 + ai * HALF + m * 16) * 2048 + col0;
#pragma unroll
                    for (int bj = 0; bj < 2; ++bj) *(u32x4*)(rowp + bj * HALF) = pack8(acc[ai][bj][m][0], acc[ai][bj][m][1]); }
        } else {
            const int col0 = (u.pn - 24) * BM + cw;
#pragma unroll
            for (int ai = 0; ai < 2; ++ai)
#pragma unroll
                for (int m = 0; m < 4; ++m) { bf16_t* rowp = G + (size_t)(row0 + ai * HALF + m * 16) * 8192 + col0;
#pragma unroll
                    for (int bj = 0; bj < 2; ++bj) { f32x4 v0, v1;
#pragma unroll
                        for (int j = 0; j < 4; ++j) { v0[j] = fast_sigmoid(acc[ai][bj][m][0][j]); v1[j] = fast_sigmoid(acc[ai][bj][m][1][j]); }
                        *(u32x4*)(rowp + bj * HALF) = pack8(v0, v1); } }
        }
    }
};
struct EpiGlu {
    static constexpr bool PERM = true, AFTER_DRAIN = false, SEG = false;
    const bf16_t* G2; const float* bias; bf16_t* O;
    __device__ __forceinline__ void operator()(f32x4 (&acc)[2][2][4][2], const Unit& u, int wr, int wc, int fr, int fq) const {
        const int row0 = u.pm * BM + wr * 64 + fr, col0 = u.pn * BM + wc * 32 + 8 * fq;
        f32x4 bv[2][2];
#pragma unroll
        for (int bj = 0; bj < 2; ++bj)
#pragma unroll
            for (int n = 0; n < 2; ++n) bv[bj][n] = *(const f32x4*)(bias + col0 + bj * HALF + 4 * n);
#pragma unroll
        for (int ai = 0; ai < 2; ++ai)
#pragma unroll
            for (int m = 0; m < 4; ++m) { const size_t r = (size_t)(row0 + ai * HALF + m * 16);
#pragma unroll
                for (int bj = 0; bj < 2; ++bj) { const u32x4 gw = *(const u32x4*)(G2 + r * 2048 + col0 + bj * HALF);
                    const f32x4 a0 = acc[ai][bj][m][0] + bv[bj][0], a1 = acc[ai][bj][m][1] + bv[bj][1]; f32x4 v0, v1;
                    v0[0] = bf_lo(gw.x) * fast_sigmoid(a0[0]); v0[1] = bf_hi(gw.x) * fast_sigmoid(a0[1]); v0[2] = bf_lo(gw.y) * fast_sigmoid(a0[2]); v0[3] = bf_hi(gw.y) * fast_sigmoid(a0[3]);
                    v1[0] = bf_lo(gw.z) * fast_sigmoid(a1[0]); v1[1] = bf_hi(gw.z) * fast_sigmoid(a1[1]); v1[2] = bf_lo(gw.w) * fast_sigmoid(a1[2]); v1[3] = bf_hi(gw.w) * fast_sigmoid(a1[3]);
                    *(u32x4*)(O + r * 4096 + col0 + bj * HALF) = pack8(v0, v1); } }
    }
};
struct EpiOut {
    static constexpr bool PERM = true, AFTER_DRAIN = false, SEG = true;
    const bf16_t* G; bf16_t* O;
    __device__ __forceinline__ void seg0(f32x4 (&acc)[2][2][4][2], const Unit& u, int wr, int wc, int fr, int fq) const {
        const int row0 = u.pm * BM + wr * 64 + fr, col0 = u.pn * BM + wc * 32 + 8 * fq;
#pragma unroll
        for (int ai = 0; ai < 2; ++ai)
#pragma unroll
            for (int m = 0; m < 4; ++m) { const bf16_t* gp = G + (size_t)(row0 + ai * HALF + m * 16) * 8192 + col0;
#pragma unroll
                for (int bj = 0; bj < 2; ++bj) { const u32x4 a = *(const u32x4*)(gp + bj * HALF), b = *(const u32x4*)(gp + 4096 + bj * HALF);
                    f32x4 r0, r1;
                    r0[0] = bf_lo(a.x) * __builtin_amdgcn_rcpf(fmaxf(bf_lo(b.x), 1e-30f)); r0[1] = bf_hi(a.x) * __builtin_amdgcn_rcpf(fmaxf(bf_hi(b.x), 1e-30f));
                    r0[2] = bf_lo(a.y) * __builtin_amdgcn_rcpf(fmaxf(bf_lo(b.y), 1e-30f)); r0[3] = bf_hi(a.y) * __builtin_amdgcn_rcpf(fmaxf(bf_hi(b.y), 1e-30f));
                    r1[0] = bf_lo(a.z) * __builtin_amdgcn_rcpf(fmaxf(bf_lo(b.z), 1e-30f)); r1[1] = bf_hi(a.z) * __builtin_amdgcn_rcpf(fmaxf(bf_hi(b.z), 1e-30f));
                    r1[2] = bf_lo(a.w) * __builtin_amdgcn_rcpf(fmaxf(bf_lo(b.w), 1e-30f)); r1[3] = bf_hi(a.w) * __builtin_amdgcn_rcpf(fmaxf(bf_hi(b.w), 1e-30f));
                    acc[ai][bj][m][0] = acc[ai][bj][m][0] * r0; acc[ai][bj][m][1] = acc[ai][bj][m][1] * r1; }
                asm volatile("" ::: "memory"); }
    }
    __device__ __forceinline__ void operator()(f32x4 (&acc)[2][2][4][2], const Unit& u, int wr, int wc, int fr, int fq) const { if (u.seg == 0) seg0(acc, u, wr, wc, fr, fq); else seg1(acc, u, wr, wc, fr, fq); }
    __device__ __forceinline__ void seg1(const f32x4 (&acc)[2][2][4][2], const Unit& u, int wr, int wc, int fr, int fq) const {
        const int row0 = u.pm * BM + wr * 64 + fr, col0 = u.pn * BM + wc * 32 + 8 * fq;
#pragma unroll
        for (int ai = 0; ai < 2; ++ai)
#pragma unroll
            for (int m = 0; m < 4; ++m) { const size_t r = (size_t)(row0 + ai * HALF + m * 16);
#pragma unroll
                for (int bj = 0; bj < 2; ++bj) { const u32x4 b = *(const u32x4*)(G + r * 8192 + 4096 + col0 + bj * HALF);
                    f32x4 g0, g1;
                    g0[0] = fmaxf(bf_lo(b.x), 1e-30f); g0[1] = fmaxf(bf_hi(b.x), 1e-30f); g0[2] = fmaxf(bf_lo(b.y), 1e-30f); g0[3] = fmaxf(bf_hi(b.y), 1e-30f);
                    g1[0] = fmaxf(bf_lo(b.z), 1e-30f); g1[1] = fmaxf(bf_hi(b.z), 1e-30f); g1[2] = fmaxf(bf_lo(b.w), 1e-30f); g1[3] = fmaxf(bf_hi(b.w), 1e-30f);
                    *(u32x4*)(O + r * 4096 + col0 + bj * HALF) = pack8(acc[ai][bj][m][0] * g0, acc[ai][bj][m][1] * g1); } }
    }
};

template <class Epi, class Sched, bool ALIGN_EPI = false, bool SP2 = false>
__device__ __forceinline__ void gemm_phase(PG8_LAS unsigned char* lds, const Gemm g, const Sched& S, const Epi& E) {
    const int tid = threadIdx.x, wid = __builtin_amdgcn_readfirstlane(tid >> 6), lane = tid & 63, wr = wid >> 2, wc = wid & 3, fr = lane & 15, fq = lane >> 4;
    const int LD = g.ld;
    unsigned voffA[2], voffB[2];
#pragma unroll
    for (int i = 0; i < 2; ++i) { int R, C; stage_rc(tid * 16 + i * 8192, R, C); const int Rb = Epi::PERM ? ((R & ~31) + perm32(R & 31)) : R;
        voffA[i] = (unsigned)(R * LD + C) * 2u; voffB[i] = (unsigned)(Rb * LD + C) * 2u; }
    const size_t kstep = (size_t)(BK * 2);
    const size_t hstep = (size_t)HALF * LD * 2;
    const size_t tstep = 2 * hstep;
    const unsigned ldsw = (unsigned)wid * 1024u;
    const int aoff = lds_byte(wr * 64 + fr, fq * 8), boff = lds_byte(wc * 32 + fr, fq * 8);
#define PG8_SA(b, h) (((b) * 2 + (h)) * HTB)
#define PG8_SB(b, h) ((4 + (b) * 2 + (h)) * HTB)
#define PG8_STAGE(bufoff, gbase, voff) do { _Pragma("unroll") for (int _i = 0; _i < 2; ++_i) \
        __builtin_amdgcn_global_load_lds((const unsigned*)((const char*)(gbase) + (voff)[_i]), (PG8_LAS unsigned*)(lds + (bufoff) + ldsw + _i * 8192), 16, 0, 0); } while (0)
#define PG8_LDA(dst, b, h) do { _Pragma("unroll") for (int m = 0; m < 4; ++m) _Pragma("unroll") for (int k = 0; k < 2; ++k) dst[m][k] = *(const PG8_LAS bf16x8*)(lds + PG8_SA(b, h) + aoff + m * 2048 + k * 1024); } while (0)
#define PG8_LDB(dst, b, h) do { _Pragma("unroll") for (int n = 0; n < 2; ++n) _Pragma("unroll") for (int k = 0; k < 2; ++k) dst[n][k] = *(const PG8_LAS bf16x8*)(lds + PG8_SB(b, h) + boff + n * 2048 + k * 1024); } while (0)
#define PG8_MMA(ai, bj, At, Bt) do { __builtin_amdgcn_s_setprio(1); _Pragma("unroll") for (int m = 0; m < 4; ++m) _Pragma("unroll") for (int n = 0; n < 2; ++n) _Pragma("unroll") for (int k = 0; k < 2; ++k) \
        acc[ai][bj][m][n] = __builtin_amdgcn_mfma_f32_16x16x32_bf16(Bt[n][k], At[m][k], acc[ai][bj][m][n], 0, 0, 0); __builtin_amdgcn_s_setprio(0); } while (0)
#define PG8_WAIT_V(n) asm volatile("s_waitcnt vmcnt(" #n ")" ::: "memory")
#define PG8_WAIT_L(n) asm volatile("s_waitcnt lgkmcnt(" #n ")" ::: "memory")
#define PG8_BAR __builtin_amdgcn_s_barrier()
#define PG8_SCHED __builtin_amdgcn_sched_barrier(0)
    Unit cur, nxt; int ui = 0;
    if (!S.next(0, cur)) return;
    f32x4 acc[2][2][4][2];
#pragma unroll
    for (int a = 0; a < 2; ++a)
#pragma unroll
        for (int b = 0; b < 2; ++b)
#pragma unroll
            for (int m = 0; m < 4; ++m)
#pragma unroll
                for (int n = 0; n < 2; ++n) acc[a][b][m][n] = (f32x4){0.f, 0.f, 0.f, 0.f};
    bf16x8 At[4][2], B0[2][2], B1[2][2];
    const char* cA = (const char*)g.A + (size_t)cur.pm * tstep + (size_t)cur.k0 * kstep; const char* cB = (const char*)g.Bt + (size_t)cur.pn * tstep + (size_t)cur.k0 * kstep;
    S.a_ready(cur);
    if constexpr (SP2) {
        PG8_STAGE(PG8_SB(0, 0), cB, voffB); PG8_STAGE(PG8_SB(0, 1), cB + hstep, voffB); PG8_STAGE(PG8_SA(0, 0), cA, voffA); PG8_STAGE(PG8_SA(0, 1), cA + hstep, voffA);
        if (wr == 1) PG8_BAR;
        PG8_WAIT_V(2); PG8_BAR;
        PG8_STAGE(PG8_SB(1, 0), cB + kstep, voffB); PG8_STAGE(PG8_SA(1, 0), cA + kstep, voffA); PG8_STAGE(PG8_SB(1, 1), cB + hstep + kstep, voffB);
        PG8_WAIT_V(6); PG8_BAR;
    } else {
        PG8_STAGE(PG8_SB(0, 0), cB, voffB); PG8_STAGE(PG8_SA(0, 0), cA, voffA); PG8_STAGE(PG8_SB(0, 1), cB + hstep, voffB); PG8_STAGE(PG8_SA(0, 1), cA + hstep, voffA);
        if (wr == 1) PG8_BAR;
        PG8_WAIT_V(4); PG8_BAR;
        PG8_STAGE(PG8_SB(1, 0), cB + kstep, voffB); PG8_STAGE(PG8_SA(1, 0), cA + kstep, voffA); PG8_STAGE(PG8_SB(1, 1), cB + hstep + kstep, voffB);
        PG8_WAIT_V(6); PG8_BAR;
    }
    for (;;) {
        const bool has_next = S.next(ui + 1, nxt);
        const char* nA = has_next ? (const char*)g.A + (size_t)nxt.pm * tstep + (size_t)nxt.k0 * kstep : cA; const char* nB = has_next ? (const char*)g.Bt + (size_t)nxt.pn * tstep + (size_t)nxt.k0 * kstep : cB;
        const int nt = cur.nt;
        for (int t = 0; t < nt; t += 2) {
            const bool last = (t == nt - 2);
            const char* a1 = cA + (size_t)(t + 1) * kstep;
            const char* a2 = last ? nA : cA + (size_t)(t + 2) * kstep; const char* b2 = last ? nB : cB + (size_t)(t + 2) * kstep;
            const char* a3 = a2 + kstep; const char* b3 = b2 + kstep;
            if (last && has_next) S.a_ready(nxt);
            if constexpr (SP2) {
            PG8_LDB(B0, 0, 0); PG8_LDB(B1, 0, 1); PG8_SCHED; PG8_LDA(At, 0, 0); PG8_STAGE(PG8_SA(1, 1), a1 + hstep, voffA);
            PG8_WAIT_V(8); PG8_WAIT_L(0); PG8_BAR; PG8_MMA(0, 0, At, B0); PG8_MMA(0, 1, At, B1); PG8_BAR; PG8_SCHED;
            PG8_LDA(At, 0, 1); PG8_STAGE(PG8_SB(0, 0), b2, voffB); PG8_STAGE(PG8_SB(0, 1), b2 + hstep, voffB); PG8_STAGE(PG8_SA(0, 0), a2, voffA);
            PG8_WAIT_V(8); PG8_WAIT_L(0); PG8_BAR; PG8_MMA(1, 0, At, B0); PG8_MMA(1, 1, At, B1); PG8_BAR; PG8_SCHED;
            PG8_LDB(B0, 1, 0); PG8_LDB(B1, 1, 1); PG8_SCHED; PG8_LDA(At, 1, 0); PG8_STAGE(PG8_SA(0, 1), a2 + hstep, voffA);
            PG8_WAIT_V(8); PG8_WAIT_L(0); PG8_BAR; PG8_MMA(0, 0, At, B0); PG8_MMA(0, 1, At, B1); PG8_BAR; PG8_SCHED;
            PG8_LDA(At, 1, 1); PG8_STAGE(PG8_SB(1, 0), b3, voffB); PG8_STAGE(PG8_SB(1, 1), b3 + hstep, voffB); PG8_STAGE(PG8_SA(1, 0), a3, voffA);
            PG8_WAIT_V(8); PG8_WAIT_L(0); PG8_BAR; PG8_MMA(1, 0, At, B0); PG8_MMA(1, 1, At, B1); PG8_BAR; PG8_SCHED;
            } else {
            PG8_LDB(B0, 0, 0); PG8_SCHED; PG8_LDA(At, 0, 0); PG8_STAGE(PG8_SA(1, 1), a1 + hstep, voffA);
            PG8_WAIT_L(8); PG8_BAR; PG8_WAIT_L(0); PG8_MMA(0, 0, At, B0); PG8_BAR; PG8_SCHED;
            PG8_LDB(B1, 0, 1); PG8_STAGE(PG8_SB(0, 0), b2, voffB);
            PG8_BAR; PG8_WAIT_L(0); PG8_MMA(0, 1, At, B1); PG8_BAR;
            PG8_LDA(At, 0, 1); PG8_STAGE(PG8_SA(0, 0), a2, voffA);
            PG8_BAR; PG8_WAIT_L(0); PG8_MMA(1, 0, At, B0); PG8_BAR; PG8_SCHED;
            PG8_STAGE(PG8_SB(0, 1), b2 + hstep, voffB);
            PG8_WAIT_V(6); PG8_BAR; PG8_MMA(1, 1, At, B1); PG8_BAR;
            PG8_LDB(B0, 1, 0); PG8_SCHED; PG8_LDA(At, 1, 0); PG8_STAGE(PG8_SA(0, 1), a2 + hstep, voffA);
            PG8_WAIT_L(8); PG8_BAR; PG8_WAIT_L(0); PG8_MMA(0, 0, At, B0); PG8_BAR; PG8_SCHED;
            PG8_LDB(B1, 1, 1); PG8_STAGE(PG8_SB(1, 0), b3, voffB);
            PG8_BAR; PG8_WAIT_L(0); PG8_MMA(0, 1, At, B1); PG8_BAR;
            PG8_LDA(At, 1, 1); PG8_STAGE(PG8_SA(1, 0), a3, voffA);
            PG8_BAR; PG8_WAIT_L(0); PG8_MMA(1, 0, At, B0); PG8_BAR; PG8_SCHED;
            PG8_STAGE(PG8_SB(1, 1), b3 + hstep, voffB);
            PG8_WAIT_V(6); PG8_BAR; PG8_MMA(1, 1, At, B1); PG8_BAR;
            }
        }
        if constexpr (ALIGN_EPI) { if (wr == 0) PG8_BAR; }
        if constexpr (!Epi::AFTER_DRAIN) { E(acc, cur, wr, wc, fr, fq); S.done(cur); }
        if (!has_next) break;
        if (!Epi::SEG || nxt.seg == 0) {
#pragma unroll
        for (int a = 0; a < 2; ++a)
#pragma unroll
            for (int b = 0; b < 2; ++b)
#pragma unroll
                for (int m = 0; m < 4; ++m)
#pragma unroll
                    for (int n = 0; n < 2; ++n) acc[a][b][m][n] = (f32x4){0.f, 0.f, 0.f, 0.f};
        }
        cur = nxt; cA = nA; cB = nB; ++ui;
        if constexpr (ALIGN_EPI) { if (wr == 1) PG8_BAR; }
    }
    PG8_WAIT_V(0);
    if constexpr (!ALIGN_EPI) { if (wr == 0) PG8_BAR; }
    PG8_BAR;
    if constexpr (Epi::AFTER_DRAIN) { E.fused(acc, cur, wr, wc, fr, fq, lds, wid, lane); S.done(cur); }
#undef PG8_SA
#undef PG8_SB
#undef PG8_STAGE
#undef PG8_LDA
#undef PG8_LDB
#undef PG8_MMA
#undef PG8_WAIT_V
#undef PG8_WAIT_L
#undef PG8_BAR
#undef PG8_SCHED
}
}

#ifndef PG8_SP2
#define PG8_SP2 true
#endif
#ifndef PG8_ALIGN
#define PG8_ALIGN true
#endif

constexpr int NWAVES = 8;
#ifndef MK_N_LAUNCHES
#define MK_N_LAUNCHES 1
#endif
constexpr int N_PHASES = 13;
constexpr int N_LAUNCHES = MK_N_LAUNCHES;

constexpr int D = 4096, DFF = 11008, DLRU = 2048, DSSM = 2048, DIN = 14336;
constexpr int NP = 4, TP = 2048, NS = 128, TS = 8;
constexpr int MP = NP * TP, MS = NS * TS, M = MP + MS;
constexpr int NGRP = 128, SP = 64, SCG = 16;
constexpr float EPS = 1e-6f;

constexpr size_t MiB = 1u << 20;
constexpr size_t WS_CTL = 0, CTL_ZERO_BYTES = 1 * MiB;
constexpr size_t WS_ABAR = 2 * MiB;
constexpr size_t WS_BB = 3 * MiB;
constexpr size_t WS_CC = 4 * MiB;
constexpr size_t WS_WG = 5 * MiB;
constexpr size_t WS_WGU1 = 8 * MiB, WS_WD1 = 180 * MiB, WS_WIN = 266 * MiB, WS_WGLU = 378 * MiB, WS_WOUT = 386 * MiB, WS_WO = 418 * MiB, WS_WGU2 = 450 * MiB, WS_WD2 = 622 * MiB;
constexpr size_t WS_XN = 708 * MiB;
constexpr size_t WS_HID = 780 * MiB;
constexpr size_t WS_XA = WS_HID, WS_GA = WS_HID + 72 * MiB, WS_XB = WS_HID + 108 * MiB, WS_G2 = WS_HID + 144 * MiB;
constexpr size_t WS_F = 974 * MiB;
constexpr size_t WS_G = WS_F;
constexpr size_t WS_YAB = 1118 * MiB, WS_END = 1190 * MiB;
constexpr size_t WS_SLAB = WS_YAB, SLAB_FLOATS = (size_t)MS * D;
static_assert(3 * SLAB_FLOATS * 4 <= (size_t)M * D * 2, "slabs inside YAB");
static_assert(WS_WGU1 + (size_t)2 * DFF * D * 2 <= WS_WD1 && WS_WD1 + (size_t)D * DFF * 2 <= WS_WIN && WS_WIN + (size_t)DIN * D * 2 <= WS_WGLU && WS_WGLU + (size_t)DSSM * DSSM * 2 <= WS_WOUT, "ws map 1");
static_assert(WS_WOUT + (size_t)D * D * 2 <= WS_WO && WS_WO + (size_t)D * D * 2 <= WS_WGU2 && WS_WGU2 + (size_t)2 * DFF * D * 2 <= WS_WD2 && WS_WD2 + (size_t)D * DFF * 2 <= WS_XN, "ws map 2");
static_assert(WS_XN + (size_t)M * D * 2 <= WS_HID && WS_HID + (size_t)M * DFF * 2 <= WS_F && WS_G2 + (size_t)M * DSSM * 2 <= WS_F && WS_F + (size_t)M * D * 4 <= WS_YAB && WS_YAB + (size_t)M * D * 2 <= WS_END, "ws map 3");
constexpr int CW_TMO = 0, CW_CODE = 1;
constexpr int CW_BAR = 4096;

constexpr int RING_OFF = 0, RING_BYTES = 131072;
constexpr int LDSCTL_OFF = RING_BYTES, MISC_OFF = LDSCTL_OFF + 320;
constexpr int LDS_BYTES = 147456;
static_assert(MISC_OFF + 128 <= LDS_BYTES, "LDS map");

#define GAS __attribute__((address_space(1)))
#define LAS __attribute__((address_space(3)))
typedef unsigned short bf16;
typedef unsigned v4u __attribute__((ext_vector_type(4)));
typedef unsigned v2u __attribute__((ext_vector_type(2)));
typedef float f32x4 __attribute__((ext_vector_type(4)));
typedef float f32x2 __attribute__((ext_vector_type(2)));
typedef short bf16x8 __attribute__((ext_vector_type(8)));
typedef GAS unsigned gu32;
typedef GAS unsigned long long gu64;
#define RLX_AGENT __ATOMIC_RELAXED, __HIP_MEMORY_SCOPE_AGENT
#define LDS_WAIT() asm volatile("s_waitcnt lgkmcnt(0)" ::: "memory")
#define VM_WAIT() asm volatile("s_waitcnt vmcnt(0)" ::: "memory")
__device__ __forceinline__ unsigned f2bf(float f) { unsigned u = __builtin_bit_cast(unsigned, f); return (u + 0x7fffu + ((u >> 16) & 1u)) >> 16; }
__device__ __forceinline__ unsigned pk2(float lo, float hi) { return pg8::cvt_pk_bf16(lo, hi); }
using pg8::bf_lo; using pg8::bf_hi; using pg8::fast_sigmoid; using pg8::gelu_tanh_f;
#define XB_TMO      128
#define XB_XCNT(j)  (256  + 64 * (j))
#define XB_XSUB(j)  (1280 + 64 * (j))
#define XB_XGEN(j)  (2304 + 64 * (j))
#define XB_TOP      3328
#define XB_TOPGEN   3392
#define XCD_BAR_WORDS 3456
#define XB_SPIN_CAP (1u << 18)

__device__ __forceinline__ unsigned xb_ld(unsigned* p)              { return __hip_atomic_load(p, __ATOMIC_RELAXED, __HIP_MEMORY_SCOPE_AGENT); }
__device__ __forceinline__ unsigned xb_add(unsigned* p, unsigned v) { return __hip_atomic_fetch_add(p, v, __ATOMIC_RELAXED, __HIP_MEMORY_SCOPE_AGENT); }
__device__ __forceinline__ unsigned xb_xcc_id() { return (unsigned)__builtin_amdgcn_s_getreg((3 << 11) | 20) & 0xFu; }
#define XB_SPIN(cond, bar) do { unsigned _sp = 0; while (cond) { __builtin_amdgcn_s_sleep(1); \
    if ((++_sp & 255u) == 0u) { if (xb_ld(&(bar)[XB_TMO])) break; if (_sp > XB_SPIN_CAP) { atomicAdd(&(bar)[XB_TMO], 1u); break; } } } } while (0)

struct XcdBarrier {
    unsigned* bar; unsigned x;
    volatile LAS unsigned* st;
};

__device__ __forceinline__ XcdBarrier xcd_barrier_post(unsigned* bar, volatile LAS unsigned* st) {
    XcdBarrier b; b.bar = bar; b.x = xb_xcc_id(); b.st = st;
    if (threadIdx.x == 0) (void)xb_add(&bar[XB_XCNT(b.x)], 1u);
    return b;
}
__device__ __forceinline__ void xcd_barrier_complete(unsigned* bar, unsigned x, unsigned& nloc, unsigned& nx) {
    const unsigned G = gridDim.x * gridDim.y * gridDim.z;
    unsigned sum, cnt, mine, sp = 0u;
    for (;;) {
        sum = 0u; cnt = 0u; mine = 0u;
#pragma unroll
        for (unsigned j = 0; j < 16; ++j) { const unsigned c = xb_ld(&bar[XB_XCNT(j)]); sum += c; cnt += (c > 0u) ? 1u : 0u; mine = (j == x) ? c : mine; }
        if (sum == G) break;
        __builtin_amdgcn_s_sleep(1);
        if ((++sp & 255u) == 0u) { if (xb_ld(&bar[XB_TMO])) break; if (sp > XB_SPIN_CAP) { atomicAdd(&bar[XB_TMO], 1u); break; } }
    }
    nloc = mine > 0u ? mine : 1u; nx = cnt > 0u ? cnt : 1u;
}

__device__ __forceinline__ void xcd_barrier(const XcdBarrier& b) {
    asm volatile("s_waitcnt vmcnt(0)" ::: "memory");
    __syncthreads();
    if (threadIdx.x == 0) {
        unsigned* bar = b.bar;
        __builtin_amdgcn_s_waitcnt(0);
        unsigned nloc = b.st[0], nx = b.st[1];
        if (nloc == 0u) { xcd_barrier_complete(bar, b.x, nloc, nx); b.st[0] = nloc; b.st[1] = nx; }
        const unsigned old = xb_add(&bar[XB_XSUB(b.x)], 1u);
        const unsigned gen = old / nloc;
        if (old + 1u == (gen + 1u) * nloc) {
            __builtin_amdgcn_fence(__ATOMIC_RELEASE, "agent");
            asm volatile("s_waitcnt vmcnt(0)" ::: "memory");
            const unsigned og = xb_add(&bar[XB_TOP], 1u);
            const unsigned tg = og / nx;
            if (og + 1u == (tg + 1u) * nx) xb_add(&bar[XB_TOPGEN], 1u);
            else XB_SPIN(xb_ld(&bar[XB_TOPGEN]) == tg, bar);
            __builtin_amdgcn_fence(__ATOMIC_ACQUIRE, "agent");
            xb_add(&bar[XB_XGEN(b.x)], 1u);
            asm volatile("s_waitcnt vmcnt(0)" ::: "memory");
        } else {
            XB_SPIN(xb_ld(&bar[XB_XGEN(b.x)]) == gen, bar);
            __builtin_amdgcn_fence(__ATOMIC_ACQUIRE, "agent");
            asm volatile("s_waitcnt vmcnt(0)" ::: "memory");
        }
    }
    __syncthreads();
}

__device__ __forceinline__ float wave_sum(float v) {
#pragma unroll
    for (int o = 1; o < 64; o <<= 1) v += __shfl_xor(v, o);
    return v;
}
constexpr size_t O_Y = 0, O_PLRU = (size_t)M * D, O_PCONV = O_PLRU + NP * DLRU, O_PRE = O_PCONV + NP * 3 * DLRU, O_PIM = O_PRE + NP * NGRP * SP, O_SLRU = O_PIM + NP * NGRP * SP,
                 O_SCONV = O_SLRU + NS * DLRU, O_SRE = O_SCONV + NS * 3 * DLRU, O_SIM = O_SRE + NS * NGRP * SP, O_END = O_SIM + NS * NGRP * SP;
static_assert(O_END == 40992768, "output size");

struct Args { const float* in[39]; float* out; unsigned char* ws; int ph_lo, ph_hi, li, pad; };
enum { I_XP = 0, I_XS, I_SLRU, I_SCONV, I_SRE, I_SIM, I_F1PRE, I_F1POST, I_F1G, I_F1U, I_F1D, I_MPRE, I_MPOST, I_WIN, I_CONVW, I_CONVB, I_WRG, I_BRG, I_WIG, I_BIG, I_LAM,
       I_ARE, I_AIM, I_LDT, I_BRE, I_BIM, I_CRE, I_CIM, I_DSK, I_WGLU, I_BGLU, I_WOA, I_WOB, I_WO, I_F2PRE, I_F2POST, I_F2G, I_F2U, I_F2D };

__device__ __forceinline__ void transpose_item(const float* W, int N, bf16* WT, int pitch, int k0, int n0, int drow, int dcol, LAS float* scr, int lane) {
#pragma unroll 8
    for (int i = 0; i < 32; ++i) { const int kk = 2 * i + (lane >> 5); scr[kk * 33 + (lane & 31)] = W[(size_t)(k0 + kk) * N + n0 + (lane & 31)]; }
    LDS_WAIT(); asm volatile("" ::: "memory");
    const int c = lane & 7;
#pragma unroll
    for (int j = 0; j < 4; ++j) { const int n = (lane >> 3) + 8 * j; const LAS float* s = scr + (8 * c) * 33 + n;
        v4u o; o.x = pk2(s[0 * 33], s[1 * 33]); o.y = pk2(s[2 * 33], s[3 * 33]); o.z = pk2(s[4 * 33], s[5 * 33]); o.w = pk2(s[6 * 33], s[7 * 33]);
        *(GAS v4u*)(WT + (size_t)(drow + n) * pitch + dcol + k0 + 8 * c) = o; }
    LDS_WAIT(); asm volatile("" ::: "memory");
}
__device__ __forceinline__ void tr_plain(const float* W, int K, int N, bf16* WT, int pitch, int dcol, int item, LAS float* scr, int lane) {
    const int nblk = N / 32, kb = item / nblk, nb = item - kb * nblk; (void)K;
    transpose_item(W, N, WT, pitch, 64 * kb, 32 * nb, 32 * nb, dcol, scr, lane);
}
__device__ __forceinline__ void tr_gu(const float* W, bf16* WT, int up, int item, LAS float* scr, int lane) {
    const int nblk = DFF / 32, kb = item / nblk, nb = item - kb * nblk, n0 = 32 * nb;
    transpose_item(W, DFF, WT, D, 64 * kb, n0, 256 * (n0 >> 7) + up * 128 + (n0 & 127), 0, scr, lane);
}
constexpr int IT_GU = (D / 64) * (DFF / 32), IT_DN = (DFF / 64) * (D / 32), IT_IN = (D / 64) * (DIN / 32), IT_GLU = (DSSM / 64) * (DSSM / 32), IT_OA = (DLRU / 64) * (D / 32), IT_WO = (D / 64) * (D / 32), IT_RG = 16 * 2 * 4;
constexpr int IT_TOTAL = 4 * IT_GU + 2 * IT_DN + IT_IN + IT_GLU + 2 * IT_OA + IT_WO + 2 * IT_RG;

template <int MODE> __device__ __forceinline__ void thin_rows(const Args& args, int gw, int ngw, int lane);

__device__ __forceinline__ void p0_prologue(const Args& args, LAS unsigned char* lds, int wave, int lane, int gw, int ngw) {
    unsigned char* ws = args.ws;
    LAS float* scr = (LAS float*)(lds + RING_OFF + wave * 16384);
    for (int it = gw; it < IT_TOTAL; it += ngw) {
        int r = it;
        if (r < IT_GU) { tr_gu(args.in[I_F1G], (bf16*)(ws + WS_WGU1), 0, r, scr, lane); continue; } r -= IT_GU;
        if (r < IT_GU) { tr_gu(args.in[I_F1U], (bf16*)(ws + WS_WGU1), 1, r, scr, lane); continue; } r -= IT_GU;
        if (r < IT_DN) { tr_plain(args.in[I_F1D], DFF, D, (bf16*)(ws + WS_WD1), DFF, 0, r, scr, lane); continue; } r -= IT_DN;
        if (r < IT_IN) { tr_plain(args.in[I_WIN], D, DIN, (bf16*)(ws + WS_WIN), D, 0, r, scr, lane); continue; } r -= IT_IN;
        if (r < IT_GLU) { tr_plain(args.in[I_WGLU], DSSM, DSSM, (bf16*)(ws + WS_WGLU), DSSM, 0, r, scr, lane); continue; } r -= IT_GLU;
        if (r < IT_OA) { tr_plain(args.in[I_WOA], DLRU, D, (bf16*)(ws + WS_WOUT), D, 0, r, scr, lane); continue; } r -= IT_OA;
        if (r < IT_OA) { tr_plain(args.in[I_WOB], DSSM, D, (bf16*)(ws + WS_WOUT), D, DLRU, r, scr, lane); continue; } r -= IT_OA;
        if (r < IT_WO) { tr_plain(args.in[I_WO], D, D, (bf16*)(ws + WS_WO), D, 0, r, scr, lane); continue; } r -= IT_WO;
        if (r < IT_GU) { tr_gu(args.in[I_F2G], (bf16*)(ws + WS_WGU2), 0, r, scr, lane); continue; } r -= IT_GU;
        if (r < IT_GU) { tr_gu(args.in[I_F2U], (bf16*)(ws + WS_WGU2), 1, r, scr, lane); continue; } r -= IT_GU;
        if (r < IT_DN) { tr_plain(args.in[I_F2D], DFF, D, (bf16*)(ws + WS_WD2), DFF, 0, r, scr, lane); continue; } r -= IT_DN;
        { const int ig = r >= IT_RG ? 1 : 0; const int q = r - ig * IT_RG, h = q >> 3, sub = q & 7, kb = sub >> 2, nb = sub & 3;
          const float* W = (ig ? args.in[I_WIG] : args.in[I_WRG]) + (size_t)h * 128 * 128;
          transpose_item(W, 128, (bf16*)(ws + WS_WG) + (size_t)h * 256 * 128, 128, 64 * kb, 32 * nb, ig * 128 + 32 * nb, 0, scr, lane); }
    }
    {
        const int gt = gw * 64 + lane;
        if (gt < NGRP * SP) {
            const int g = gt >> 6, p = gt & 63;
            const double dt = exp((double)args.in[I_LDT][g]);
            const double ar = (double)args.in[I_ARE][gt], ai = (double)args.in[I_AIM][gt];
            const double mag = exp(ar * dt);
            double th = ai * dt; th -= 6.283185307179586476925 * rint(th * 0.15915494309189533577);
            const double x = 0.25 * th, x2 = x * x;
            double s = x * (1.0 + x2 * (-1.0 / 6 + x2 * (1.0 / 120 + x2 * (-1.0 / 5040 + x2 * (1.0 / 362880 + x2 * (-1.0 / 39916800 + x2 * (1.0 / 6227020800.0)))))));
            double c = 1.0 + x2 * (-0.5 + x2 * (1.0 / 24 + x2 * (-1.0 / 720 + x2 * (1.0 / 40320 + x2 * (-1.0 / 3628800 + x2 * (1.0 / 479001600.0 + x2 * (-1.0 / 87178291200.0)))))));
            { const double s2 = 2.0 * s * c, c2 = 1.0 - 2.0 * s * s; s = s2; c = c2; }
            { const double s2 = 2.0 * s * c, c2 = 1.0 - 2.0 * s * s; s = s2; c = c2; }
            const double abr = mag * c, abi = mag * s;
            const double den = ar * ar + ai * ai, nr = abr - 1.0, ni = abi;
            const double cre = (nr * ar + ni * ai) / den, cim = (ni * ar - nr * ai) / den;
            float* AB = (float*)(ws + WS_ABAR); AB[2 * gt] = (float)abr; AB[2 * gt + 1] = (float)abi;
            bf16* BB = (bf16*)(ws + WS_BB); bf16* CC = (bf16*)(ws + WS_CC);
            const float* bre = args.in[I_BRE] + (size_t)gt * SCG; const float* bim = args.in[I_BIM] + (size_t)gt * SCG;
#pragma unroll 4
            for (int ch = 0; ch < SCG; ++ch) {
                const double br = (double)bre[ch], bi = (double)bim[ch];
                const float vre = (float)(cre * br - cim * bi), vim = (float)(cre * bi + cim * br);
#pragma unroll
                for (int ri = 0; ri < 2; ++ri) { const int col = 2 * p + ri, j = col >> 4, ln = (col & 15) + 16 * (ch >> 3);
                    BB[((size_t)(g * 8 + j) * 64 + ln) * 8 + (ch & 7)] = (bf16)f2bf(ri ? vim : vre); }
                const float c_re = args.in[I_CRE][((size_t)g * SCG + ch) * SP + p], c_im = args.in[I_CIM][((size_t)g * SCG + ch) * SP + p];
#pragma unroll
                for (int ri = 0; ri < 2; ++ri) { const int k = 2 * p + ri, kk = k >> 5, ln = ch + 16 * ((k & 31) >> 3);
                    CC[((size_t)(g * 4 + kk) * 64 + ln) * 8 + (k & 7)] = (bf16)f2bf(ri ? -c_im : c_re); }
            }
        }
    }
    thin_rows<0>(args, gw, ngw, lane);
}

template <int MODE> __device__ __forceinline__ void thin_rows(const Args& args, int gw, int ngw, int lane) {
    const float* gA = MODE == 1 ? args.in[I_F1POST] : (MODE == 2 ? args.in[I_MPOST] : args.in[I_F2POST]);
    const float* gB = MODE == 0 ? args.in[I_F1PRE] : (MODE == 1 ? args.in[I_MPRE] : args.in[I_F2PRE]);
    const float sc = MODE == 2 ? 1.0f : 0.5f;
    float* Y = args.out + O_Y; const float* Fb = (const float*)(args.ws + WS_F); bf16* XN = (bf16*)(args.ws + WS_XN);
    for (int m = gw; m < M; m += ngw) {
        const float* xin = (MODE <= 1) ? (m < MP ? args.in[I_XP] + (size_t)m * D : args.in[I_XS] + (size_t)(m - MP) * D) : Y + (size_t)m * D;
        const GAS f32x4* xr = (const GAS f32x4*)xin + lane;
        f32x4 v[16];
#pragma unroll
        for (int j = 0; j < 16; ++j) v[j] = xr[64 * j];
        if (MODE >= 1) {
            const GAS f32x4* fr = (const GAS f32x4*)(Fb + (size_t)m * D) + lane;
            f32x4 f[16]; float s = 0.f;
#pragma unroll
            for (int j = 0; j < 16; ++j) f[j] = fr[64 * j];
            if (m >= MP) {
#pragma unroll
                for (int q = 0; q < 3; ++q) { const GAS f32x4* sr = (const GAS f32x4*)((const float*)(args.ws + WS_SLAB) + q * SLAB_FLOATS + (size_t)(m - MP) * D) + lane;
#pragma unroll
                    for (int j = 0; j < 16; ++j) f[j] = f[j] + sr[64 * j]; } }
#pragma unroll
            for (int j = 0; j < 16; ++j) s += (f[j].x * f[j].x + f[j].y * f[j].y) + (f[j].z * f[j].z + f[j].w * f[j].w);
            const float rstd = sc / sqrtf(wave_sum(s) * (1.f / D) + EPS);
            const GAS f32x4* gr = (const GAS f32x4*)gA + lane;
            GAS f32x4* yo = (GAS f32x4*)(Y + (size_t)m * D) + lane;
#pragma unroll
            for (int j = 0; j < 16; ++j) { const f32x4 g = gr[64 * j]; v[j] = v[j] + f[j] * rstd * g; yo[64 * j] = v[j]; }
        }
        if (MODE <= 2) {
            float s = 0.f;
#pragma unroll
            for (int j = 0; j < 16; ++j) s += (v[j].x * v[j].x + v[j].y * v[j].y) + (v[j].z * v[j].z + v[j].w * v[j].w);
            const float rstd = 1.0f / sqrtf(wave_sum(s) * (1.f / D) + EPS);
            const GAS f32x4* gr = (const GAS f32x4*)gB + lane;
            GAS v2u* o8 = (GAS v2u*)(XN + (size_t)m * D) + lane;
#pragma unroll
            for (int j = 0; j < 16; ++j) { const f32x4 g = gr[64 * j]; const f32x4 o = v[j] * rstd * g; v2u w; w.x = pk2(o.x, o.y); w.y = pk2(o.z, o.w); o8[64 * j] = w; }
        }
    }
}

constexpr int L_WSL = 0, L_XCB = 17408, L_XCF = 34816, L_LA = 43264, L_LB = 51712, L_LH = 60160, L_END = 68608;
constexpr int LP = 33;
template <bool SAMPLE> __device__ __forceinline__ void lru_task(const Args& args, LAS unsigned char* lds, int tid, int wave, int lane, int chain, int head, int q) {
    unsigned char* ws = args.ws;
    const float* XA = (const float*)(ws + WS_XA); const bf16* GA = (const bf16*)(ws + WS_GA); bf16* YAB = (bf16*)(ws + WS_YAB);
    const int chb = head * 128;
    { const bf16* WG = (const bf16*)(ws + WS_WG) + (size_t)head * 256 * 128;
      for (int i = tid; i < 1024; i += 512) { const int r = i >> 4, c16 = i & 15; const int srow = (r < 32) ? (32 * q + r) : (128 + 32 * q + (r - 32));
          *(LAS v4u*)(lds + L_WSL + r * 272 + c16 * 16) = *(const GAS v4u*)(WG + (size_t)srow * 128 + c16 * 8); } }
    const int cg = tid & 31, tg = tid >> 5;
    const f32x4 cw0 = *(const f32x4*)(args.in[I_CONVW] + 0 * DLRU + chb + 4 * cg), cw1 = *(const f32x4*)(args.in[I_CONVW] + 1 * DLRU + chb + 4 * cg),
                cw2 = *(const f32x4*)(args.in[I_CONVW] + 2 * DLRU + chb + 4 * cg), cw3 = *(const f32x4*)(args.in[I_CONVW] + 3 * DLRU + chb + 4 * cg),
                cbv = *(const f32x4*)(args.in[I_CONVB] + chb + 4 * cg);
    const int tb = wave & 3, ct = wave >> 2, l15 = lane & 15, lq = lane >> 4;
    const int chg = chb + 32 * q + 16 * ct + l15;
    const float brg = args.in[I_BRG][chg], big = args.in[I_BIG][chg];
    const float lam = args.in[I_LAM][chg];
    const float sp8 = -8.0f * log1pf(expf(-lam));
    float hcar = 0.f;
    const int ntile = SAMPLE ? 1 : 32;
    for (int k = 0; k < ntile; ++k) {
        const size_t rbase = SAMPLE ? (size_t)MP + 64 * chain : (size_t)chain * TP + 64 * k;
        {
            f32x4 v[7];
#pragma unroll
            for (int i = 0; i < 7; ++i) {
                if (SAMPLE) { const int ts = 4 * (tg & 1) - 3 + i, sl = tg >> 1;
                    v[i] = (ts >= 0) ? *(const GAS f32x4*)(XA + (rbase + 8 * sl + ts) * DLRU + chb + 4 * cg)
                                     : *(const GAS f32x4*)(args.in[I_SCONV] + ((size_t)(8 * chain + sl) * 3 + (3 + ts)) * DLRU + chb + 4 * cg);
                } else { const int tt = 4 * tg - 3 + i;
                    v[i] = (k > 0 || tt >= 0) ? *(const GAS f32x4*)(XA + (rbase + tt) * DLRU + chb + 4 * cg) : (f32x4){0.f, 0.f, 0.f, 0.f}; }
            }
#pragma unroll
            for (int o = 0; o < 4; ++o) { const f32x4 xc = cbv + cw0 * v[o] + cw1 * v[o + 1] + cw2 * v[o + 2] + cw3 * v[o + 3];
                v2u w; w.x = pk2(xc.x, xc.y); w.y = pk2(xc.z, xc.w);
                *(LAS v2u*)(lds + L_XCB + (4 * tg + o) * 272 + cg * 8) = w;
                if ((cg >> 3) == q) { LAS float* xf = (LAS float*)(lds + L_XCF) + (4 * tg + o) * LP + 4 * (cg & 7); xf[0] = xc.x; xf[1] = xc.y; xf[2] = xc.z; xf[3] = xc.w; } }
        }
        __syncthreads();
        pg8::f32x4 accr = {0.f, 0.f, 0.f, 0.f}, acci = {0.f, 0.f, 0.f, 0.f};
#pragma unroll
        for (int kk = 0; kk < 4; ++kk) {
            const bf16x8 a = *(const LAS bf16x8*)(lds + L_XCB + (16 * tb + l15) * 272 + kk * 64 + lq * 16);
            const bf16x8 br = *(const LAS bf16x8*)(lds + L_WSL + (16 * ct + l15) * 272 + kk * 64 + lq * 16);
            const bf16x8 bi = *(const LAS bf16x8*)(lds + L_WSL + (32 + 16 * ct + l15) * 272 + kk * 64 + lq * 16);
            accr = __builtin_amdgcn_mfma_f32_16x16x32_bf16(a, br, accr, 0, 0, 0);
            acci = __builtin_amdgcn_mfma_f32_16x16x32_bf16(a, bi, acci, 0, 0, 0);
        }
#pragma unroll
        for (int r = 0; r < 4; ++r) { const int tt = 16 * tb + 4 * lq + r, cl = 16 * ct + l15;
            const float rg = fast_sigmoid(accr[r] + brg), ig = fast_sigmoid(acci[r] + big);
            const float la = sp8 * rg;
            const float a = __builtin_amdgcn_exp2f(la * 1.4426950408889634f);
            const float x2 = 2.0f * la;
            const float em = (x2 > -0.25f) ? -x2 * (1.0f + x2 * (0.5f + x2 * (1.0f / 6 + x2 * (1.0f / 24 + x2 * (1.0f / 120 + x2 * (1.0f / 720))))))
                                           : 1.0f - __builtin_amdgcn_exp2f(x2 * 1.4426950408889634f);
            const float xcv = ((const LAS float*)(lds + L_XCF))[tt * LP + cl];
            ((LAS float*)(lds + L_LA))[tt * LP + cl] = a;
            ((LAS float*)(lds + L_LB))[tt * LP + cl] = sqrtf(em) * ig * xcv; }
        __syncthreads();
        if (tid < 32) {
            const LAS float* la = (const LAS float*)(lds + L_LA) + tid; const LAS float* lb = (const LAS float*)(lds + L_LB) + tid; LAS float* lh = (LAS float*)(lds + L_LH) + tid;
            const int ch = chb + 32 * q + tid;
#pragma unroll 8
            for (int tt = 0; tt < 64; ++tt) {
                if (SAMPLE && (tt & 7) == 0) hcar = args.in[I_SLRU][(size_t)(8 * chain + (tt >> 3)) * DLRU + ch];
                hcar = la[tt * LP] * hcar + lb[tt * LP]; lh[tt * LP] = hcar;
                if (SAMPLE && (tt & 7) == 7) args.out[O_SLRU + (size_t)(8 * chain + (tt >> 3)) * DLRU + ch] = hcar;
            }
            if (!SAMPLE && k == ntile - 1) args.out[O_PLRU + (size_t)chain * DLRU + ch] = hcar;
        }
        __syncthreads();
        { const int t = tid >> 3, c4 = (tid & 7) * 4; const LAS float* lh = (const LAS float*)(lds + L_LH) + t * LP + c4;
          const v2u gw = *(const GAS v2u*)(GA + (rbase + t) * DLRU + chb + 32 * q + c4);
          v2u o; o.x = pk2(lh[0] * bf_lo(gw.x), lh[1] * bf_hi(gw.x)); o.y = pk2(lh[2] * bf_lo(gw.y), lh[3] * bf_hi(gw.y));
          *(GAS v2u*)(YAB + (rbase + t) * D + chb + 32 * q + c4) = o; }
    }
    __syncthreads();
}

constexpr int S5_WAVE_LDS = 12800, S5_BU = 0, S5_HS = 8448;
template <bool SAMPLE> __device__ __forceinline__ void s5_task(const Args& args, LAS unsigned char* wl, int lane, int chain, int g) {
    unsigned char* ws = args.ws;
    const bf16* XB = (const bf16*)(ws + WS_XB); bf16* G2 = (bf16*)(ws + WS_G2);
    const int l15 = lane & 15, lq = lane >> 4;
    const f32x2 ab = *(const GAS f32x2*)((const float*)(ws + WS_ABAR) + 2 * (g * SP + lane));
    bf16x8 bfrag[8], cfrag[4];
#pragma unroll
    for (int j = 0; j < 8; ++j) { bfrag[j] = (bf16x8){0, 0, 0, 0, 0, 0, 0, 0}; if (lane < 32) bfrag[j] = *(const GAS bf16x8*)((const bf16*)(ws + WS_BB) + ((size_t)(g * 8 + j) * 64 + lane) * 8); }
#pragma unroll
    for (int kk = 0; kk < 4; ++kk) cfrag[kk] = *(const GAS bf16x8*)((const bf16*)(ws + WS_CC) + ((size_t)(g * 4 + kk) * 64 + lane) * 8);
    const f32x4 dsk = *(const GAS f32x4*)(args.in[I_DSK] + g * SCG + 4 * lq);
    float hr = 0.f, hi = 0.f;
    const int ntile = SAMPLE ? 1 : 32;
    for (int k = 0; k < ntile; ++k) {
        const size_t rbase = SAMPLE ? (size_t)MP + 64 * chain : (size_t)chain * TP + 64 * k;
#pragma unroll 1
        for (int tb = 0; tb < 4; ++tb) {
            const size_t row0 = rbase + 16 * tb;
            bf16x8 a = (bf16x8){0, 0, 0, 0, 0, 0, 0, 0};
            if (lane < 32) a = *(const GAS bf16x8*)(XB + (row0 + l15) * DSSM + g * SCG + 8 * lq);
#pragma unroll
            for (int j = 0; j < 8; ++j) { const pg8::f32x4 c = __builtin_amdgcn_mfma_f32_16x16x32_bf16(a, bfrag[j], (pg8::f32x4){0.f, 0.f, 0.f, 0.f}, 0, 0, 0);
#pragma unroll
                for (int r = 0; r < 4; ++r) ((LAS float*)(wl + S5_BU))[(4 * lq + r) * 132 + 16 * j + l15] = c[r]; }
            LDS_WAIT();
            f32x2 bu[16];
#pragma unroll
            for (int t = 0; t < 16; ++t) bu[t] = *(const LAS f32x2*)(wl + S5_BU + (t * 132 + 2 * lane) * 4);
#pragma unroll
            for (int t = 0; t < 16; ++t) {
                if (SAMPLE && (t & 7) == 0) { const size_t si = ((size_t)(8 * chain + 2 * tb + (t >> 3)) * NGRP + g) * SP + lane; hr = args.in[I_SRE][si]; hi = args.in[I_SIM][si]; }
                const float nr = ab.x * hr - ab.y * hi + bu[t].x, ni = ab.x * hi + ab.y * hr + bu[t].y; hr = nr; hi = ni;
                *(LAS unsigned*)(wl + S5_HS + t * 272 + 4 * lane) = pk2(hr, hi);
                if (SAMPLE && (t & 7) == 7) { const size_t si = ((size_t)(8 * chain + 2 * tb + (t >> 3)) * NGRP + g) * SP + lane; args.out[O_SRE + si] = hr; args.out[O_SIM + si] = hi; }
            }
            LDS_WAIT();
            pg8::f32x4 y = {0.f, 0.f, 0.f, 0.f};
#pragma unroll
            for (int kk = 0; kk < 4; ++kk) { const bf16x8 hb = *(const LAS bf16x8*)(wl + S5_HS + l15 * 272 + kk * 64 + lq * 16);
                y = __builtin_amdgcn_mfma_f32_16x16x32_bf16(cfrag[kk], hb, y, 0, 0, 0); }
            LDS_WAIT();
            const v2u uw = *(const GAS v2u*)(XB + (row0 + l15) * DSSM + g * SCG + 4 * lq);
            const float y0 = y[0] + dsk.x * bf_lo(uw.x), y1 = y[1] + dsk.y * bf_hi(uw.x), y2 = y[2] + dsk.z * bf_lo(uw.y), y3 = y[3] + dsk.w * bf_hi(uw.y);
            v2u o; o.x = pk2(gelu_tanh_f(y0), gelu_tanh_f(y1)); o.y = pk2(gelu_tanh_f(y2), gelu_tanh_f(y3));
            *(GAS v2u*)(G2 + (row0 + l15) * DSSM + g * SCG + 4 * lq) = o;
        }
    }
    if (!SAMPLE) { const size_t si = ((size_t)chain * NGRP + g) * SP + lane; args.out[O_PRE + si] = hr; args.out[O_PIM + si] = hi; }
}

__device__ __forceinline__ void p5_mixer(const Args& args, LAS unsigned char* lds, int tid, int wave, int lane, int bx, int G) {
    { const float* XA = (const float*)(args.ws + WS_XA);
      const int nv = (NP + NS) * 3 * (DLRU / 4);
      for (int i = bx * 512 + tid; i < nv; i += G * 512) { const int c4 = i % (DLRU / 4), rj = i / (DLRU / 4), s = rj / 3, j = rj % 3;
          if (s < NP) *(GAS f32x4*)(args.out + O_PCONV + ((size_t)s * 3 + j) * DLRU + 4 * c4) = *(const GAS f32x4*)(XA + ((size_t)s * TP + TP - 3 + j) * DLRU + 4 * c4);
          else { const int ss = s - NP; *(GAS f32x4*)(args.out + O_SCONV + ((size_t)ss * 3 + j) * DLRU + 4 * c4) = *(const GAS f32x4*)(XA + ((size_t)MP + 8 * ss + 5 + j) * DLRU + 4 * c4); } } }
#if !defined(SKIP_LRU)
    for (int t = bx; t < NP * 64; t += G) lru_task<false>(args, lds, tid, wave, lane, t >> 6, (t >> 2) & 15, t & 3);
    for (int t = bx; t < 16 * 64; t += G) lru_task<true>(args, lds, tid, wave, lane, t >> 6, (t >> 2) & 15, t & 3);
#endif
#if defined(S5_PROBE)
    { const bf16* CCp = (const bf16*)(args.ws + WS_CC); const bf16* BBp = (const bf16*)(args.ws + WS_BB); const float* ABp = (const float*)(args.ws + WS_ABAR); const bf16* XBp = (const bf16*)(args.ws + WS_XB);
      for (int i = bx * 512 + tid; i < 32768; i += G * 512) { float s = 0.f, s2 = 0.f;
          for (int e = 0; e < 8; ++e) { s += __uint_as_float((unsigned)CCp[(size_t)i * 8 + e] << 16); s2 += __uint_as_float((unsigned)BBp[((size_t)(i >> 5) * 64 + (i & 31)) * 8 + e] << 16); }
          args.out[O_PRE + i] = s; args.out[O_PIM + i] = s2; if (i < 16384) args.out[O_SRE + i] = ABp[i]; }
      for (int i = bx * 512 + tid; i < 1048576; i += G * 512) { float s = 0.f; for (int e = 0; e < 18; ++e) s += __uint_as_float((unsigned)XBp[(size_t)i * 18 + e] << 16); args.out[O_SIM + i] = s; } }
#endif
#if !defined(SKIP_S5)
    LAS unsigned char* wl = lds + wave * S5_WAVE_LDS;
    const int gw = bx * NWAVES + wave, ngw = G * NWAVES;
    if (ngw >= 1024) {
        if (gw < NP * NGRP) s5_task<false>(args, wl, lane, gw >> 7, gw & 127);
        else for (int t = gw - NP * NGRP; t < 16 * NGRP; t += ngw - NP * NGRP) s5_task<true>(args, wl, lane, t >> 7, t & 127);
    } else {
        for (int t = gw; t < NP * NGRP; t += ngw) s5_task<false>(args, wl, lane, t >> 7, t & 127);
        for (int t = gw; t < 16 * NGRP; t += ngw) s5_task<true>(args, wl, lane, t >> 7, t & 127);
    }
#endif
    __syncthreads();
}

__global__ void __launch_bounds__(NWAVES * 64, 2) hawk_fwd(Args args) {
    extern __shared__ __attribute__((aligned(16))) unsigned char lds_raw[];
    LAS unsigned char* lds = (LAS unsigned char*)lds_raw;
    volatile LAS unsigned* MISC = (volatile LAS unsigned*)(lds + MISC_OFF);
    const int tid = threadIdx.x, lane = tid & 63, wave = __builtin_amdgcn_readfirstlane(tid >> 6);
    const int G = gridDim.x, bx = blockIdx.x;
    const int gw = bx * NWAVES + wave, ngw = G * NWAVES;
    unsigned char* ws = args.ws;
    gu32* ctl = (gu32*)(ws + WS_CTL);
    for (int u = tid; u < (LDS_BYTES - LDSCTL_OFF) / 4; u += NWAVES * 64) ((LAS unsigned*)(lds + LDSCTL_OFF))[u] = 0u;
#if defined(XCHK) && XCHK
    for (int u = tid; u < RING_BYTES / 4; u += NWAVES * 64) ((LAS unsigned*)lds)[u] = 0xFFFFFFFFu;
#endif
    __syncthreads();
    XcdBarrier bar = xcd_barrier_post((unsigned*)(ctl + CW_BAR) + args.li * XCD_BAR_WORDS, MISC + 8);
    const int lo = args.ph_lo, hi = args.ph_hi;
#ifndef PHMASK
#define PHMASK 0x1fff
#endif
#define IN(k) ((((PHMASK) >> (k)) & 1) && lo <= (k) && (k) < hi)
#define BOTH(k) (IN(k) && IN((k) + 1))
#define SEAM(k) do { if (BOTH(k)) xcd_barrier(bar); } while (0)
    bf16* XN = (bf16*)(ws + WS_XN); bf16* HID = (bf16*)(ws + WS_HID); float* Fb = (float*)(ws + WS_F); bf16* YAB = (bf16*)(ws + WS_YAB);

#if defined(XCHK) && XCHK
    if (lo == 0) {
        GAS v4u* w4 = (GAS v4u*)(ws + 2 * MiB); const size_t n4 = (WS_END - 2 * MiB) / 16; const v4u q = {0xFFFFFFFFu, 0xFFFFFFFFu, 0xFFFFFFFFu, 0xFFFFFFFFu};
        for (size_t i = (size_t)bx * 512 + tid; i < n4; i += (size_t)G * 512) w4[i] = q;
        GAS v4u* o4 = (GAS v4u*)args.out; const size_t m4 = O_END / 4;
        for (size_t i = (size_t)bx * 512 + tid; i < m4; i += (size_t)G * 512) o4[i] = q;
        if (hi > 1) xcd_barrier(bar);
    }
#endif
    if (IN(0)) { p0_prologue(args, lds, wave, lane, gw, ngw); SEAM(0); }
    if (IN(1)) { pg8::Gemm g{XN, (const bf16*)(ws + WS_WGU1), M, 2 * DFF, D, D}; pg8::StaticOrder S; S.init(M, 2 * DFF, D, G, bx);
        pg8::EpiSwiglu E{HID, DFF};
        pg8::gemm_phase<pg8::EpiSwiglu, pg8::StaticOrder, PG8_ALIGN, PG8_SP2>(lds + RING_OFF, g, S, E); SEAM(1); }
    if (IN(2)) { pg8::Gemm g{HID, (const bf16*)(ws + WS_WD1), M, D, DFF, DFF}; pg8::TailOrder S; S.init(D, DFF, G, bx);
        pg8::EpiF32 E{Fb, D, (float*)(ws + WS_SLAB), SLAB_FLOATS, MP};
        pg8::gemm_phase<pg8::EpiF32, pg8::TailOrder, PG8_ALIGN, PG8_SP2>(lds + RING_OFF, g, S, E); SEAM(2); }
    if (IN(3)) { thin_rows<1>(args, gw, ngw, lane); SEAM(3); }
    if (IN(4)) { pg8::Gemm g{XN, (const bf16*)(ws + WS_WIN), M, DIN, D, D}; pg8::StaticOrder S; S.init(M, DIN, D, G, bx);
        pg8::EpiWin E{(float*)(ws + WS_XA), (bf16*)(ws + WS_GA), (bf16*)(ws + WS_XB), (bf16*)(ws + WS_G)};
        pg8::gemm_phase<pg8::EpiWin, pg8::StaticOrder, PG8_ALIGN, PG8_SP2>(lds + RING_OFF, g, S, E); SEAM(4); }
    if (IN(5)) { p5_mixer(args, lds, tid, wave, lane, bx, G); SEAM(5); }
    if (IN(6)) { pg8::Gemm g{(const bf16*)(ws + WS_G2), (const bf16*)(ws + WS_WGLU), M, DSSM, DSSM, DSSM}; pg8::StaticOrder S; S.init(M, DSSM, DSSM, G, bx);
        pg8::EpiGlu E{(const bf16*)(ws + WS_G2), args.in[I_BGLU], YAB + DLRU};
        pg8::gemm_phase<pg8::EpiGlu, pg8::StaticOrder, PG8_ALIGN, PG8_SP2>(lds + RING_OFF, g, S, E); SEAM(6); }
    if (IN(7)) { pg8::Gemm g{YAB, (const bf16*)(ws + WS_WOUT), M, D, D, D}; pg8::SegOrder S; S.init(M, D, D, G, bx);
        pg8::EpiOut E{(const bf16*)(ws + WS_G), XN};
        pg8::gemm_phase<pg8::EpiOut, pg8::SegOrder, PG8_ALIGN, PG8_SP2>(lds + RING_OFF, g, S, E); SEAM(7); }
    if (IN(8)) { pg8::Gemm g{XN, (const bf16*)(ws + WS_WO), M, D, D, D}; pg8::TailOrder S; S.init(D, D, G, bx);
        pg8::EpiF32 E{Fb, D, (float*)(ws + WS_SLAB), SLAB_FLOATS, MP};
        pg8::gemm_phase<pg8::EpiF32, pg8::TailOrder, PG8_ALIGN, PG8_SP2>(lds + RING_OFF, g, S, E); SEAM(8); }
    if (IN(9)) { thin_rows<2>(args, gw, ngw, lane); SEAM(9); }
    if (IN(10)) { pg8::Gemm g{XN, (const bf16*)(ws + WS_WGU2), M, 2 * DFF, D, D}; pg8::StaticOrder S; S.init(M, 2 * DFF, D, G, bx);
        pg8::EpiSwiglu E{HID, DFF};
        pg8::gemm_phase<pg8::EpiSwiglu, pg8::StaticOrder, PG8_ALIGN, PG8_SP2>(lds + RING_OFF, g, S, E); SEAM(10); }
    if (IN(11)) { pg8::Gemm g{HID, (const bf16*)(ws + WS_WD2), M, D, DFF, DFF}; pg8::TailOrder S; S.init(D, DFF, G, bx);
        pg8::EpiF32 E{Fb, D, (float*)(ws + WS_SLAB), SLAB_FLOATS, MP};
        pg8::gemm_phase<pg8::EpiF32, pg8::TailOrder, PG8_ALIGN, PG8_SP2>(lds + RING_OFF, g, S, E); SEAM(11); }
    if (IN(12)) { thin_rows<3>(args, gw, ngw, lane); }
#undef IN
#undef BOTH
#undef SEAM
}

extern "C" void kernel_launch(void* const* d_in, const int* in_sizes, int n_in, void* d_out, int out_size, void* d_ws, size_t ws_size, hipStream_t stream) {
    static int grid = 0;
    if (grid == 0) {
        if (n_in != 39 || in_sizes[0] != MP * D || out_size != (int)O_END || ws_size < WS_END) { fprintf(stderr, "kernel_launch: unexpected shapes (n_in %d, in0 %d, out %d, ws %zu); nothing launched\n", n_in, n_in > 0 ? in_sizes[0] : -1, out_size, ws_size); grid = -1; return; }
        int dev = 0, cus = 0, per_cu = 0;
        if (hipGetDevice(&dev) != hipSuccess || hipDeviceGetAttribute(&cus, hipDeviceAttributeMultiprocessorCount, dev) != hipSuccess) { grid = -1; return; }
        if (hipFuncSetAttribute((const void*)hawk_fwd, hipFuncAttributeMaxDynamicSharedMemorySize, LDS_BYTES) != hipSuccess) { fprintf(stderr, "kernel_launch: hipFuncSetAttribute failed\n"); grid = -1; return; }
        if (hipOccupancyMaxActiveBlocksPerMultiprocessor(&per_cu, (const void*)hawk_fwd, NWAVES * 64, LDS_BYTES) != hipSuccess || per_cu < 1)
            fprintf(stderr, "kernel_launch: note: occupancy query reports %d workgroups per CU\n", per_cu);
        (void)hipGetLastError();
        grid = cus;
    }
    if (grid < 0) return;
    if (hipMemsetAsync((char*)d_ws + WS_CTL, 0, CTL_ZERO_BYTES, stream) != hipSuccess) return;
    Args a{};
    for (int i = 0; i < 39; ++i) a.in[i] = (const float*)d_in[i];
    a.out = (float*)d_out; a.ws = (unsigned char*)d_ws;
    static_assert(N_LAUNCHES == 1 || N_LAUNCHES == N_PHASES, "MK_N_LAUNCHES: 1 or one launch per phase");
    for (int li = 0; li < N_LAUNCHES; ++li) {
        a.ph_lo = (N_LAUNCHES == 1) ? 0 : li; a.ph_hi = (N_LAUNCHES == 1) ? N_PHASES : li + 1; a.li = li; a.pad = 0;
        hipLaunchKernelGGL(hawk_fwd, dim3(grid), dim3(NWAVES * 64), LDS_BYTES, stream, a);
        const hipError_t le = hipPeekAtLastError();
        if (le != hipSuccess) { fprintf(stderr, "kernel_launch: launch %d failed: %s\n", li, hipGetErrorName(le)); break; }
    }
}
```

```cpp
#include <hip/hip_runtime.h>
#include <cstdio>
#include <cstdint>
namespace pg8 {
#define PG8_LAS __attribute__((address_space(3)))
typedef unsigned short bf16_t;
typedef short bf16x8 __attribute__((ext_vector_type(8)));
typedef float f32x4 __attribute__((ext_vector_type(4)));
typedef unsigned u32x4 __attribute__((ext_vector_type(4)));
constexpr int BM = 256, BK = 64, HALF = 128, HTB = HALF * BK * 2  , STAGE_BYTES = 8 * HTB, NXCD = 8, WGM = 8;

__host__ __device__ __forceinline__ int lds_byte(int r, int c) { const int st = (r >> 4) * 2 + (c >> 5), rr = r & 15, cc = c & 31, ob = rr * 64 + cc * 2; return st * 1024 + (ob ^ (((ob >> 9) & 1) << 5)); }
__host__ __device__ __forceinline__ void stage_rc(int b, int& R, int& C) { const int st = b / 1024, sb = b % 1024, swz = sb ^ (((sb >> 9) & 1) << 5); R = (st >> 1) * 16 + swz / 64; C = (st & 1) * 32 + (swz % 64) / 2; }
__host__ __device__ __forceinline__ int perm32(int rho) { const int n = rho >> 4, i = rho & 15; return 8 * (i >> 2) + 4 * n + (i & 3); }

struct Unit { int pm, pn, seg, k0, nt, slab; };
struct Gemm { const bf16_t* A; const bf16_t* Bt; int M, N, K, ld; };

struct StaticOrder {
    int nM, nN, nwg, G, c, ntk;
    __host__ __device__ __forceinline__ void init(int M, int N, int K, int G_, int c_) { nM = M / BM; nN = N / BM; nwg = nM * nN; G = G_; c = c_; ntk = K / BK; }
    __host__ __device__ __forceinline__ bool next(int i, Unit& u) const {
        const long L = (long)i * G + c; if (L >= nwg) return false;
        int wgid = (int)L; { const int q = nwg / NXCD, r = nwg % NXCD, xcd = wgid % NXCD, off = wgid / NXCD; wgid = (xcd < r ? xcd * (q + 1) : r * (q + 1) + (xcd - r) * q) + off; }
        const int nig = WGM * nN, gid = wgid / nig, fm = gid * WGM, gsz = (nM - fm) < WGM ? (nM - fm) : WGM;
        u.pm = fm + ((wgid % nig) % gsz); u.pn = (wgid % nig) / gsz; u.seg = 0; u.k0 = 0; u.nt = ntk; u.slab = 0; return true;
    }
    __device__ __forceinline__ void a_ready(const Unit&) const {}
    __device__ __forceinline__ void done(const Unit&) const {}
};
struct SegOrder : StaticOrder {
    __host__ __device__ __forceinline__ bool next(int i, Unit& u) const { const bool ok = StaticOrder::next(i >> 1, u); u.seg = i & 1; u.nt = ntk >> 1; u.k0 = (i & 1) * (ntk >> 1); return ok; }
};
struct TailOrder {
    StaticOrder base; int c, ntk;
    __host__ __device__ __forceinline__ void init(int N, int K, int G_, int c_) { base.init(32 * BM, N, K, G_, c_); c = c_; ntk = K / BK; }
    __host__ __device__ __forceinline__ bool next(int i, Unit& u) const {
        const bool full = i < 2; Unit b; const bool okb = base.next(full ? i : 0, b);
        const int x = c & 7, j = c >> 3, q = x & 3;
        const int qa = ((ntk >> 2) + 1) & ~1, qb = (ntk - 2 * qa) >> 1;
        u.pm = full ? b.pm : 32 + (j >> 3); u.pn = full ? b.pn : 8 * (x >> 2) + (j & 7); u.seg = 0; u.slab = full ? 0 : q;
        u.k0 = full ? 0 : (q < 2 ? q * qa : 2 * qa + (q - 2) * qb); u.nt = full ? ntk : (q < 2 ? qa : qb);
        return full ? okb : (i == 2 && base.G == 256 && base.nN == 16);
    }
    __device__ __forceinline__ void a_ready(const Unit&) const {}
    __device__ __forceinline__ void done(const Unit&) const {}
};

typedef float cvt_f32x2_t __attribute__((ext_vector_type(2)));
typedef __bf16 cvt_bf16x2_t __attribute__((ext_vector_type(2)));
__device__ __forceinline__ unsigned cvt_pk_bf16(float lo, float hi) { const cvt_f32x2_t v = {lo, hi}; const cvt_bf16x2_t b = __builtin_convertvector(v, cvt_bf16x2_t); return __builtin_bit_cast(unsigned, b); }
typedef float f32x2 __attribute__((ext_vector_type(2)));
__device__ __forceinline__ f32x2 gelu_pk(f32x2 v) {
    const f32x2 av = __builtin_elementwise_abs(v), d = av * 0.2316418882f + 1.0f;
    f32x2 t; t.x = __builtin_amdgcn_rcpf(d.x); t.y = __builtin_amdgcn_rcpf(d.y);
    f32x2 q = t * 0.5307027145f + (-0.7265760135f); q = q * t + 0.7107068705f; q = q * t + (-0.142248368f); q = q * t + 0.127414796f; q = q * t;
    const f32x2 s = (v * v) * (-0.72134752044f);
    f32x2 e; e.x = __builtin_amdgcn_exp2f(s.x); e.y = __builtin_amdgcn_exp2f(s.y);
    const f32x2 m = v * (q * e), r = v - m;
    f32x2 o; o.x = v.x < 0.f ? m.x : r.x; o.y = v.y < 0.f ? m.y : r.y; return o;
}


__device__ __forceinline__ float bf_lo(unsigned w) { return __uint_as_float(w << 16); }
__device__ __forceinline__ float bf_hi(unsigned w) { return __uint_as_float(w & 0xffff0000u); }
__device__ __forceinline__ float fast_sigmoid(float x) { return __builtin_amdgcn_rcpf(1.0f + __builtin_amdgcn_exp2f(-1.4426950408889634f * x)); }
__device__ __forceinline__ float silu_f(float x) { return x * fast_sigmoid(x); }
__device__ __forceinline__ float gelu_tanh_f(float x) { const float z = 1.5957691216057308f * (x + 0.044715f * x * x * x); return x * fast_sigmoid(z); }
__device__ __forceinline__ u32x4 pack8(const f32x4& v0, const f32x4& v1) { u32x4 w; w.x = cvt_pk_bf16(v0[0], v0[1]); w.y = cvt_pk_bf16(v0[2], v0[3]); w.z = cvt_pk_bf16(v1[0], v1[1]); w.w = cvt_pk_bf16(v1[2], v1[3]); return w; }

struct EpiSwiglu {
    static constexpr bool PERM = true, AFTER_DRAIN = false, SEG = false;
    bf16_t* O; int ldc;
    __device__ __forceinline__ void operator()(f32x4 (&acc)[2][2][4][2], const Unit& u, int wr, int wc, int fr, int fq) const {
        const int row0 = u.pm * BM + wr * 64 + fr, col0 = u.pn * HALF + wc * 32 + 8 * fq;
#pragma unroll
        for (int ai = 0; ai < 2; ++ai)
#pragma unroll
            for (int m = 0; m < 4; ++m) { bf16_t* rowp = O + (size_t)(row0 + ai * HALF + m * 16) * ldc + col0;
                f32x4 v0, v1;
#pragma unroll
                for (int j = 0; j < 4; ++j) { v0[j] = silu_f(acc[ai][0][m][0][j]) * acc[ai][1][m][0][j]; v1[j] = silu_f(acc[ai][0][m][1][j]) * acc[ai][1][m][1][j]; }
                *(u32x4*)rowp = pack8(v0, v1); }
    }
};
struct EpiF32 {
    static constexpr bool PERM = true, AFTER_DRAIN = false, SEG = false;
    float* C; int ldc; float* S; size_t slab_stride; int slab_row0;
    __device__ __forceinline__ void operator()(f32x4 (&acc)[2][2][4][2], const Unit& u, int wr, int wc, int fr, int fq) const {
        const int row0 = u.pm * BM + wr * 64 + fr, col0 = u.pn * BM + wc * 32 + 8 * fq;
        float* base = u.slab == 0 ? C : S + (size_t)(u.slab - 1) * slab_stride - (size_t)slab_row0 * ldc;
#pragma unroll
        for (int ai = 0; ai < 2; ++ai)
#pragma unroll
            for (int m = 0; m < 4; ++m) { float* rowp = base + (size_t)(row0 + ai * HALF + m * 16) * ldc + col0;
#pragma unroll
                for (int bj = 0; bj < 2; ++bj)
#pragma unroll
                    for (int n = 0; n < 2; ++n) *(f32x4*)(rowp + bj * HALF + n * 4) = acc[ai][bj][m][n]; }
    }
};
struct EpiWin {
    static constexpr bool PERM = true, AFTER_DRAIN = false, SEG = false;
    float* XA; bf16_t* GA; bf16_t* XB; bf16_t* G;
    __device__ __forceinline__ void operator()(f32x4 (&acc)[2][2][4][2], const Unit& u, int wr, int wc, int fr, int fq) const {
        const int row0 = u.pm * BM + wr * 64 + fr, cw = wc * 32 + 8 * fq;
        if (u.pn < 8) {
            const int col0 = u.pn * BM + cw;
#pragma unroll
            for (int ai = 0; ai < 2; ++ai)
#pragma unroll
                for (int m = 0; m < 4; ++m) { float* rowp = XA + (size_t)(row0 + ai * HALF + m * 16) * 2048 + col0;
#pragma unroll
                    for (int bj = 0; bj < 2; ++bj)
#pragma unroll
                        for (int n = 0; n < 2; ++n) *(f32x4*)(rowp + bj * HALF + n * 4) = acc[ai][bj][m][n]; }
        } else if (u.pn < 16) {
            const int col0 = (u.pn - 8) * BM + cw;
#pragma unroll
            for (int ai = 0; ai < 2; ++ai)
#pragma unroll
                for (int m = 0; m < 4; ++m) { bf16_t* rowp = GA + (size_t)(row0 + ai * HALF + m * 16) * 2048 + col0;
#pragma unroll
                    for (int bj = 0; bj < 2; ++bj) { f32x4 v0, v1;
#pragma unroll
                        for (int j = 0; j < 4; ++j) { v0[j] = gelu_tanh_f(acc[ai][bj][m][0][j]); v1[j] = gelu_tanh_f(acc[ai][bj][m][1][j]); }
                        *(u32x4*)(rowp + bj * HALF) = pack8(v0, v1); } }
        } else if (u.pn < 24) {
            const int col0 = (u.pn - 16) * BM + cw;
#pragma unroll
            for (int ai = 0; ai < 2; ++ai)
#pragma unroll
                for (int m = 0; m < 4; ++m) { bf16_t* rowp = XB + (size_t)(row0 + ai * HALF + m * 16) * 2048 + col0;
#pragma unroll
                    for (int bj = 0; bj < 2; ++bj) *(u32x4*)(rowp + bj * HALF) = pack8(acc[ai][bj][m][0], acc[ai][bj][m][1]); }
        } else {
            const int col0 = (u.pn - 24) * BM + cw;
#pragma unroll
            for (int ai = 0; ai < 2; ++ai)
#pragma unroll
                for (int m = 0; m < 4; ++m) { bf16_t* rowp = G + (size_t)(row0 + ai * HALF + m * 16) * 8192 + col0;
#pragma unroll
                    for (int bj = 0; bj < 2; ++bj) { f32x4 v0, v1;
#pragma unroll
                        for (int j = 0; j < 4; ++j) { v0[j] = fast_sigmoid(acc[ai][bj][m][0][j]); v1[j] = fast_sigmoid(acc[ai][bj][m][1][j]); }
                        *(u32x4*)(rowp + bj * HALF) = pack8(v0, v1); } }
        }
    }
};
struct EpiGlu {
    static constexpr bool PERM = true, AFTER_DRAIN = false, SEG = false;
    const bf16_t* G2; const float* bias; bf16_t* O;
    __device__ __forceinline__ void operator()(f32x4 (&acc)[2][2][4][2], const Unit& u, int wr, int wc, int fr, int fq) const {
        const int row0 = u.pm * BM + wr * 64 + fr, col0 = u.pn * BM + wc * 32 + 8 * fq;
        f32x4 bv[2][2];
#pragma unroll
        for (int bj = 0; bj < 2; ++bj)
#pragma unroll
            for (int n = 0; n < 2; ++n) bv[bj][n] = *(const f32x4*)(bias + col0 + bj * HALF + 4 * n);
#pragma unroll
        for (int ai = 0; ai < 2; ++ai)
#pragma unroll
            for (int m = 0; m < 4; ++m) { const size_t r = (size_t)(row0 + ai * HALF + m * 16);
#pragma unroll
                for (int bj = 0; bj < 2; ++bj) { const u32x4 gw = *(const u32x4*)(G2 + r * 2048 + col0 + bj * HALF);
                    const f32x4 a0 = acc[ai][bj][m][0] + bv[bj][0], a1 = acc[ai][bj][m][1] + bv[bj][1]; f32x4 v0, v1;
                    v0[0] = bf_lo(gw.x) * fast_sigmoid(a0[0]); v0[1] = bf_hi(gw.x) * fast_sigmoid(a0[1]); v0[2] = bf_lo(gw.y) * fast_sigmoid(a0[2]); v0[3] = bf_hi(gw.y) * fast_sigmoid(a0[3]);
                    v1[0] = bf_lo(gw.z) * fast_sigmoid(a1[0]); v1[1] = bf_hi(gw.z) * fast_sigmoid(a1[1]); v1[2] = bf_lo(gw.w) * fast_sigmoid(a1[2]); v1[3] = bf_hi(gw.w) * fast_sigmoid(a1[3]);
                    *(u32x4*)(O + r * 4096 + col0 + bj * HALF) = pack8(v0, v1); } }
    }
};
struct EpiOut {
    static constexpr bool PERM = true, AFTER_DRAIN = false, SEG = true;
    const bf16_t* G; bf16_t* O;
    __device__ __forceinline__ void seg0(f32x4 (&acc)[2][2][4][2], const Unit& u, int wr, int wc, int fr, int fq) const {
        const int row0 = u.pm * BM + wr * 64 + fr, col0 = u.pn * BM + wc * 32 + 8 * fq;
#pragma unroll
        for (int ai = 0; ai < 2; ++ai)
#pragma unroll
            for (int m = 0; m < 4; ++m) { const bf16_t* gp = G + (size_t)(row0 + ai * HALF + m * 16) * 8192 + col0;
#pragma unroll
                for (int bj = 0; bj < 2; ++bj) { const u32x4 a = *(const u32x4*)(gp + bj * HALF), b = *(const u32x4*)(gp + 4096 + bj * HALF);
                    f32x4 r0, r1;
                    r0[0] = bf_lo(a.x) * __builtin_amdgcn_rcpf(fmaxf(bf_lo(b.x), 1e-30f)); r0[1] = bf_hi(a.x) * __builtin_amdgcn_rcpf(fmaxf(bf_hi(b.x), 1e-30f));
                    r0[2] = bf_lo(a.y) * __builtin_amdgcn_rcpf(fmaxf(bf_lo(b.y), 1e-30f)); r0[3] = bf_hi(a.y) * __builtin_amdgcn_rcpf(fmaxf(bf_hi(b.y), 1e-30f));
                    r1[0] = bf_lo(a.z) * __builtin_amdgcn_rcpf(fmaxf(bf_lo(b.z), 1e-30f)); r1[1] = bf_hi(a.z) * __builtin_amdgcn_rcpf(fmaxf(bf_hi(b.z), 1e-30f));
                    r1[2] = bf_lo(a.w) * __builtin_amdgcn_rcpf(fmaxf(bf_lo(b.w), 1e-30f)); r1[3] = bf_hi(a.w) * __builtin_amdgcn_rcpf(fmaxf(bf_hi(b.w), 1e-30f));
                    acc[ai][bj][m][0] = acc[ai][bj][m][0] * r0; acc[ai][bj][m][1] = acc[ai][bj][m][1] * r1; }
                asm volatile("" ::: "memory"); }
    }
    __device__ __forceinline__ void operator()(f32x4 (&acc)[2][2][4][2], const Unit& u, int wr, int wc, int fr, int fq) const { if (u.seg == 0) seg0(acc, u, wr, wc, fr, fq); else seg1(acc, u, wr, wc, fr, fq); }
    __device__ __forceinline__ void seg1(const f32x4 (&acc)[2][2][4][2], const Unit& u, int wr, int wc, int fr, int fq) const {
        const int row0 = u.pm * BM + wr * 64 + fr, col0 = u.pn * BM + wc * 32 + 8 * fq;
#pragma unroll
        for (int ai = 0; ai < 2; ++ai)
#pragma unroll
            for (int m = 0; m < 4; ++m) { const size_t r = (size_t)(row0 + ai * HALF + m * 16);
#pragma unroll
                for (int bj = 0; bj < 2; ++bj) { const u32x4 b = *(const u32x4*)(G + r * 8192 + 4096 + col0 + bj * HALF);
                    f32x4 g0, g1;
                    g0[0] = fmaxf(bf_lo(b.x), 1e-30f); g0[1] = fmaxf(bf_hi(b.x), 1e-30f); g0[2] = fmaxf(bf_lo(b.y), 1e-30f); g0[3] = fmaxf(bf_hi(b.y), 1e-30f);
                    g1[0] = fmaxf(bf_lo(b.z), 1e-30f); g1[1] = fmaxf(bf_hi(b.z), 1e-30f); g1[2] = fmaxf(bf_lo(b.w), 1e-30f); g1[3] = fmaxf(bf_hi(b.w), 1e-30f);
                    *(u32x4*)(O + r * 4096 + col0 + bj * HALF) = pack8(acc[ai][bj][m][0] * g0, acc[ai][bj][m][1] * g1); } }
    }
};

template <class Epi, class Sched, bool ALIGN_EPI = false, bool SP2 = false>
__device__ __forceinline__ void gemm_phase(PG8_LAS unsigned char* lds, const Gemm g, const Sched& S, const Epi& E) {
    const int tid = threadIdx.x, wid = __builtin_amdgcn_readfirstlane(tid >> 6), lane = tid & 63, wr = wid >> 2, wc = wid & 3, fr = lane & 15, fq = lane >> 4;
    const int LD = g.ld;
    unsigned voffA[2], voffB[2];
#pragma unroll
    for (int i = 0; i < 2; ++i) { int R, C; stage_rc(tid * 16 + i * 8192, R, C); const int Rb = Epi::PERM ? ((R & ~31) + perm32(R & 31)) : R;
        voffA[i] = (unsigned)(R * LD + C) * 2u; voffB[i] = (unsigned)(Rb * LD + C) * 2u; }
    const size_t kstep = (size_t)(BK * 2);
    const size_t hstep = (size_t)HALF * LD * 2;
    const size_t tstep = 2 * hstep;
    const unsigned ldsw = (unsigned)wid * 1024u;
    const int aoff = lds_byte(wr * 64 + fr, fq * 8), boff = lds_byte(wc * 32 + fr, fq * 8);
#define PG8_SA(b, h) (((b) * 2 + (h)) * HTB)
#define PG8_SB(b, h) ((4 + (b) * 2 + (h)) * HTB)
#define PG8_STAGE(bufoff, gbase, voff) do { _Pragma("unroll") for (int _i = 0; _i < 2; ++_i) \
        __builtin_amdgcn_global_load_lds((const unsigned*)((const char*)(gbase) + (voff)[_i]), (PG8_LAS unsigned*)(lds + (bufoff) + ldsw + _i * 8192), 16, 0, 0); } while (0)
#define PG8_LDA(dst, b, h) do { _Pragma("unroll") for (int m = 0; m < 4; ++m) _Pragma("unroll") for (int k = 0; k < 2; ++k) dst[m][k] = *(const PG8_LAS bf16x8*)(lds + PG8_SA(b, h) + aoff + m * 2048 + k * 1024); } while (0)
#define PG8_LDB(dst, b, h) do { _Pragma("unroll") for (int n = 0; n < 2; ++n) _Pragma("unroll") for (int k = 0; k < 2; ++k) dst[n][k] = *(const PG8_LAS bf16x8*)(lds + PG8_SB(b, h) + boff + n * 2048 + k * 1024); } while (0)
#define PG8_MMA(ai, bj, At, Bt) do { __builtin_amdgcn_s_setprio(1); _Pragma("unroll") for (int m = 0; m < 4; ++m) _Pragma("unroll") for (int n = 0; n < 2; ++n) _Pragma("unroll") for (int k = 0; k < 2; ++k) \
        acc[ai][bj][m][n] = __builtin_amdgcn_mfma_f32_16x16x32_bf16(Bt[n][k], At[m][k], acc[ai][bj][m][n], 0, 0, 0); __builtin_amdgcn_s_setprio(0); } while (0)
#define PG8_WAIT_V(n) asm volatile("s_waitcnt vmcnt(" #n ")" ::: "memory")
#define PG8_WAIT_L(n) asm volatile("s_waitcnt lgkmcnt(" #n ")" ::: "memory")
#define PG8_BAR __builtin_amdgcn_s_barrier()
#define PG8_SCHED __builtin_amdgcn_sched_barrier(0)
    Unit cur, nxt; int ui = 0;
    if (!S.next(0, cur)) return;
    f32x4 acc[2][2][4][2];
#pragma unroll
    for (int a = 0; a < 2; ++a)
#pragma unroll
        for (int b = 0; b < 2; ++b)
#pragma unroll
            for (int m = 0; m < 4; ++m)
#pragma unroll
                for (int n = 0; n < 2; ++n) acc[a][b][m][n] = (f32x4){0.f, 0.f, 0.f, 0.f};
    bf16x8 At[4][2], B0[2][2], B1[2][2];
    const char* cA = (const char*)g.A + (size_t)cur.pm * tstep + (size_t)cur.k0 * kstep; const char* cB = (const char*)g.Bt + (size_t)cur.pn * tstep + (size_t)cur.k0 * kstep;
    S.a_ready(cur);
    if constexpr (SP2) {
        PG8_STAGE(PG8_SB(0, 0), cB, voffB); PG8_STAGE(PG8_SB(0, 1), cB + hstep, voffB); PG8_STAGE(PG8_SA(0, 0), cA, voffA); PG8_STAGE(PG8_SA(0, 1), cA + hstep, voffA);
        if (wr == 1) PG8_BAR;
        PG8_WAIT_V(2); PG8_BAR;
        PG8_STAGE(PG8_SB(1, 0), cB + kstep, voffB); PG8_STAGE(PG8_SA(1, 0), cA + kstep, voffA); PG8_STAGE(PG8_SB(1, 1), cB + hstep + kstep, voffB);
        PG8_WAIT_V(6); PG8_BAR;
    } else {
        PG8_STAGE(PG8_SB(0, 0), cB, voffB); PG8_STAGE(PG8_SA(0, 0), cA, voffA); PG8_STAGE(PG8_SB(0, 1), cB + hstep, voffB); PG8_STAGE(PG8_SA(0, 1), cA + hstep, voffA);
        if (wr == 1) PG8_BAR;
        PG8_WAIT_V(4); PG8_BAR;
        PG8_STAGE(PG8_SB(1, 0), cB + kstep, voffB); PG8_STAGE(PG8_SA(1, 0), cA + kstep, voffA); PG8_STAGE(PG8_SB(1, 1), cB + hstep + kstep, voffB);
        PG8_WAIT_V(6); PG8_BAR;
    }
    for (;;) {
        const bool has_next = S.next(ui + 1, nxt);
        const char* nA = has_next ? (const char*)g.A + (size_t)nxt.pm * tstep + (size_t)nxt.k0 * kstep : cA; const char* nB = has_next ? (const char*)g.Bt + (size_t)nxt.pn * tstep + (size_t)nxt.k0 * kstep : cB;
        const int nt = cur.nt;
        for (int t = 0; t < nt; t += 2) {
            const bool last = (t == nt - 2);
            const char* a1 = cA + (size_t)(t + 1) * kstep;
            const char* a2 = last ? nA : cA + (size_t)(t + 2) * kstep; const char* b2 = last ? nB : cB + (size_t)(t + 2) * kstep;
            const char* a3 = a2 + kstep; const char* b3 = b2 + kstep;
            if (last && has_next) S.a_ready(nxt);
            if constexpr (SP2) {
            PG8_LDB(B0, 0, 0); PG8_LDB(B1, 0, 1); PG8_SCHED; PG8_LDA(At, 0, 0); PG8_STAGE(PG8_SA(1, 1), a1 + hstep, voffA);
            PG8_WAIT_V(8); PG8_WAIT_L(0); PG8_BAR; PG8_MMA(0, 0, At, B0); PG8_MMA(0, 1, At, B1); PG8_BAR; PG8_SCHED;
            PG8_LDA(At, 0, 1); PG8_STAGE(PG8_SB(0, 0), b2, voffB); PG8_STAGE(PG8_SB(0, 1), b2 + hstep, voffB); PG8_STAGE(PG8_SA(0, 0), a2, voffA);
            PG8_WAIT_V(8); PG8_WAIT_L(0); PG8_BAR; PG8_MMA(1, 0, At, B0); PG8_MMA(1, 1, At, B1); PG8_BAR; PG8_SCHED;
            PG8_LDB(B0, 1, 0); PG8_LDB(B1, 1, 1); PG8_SCHED; PG8_LDA(At, 1, 0); PG8_STAGE(PG8_SA(0, 1), a2 + hstep, voffA);
            PG8_WAIT_V(8); PG8_WAIT_L(0); PG8_BAR; PG8_MMA(0, 0, At, B0); PG8_MMA(0, 1, At, B1); PG8_BAR; PG8_SCHED;
            PG8_LDA(At, 1, 1); PG8_STAGE(PG8_SB(1, 0), b3, voffB); PG8_STAGE(PG8_SB(1, 1), b3 + hstep, voffB); PG8_STAGE(PG8_SA(1, 0), a3, voffA);
            PG8_WAIT_V(8); PG8_WAIT_L(0); PG8_BAR; PG8_MMA(1, 0, At, B0); PG8_MMA(1, 1, At, B1); PG8_BAR; PG8_SCHED;
            } else {
            PG8_LDB(B0, 0, 0); PG8_SCHED; PG8_LDA(At, 0, 0); PG8_STAGE(PG8_SA(1, 1), a1 + hstep, voffA);
            PG8_WAIT_L(8); PG8_BAR; PG8_WAIT_L(0); PG8_MMA(0, 0, At, B0); PG8_BAR; PG8_SCHED;
            PG8_LDB(B1, 0, 1); PG8_STAGE(PG8_SB(0, 0), b2, voffB);
            PG8_BAR; PG8_WAIT_L(0); PG8_MMA(0, 1, At, B1); PG8_BAR;
            PG8_LDA(At, 0, 1); PG8_STAGE(PG8_SA(0, 0), a2, voffA);
            PG8_BAR; PG8_WAIT_L(0); PG8_MMA(1, 0, At, B0); PG8_BAR; PG8_SCHED;
            PG8_STAGE(PG8_SB(0, 1), b2 + hstep, voffB);
            PG8_WAIT_V(6); PG8_BAR; PG8_MMA(1, 1, At, B1); PG8_BAR;
            PG8_LDB(B0, 1, 0); PG8_SCHED; PG8_LDA(At, 1, 0); PG8_STAGE(PG8_SA(0, 1), a2 + hstep, voffA);
            PG8_WAIT_L(8); PG8_BAR; PG8_WAIT_L(0); PG8_MMA(0, 0, At, B0); PG8_BAR; PG8_SCHED;
            PG8_LDB(B1, 1, 1); PG8_STAGE(PG8_SB(1, 0), b3, voffB);
            PG8_BAR; PG8_WAIT_L(0); PG8_MMA(0, 1, At, B1); PG8_BAR;
            PG8_LDA(At, 1, 1); PG8_STAGE(PG8_SA(1, 0), a3, voffA);
            PG8_BAR; PG8_WAIT_L(0); PG8_MMA(1, 0, At, B0); PG8_BAR; PG8_SCHED;
            PG8_STAGE(PG8_SB(1, 1), b3 + hstep, voffB);
            PG8_WAIT_V(6); PG8_BAR; PG8_MMA(1, 1, At, B1); PG8_BAR;
            }
        }
        if constexpr (ALIGN_EPI) { if (wr == 0) PG8_BAR; }
        if constexpr (!Epi::AFTER_DRAIN) { E(acc, cur, wr, wc, fr, fq); S.done(cur); }
        if (!has_next) break;
        if (!Epi::SEG || nxt.seg == 0) {
#pragma unroll
        for (int a = 0; a < 2; ++a)
#pragma unroll
            for (int b = 0; b < 2; ++b)
#pragma unroll
                for (int m = 0; m < 4; ++m)
#pragma unroll
                    for (int n = 0; n < 2; ++n) acc[a][b][m][n] = (f32x4){0.f, 0.f, 0.f, 0.f};
        }
        cur = nxt; cA = nA; cB = nB; ++ui;
        if constexpr (ALIGN_EPI) { if (wr == 1) PG8_BAR; }
    }
    PG8_WAIT_V(0);
    if constexpr (!ALIGN_EPI) { if (wr == 0) PG8_BAR; }
    PG8_BAR;
    if constexpr (Epi::AFTER_DRAIN) { E.fused(acc, cur, wr, wc, fr, fq, lds, wid, lane); S.done(cur); }
#undef PG8_SA
#undef PG8_SB
#undef PG8_STAGE
#undef PG8_LDA
#undef PG8_LDB
#undef PG8_MMA
#undef PG8_WAIT_V
#undef PG8_WAIT_L
#undef PG8_BAR
#undef PG8_SCHED
}
}

#ifndef PG8_SP2
#define PG8_SP2 true
#endif
#ifndef PG8_ALIGN
#define PG8_ALIGN true
#endif

constexpr int NWAVES = 8;
#ifndef MK_N_LAUNCHES
#define MK_N_LAUNCHES 1
#endif
constexpr int N_PHASES = 13;
constexpr int N_LAUNCHES = MK_N_LAUNCHES;

constexpr int D = 4096, DFF = 11008, DLRU = 2048, DSSM = 2048, DIN = 14336;
constexpr int NP = 4, TP = 2048, NS = 128, TS = 8;
constexpr int MP = NP * TP, MS = NS * TS, M = MP + MS;
constexpr int NGRP = 128, SP = 64, SCG = 16;
constexpr float EPS = 1e-6f;

constexpr size_t MiB = 1u << 20;
constexpr size_t WS_CTL = 0, CTL_ZERO_BYTES = 1 * MiB;
constexpr size_t WS_ABAR = 2 * MiB;
constexpr size_t WS_BB = 3 * MiB;
constexpr size_t WS_CC = 4 * MiB;
constexpr size_t WS_WG = 5 * MiB;
constexpr size_t WS_WGU1 = 8 * MiB, WS_WD1 = 180 * MiB, WS_WIN = 266 * MiB, WS_WGLU = 378 * MiB, WS_WOUT = 386 * MiB, WS_WO = 418 * MiB, WS_WGU2 = 450 * MiB, WS_WD2 = 622 * MiB;
constexpr size_t WS_XN = 708 * MiB;
constexpr size_t WS_HID = 780 * MiB;
constexpr size_t WS_XA = WS_HID, WS_GA = WS_HID + 72 * MiB, WS_XB = WS_HID + 108 * MiB, WS_G2 = WS_HID + 144 * MiB;
constexpr size_t WS_F = 974 * MiB;
constexpr size_t WS_G = WS_F;
constexpr size_t WS_YAB = 1118 * MiB, WS_END = 1190 * MiB;
constexpr size_t WS_SLAB = WS_YAB, SLAB_FLOATS = (size_t)MS * D;
static_assert(3 * SLAB_FLOATS * 4 <= (size_t)M * D * 2, "slabs inside YAB");
static_assert(WS_WGU1 + (size_t)2 * DFF * D * 2 <= WS_WD1 && WS_WD1 + (size_t)D * DFF * 2 <= WS_WIN && WS_WIN + (size_t)DIN * D * 2 <= WS_WGLU && WS_WGLU + (size_t)DSSM * DSSM * 2 <= WS_WOUT, "ws map 1");
static_assert(WS_WOUT + (size_t)D * D * 2 <= WS_WO && WS_WO + (size_t)D * D * 2 <= WS_WGU2 && WS_WGU2 + (size_t)2 * DFF * D * 2 <= WS_WD2 && WS_WD2 + (size_t)D * DFF * 2 <= WS_XN, "ws map 2");
static_assert(WS_XN + (size_t)M * D * 2 <= WS_HID && WS_HID + (size_t)M * DFF * 2 <= WS_F && WS_G2 + (size_t)M * DSSM * 2 <= WS_F && WS_F + (size_t)M * D * 4 <= WS_YAB && WS_YAB + (size_t)M * D * 2 <= WS_END, "ws map 3");
constexpr int CW_TMO = 0, CW_CODE = 1;
constexpr int CW_BAR = 4096;

constexpr int RING_OFF = 0, RING_BYTES = 131072;
constexpr int LDSCTL_OFF = RING_BYTES, MISC_OFF = LDSCTL_OFF + 320;
constexpr int LDS_BYTES = 147456;
static_assert(MISC_OFF + 128 <= LDS_BYTES, "LDS map");

#define GAS __attribute__((address_space(1)))
#define LAS __attribute__((address_space(3)))
typedef unsigned short bf16;
typedef unsigned v4u __attribute__((ext_vector_type(4)));
typedef unsigned v2u __attribute__((ext_vector_type(2)));
typedef float f32x4 __attribute__((ext_vector_type(4)));
typedef float f32x2 __attribute__((ext_vector_type(2)));
typedef short bf16x8 __attribute__((ext_vector_type(8)));
typedef GAS unsigned gu32;
typedef GAS unsigned long long gu64;
#define RLX_AGENT __ATOMIC_RELAXED, __HIP_MEMORY_SCOPE_AGENT
#define LDS_WAIT() asm volatile("s_waitcnt lgkmcnt(0)" ::: "memory")
#define VM_WAIT() asm volatile("s_waitcnt vmcnt(0)" ::: "memory")
__device__ __forceinline__ unsigned f2bf(float f) { unsigned u = __builtin_bit_cast(unsigned, f); return (u + 0x7fffu + ((u >> 16) & 1u)) >> 16; }
__device__ __forceinline__ unsigned pk2(float lo, float hi) { return pg8::cvt_pk_bf16(lo, hi); }
using pg8::bf_lo; using pg8::bf_hi; using pg8::fast_sigmoid; using pg8::gelu_tanh_f;
#define XB_TMO      128
#define XB_XCNT(j)  (256  + 64 * (j))
#define XB_XSUB(j)  (1280 + 64 * (j))
#define XB_XGEN(j)  (2304 + 64 * (j))
#define XB_TOP      3328
#define XB_TOPGEN   3392
#define XCD_BAR_WORDS 3456
#define XB_SPIN_CAP (1u << 18)

__device__ __forceinline__ unsigned xb_ld(unsigned* p)              { return __hip_atomic_load(p, __ATOMIC_RELAXED, __HIP_MEMORY_SCOPE_AGENT); }
__device__ __forceinline__ unsigned xb_add(unsigned* p, unsigned v) { return __hip_atomic_fetch_add(p, v, __ATOMIC_RELAXED, __HIP_MEMORY_SCOPE_AGENT); }
__device__ __forceinline__ unsigned xb_xcc_id() { return (unsigned)__builtin_amdgcn_s_getreg((3 << 11) | 20) & 0xFu; }
#define XB_SPIN(cond, bar) do { unsigned _sp = 0; while (cond) { __builtin_amdgcn_s_sleep(1); \
    if ((++_sp & 255u) == 0u) { if (xb_ld(&(bar)[XB_TMO])) break; if (_sp > XB_SPIN_CAP) { atomicAdd(&(bar)[XB_TMO], 1u); break; } } } } while (0)

struct XcdBarrier {
    unsigned* bar; unsigned x;
    volatile LAS unsigned* st;
};

__device__ __forceinline__ XcdBarrier xcd_barrier_post(unsigned* bar, volatile LAS unsigned* st) {
    XcdBarrier b; b.bar = bar; b.x = xb_xcc_id(); b.st = st;
    if (threadIdx.x == 0) (void)xb_add(&bar[XB_XCNT(b.x)], 1u);
    return b;
}
__device__ __forceinline__ void xcd_barrier_complete(unsigned* bar, unsigned x, unsigned& nloc, unsigned& nx) {
    const unsigned G = gridDim.x * gridDim.y * gridDim.z;
    unsigned sum, cnt, mine, sp = 0u;
    for (;;) {
        sum = 0u; cnt = 0u; mine = 0u;
#pragma unroll
        for (unsigned j = 0; j < 16; ++j) { const unsigned c = xb_ld(&bar[XB_XCNT(j)]); sum += c; cnt += (c > 0u) ? 1u : 0u; mine = (j == x) ? c : mine; }
        if (sum == G) break;
        __builtin_amdgcn_s_sleep(1);
        if ((++sp & 255u) == 0u) { if (xb_ld(&bar[XB_TMO])) break; if (sp > XB_SPIN_CAP) { atomicAdd(&bar[XB_TMO], 1u); break; } }
    }
    nloc = mine > 0u ? mine : 1u; nx = cnt > 0u ? cnt : 1u;
}

__device__ __forceinline__ void xcd_barrier(const XcdBarrier& b) {
    asm volatile("s_waitcnt vmcnt(0)" ::: "memory");
    __syncthreads();
    if (threadIdx.x == 0) {
        unsigned* bar = b.bar;
        __builtin_amdgcn_s_waitcnt(0);
        unsigned nloc = b.st[0], nx = b.st[1];
        if (nloc == 0u) { xcd_barrier_complete(bar, b.x, nloc, nx); b.st[0] = nloc; b.st[1] = nx; }
        const unsigned old = xb_add(&bar[XB_XSUB(b.x)], 1u);
        const unsigned gen = old / nloc;
        if (old + 1u == (gen + 1u) * nloc) {
            __builtin_amdgcn_fence(__ATOMIC_RELEASE, "agent");
            asm volatile("s_waitcnt vmcnt(0)" ::: "memory");
            const unsigned og = xb_add(&bar[XB_TOP], 1u);
            const unsigned tg = og / nx;
            if (og + 1u == (tg + 1u) * nx) xb_add(&bar[XB_TOPGEN], 1u);
            else XB_SPIN(xb_ld(&bar[XB_TOPGEN]) == tg, bar);
            __builtin_amdgcn_fence(__ATOMIC_ACQUIRE, "agent");
            xb_add(&bar[XB_XGEN(b.x)], 1u);
            asm volatile("s_waitcnt vmcnt(0)" ::: "memory");
        } else {
            XB_SPIN(xb_ld(&bar[XB_XGEN(b.x)]) == gen, bar);
            __builtin_amdgcn_fence(__ATOMIC_ACQUIRE, "agent");
            asm volatile("s_waitcnt vmcnt(0)" ::: "memory");
        }
    }
    __syncthreads();
}

__device__ __forceinline__ float wave_sum(float v) {
#pragma unroll
    for (int o = 1; o < 64; o <<= 1) v += __shfl_xor(v, o);
    return v;
}
constexpr size_t O_Y = 0, O_PLRU = (size_t)M * D, O_PCONV = O_PLRU + NP * DLRU, O_PRE = O_PCONV + NP * 3 * DLRU, O_PIM = O_PRE + NP * NGRP * SP, O_SLRU = O_PIM + NP * NGRP * SP,
                 O_SCONV = O_SLRU + NS * DLRU, O_SRE = O_SCONV + NS * 3 * DLRU, O_SIM = O_SRE + NS * NGRP * SP, O_END = O_SIM + NS * NGRP * SP;
static_assert(O_END == 40992768, "output size");

struct Args { const float* in[39]; float* out; unsigned char* ws; int ph_lo, ph_hi, li, pad; };
enum { I_XP = 0, I_XS, I_SLRU, I_SCONV, I_SRE, I_SIM, I_F1PRE, I_F1POST, I_F1G, I_F1U, I_F1D, I_MPRE, I_MPOST, I_WIN, I_CONVW, I_CONVB, I_WRG, I_BRG, I_WIG, I_BIG, I_LAM,
       I_ARE, I_AIM, I_LDT, I_BRE, I_BIM, I_CRE, I_CIM, I_DSK, I_WGLU, I_BGLU, I_WOA, I_WOB, I_WO, I_F2PRE, I_F2POST, I_F2G, I_F2U, I_F2D };

__device__ __forceinline__ void transpose_item(const float* W, int N, bf16* WT, int pitch, int k0, int n0, int drow, int dcol, LAS float* scr, int lane) {
#pragma unroll 8
    for (int i = 0; i < 32; ++i) { const int kk = 2 * i + (lane >> 5); scr[kk * 33 + (lane & 31)] = W[(size_t)(k0 + kk) * N + n0 + (lane & 31)]; }
    LDS_WAIT(); asm volatile("" ::: "memory");
    const int c = lane & 7;
#pragma unroll
    for (int j = 0; j < 4; ++j) { const int n = (lane >> 3) + 8 * j; const LAS float* s = scr + (8 * c) * 33 + n;
        v4u o; o.x = pk2(s[0 * 33], s[1 * 33]); o.y = pk2(s[2 * 33], s[3 * 33]); o.z = pk2(s[4 * 33], s[5 * 33]); o.w = pk2(s[6 * 33], s[7 * 33]);
        *(GAS v4u*)(WT + (size_t)(drow + n) * pitch + dcol + k0 + 8 * c) = o; }
    LDS_WAIT(); asm volatile("" ::: "memory");
}
__device__ __forceinline__ void tr_plain(const float* W, int K, int N, bf16* WT, int pitch, int dcol, int item, LAS float* scr, int lane) {
    const int nblk = N / 32, kb = item / nblk, nb = item - kb * nblk; (void)K;
    transpose_item(W, N, WT, pitch, 64 * kb, 32 * nb, 32 * nb, dcol, scr, lane);
}
__device__ __forceinline__ void tr_gu(const float* W, bf16* WT, int up, int item, LAS float* scr, int lane) {
    const int nblk = DFF / 32, kb = item / nblk, nb = item - kb * nblk, n0 = 32 * nb;
    transpose_item(W, DFF, WT, D, 64 * kb, n0, 256 * (n0 >> 7) + up * 128 + (n0 & 127), 0, scr, lane);
}
constexpr int IT_GU = (D / 64) * (DFF / 32), IT_DN = (DFF / 64) * (D / 32), IT_IN = (D / 64) * (DIN / 32), IT_GLU = (DSSM / 64) * (DSSM / 32), IT_OA = (DLRU / 64) * (D / 32), IT_WO = (D / 64) * (D / 32), IT_RG = 16 * 2 * 4;
constexpr int IT_TOTAL = 4 * IT_GU + 2 * IT_DN + IT_IN + IT_GLU + 2 * IT_OA + IT_WO + 2 * IT_RG;

template <int MODE> __device__ __forceinline__ void thin_rows(const Args& args, int gw, int ngw, int lane);

__device__ __forceinline__ void p0_prologue(const Args& args, LAS unsigned char* lds, int wave, int lane, int gw, int ngw) {
    unsigned char* ws = args.ws;
    LAS float* scr = (LAS float*)(lds + RING_OFF + wave * 16384);
    for (int it = gw; it < IT_TOTAL; it += ngw) {
        int r = it;
        if (r < IT_GU) { tr_gu(args.in[I_F1G], (bf16*)(ws + WS_WGU1), 0, r, scr, lane); continue; } r -= IT_GU;
        if (r < IT_GU) { tr_gu(args.in[I_F1U], (bf16*)(ws + WS_WGU1), 1, r, scr, lane); continue; } r -= IT_GU;
        if (r < IT_DN) { tr_plain(args.in[I_F1D], DFF, D, (bf16*)(ws + WS_WD1), DFF, 0, r, scr, lane); continue; } r -= IT_DN;
        if (r < IT_IN) { tr_plain(args.in[I_WIN], D, DIN, (bf16*)(ws + WS_WIN), D, 0, r, scr, lane); continue; } r -= IT_IN;
        if (r < IT_GLU) { tr_plain(args.in[I_WGLU], DSSM, DSSM, (bf16*)(ws + WS_WGLU), DSSM, 0, r, scr, lane); continue; } r -= IT_GLU;
        if (r < IT_OA) { tr_plain(args.in[I_WOA], DLRU, D, (bf16*)(ws + WS_WOUT), D, 0, r, scr, lane); continue; } r -= IT_OA;
        if (r < IT_OA) { tr_plain(args.in[I_WOB], DSSM, D, (bf16*)(ws + WS_WOUT), D, DLRU, r, scr, lane); continue; } r -= IT_OA;
        if (r < IT_WO) { tr_plain(args.in[I_WO], D, D, (bf16*)(ws + WS_WO), D, 0, r, scr, lane); continue; } r -= IT_WO;
        if (r < IT_GU) { tr_gu(args.in[I_F2G], (bf16*)(ws + WS_WGU2), 0, r, scr, lane); continue; } r -= IT_GU;
        if (r < IT_GU) { tr_gu(args.in[I_F2U], (bf16*)(ws + WS_WGU2), 1, r, scr, lane); continue; } r -= IT_GU;
        if (r < IT_DN) { tr_plain(args.in[I_F2D], DFF, D, (bf16*)(ws + WS_WD2), DFF, 0, r, scr, lane); continue; } r -= IT_DN;
        { const int ig = r >= IT_RG ? 1 : 0; const int q = r - ig * IT_RG, h = q >> 3, sub = q & 7, kb = sub >> 2, nb = sub & 3;
          const float* W = (ig ? args.in[I_WIG] : args.in[I_WRG]) + (size_t)h * 128 * 128;
          transpose_item(W, 128, (bf16*)(ws + WS_WG) + (size_t)h * 256 * 128, 128, 64 * kb, 32 * nb, ig * 128 + 32 * nb, 0, scr, lane); }
    }
    {
        const int gt = gw * 64 + lane;
        if (gt < NGRP * SP) {
            const int g = gt >> 6, p = gt & 63;
            const double dt = exp((double)args.in[I_LDT][g]);
            const double ar = (double)args.in[I_ARE][gt], ai = (double)args.in[I_AIM][gt];
            const double mag = exp(ar * dt);
            double th = ai * dt; th -= 6.283185307179586476925 * rint(th * 0.15915494309189533577);
            const double x = 0.25 * th, x2 = x * x;
            double s = x * (1.0 + x2 * (-1.0 / 6 + x2 * (1.0 / 120 + x2 * (-1.0 / 5040 + x2 * (1.0 / 362880 + x2 * (-1.0 / 39916800 + x2 * (1.0 / 6227020800.0)))))));
            double c = 1.0 + x2 * (-0.5 + x2 * (1.0 / 24 + x2 * (-1.0 / 720 + x2 * (1.0 / 40320 + x2 * (-1.0 / 3628800 + x2 * (1.0 / 479001600.0 + x2 * (-1.0 / 87178291200.0)))))));
            { const double s2 = 2.0 * s * c, c2 = 1.0 - 2.0 * s * s; s = s2; c = c2; }
            { const double s2 = 2.0 * s * c, c2 = 1.0 - 2.0 * s * s; s = s2; c = c2; }
            const double abr = mag * c, abi = mag * s;
            const double den = ar * ar + ai * ai, nr = abr - 1.0, ni = abi;
            const double cre = (nr * ar + ni * ai) / den, cim = (ni * ar - nr * ai) / den;
            float* AB = (float*)(ws + WS_ABAR); AB[2 * gt] = (float)abr; AB[2 * gt + 1] = (float)abi;
            bf16* BB = (bf16*)(ws + WS_BB); bf16* CC = (bf16*)(ws + WS_CC);
            const float* bre = args.in[I_BRE] + (size_t)gt * SCG; const float* bim = args.in[I_BIM] + (size_t)gt * SCG;
#pragma unroll 4
            for (int ch = 0; ch < SCG; ++ch) {
                const double br = (double)bre[ch], bi = (double)bim[ch];
                const float vre = (float)(cre * br - cim * bi), vim = (float)(cre * bi + cim * br);
#pragma unroll
                for (int ri = 0; ri < 2; ++ri) { const int col = 2 * p + ri, j = col >> 4, ln = (col & 15) + 16 * (ch >> 3);
                    BB[((size_t)(g * 8 + j) * 64 + ln) * 8 + (ch & 7)] = (bf16)f2bf(ri ? vim : vre); }
                const float c_re = args.in[I_CRE][((size_t)g * SCG + ch) * SP + p], c_im = args.in[I_CIM][((size_t)g * SCG + ch) * SP + p];
#pragma unroll
                for (int ri = 0; ri < 2; ++ri) { const int k = 2 * p + ri, kk = k >> 5, ln = ch + 16 * ((k & 31) >> 3);
                    CC[((size_t)(g * 4 + kk) * 64 + ln) * 8 + (k & 7)] = (bf16)f2bf(ri ? -c_im : c_re); }
            }
        }
    }
    thin_rows<0>(args, gw, ngw, lane);
}

template <int MODE> __device__ __forceinline__ void thin_rows(const Args& args, int gw, int ngw, int lane) {
    const float* gA = MODE == 1 ? args.in[I_F1POST] : (MODE == 2 ? args.in[I_MPOST] : args.in[I_F2POST]);
    const float* gB = MODE == 0 ? args.in[I_F1PRE] : (MODE == 1 ? args.in[I_MPRE] : args.in[I_F2PRE]);
    const float sc = MODE == 2 ? 1.0f : 0.5f;
    float* Y = args.out + O_Y; const float* Fb = (const float*)(args.ws + WS_F); bf16* XN = (bf16*)(args.ws + WS_XN);
    for (int m = gw; m < M; m += ngw) {
        const float* xin = (MODE <= 1) ? (m < MP ? args.in[I_XP] + (size_t)m * D : args.in[I_XS] + (size_t)(m - MP) * D) : Y + (size_t)m * D;
        const GAS f32x4* xr = (const GAS f32x4*)xin + lane;
        f32x4 v[16];
#pragma unroll
        for (int j = 0; j < 16; ++j) v[j] = xr[64 * j];
        if (MODE >= 1) {
            const GAS f32x4* fr = (const GAS f32x4*)(Fb + (size_t)m * D) + lane;
            f32x4 f[16]; float s = 0.f;
#pragma unroll
            for (int j = 0; j < 16; ++j) f[j] = fr[64 * j];
            if (m >= MP) {
#pragma unroll
                for (int q = 0; q < 3; ++q) { const GAS f32x4* sr = (const GAS f32x4*)((const float*)(args.ws + WS_SLAB) + q * SLAB_FLOATS + (size_t)(m - MP) * D) + lane;
#pragma unroll
                    for (int j = 0; j < 16; ++j) f[j] = f[j] + sr[64 * j]; } }
#pragma unroll
            for (int j = 0; j < 16; ++j) s += (f[j].x * f[j].x + f[j].y * f[j].y) + (f[j].z * f[j].z + f[j].w * f[j].w);
            const float rstd = sc / sqrtf(wave_sum(s) * (1.f / D) + EPS);
            const GAS f32x4* gr = (const GAS f32x4*)gA + lane;
            GAS f32x4* yo = (GAS f32x4*)(Y + (size_t)m * D) + lane;
#pragma unroll
            for (int j = 0; j < 16; ++j) { const f32x4 g = gr[64 * j]; v[j] = v[j] + f[j] * rstd * g; yo[64 * j] = v[j]; }
        }
        if (MODE <= 2) {
            float s = 0.f;
#pragma unroll
            for (int j = 0; j < 16; ++j) s += (v[j].x * v[j].x + v[j].y * v[j].y) + (v[j].z * v[j].z + v[j].w * v[j].w);
            const float rstd = 1.0f / sqrtf(wave_sum(s) * (1.f / D) + EPS);
            const GAS f32x4* gr = (const GAS f32x4*)gB + lane;
            GAS v2u* o8 = (GAS v2u*)(XN + (size_t)m * D) + lane;
#pragma unroll
            for (int j = 0; j < 16; ++j) { const f32x4 g = gr[64 * j]; const f32x4 o = v[j] * rstd * g; v2u w; w.x = pk2(o.x, o.y); w.y = pk2(o.z, o.w); o8[64 * j] = w; }
        }
    }
}

constexpr int L_WSL = 0, L_XCB = 17408, L_XCF = 34816, L_LA = 43264, L_LB = 51712, L_LH = 60160, L_END = 68608;
constexpr int LP = 33;
template <bool SAMPLE> __device__ __forceinline__ void lru_task(const Args& args, LAS unsigned char* lds, int tid, int wave, int lane, int chain, int head, int q) {
    unsigned char* ws = args.ws;
    const float* XA = (const float*)(ws + WS_XA); const bf16* GA = (const bf16*)(ws + WS_GA); bf16* YAB = (bf16*)(ws + WS_YAB);
    const int chb = head * 128;
    { const bf16* WG = (const bf16*)(ws + WS_WG) + (size_t)head * 256 * 128;
      for (int i = tid; i < 1024; i += 512) { const int r = i >> 4, c16 = i & 15; const int srow = (r < 32) ? (32 * q + r) : (128 + 32 * q + (r - 32));
          *(LAS v4u*)(lds + L_WSL + r * 272 + c16 * 16) = *(const GAS v4u*)(WG + (size_t)srow * 128 + c16 * 8); } }
    const int cg = tid & 31, tg = tid >> 5;
    const f32x4 cw0 = *(const f32x4*)(args.in[I_CONVW] + 0 * DLRU + chb + 4 * cg), cw1 = *(const f32x4*)(args.in[I_CONVW] + 1 * DLRU + chb + 4 * cg),
                cw2 = *(const f32x4*)(args.in[I_CONVW] + 2 * DLRU + chb + 4 * cg), cw3 = *(const f32x4*)(args.in[I_CONVW] + 3 * DLRU + chb + 4 * cg),
                cbv = *(const f32x4*)(args.in[I_CONVB] + chb + 4 * cg);
    const int tb = wave & 3, ct = wave >> 2, l15 = lane & 15, lq = lane >> 4;
    const int chg = chb + 32 * q + 16 * ct + l15;
    const float brg = args.in[I_BRG][chg], big = args.in[I_BIG][chg];
    const float lam = args.in[I_LAM][chg];
    const float sp8 = -8.0f * log1pf(expf(-lam));
    float hcar = 0.f;
    const int ntile = SAMPLE ? 1 : 32;
    for (int k = 0; k < ntile; ++k) {
        const size_t rbase = SAMPLE ? (size_t)MP + 64 * chain : (size_t)chain * TP + 64 * k;
        {
            f32x4 v[7];
#pragma unroll
            for (int i = 0; i < 7; ++i) {
                if (SAMPLE) { const int ts = 4 * (tg & 1) - 3 + i, sl = tg >> 1;
                    v[i] = (ts >= 0) ? *(const GAS f32x4*)(XA + (rbase + 8 * sl + ts) * DLRU + chb + 4 * cg)
                                     : *(const GAS f32x4*)(args.in[I_SCONV] + ((size_t)(8 * chain + sl) * 3 + (3 + ts)) * DLRU + chb + 4 * cg);
                } else { const int tt = 4 * tg - 3 + i;
                    v[i] = (k > 0 || tt >= 0) ? *(const GAS f32x4*)(XA + (rbase + tt) * DLRU + chb + 4 * cg) : (f32x4){0.f, 0.f, 0.f, 0.f}; }
            }
#pragma unroll
            for (int o = 0; o < 4; ++o) { const f32x4 xc = cbv + cw0 * v[o] + cw1 * v[o + 1] + cw2 * v[o + 2] + cw3 * v[o + 3];
                v2u w; w.x = pk2(xc.x, xc.y); w.y = pk2(xc.z, xc.w);
                *(LAS v2u*)(lds + L_XCB + (4 * tg + o) * 272 + cg * 8) = w;
                if ((cg >> 3) == q) { LAS float* xf = (LAS float*)(lds + L_XCF) + (4 * tg + o) * LP + 4 * (cg & 7); xf[0] = xc.x; xf[1] = xc.y; xf[2] = xc.z; xf[3] = xc.w; } }
        }
        __syncthreads();
        pg8::f32x4 accr = {0.f, 0.f, 0.f, 0.f}, acci = {0.f, 0.f, 0.f, 0.f};
#pragma unroll
        for (int kk = 0; kk < 4; ++kk) {
            const bf16x8 a = *(const LAS bf16x8*)(lds + L_XCB + (16 * tb + l15) * 272 + kk * 64 + lq * 16);
            const bf16x8 br = *(const LAS bf16x8*)(lds + L_WSL + (16 * ct + l15) * 272 + kk * 64 + lq * 16);
            const bf16x8 bi = *(const LAS bf16x8*)(lds + L_WSL + (32 + 16 * ct + l15) * 272 + kk * 64 + lq * 16);
            accr = __builtin_amdgcn_mfma_f32_16x16x32_bf16(a, br, accr, 0, 0, 0);
            acci = __builtin_amdgcn_mfma_f32_16x16x32_bf16(a, bi, acci, 0, 0, 0);
        }
#pragma unroll
        for (int r = 0; r < 4; ++r) { const int tt = 16 * tb + 4 * lq + r, cl = 16 * ct + l15;
            const float rg = fast_sigmoid(accr[r] + brg), ig = fast_sigmoid(acci[r] + big);
            const float la = sp8 * rg;
            const float a = __builtin_amdgcn_exp2f(la * 1.4426950408889634f);
            const float x2 = 2.0f * la;
            const float em = (x2 > -0.25f) ? -x2 * (1.0f + x2 * (0.5f + x2 * (1.0f / 6 + x2 * (1.0f / 24 + x2 * (1.0f / 120 + x2 * (1.0f / 720))))))
                                           : 1.0f - __builtin_amdgcn_exp2f(x2 * 1.4426950408889634f);
            const float xcv = ((const LAS float*)(lds + L_XCF))[tt * LP + cl];
            ((LAS float*)(lds + L_LA))[tt * LP + cl] = a;
            ((LAS float*)(lds + L_LB))[tt * LP + cl] = sqrtf(em) * ig * xcv; }
        __syncthreads();
        if (tid < 32) {
            const LAS float* la = (const LAS float*)(lds + L_LA) + tid; const LAS float* lb = (const LAS float*)(lds + L_LB) + tid; LAS float* lh = (LAS float*)(lds + L_LH) + tid;
            const int ch = chb + 32 * q + tid;
#pragma unroll 8
            for (int tt = 0; tt < 64; ++tt) {
                if (SAMPLE && (tt & 7) == 0) hcar = args.in[I_SLRU][(size_t)(8 * chain + (tt >> 3)) * DLRU + ch];
                hcar = la[tt * LP] * hcar + lb[tt * LP]; lh[tt * LP] = hcar;
                if (SAMPLE && (tt & 7) == 7) args.out[O_SLRU + (size_t)(8 * chain + (tt >> 3)) * DLRU + ch] = hcar;
            }
            if (!SAMPLE && k == ntile - 1) args.out[O_PLRU + (size_t)chain * DLRU + ch] = hcar;
        }
        __syncthreads();
        { const int t = tid >> 3, c4 = (tid & 7) * 4; const LAS float* lh = (const LAS float*)(lds + L_LH) + t * LP + c4;
          const v2u gw = *(const GAS v2u*)(GA + (rbase + t) * DLRU + chb + 32 * q + c4);
          v2u o; o.x = pk2(lh[0] * bf_lo(gw.x), lh[1] * bf_hi(gw.x)); o.y = pk2(lh[2] * bf_lo(gw.y), lh[3] * bf_hi(gw.y));
          *(GAS v2u*)(YAB + (rbase + t) * D + chb + 32 * q + c4) = o; }
    }
    __syncthreads();
}

constexpr int S5_WAVE_LDS = 12800, S5_BU = 0, S5_HS = 8448;
template <bool SAMPLE> __device__ __forceinline__ void s5_task(const Args& args, LAS unsigned char* wl, int lane, int chain, int g) {
    unsigned char* ws = args.ws;
    const bf16* XB = (const bf16*)(ws + WS_XB); bf16* G2 = (bf16*)(ws + WS_G2);
    const int l15 = lane & 15, lq = lane >> 4;
    const f32x2 ab = *(const GAS f32x2*)((const float*)(ws + WS_ABAR) + 2 * (g * SP + lane));
    bf16x8 bfrag[8], cfrag[4];
#pragma unroll
    for (int j = 0; j < 8; ++j) { bfrag[j] = (bf16x8){0, 0, 0, 0, 0, 0, 0, 0}; if (lane < 32) bfrag[j] = *(const GAS bf16x8*)((const bf16*)(ws + WS_BB) + ((size_t)(g * 8 + j) * 64 + lane) * 8); }
#pragma unroll
    for (int kk = 0; kk < 4; ++kk) cfrag[kk] = *(const GAS bf16x8*)((const bf16*)(ws + WS_CC) + ((size_t)(g * 4 + kk) * 64 + lane) * 8);
    const f32x4 dsk = *(const GAS f32x4*)(args.in[I_DSK] + g * SCG + 4 * lq);
    float hr = 0.f, hi = 0.f;
    const int ntile = SAMPLE ? 1 : 32;
    for (int k = 0; k < ntile; ++k) {
        const size_t rbase = SAMPLE ? (size_t)MP + 64 * chain : (size_t)chain * TP + 64 * k;
#pragma unroll 1
        for (int tb = 0; tb < 4; ++tb) {
            const size_t row0 = rbase + 16 * tb;
            bf16x8 a = (bf16x8){0, 0, 0, 0, 0, 0, 0, 0};
            if (lane < 32) a = *(const GAS bf16x8*)(XB + (row0 + l15) * DSSM + g * SCG + 8 * lq);
#pragma unroll
            for (int j = 0; j < 8; ++j) { const pg8::f32x4 c = __builtin_amdgcn_mfma_f32_16x16x32_bf16(a, bfrag[j], (pg8::f32x4){0.f, 0.f, 0.f, 0.f}, 0, 0, 0);
#pragma unroll
                for (int r = 0; r < 4; ++r) ((LAS float*)(wl + S5_BU))[(4 * lq + r) * 132 + 16 * j + l15] = c[r]; }
            LDS_WAIT();
            f32x2 bu[16];
#pragma unroll
            for (int t = 0; t < 16; ++t) bu[t] = *(const LAS f32x2*)(wl + S5_BU + (t * 132 + 2 * lane) * 4);
#pragma unroll
            for (int t = 0; t < 16; ++t) {
                if (SAMPLE && (t & 7) == 0) { const size_t si = ((size_t)(8 * chain + 2 * tb + (t >> 3)) * NGRP + g) * SP + lane; hr = args.in[I_SRE][si]; hi = args.in[I_SIM][si]; }
                const float nr = ab.x * hr - ab.y * hi + bu[t].x, ni = ab.x * hi + ab.y * hr + bu[t].y; hr = nr; hi = ni;
                *(LAS unsigned*)(wl + S5_HS + t * 272 + 4 * lane) = pk2(hr, hi);
                if (SAMPLE && (t & 7) == 7) { const size_t si = ((size_t)(8 * chain + 2 * tb + (t >> 3)) * NGRP + g) * SP + lane; args.out[O_SRE + si] = hr; args.out[O_SIM + si] = hi; }
            }
            LDS_WAIT();
            pg8::f32x4 y = {0.f, 0.f, 0.f, 0.f};
#pragma unroll
            for (int kk = 0; kk < 4; ++kk) { const bf16x8 hb = *(const LAS bf16x8*)(wl + S5_HS + l15 * 272 + kk * 64 + lq * 16);
                y = __builtin_amdgcn_mfma_f32_16x16x32_bf16(cfrag[kk], hb, y, 0, 0, 0); }
            LDS_WAIT();
            const v2u uw = *(const GAS v2u*)(XB + (row0 + l15) * DSSM + g * SCG + 4 * lq);
            const float y0 = y[0] + dsk.x * bf_lo(uw.x), y1 = y[1] + dsk.y * bf_hi(uw.x), y2 = y[2] + dsk.z * bf_lo(uw.y), y3 = y[3] + dsk.w * bf_hi(uw.y);
            v2u o; o.x = pk2(gelu_tanh_f(y0), gelu_tanh_f(y1)); o.y = pk2(gelu_tanh_f(y2), gelu_tanh_f(y3));
            *(GAS v2u*)(G2 + (row0 + l15) * DSSM + g * SCG + 4 * lq) = o;
        }
    }
    if (!SAMPLE) { const size_t si = ((size_t)chain * NGRP + g) * SP + lane; args.out[O_PRE + si] = hr; args.out[O_PIM + si] = hi; }
}

__device__ __forceinline__ void p5_mixer(const Args& args, LAS unsigned char* lds, int tid, int wave, int lane, int bx, int G) {
    { const float* XA = (const float*)(args.ws + WS_XA);
      const int nv = (NP + NS) * 3 * (DLRU / 4);
      for (int i = bx * 512 + tid; i < nv; i += G * 512) { const int c4 = i % (DLRU / 4), rj = i / (DLRU / 4), s = rj / 3, j = rj % 3;
          if (s < NP) *(GAS f32x4*)(args.out + O_PCONV + ((size_t)s * 3 + j) * DLRU + 4 * c4) = *(const GAS f32x4*)(XA + ((size_t)s * TP + TP - 3 + j) * DLRU + 4 * c4);
          else { const int ss = s - NP; *(GAS f32x4*)(args.out + O_SCONV + ((size_t)ss * 3 + j) * DLRU + 4 * c4) = *(const GAS f32x4*)(XA + ((size_t)MP + 8 * ss + 5 + j) * DLRU + 4 * c4); } } }
#if !defined(SKIP_LRU)
    for (int t = bx; t < NP * 64; t += G) lru_task<false>(args, lds, tid, wave, lane, t >> 6, (t >> 2) & 15, t & 3);
    for (int t = bx; t < 16 * 64; t += G) lru_task<true>(args, lds, tid, wave, lane, t >> 6, (t >> 2) & 15, t & 3);
#endif
#if defined(S5_PROBE)
    { const bf16* CCp = (const bf16*)(args.ws + WS_CC); const bf16* BBp = (const bf16*)(args.ws + WS_BB); const float* ABp = (const float*)(args.ws + WS_ABAR); const bf16* XBp = (const bf16*)(args.ws + WS_XB);
      for (int i = bx * 512 + tid; i < 32768; i += G * 512) { float s = 0.f, s2 = 0.f;
          for (int e = 0; e < 8; ++e) { s += __uint_as_float((unsigned)CCp[(size_t)i * 8 + e] << 16); s2 += __uint_as_float((unsigned)BBp[((size_t)(i >> 5) * 64 + (i & 31)) * 8 + e] << 16); }
          args.out[O_PRE + i] = s; args.out[O_PIM + i] = s2; if (i < 16384) args.out[O_SRE + i] = ABp[i]; }
      for (int i = bx * 512 + tid; i < 1048576; i += G * 512) { float s = 0.f; for (int e = 0; e < 18; ++e) s += __uint_as_float((unsigned)XBp[(size_t)i * 18 + e] << 16); args.out[O_SIM + i] = s; } }
#endif
#if !defined(SKIP_S5)
    LAS unsigned char* wl = lds + wave * S5_WAVE_LDS;
    const int gw = bx * NWAVES + wave, ngw = G * NWAVES;
    if (ngw >= 1024) {
        if (gw < NP * NGRP) s5_task<false>(args, wl, lane, gw >> 7, gw & 127);
        else for (int t = gw - NP * NGRP; t < 16 * NGRP; t += ngw - NP * NGRP) s5_task<true>(args, wl, lane, t >> 7, t & 127);
    } else {
        for (int t = gw; t < NP * NGRP; t += ngw) s5_task<false>(args, wl, lane, t >> 7, t & 127);
        for (int t = gw; t < 16 * NGRP; t += ngw) s5_task<true>(args, wl, lane, t >> 7, t & 127);
    }
#endif
    __syncthreads();
}

__global__ void __launch_bounds__(NWAVES * 64, 2) hawk_fwd(Args args) {
    extern __shared__ __attribute__((aligned(16))) unsigned char lds_raw[];
    LAS unsigned char* lds = (LAS unsigned char*)lds_raw;
    volatile LAS unsigned* MISC = (volatile LAS unsigned*)(lds + MISC_OFF);
    const int tid = threadIdx.x, lane = tid & 63, wave = __builtin_amdgcn_readfirstlane(tid >> 6);
    const int G = gridDim.x, bx = blockIdx.x;
    const int gw = bx * NWAVES + wave, ngw = G * NWAVES;
    unsigned char* ws = args.ws;
    gu32* ctl = (gu32*)(ws + WS_CTL);
    for (int u = tid; u < (LDS_BYTES - LDSCTL_OFF) / 4; u += NWAVES * 64) ((LAS unsigned*)(lds + LDSCTL_OFF))[u] = 0u;
#if defined(XCHK) && XCHK
    for (int u = tid; u < RING_BYTES / 4; u += NWAVES * 64) ((LAS unsigned*)lds)[u] = 0xFFFFFFFFu;
#endif
    __syncthreads();
    XcdBarrier bar = xcd_barrier_post((unsigned*)(ctl + CW_BAR) + args.li * XCD_BAR_WORDS, MISC + 8);
    const int lo = args.ph_lo, hi = args.ph_hi;
#ifndef PHMASK
#define PHMASK 0x1fff
#endif
#define IN(k) ((((PHMASK) >> (k)) & 1) && lo <= (k) && (k) < hi)
#define BOTH(k) (IN(k) && IN((k) + 1))
#define SEAM(k) do { if (BOTH(k)) xcd_barrier(bar); } while (0)
    bf16* XN = (bf16*)(ws + WS_XN); bf16* HID = (bf16*)(ws + WS_HID); float* Fb = (float*)(ws + WS_F); bf16* YAB = (bf16*)(ws + WS_YAB);

#if defined(XCHK) && XCHK
    if (lo == 0) {
        GAS v4u* w4 = (GAS v4u*)(ws + 2 * MiB); const size_t n4 = (WS_END - 2 * MiB) / 16; const v4u q = {0xFFFFFFFFu, 0xFFFFFFFFu, 0xFFFFFFFFu, 0xFFFFFFFFu};
        for (size_t i = (size_t)bx * 512 + tid; i < n4; i += (size_t)G * 512) w4[i] = q;
        GAS v4u* o4 = (GAS v4u*)args.out; const size_t m4 = O_END / 4;
        for (size_t i = (size_t)bx * 512 + tid; i < m4; i += (size_t)G * 512) o4[i] = q;
        if (hi > 1) xcd_barrier(bar);
    }
#endif
    if (IN(0)) { p0_prologue(args, lds, wave, lane, gw, ngw); SEAM(0); }
    if (IN(1)) { pg8::Gemm g{XN, (const bf16*)(ws + WS_WGU1), M, 2 * DFF, D, D}; pg8::StaticOrder S; S.init(M, 2 * DFF, D, G, bx);
        pg8::EpiSwiglu E{HID, DFF};
        pg8::gemm_phase<pg8::EpiSwiglu, pg8::StaticOrder, PG8_ALIGN, PG8_SP2>(lds + RING_OFF, g, S, E); SEAM(1); }
    if (IN(2)) { pg8::Gemm g{HID, (const bf16*)(ws + WS_WD1), M, D, DFF, DFF}; pg8::TailOrder S; S.init(D, DFF, G, bx);
        pg8::EpiF32 E{Fb, D, (float*)(ws + WS_SLAB), SLAB_FLOATS, MP};
        pg8::gemm_phase<pg8::EpiF32, pg8::TailOrder, PG8_ALIGN, PG8_SP2>(lds + RING_OFF, g, S, E); SEAM(2); }
    if (IN(3)) { thin_rows<1>(args, gw, ngw, lane); SEAM(3); }
    if (IN(4)) { pg8::Gemm g{XN, (const bf16*)(ws + WS_WIN), M, DIN, D, D}; pg8::StaticOrder S; S.init(M, DIN, D, G, bx);
        pg8::EpiWin E{(float*)(ws + WS_XA), (bf16*)(ws + WS_GA), (bf16*)(ws + WS_XB), (bf16*)(ws + WS_G)};
        pg8::gemm_phase<pg8::EpiWin, pg8::StaticOrder, PG8_ALIGN, PG8_SP2>(lds + RING_OFF, g, S, E); SEAM(4); }
    if (IN(5)) { p5_mixer(args, lds, tid, wave, lane, bx, G); SEAM(5); }
    if (IN(6)) { pg8::Gemm g{(const bf16*)(ws + WS_G2), (const bf16*)(ws + WS_WGLU), M, DSSM, DSSM, DSSM}; pg8::StaticOrder S; S.init(M, DSSM, DSSM, G, bx);
        pg8::EpiGlu E{(const bf16*)(ws + WS_G2), args.in[I_BGLU], YAB + DLRU};
        pg8::gemm_phase<pg8::EpiGlu, pg8::StaticOrder, PG8_ALIGN, PG8_SP2>(lds + RING_OFF, g, S, E); SEAM(6); }
    if (IN(7)) { pg8::Gemm g{YAB, (const bf16*)(ws + WS_WOUT), M, D, D, D}; pg8::SegOrder S; S.init(M, D, D, G, bx);
        pg8::EpiOut E{(const bf16*)(ws + WS_G), XN};
        pg8::gemm_phase<pg8::EpiOut, pg8::SegOrder, PG8_ALIGN, PG8_SP2>(lds + RING_OFF, g, S, E); SEAM(7); }
    if (IN(8)) { pg8::Gemm g{XN, (const bf16*)(ws + WS_WO), M, D, D, D}; pg8::TailOrder S; S.init(D, D, G, bx);
        pg8::EpiF32 E{Fb, D, (float*)(ws + WS_SLAB), SLAB_FLOATS, MP};
        pg8::gemm_phase<pg8::EpiF32, pg8::TailOrder, PG8_ALIGN, PG8_SP2>(lds + RING_OFF, g, S, E); SEAM(8); }
    if (IN(9)) { thin_rows<2>(args, gw, ngw, lane); SEAM(9); }
    if (IN(10)) { pg8::Gemm g{XN, (const bf16*)(ws + WS_WGU2), M, 2 * DFF, D, D}; pg8::StaticOrder S; S.init(M, 2 * DFF, D, G, bx);
        pg8::EpiSwiglu E{HID, DFF};
        pg8::gemm_phase<pg8::EpiSwiglu, pg8::StaticOrder, PG8_ALIGN, PG8_SP2>(lds + RING_OFF, g, S, E); SEAM(10); }
    if (IN(11)) { pg8::Gemm g{HID, (const bf16*)(ws + WS_WD2), M, D, DFF, DFF}; pg8::TailOrder S; S.init(D, DFF, G, bx);
        pg8::EpiF32 E{Fb, D, (float*)(ws + WS_SLAB), SLAB_FLOATS, MP};
        pg8::gemm_phase<pg8::EpiF32, pg8::TailOrder, PG8_ALIGN, PG8_SP2>(lds + RING_OFF, g, S, E); SEAM(11); }
    if (IN(12)) { thin_rows<3>(args, gw, ngw, lane); }
#undef IN
#undef BOTH
#undef SEAM
}

extern "C" void kernel_launch(void* const* d_in, const int* in_sizes, int n_in, void* d_out, int out_size, void* d_ws, size_t ws_size, hipStream_t stream) {
    static int grid = 0;
    if (grid == 0) {
        if (n_in != 39 || in_sizes[0] != MP * D || out_size != (int)O_END || ws_size < WS_END) { fprintf(stderr, "kernel_launch: unexpected shapes (n_in %d, in0 %d, out %d, ws %zu); nothing launched\n", n_in, n_in > 0 ? in_sizes[0] : -1, out_size, ws_size); grid = -1; return; }
        int dev = 0, cus = 0, per_cu = 0;
        if (hipGetDevice(&dev) != hipSuccess || hipDeviceGetAttribute(&cus, hipDeviceAttributeMultiprocessorCount, dev) != hipSuccess) { grid = -1; return; }
        if (hipFuncSetAttribute((const void*)hawk_fwd, hipFuncAttributeMaxDynamicSharedMemorySize, LDS_BYTES) != hipSuccess) { fprintf(stderr, "kernel_launch: hipFuncSetAttribute failed\n"); grid = -1; return; }
        if (hipOccupancyMaxActiveBlocksPerMultiprocessor(&per_cu, (const void*)hawk_fwd, NWAVES * 64, LDS_BYTES) != hipSuccess || per_cu < 1)
            fprintf(stderr, "kernel_launch: note: occupancy query reports %d workgroups per CU\n", per_cu);
        (void)hipGetLastError();
        grid = cus;
    }
    if (grid < 0) return;
    if (hipMemsetAsync((char*)d_ws + WS_CTL, 0, CTL_ZERO_BYTES, stream) != hipSuccess) return;
    Args a{};
    for (int i = 0; i < 39; ++i) a.in[i] = (const float*)d_in[i];
    a.out = (float*)d_out; a.ws = (unsigned char*)d_ws;
    static_assert(N_LAUNCHES == 1 || N_LAUNCHES == N_PHASES, "MK_N_LAUNCHES: 1 or one launch per phase");
    for (int li = 0; li < N_LAUNCHES; ++li) {
        a.ph_lo = (N_LAUNCHES == 1) ? 0 : li; a.ph_hi = (N_LAUNCHES == 1) ? N_PHASES : li + 1; a.li = li; a.pad = 0;
        hipLaunchKernelGGL(hawk_fwd, dim3(grid), dim3(NWAVES * 64), LDS_BYTES, stream, a);
        const hipError_t le = hipPeekAtLastError();
        if (le != hipSuccess) { fprintf(stderr, "kernel_launch: launch %d failed: %s\n", li, hipGetErrorName(le)); break; }
    }
}
```

```cpp
#include <hip/hip_runtime.h>
#include <cstdio>
#include <cstdint>
namespace pg8 {
#define PG8_LAS __attribute__((address_space(3)))
typedef unsigned short bf16_t;
typedef short bf16x8 __attribute__((ext_vector_type(8)));
typedef float f32x4 __attribute__((ext_vector_type(4)));
typedef unsigned u32x4 __attribute__((ext_vector_type(4)));
constexpr int BM = 256, BK = 64, HALF = 128, HTB = HALF * BK * 2  , STAGE_BYTES = 8 * HTB, NXCD = 8, WGM = 8;

__host__ __device__ __forceinline__ int lds_byte(int r, int c) { const int st = (r >> 4) * 2 + (c >> 5), rr = r & 15, cc = c & 31, ob = rr * 64 + cc * 2; return st * 1024 + (ob ^ (((ob >> 9) & 1) << 5)); }
__host__ __device__ __forceinline__ void stage_rc(int b, int& R, int& C) { const int st = b / 1024, sb = b % 1024, swz = sb ^ (((sb >> 9) & 1) << 5); R = (st >> 1) * 16 + swz / 64; C = (st & 1) * 32 + (swz % 64) / 2; }
__host__ __device__ __forceinline__ int perm32(int rho) { const int n = rho >> 4, i = rho & 15; return 8 * (i >> 2) + 4 * n + (i & 3); }

struct Unit { int pm, pn, seg, k0, nt, slab; };
struct Gemm { const bf16_t* A; const bf16_t* Bt; int M, N, K, ld; };

struct StaticOrder {
    int nM, nN, nwg, G, c, ntk;
    __host__ __device__ __forceinline__ void init(int M, int N, int K, int G_, int c_) { nM = M / BM; nN = N / BM; nwg = nM * nN; G = G_; c = c_; ntk = K / BK; }
    __host__ __device__ __forceinline__ bool next(int i, Unit& u) const {
        const long L = (long)i * G + c; if (L >= nwg) return false;
        int wgid = (int)L; { const int q = nwg / NXCD, r = nwg % NXCD, xcd = wgid % NXCD, off = wgid / NXCD; wgid = (xcd < r ? xcd * (q + 1) : r * (q + 1) + (xcd - r) * q) + off; }
        const int nig = WGM * nN, gid = wgid / nig, fm = gid * WGM, gsz = (nM - fm) < WGM ? (nM - fm) : WGM;
        u.pm = fm + ((wgid % nig) % gsz); u.pn = (wgid % nig) / gsz; u.seg = 0; u.k0 = 0; u.nt = ntk; u.slab = 0; return true;
    }
    __device__ __forceinline__ void a_ready(const Unit&) const {}
    __device__ __forceinline__ void done(const Unit&) const {}
};
struct SegOrder : StaticOrder {
    __host__ __device__ __forceinline__ bool next(int i, Unit& u) const { const bool ok = StaticOrder::next(i >> 1, u); u.seg = i & 1; u.nt = ntk >> 1; u.k0 = (i & 1) * (ntk >> 1); return ok; }
};
struct TailOrder {
    StaticOrder base; int c, ntk;
    __host__ __device__ __forceinline__ void init(int N, int K, int G_, int c_) { base.init(32 * BM, N, K, G_, c_); c = c_; ntk = K / BK; }
    __host__ __device__ __forceinline__ bool next(int i, Unit& u) const {
        const bool full = i < 2; Unit b; const bool okb = base.next(full ? i : 0, b);
        const int x = c & 7, j = c >> 3, q = x & 3;
        const int qa = ((ntk >> 2) + 1) & ~1, qb = (ntk - 2 * qa) >> 1;
        u.pm = full ? b.pm : 32 + (j >> 3); u.pn = full ? b.pn : 8 * (x >> 2) + (j & 7); u.seg = 0; u.slab = full ? 0 : q;
        u.k0 = full ? 0 : (q < 2 ? q * qa : 2 * qa + (q - 2) * qb); u.nt = full ? ntk : (q < 2 ? qa : qb);
        return full ? okb : (i == 2 && base.G == 256 && base.nN == 16);
    }
    __device__ __forceinline__ void a_ready(const Unit&) const {}
    __device__ __forceinline__ void done(const Unit&) const {}
};

typedef float cvt_f32x2_t __attribute__((ext_vector_type(2)));
typedef __bf16 cvt_bf16x2_t __attribute__((ext_vector_type(2)));
__device__ __forceinline__ unsigned cvt_pk_bf16(float lo, float hi) { const cvt_f32x2_t v = {lo, hi}; const cvt_bf16x2_t b = __builtin_convertvector(v, cvt_bf16x2_t); return __builtin_bit_cast(unsigned, b); }
typedef float f32x2 __attribute__((ext_vector_type(2)));
__device__ __forceinline__ f32x2 gelu_pk(f32x2 v) {
    const f32x2 av = __builtin_elementwise_abs(v), d = av * 0.2316418882f + 1.0f;
    f32x2 t; t.x = __builtin_amdgcn_rcpf(d.x); t.y = __builtin_amdgcn_rcpf(d.y);
    f32x2 q = t * 0.5307027145f + (-0.7265760135f); q = q * t + 0.7107068705f; q = q * t + (-0.142248368f); q = q * t + 0.127414796f; q = q * t;
    const f32x2 s = (v * v) * (-0.72134752044f);
    f32x2 e; e.x = __builtin_amdgcn_exp2f(s.x); e.y = __builtin_amdgcn_exp2f(s.y);
    const f32x2 m = v * (q * e), r = v - m;
    f32x2 o; o.x = v.x < 0.f ? m.x : r.x; o.y = v.y < 0.f ? m.y : r.y; return o;
}


__device__ __forceinline__ float bf_lo(unsigned w) { return __uint_as_float(w << 16); }
__device__ __forceinline__ float bf_hi(unsigned w) { return __uint_as_float(w & 0xffff0000u); }
__device__ __forceinline__ float fast_sigmoid(float x) { return __builtin_amdgcn_rcpf(1.0f + __builtin_amdgcn_exp2f(-1.4426950408889634f * x)); }
__device__ __forceinline__ float silu_f(float x) { return x * fast_sigmoid(x); }
__device__ __forceinline__ float gelu_tanh_f(float x) { const float z = 1.5957691216057308f * (x + 0.044715f * x * x * x); return x * fast_sigmoid(z); }
__device__ __forceinline__ u32x4 pack8(const f32x4& v0, const f32x4& v1) { u32x4 w; w.x = cvt_pk_bf16(v0[0], v0[1]); w.y = cvt_pk_bf16(v0[2], v0[3]); w.z = cvt_pk_bf16(v1[0], v1[1]); w.w = cvt_pk_bf16(v1[2], v1[3]); return w; }

struct EpiSwiglu {
    static constexpr bool PERM = true, AFTER_DRAIN = false, SEG = false;
    bf16_t* O; int ldc;
    __device__ __forceinline__ void operator()(f32x4 (&acc)[2][2][4][2], const Unit& u, int wr, int wc, int fr, int fq) const {
        const int row0 = u.pm * BM + wr * 64 + fr, col0 = u.pn * HALF + wc * 32 + 8 * fq;
#pragma unroll
        for (int ai = 0; ai < 2; ++ai)
#pragma unroll
            for (int m = 0; m < 4; ++m) { bf16_t* rowp = O + (size_t)(row0 + ai * HALF + m * 16) * ldc + col0;
                f32x4 v0, v1;
#pragma unroll
                for (int j = 0; j < 4; ++j) { v0[j] = silu_f(acc[ai][0][m][0][j]) * acc[ai][1][m][0][j]; v1[j] = silu_f(acc[ai][0][m][1][j]) * acc[ai][1][m][1][j]; }
                *(u32x4*)rowp = pack8(v0, v1); }
    }
};
struct EpiF32 {
    static constexpr bool PERM = true, AFTER_DRAIN = false, SEG = false;
    float* C; int ldc; float* S; size_t slab_stride; int slab_row0;
    __device__ __forceinline__ void operator()(f32x4 (&acc)[2][2][4][2], const Unit& u, int wr, int wc, int fr, int fq) const {
        const int row0 = u.pm * BM + wr * 64 + fr, col0 = u.pn * BM + wc * 32 + 8 * fq;
        float* base = u.slab == 0 ? C : S + (size_t)(u.slab - 1) * slab_stride - (size_t)slab_row0 * ldc;
#pragma unroll
        for (int ai = 0; ai < 2; ++ai)
#pragma unroll
            for (int m = 0; m < 4; ++m) { float* rowp = base + (size_t)(row0 + ai * HALF + m * 16) * ldc + col0;
#pragma unroll
                for (int bj = 0; bj < 2; ++bj)
#pragma unroll
                    for (int n = 0; n < 2; ++n) *(f32x4*)(rowp + bj * HALF + n * 4) = acc[ai][bj][m][n]; }
    }
};
struct EpiWin {
    static constexpr bool PERM = true, AFTER_DRAIN = false, SEG = false;
    float* XA; bf16_t* GA; bf16_t* XB; bf16_t* G;
    __device__ __forceinline__ void operator()(f32x4 (&acc)[2][2][4][2], const Unit& u, int wr, int wc, int fr, int fq) const {
        const int row0 = u.pm * BM + wr * 64 + fr, cw = wc * 32 + 8 * fq;
        if (u.pn < 8) {
            const int col0 = u.pn * BM + cw;
#pragma unroll
            for (int ai = 0; ai < 2; ++ai)
#pragma unroll
                for (int m = 0; m < 4; ++m) { float* rowp = XA + (size_t)(row0 + ai * HALF + m * 16) * 2048 + col0;
#pragma unroll
                    for (int bj = 0; bj < 2; ++bj)
#pragma unroll
                        for (int n = 0; n < 2; ++n) *(f32x4*)(rowp + bj * HALF + n * 4) = acc[ai][bj][m][n]; }
        } else if (u.pn < 16) {
            const int col0 = (u.pn - 8) * BM + cw;
#pragma unroll
            for (int ai = 0; ai < 2; ++ai)
#pragma unroll
                for (int m = 0; m < 4; ++m) { bf16_t* rowp = GA + (size_t)(row0 + ai * HALF + m * 16) * 2048 + col0;
#pragma unroll
                    for (int bj = 0; bj < 2; ++bj) { f32x4 v0, v1;
#pragma unroll
                        for (int j = 0; j < 4; ++j) { v0[j] = gelu_tanh_f(acc[ai][bj][m][0][j]); v1[j] = gelu_tanh_f(acc[ai][bj][m][1][j]); }
                        *(u32x4*)(rowp + bj * HALF) = pack8(v0, v1); } }
        } else if (u.pn < 24) {
            const int col0 = (u.pn - 16) * BM + cw;
#pragma unroll
            for (int ai = 0; ai < 2; ++ai)
#pragma unroll
                for (int m = 0; m < 4; ++m) { bf16_t* rowp = XB + (size_t)(row0 + ai * HALF + m * 16) * 2048 + col0;
#pragma unroll
                    for (int bj = 0; bj < 2; ++bj) *(u32x4*)(rowp + bj * HALF) = pack8(acc[ai][bj][m][0], acc[ai][bj][m][1]); }
        } else {
            const int col0 = (u.pn - 24) * BM + cw;
#pragma unroll
            for (int ai = 0; ai < 2; ++ai)
#pragma unroll
                for (int m = 0; m < 4; ++m) { bf16_t* rowp = G + (size_t)(row0 + ai * HALF + m * 16) * 8192 + col0;
#pragma unroll
                    for (int bj = 0; bj < 2; ++bj) { f32x4 v0, v1;
#pragma unroll
                        for (int j = 0; j < 4; ++j) { v0[j] = fast_sigmoid(acc[ai][bj][m][0][j]); v1[j] = fast_sigmoid(acc[ai][bj][m][1][j]); }
                        *(u32x4*)(rowp + bj * HALF) = pack8(v0, v1); } }
        }
    }
};
struct EpiGlu {
    static constexpr bool PERM = true, AFTER_DRAIN = false, SEG = false;
    const bf16_t* G2; const float* bias; bf16_t* O;
    __device__ __forceinline__ void operator()(f32x4 (&acc)[2][2][4][2], const Unit& u, int wr, int wc, int fr, int fq) const {
        const int row0 = u.pm * BM + wr * 64 + fr, col0 = u.pn * BM + wc * 32 + 8 * fq;
        f32x4 bv[2][2];
#pragma unroll
        for (int bj = 0; bj < 2; ++bj)
#pragma unroll
            for (int n = 0; n < 2; ++n) bv[bj][n] = *(const f32x4*)(bias + col0 + bj * HALF + 4 * n);
#pragma unroll
        for (int ai = 0; ai < 2; ++ai)
#pragma unroll
            for (int m = 0; m < 4; ++m) { const size_t r = (size_t)(row0 + ai * HALF + m * 16);
#pragma unroll
                for (int bj = 0; bj < 2; ++bj) { const u32x4 gw = *(const u32x4*)(G2 + r * 2048 + col0 + bj * HALF);
                    const f32x4 a0 = acc[ai][bj][m][0] + bv[bj][0], a1 = acc[ai][bj][m][1] + bv[bj][1]; f32x4 v0, v1;
                    v0[0] = bf_lo(gw.x) * fast_sigmoid(a0[0]); v0[1] = bf_hi(gw.x) * fast_sigmoid(a0[1]); v0[2] = bf_lo(gw.y) * fast_sigmoid(a0[2]); v0[3] = bf_hi(gw.y) * fast_sigmoid(a0[3]);
                    v1[0] = bf_lo(gw.z) * fast_sigmoid(a1[0]); v1[1] = bf_hi(gw.z) * fast_sigmoid(a1[1]); v1[2] = bf_lo(gw.w) * fast_sigmoid(a1[2]); v1[3] = bf_hi(gw.w) * fast_sigmoid(a1[3]);
                    *(u32x4*)(O + r * 4096 + col0 + bj * HALF) = pack8(v0, v1); } }
    }
};
struct EpiOut {
    static constexpr bool PERM = true, AFTER_DRAIN = false, SEG = true;
    const bf16_t* G; bf16_t* O;
    __device__ __forceinline__ void seg0(f32x4 (&acc)[2][2][4][2], const Unit& u, int wr, int wc, int fr, int fq) const {
        const int row0 = u.pm * BM + wr * 64 + fr, col0 = u.pn * BM + wc * 32 + 8 * fq;
#pragma unroll
        for (int ai = 0; ai < 2; ++ai)
#pragma unroll
            for (int m = 0; m < 4; ++m) { const bf16_t* gp = G + (size_t)(row0 + ai * HALF + m * 16) * 8192 + col0;
#pragma unroll
                for (int bj = 0; bj < 2; ++bj) { const u32x4 a = *(const u32x4*)(gp + bj * HALF), b = *(const u32x4*)(gp + 4096 + bj * HALF);
                    f32x4 r0, r1;
                    r0[0] = bf_lo(a.x) * __builtin_amdgcn_rcpf(fmaxf(bf_lo(b.x), 1e-30f)); r0[1] = bf_hi(a.x) * __builtin_amdgcn_rcpf(fmaxf(bf_hi(b.x), 1e-30f));
                    r0[2] = bf_lo(a.y) * __builtin_amdgcn_rcpf(fmaxf(bf_lo(b.y), 1e-30f)); r0[3] = bf_hi(a.y) * __builtin_amdgcn_rcpf(fmaxf(bf_hi(b.y), 1e-30f));
                    r1[0] = bf_lo(a.z) * __builtin_amdgcn_rcpf(fmaxf(bf_lo(b.z), 1e-30f)); r1[1] = bf_hi(a.z) * __builtin_amdgcn_rcpf(fmaxf(bf_hi(b.z), 1e-30f));
                    r1[2] = bf_lo(a.w) * __builtin_amdgcn_rcpf(fmaxf(bf_lo(b.w), 1e-30f)); r1[3] = bf_hi(a.w) * __builtin_amdgcn_rcpf(fmaxf(bf_hi(b.w), 1e-30f));
                    acc[ai][bj][m][0] = acc[ai][bj][m][0] * r0; acc[ai][bj][m][1] = acc[ai][bj][m][1] * r1; }
                asm volatile("" ::: "memory"); }
    }
    __device__ __forceinline__ void operator()(f32x4 (&acc)[2][2][4][2], const Unit& u, int wr, int wc, int fr, int fq) const { if (u.seg == 0) seg0(acc, u, wr, wc, fr, fq); else seg1(acc, u, wr, wc, fr, fq); }
    __device__ __forceinline__ void seg1(const f32x4 (&acc)[2][2][4][2], const Unit& u, int wr, int wc, int fr, int fq) const {
        const int row0 = u.pm * BM + wr * 64 + fr, col0 = u.pn * BM + wc * 32 + 8 * fq;
#pragma unroll
        for (int ai = 0; ai < 2; ++ai)
#pragma unroll
            for (int m = 0; m < 4; ++m) { const size_t r = (size_t)(row0 + ai * HALF + m * 16);
#pragma unroll
                for (int bj = 0; bj < 2; ++bj) { const u32x4 b = *(const u32x4*)(G + r * 8192 + 4096 + col0 + bj * HALF);
                    f32x4 g0, g1;
                    g0[0] = fmaxf(bf_lo(b.x), 1e-30f); g0[1] = fmaxf(bf_hi(b.x), 1e-30f); g0[2] = fmaxf(bf_lo(b.y), 1e-30f); g0[3] = fmaxf(bf_hi(b.y), 1e-30f);
                    g1[0] = fmaxf(bf_lo(b.z), 1e-30f); g1[1] = fmaxf(bf_hi(b.z), 1e-30f); g1[2] = fmaxf(bf_lo(b.w), 1e-30f); g1[3] = fmaxf(bf_hi(b.w), 1e-30f);
                    *(u32x4*)(O + r * 4096 + col0 + bj * HALF) = pack8(acc[ai][bj][m][0] * g0, acc[ai][bj][m][1] * g1); } }
    }
};

template <class Epi, class Sched, bool ALIGN_EPI = false, bool SP2 = false>
__device__ __forceinline__ void gemm_phase(PG8_LAS unsigned char* lds, const Gemm g, const Sched& S, const Epi& E) {
    const int tid = threadIdx.x, wid = __builtin_amdgcn_readfirstlane(tid >> 6), lane = tid & 63, wr = wid >> 2, wc = wid & 3, fr = lane & 15, fq = lane >> 4;
    const int LD = g.ld;
    unsigned voffA[2], voffB[2];
#pragma unroll
    for (int i = 0; i < 2; ++i) { int R, C; stage_rc(tid * 16 + i * 8192, R, C); const int Rb = Epi::PERM ? ((R & ~31) + perm32(R & 31)) : R;
        voffA[i] = (unsigned)(R * LD + C) * 2u; voffB[i] = (unsigned)(Rb * LD + C) * 2u; }
    const size_t kstep = (size_t)(BK * 2);
    const size_t hstep = (size_t)HALF * LD * 2;
    const size_t tstep = 2 * hstep;
    const unsigned ldsw = (unsigned)wid * 1024u;
    const int aoff = lds_byte(wr * 64 + fr, fq * 8), boff = lds_byte(wc * 32 + fr, fq * 8);
#define PG8_SA(b, h) (((b) * 2 + (h)) * HTB)
#define PG8_SB(b, h) ((4 + (b) * 2 + (h)) * HTB)
#define PG8_STAGE(bufoff, gbase, voff) do { _Pragma("unroll") for (int _i = 0; _i < 2; ++_i) \
        __builtin_amdgcn_global_load_lds((const unsigned*)((const char*)(gbase) + (voff)[_i]), (PG8_LAS unsigned*)(lds + (bufoff) + ldsw + _i * 8192), 16, 0, 0); } while (0)
#define PG8_LDA(dst, b, h) do { _Pragma("unroll") for (int m = 0; m < 4; ++m) _Pragma("unroll") for (int k = 0; k < 2; ++k) dst[m][k] = *(const PG8_LAS bf16x8*)(lds + PG8_SA(b, h) + aoff + m * 2048 + k * 1024); } while (0)
#define PG8_LDB(dst, b, h) do { _Pragma("unroll") for (int n = 0; n < 2; ++n) _Pragma("unroll") for (int k = 0; k < 2; ++k) dst[n][k] = *(const PG8_LAS bf16x8*)(lds + PG8_SB(b, h) + boff + n * 2048 + k * 1024); } while (0)
#define PG8_MMA(ai, bj, At, Bt) do { __builtin_amdgcn_s_setprio(1); _Pragma("unroll") for (int m = 0; m < 4; ++m) _Pragma("unroll") for (int n = 0; n < 2; ++n) _Pragma("unroll") for (int k = 0; k < 2; ++k) \
        acc[ai][bj][m][n] = __builtin_amdgcn_mfma_f32_16x16x32_bf16(Bt[n][k], At[m][k], acc[ai][bj][m][n], 0, 0, 0); __builtin_amdgcn_s_setprio(0); } while (0)
#define PG8_WAIT_V(n) asm volatile("s_waitcnt vmcnt(" #n ")" ::: "memory")
#define PG8_WAIT_L(n) asm volatile("s_waitcnt lgkmcnt(" #n ")" ::: "memory")
#define PG8_BAR __builtin_amdgcn_s_barrier()
#define PG8_SCHED __builtin_amdgcn_sched_barrier(0)
    Unit cur, nxt; int ui = 0;
    if (!S.next(0, cur)) return;
    f32x4 acc[2][2][4][2];
#pragma unroll
    for (int a = 0; a < 2; ++a)
#pragma unroll
        for (int b = 0; b < 2; ++b)
#pragma unroll
            for (int m = 0; m < 4; ++m)
#pragma unroll
                for (int n = 0; n < 2; ++n) acc[a][b][m][n] = (f32x4){0.f, 0.f, 0.f, 0.f};
    bf16x8 At[4][2], B0[2][2], B1[2][2];
    const char* cA = (const char*)g.A + (size_t)cur.pm * tstep + (size_t)cur.k0 * kstep; const char* cB = (const char*)g.Bt + (size_t)cur.pn * tstep + (size_t)cur.k0 * kstep;
    S.a_ready(cur);
    if constexpr (SP2) {
        PG8_STAGE(PG8_SB(0, 0), cB, voffB); PG8_STAGE(PG8_SB(0, 1), cB + hstep, voffB); PG8_STAGE(PG8_SA(0, 0), cA, voffA); PG8_STAGE(PG8_SA(0, 1), cA + hstep, voffA);
        if (wr == 1) PG8_BAR;
        PG8_WAIT_V(2); PG8_BAR;
        PG8_STAGE(PG8_SB(1, 0), cB + kstep, voffB); PG8_STAGE(PG8_SA(1, 0), cA + kstep, voffA); PG8_STAGE(PG8_SB(1, 1), cB + hstep + kstep, voffB);
        PG8_WAIT_V(6); PG8_BAR;
    } else {
        PG8_STAGE(PG8_SB(0, 0), cB, voffB); PG8_STAGE(PG8_SA(0, 0), cA, voffA); PG8_STAGE(PG8_SB(0, 1), cB + hstep, voffB); PG8_STAGE(PG8_SA(0, 1), cA + hstep, voffA);
        if (wr == 1) PG8_BAR;
        PG8_WAIT_V(4); PG8_BAR;
        PG8_STAGE(PG8_SB(1, 0), cB + kstep, voffB); PG8_STAGE(PG8_SA(1, 0), cA + kstep, voffA); PG8_STAGE(PG8_SB(1, 1), cB + hstep + kstep, voffB);
        PG8_WAIT_V(6); PG8_BAR;
    }
    for (;;) {
        const bool has_next = S.next(ui + 1, nxt);
        const char* nA = has_next ? (const char*)g.A + (size_t)nxt.pm * tstep + (size_t)nxt.k0 * kstep : cA; const char* nB = has_next ? (const char*)g.Bt + (size_t)nxt.pn * tstep + (size_t)nxt.k0 * kstep : cB;
        const int nt = cur.nt;
        for (int t = 0; t < nt; t += 2) {
            const bool last = (t == nt - 2);
            const char* a1 = cA + (size_t)(t + 1) * kstep;
            const char* a2 = last ? nA : cA + (size_t)(t + 2) * kstep; const char* b2 = last ? nB : cB + (size_t)(t + 2) * kstep;
            const char* a3 = a2 + kstep; const char* b3 = b2 + kstep;
            if (last && has_next) S.a_ready(nxt);
            if constexpr (SP2) {
            PG8_LDB(B0, 0, 0); PG8_LDB(B1, 0, 1); PG8_SCHED; PG8_LDA(At, 0, 0); PG8_STAGE(PG8_SA(1, 1), a1 + hstep, voffA);
            PG8_WAIT_V(8); PG8_WAIT_L(0); PG8_BAR; PG8_MMA(0, 0, At, B0); PG8_MMA(0, 1, At, B1); PG8_BAR; PG8_SCHED;
            PG8_LDA(At, 0, 1); PG8_STAGE(PG8_SB(0, 0), b2, voffB); PG8_STAGE(PG8_SB(0, 1), b2 + hstep, voffB); PG8_STAGE(PG8_SA(0, 0), a2, voffA);
            PG8_WAIT_V(8); PG8_WAIT_L(0); PG8_BAR; PG8_MMA(1, 0, At, B0); PG8_MMA(1, 1, At, B1); PG8_BAR; PG8_SCHED;
            PG8_LDB(B0, 1, 0); PG8_LDB(B1, 1, 1); PG8_SCHED; PG8_LDA(At, 1, 0); PG8_STAGE(PG8_SA(0, 1), a2 + hstep, voffA);
            PG8_WAIT_V(8); PG8_WAIT_L(0); PG8_BAR; PG8_MMA(0, 0, At, B0); PG8_MMA(0, 1, At, B1); PG8_BAR; PG8_SCHED;
            PG8_LDA(At, 1, 1); PG8_STAGE(PG8_SB(1, 0), b3, voffB); PG8_STAGE(PG8_SB(1, 1), b3 + hstep, voffB); PG8_STAGE(PG8_SA(1, 0), a3, voffA);
            PG8_WAIT_V(8); PG8_WAIT_L(0); PG8_BAR; PG8_MMA(1, 0, At, B0); PG8_MMA(1, 1, At, B1); PG8_BAR; PG8_SCHED;
            } else {
            PG8_LDB(B0, 0, 0); PG8_SCHED; PG8_LDA(At, 0, 0); PG8_STAGE(PG8_SA(1, 1), a1 + hstep, voffA);
            PG8_WAIT_L(8); PG8_BAR; PG8_WAIT_L(0); PG8_MMA(0, 0, At, B0); PG8_BAR; PG8_SCHED;
            PG8_LDB(B1, 0, 1); PG8_STAGE(PG8_SB(0, 0), b2, voffB);
            PG8_BAR; PG8_WAIT_L(0); PG8_MMA(0, 1, At, B1); PG8_BAR;
            PG8_LDA(At, 0, 1); PG8_STAGE(PG8_SA(0, 0), a2, voffA);
            PG8_BAR; PG8_WAIT_L(0); PG8_MMA(1, 0, At, B0); PG8_BAR; PG8_SCHED;
            PG8_STAGE(PG8_SB(0, 1), b2 + hstep, voffB);
            PG8_WAIT_V(6); PG8_BAR; PG8_MMA(1, 1, At, B1); PG8_BAR;
            PG8_LDB(B0, 1, 0); PG8_SCHED; PG8_LDA(At, 1, 0); PG8_STAGE(PG8_SA(0, 1), a2 + hstep, voffA);
            PG8_WAIT_L(8); PG8_BAR; PG8_WAIT_L(0); PG8_MMA(0, 0, At, B0); PG8_BAR; PG8_SCHED;
            PG8_LDB(B1, 1, 1); PG8_STAGE(PG8_SB(1, 0), b3, voffB);
            PG8_BAR; PG8_WAIT_L(0); PG8_MMA(0, 1, At, B1); PG8_BAR;
            PG8_LDA(At, 1, 1); PG8_STAGE(PG8_SA(1, 0), a3, voffA);
            PG8_BAR; PG8_WAIT_L(0); PG8_MMA(1, 0, At, B0); PG8_BAR; PG8_SCHED;
            PG8_STAGE(PG8_SB(1, 1), b3 + hstep, voffB);
            PG8_WAIT_V(6); PG8_BAR; PG8_MMA(1, 1, At, B1); PG8_BAR;
            }
        }
        if constexpr (ALIGN_EPI) { if (wr == 0) PG8_BAR; }
        if constexpr (!Epi::AFTER_DRAIN) { E(acc, cur, wr, wc, fr, fq); S.done(cur); }
        if (!has_next) break;
        if (!Epi::SEG || nxt.seg == 0) {
#pragma unroll
        for (int a = 0; a < 2; ++a)
#pragma unroll
            for (int b = 0; b < 2; ++b)
#pragma unroll
                for (int m = 0; m < 4; ++m)
#pragma unroll
                    for (int n = 0; n < 2; ++n) acc[a][b][m][n] = (f32x4){0.f, 0.f, 0.f, 0.f};
        }
        cur = nxt; cA = nA; cB = nB; ++ui;
        if constexpr (ALIGN_EPI) { if (wr == 1) PG8_BAR; }
    }
    PG8_WAIT_V(0);
    if constexpr (!ALIGN_EPI) { if (wr == 0) PG8_BAR; }
    PG8_BAR;
    if constexpr (Epi::AFTER_DRAIN) { E.fused(acc, cur, wr, wc, fr, fq, lds, wid, lane); S.done(cur); }
#undef PG8_SA
#undef PG8_SB
#undef PG8_STAGE
#undef PG8_LDA
#undef PG8_LDB
#undef PG8_MMA
#undef PG8_WAIT_V
#undef PG8_WAIT_L
#undef PG8_BAR
#undef PG8_SCHED
}
}

#ifndef PG8_SP2
#define PG8_SP2 true
#endif
#ifndef PG8_ALIGN
#define PG8_ALIGN true
#endif

constexpr int NWAVES = 8;
#ifndef MK_N_LAUNCHES
#define MK_N_LAUNCHES 1
#endif
constexpr int N_PHASES = 13;
constexpr int N_LAUNCHES = MK_N_LAUNCHES;

constexpr int D = 4096, DFF = 11008, DLRU = 2048, DSSM = 2048, DIN = 14336;
constexpr int NP = 4, TP = 2048, NS = 128, TS = 8;
constexpr int MP = NP * TP, MS = NS * TS, M = MP + MS;
constexpr int NGRP = 128, SP = 64, SCG = 16;
constexpr float EPS = 1e-6f;

constexpr size_t MiB = 1u << 20;
constexpr size_t WS_CTL = 0, CTL_ZERO_BYTES = 1 * MiB;
constexpr size_t WS_ABAR = 2 * MiB;
constexpr size_t WS_BB = 3 * MiB;
constexpr size_t WS_CC = 4 * MiB;
constexpr size_t WS_WG = 5 * MiB;
constexpr size_t WS_WGU1 = 8 * MiB, WS_WD1 = 180 * MiB, WS_WIN = 266 * MiB, WS_WGLU = 378 * MiB, WS_WOUT = 386 * MiB, WS_WO = 418 * MiB, WS_WGU2 = 450 * MiB, WS_WD2 = 622 * MiB;
constexpr size_t WS_XN = 708 * MiB;
constexpr size_t WS_HID = 780 * MiB;
constexpr size_t WS_XA = WS_HID, WS_GA = WS_HID + 72 * MiB, WS_XB = WS_HID + 108 * MiB, WS_G2 = WS_HID + 144 * MiB;
constexpr size_t WS_F = 974 * MiB;
constexpr size_t WS_G = WS_F;
constexpr size_t WS_YAB = 1118 * MiB, WS_END = 1190 * MiB;
constexpr size_t WS_SLAB = WS_YAB, SLAB_FLOATS = (size_t)MS * D;
static_assert(3 * SLAB_FLOATS * 4 <= (size_t)M * D * 2, "slabs inside YAB");
static_assert(WS_WGU1 + (size_t)2 * DFF * D * 2 <= WS_WD1 && WS_WD1 + (size_t)D * DFF * 2 <= WS_WIN && WS_WIN + (size_t)DIN * D * 2 <= WS_WGLU && WS_WGLU + (size_t)DSSM * DSSM * 2 <= WS_WOUT, "ws map 1");
static_assert(WS_WOUT + (size_t)D * D * 2 <= WS_WO && WS_WO + (size_t)D * D * 2 <= WS_WGU2 && WS_WGU2 + (size_t)2 * DFF * D * 2 <= WS_WD2 && WS_WD2 + (size_t)D * DFF * 2 <= WS_XN, "ws map 2");
static_assert(WS_XN + (size_t)M * D * 2 <= WS_HID && WS_HID + (size_t)M * DFF * 2 <= WS_F && WS_G2 + (size_t)M * DSSM * 2 <= WS_F && WS_F + (size_t)M * D * 4 <= WS_YAB && WS_YAB + (size_t)M * D * 2 <= WS_END, "ws map 3");
constexpr int CW_TMO = 0, CW_CODE = 1;
constexpr int CW_BAR = 4096;

constexpr int RING_OFF = 0, RING_BYTES = 131072;
constexpr int LDSCTL_OFF = RING_BYTES, MISC_OFF = LDSCTL_OFF + 320;
constexpr int LDS_BYTES = 147456;
static_assert(MISC_OFF + 128 <= LDS_BYTES, "LDS map");

#define GAS __attribute__((address_space(1)))
#define LAS __attribute__((address_space(3)))
typedef unsigned short bf16;
typedef unsigned v4u __attribute__((ext_vector_type(4)));
typedef unsigned v2u __attribute__((ext_vector_type(2)));
typedef float f32x4 __attribute__((ext_vector_type(4)));
typedef float f32x2 __attribute__((ext_vector_type(2)));
typedef short bf16x8 __attribute__((ext_vector_type(8)));
typedef GAS unsigned gu32;
typedef GAS unsigned long long gu64;
#define RLX_AGENT __ATOMIC_RELAXED, __HIP_MEMORY_SCOPE_AGENT
#define LDS_WAIT() asm volatile("s_waitcnt lgkmcnt(0)" ::: "memory")
#define VM_WAIT() asm volatile("s_waitcnt vmcnt(0)" ::: "memory")
__device__ __forceinline__ unsigned f2bf(float f) { unsigned u = __builtin_bit_cast(unsigned, f); return (u + 0x7fffu + ((u >> 16) & 1u)) >> 16; }
__device__ __forceinline__ unsigned pk2(float lo, float hi) { return pg8::cvt_pk_bf16(lo, hi); }
using pg8::bf_lo; using pg8::bf_hi; using pg8::fast_sigmoid; using pg8::gelu_tanh_f;
#define XB_TMO      128
#define XB_XCNT(j)  (256  + 64 * (j))
#define XB_XSUB(j)  (1280 + 64 * (j))
#define XB_XGEN(j)  (2304 + 64 * (j))
#define XB_TOP      3328
#define XB_TOPGEN   3392
#define XCD_BAR_WORDS 3456
#define XB_SPIN_CAP (1u << 18)

__device__ __forceinline__ unsigned xb_ld(unsigned* p)              { return __hip_atomic_load(p, __ATOMIC_RELAXED, __HIP_MEMORY_SCOPE_AGENT); }
__device__ __forceinline__ unsigned xb_add(unsigned* p, unsigned v) { return __hip_atomic_fetch_add(p, v, __ATOMIC_RELAXED, __HIP_MEMORY_SCOPE_AGENT); }
__device__ __forceinline__ unsigned xb_xcc_id() { return (unsigned)__builtin_amdgcn_s_getreg((3 << 11) | 20) & 0xFu; }
#define XB_SPIN(cond, bar) do { unsigned _sp = 0; while (cond) { __builtin_amdgcn_s_sleep(1); \
    if ((++_sp & 255u) == 0u) { if (xb_ld(&(bar)[XB_TMO])) break; if (_sp > XB_SPIN_CAP) { atomicAdd(&(bar)[XB_TMO], 1u); break; } } } } while (0)

struct XcdBarrier {
    unsigned* bar; unsigned x;
    volatile LAS unsigned* st;
};

__device__ __forceinline__ XcdBarrier xcd_barrier_post(unsigned* bar, volatile LAS unsigned* st) {
    XcdBarrier b; b.bar = bar; b.x = xb_xcc_id(); b.st = st;
    if (threadIdx.x == 0) (void)xb_add(&bar[XB_XCNT(b.x)], 1u);
    return b;
}
__device__ __forceinline__ void xcd_barrier_complete(unsigned* bar, unsigned x, unsigned& nloc, unsigned& nx) {
    const unsigned G = gridDim.x * gridDim.y * gridDim.z;
    unsigned sum, cnt, mine, sp = 0u;
    for (;;) {
        sum = 0u; cnt = 0u; mine = 0u;
#pragma unroll
        for (unsigned j = 0; j < 16; ++j) { const unsigned c = xb_ld(&bar[XB_XCNT(j)]); sum += c; cnt += (c > 0u) ? 1u : 0u; mine = (j == x) ? c : mine; }
        if (sum == G) break;
        __builtin_amdgcn_s_sleep(1);
        if ((++sp & 255u) == 0u) { if (xb_ld(&bar[XB_TMO])) break; if (sp > XB_SPIN_CAP) { atomicAdd(&bar[XB_TMO], 1u); break; } }
    }
    nloc = mine > 0u ? mine : 1u; nx = cnt > 0u ? cnt : 1u;
}

__device__ __forceinline__ void xcd_barrier(const XcdBarrier& b) {
    asm volatile("s_waitcnt vmcnt(0)" ::: "memory");
    __syncthreads();
    if (threadIdx.x == 0) {
        unsigned* bar = b.bar;
        __builtin_amdgcn_s_waitcnt(0);
        unsigned nloc = b.st[0], nx = b.st[1];
        if (nloc == 0u) { xcd_barrier_complete(bar, b.x, nloc, nx); b.st[0] = nloc; b.st[1] = nx; }
        const unsigned old = xb_add(&bar[XB_XSUB(b.x)], 1u);
        const unsigned gen = old / nloc;
        if (old + 1u == (gen + 1u) * nloc) {
            __builtin_amdgcn_fence(__ATOMIC_RELEASE, "agent");
            asm volatile("s_waitcnt vmcnt(0)" ::: "memory");
            const unsigned og = xb_add(&bar[XB_TOP], 1u);
            const unsigned tg = og / nx;
            if (og + 1u == (tg + 1u) * nx) xb_add(&bar[XB_TOPGEN], 1u);
            else XB_SPIN(xb_ld(&bar[XB_TOPGEN]) == tg, bar);
            __builtin_amdgcn_fence(__ATOMIC_ACQUIRE, "agent");
            xb_add(&bar[XB_XGEN(b.x)], 1u);
            asm volatile("s_waitcnt vmcnt(0)" ::: "memory");
        } else {
            XB_SPIN(xb_ld(&bar[XB_XGEN(b.x)]) == gen, bar);
            __builtin_amdgcn_fence(__ATOMIC_ACQUIRE, "agent");
            asm volatile("s_waitcnt vmcnt(0)" ::: "memory");
        }
    }
    __syncthreads();
}

__device__ __forceinline__ float wave_sum(float v) {
#pragma unroll
    for (int o = 1; o < 64; o <<= 1) v += __shfl_xor(v, o);
    return v;
}
constexpr size_t O_Y = 0, O_PLRU = (size_t)M * D, O_PCONV = O_PLRU + NP * DLRU, O_PRE = O_PCONV + NP * 3 * DLRU, O_PIM = O_PRE + NP * NGRP * SP, O_SLRU = O_PIM + NP * NGRP * SP,
                 O_SCONV = O_SLRU + NS * DLRU, O_SRE = O_SCONV + NS * 3 * DLRU, O_SIM = O_SRE + NS * NGRP * SP, O_END = O_SIM + NS * NGRP * SP;
static_assert(O_END == 40992768, "output size");

struct Args { const float* in[39]; float* out; unsigned char* ws; int ph_lo, ph_hi, li, pad; };
enum { I_XP = 0, I_XS, I_SLRU, I_SCONV, I_SRE, I_SIM, I_F1PRE, I_F1POST, I_F1G, I_F1U, I_F1D, I_MPRE, I_MPOST, I_WIN, I_CONVW, I_CONVB, I_WRG, I_BRG, I_WIG, I_BIG, I_LAM,
       I_ARE, I_AIM, I_LDT, I_BRE, I_BIM, I_CRE, I_CIM, I_DSK, I_WGLU, I_BGLU, I_WOA, I_WOB, I_WO, I_F2PRE, I_F2POST, I_F2G, I_F2U, I_F2D };

__device__ __forceinline__ void transpose_item(const float* W, int N, bf16* WT, int pitch, int k0, int n0, int drow, int dcol, LAS float* scr, int lane) {
#pragma unroll 8
    for (int i = 0; i < 32; ++i) { const int kk = 2 * i + (lane >> 5); scr[kk * 33 + (lane & 31)] = W[(size_t)(k0 + kk) * N + n0 + (lane & 31)]; }
    LDS_WAIT(); asm volatile("" ::: "memory");
    const int c = lane & 7;
#pragma unroll
    for (int j = 0; j < 4; ++j) { const int n = (lane >> 3) + 8 * j; const LAS float* s = scr + (8 * c) * 33 + n;
        v4u o; o.x = pk2(s[0 * 33], s[1 * 33]); o.y = pk2(s[2 * 33], s[3 * 33]); o.z = pk2(s[4 * 33], s[5 * 33]); o.w = pk2(s[6 * 33], s[7 * 33]);
        *(GAS v4u*)(WT + (size_t)(drow + n) * pitch + dcol + k0 + 8 * c) = o; }
    LDS_WAIT(); asm volatile("" ::: "memory");
}
__device__ __forceinline__ void tr_plain(const float* W, int K, int N, bf16* WT, int pitch, int dcol, int item, LAS float* scr, int lane) {
    const int nblk = N / 32, kb = item / nblk, nb = item - kb * nblk; (void)K;
    transpose_item(W, N, WT, pitch, 64 * kb, 32 * nb, 32 * nb, dcol, scr, lane);
}
__device__ __forceinline__ void tr_gu(const float* W, bf16* WT, int up, int item, LAS float* scr, int lane) {
    const int nblk = DFF / 32, kb = item / nblk, nb = item - kb * nblk, n0 = 32 * nb;
    transpose_item(W, DFF, WT, D, 64 * kb, n0, 256 * (n0 >> 7) + up * 128 + (n0 & 127), 0, scr, lane);
}
constexpr int IT_GU = (D / 64) * (DFF / 32), IT_DN = (DFF / 64) * (D / 32), IT_IN = (D / 64) * (DIN / 32), IT_GLU = (DSSM / 64) * (DSSM / 32), IT_OA = (DLRU / 64) * (D / 32), IT_WO = (D / 64) * (D / 32), IT_RG = 16 * 2 * 4;
constexpr int IT_TOTAL = 4 * IT_GU + 2 * IT_DN + IT_IN + IT_GLU + 2 * IT_OA + IT_WO + 2 * IT_RG;

template <int MODE> __device__ __forceinline__ void thin_rows(const Args& args, int gw, int ngw, int lane);

constexpr int ITB_GU1 = 0, ITB_DN1 = ITB_GU1 + 2 * IT_GU, ITB_IN = ITB_DN1 + IT_DN, ITB_GLU = ITB_IN + IT_IN, ITB_OA = ITB_GLU + IT_GLU, ITB_OB = ITB_OA + IT_OA, ITB_WO = ITB_OB + IT_OA,
              ITB_GU2 = ITB_WO + IT_WO, ITB_DN2 = ITB_GU2 + 2 * IT_GU, ITB_RG = ITB_DN2 + IT_DN, ITB_END = ITB_RG + 2 * IT_RG;
static_assert(ITB_END == IT_TOTAL, "item numbering");
__device__ __forceinline__ void convert_item(const Args& args, int it, LAS float* scr, int lane) {
    unsigned char* ws = args.ws; int r = it;
    if (r < IT_GU) { tr_gu(args.in[I_F1G], (bf16*)(ws + WS_WGU1), 0, r, scr, lane); return; } r -= IT_GU;
    if (r < IT_GU) { tr_gu(args.in[I_F1U], (bf16*)(ws + WS_WGU1), 1, r, scr, lane); return; } r -= IT_GU;
    if (r < IT_DN) { tr_plain(args.in[I_F1D], DFF, D, (bf16*)(ws + WS_WD1), DFF, 0, r, scr, lane); return; } r -= IT_DN;
    if (r < IT_IN) { tr_plain(args.in[I_WIN], D, DIN, (bf16*)(ws + WS_WIN), D, 0, r, scr, lane); return; } r -= IT_IN;
    if (r < IT_GLU) { tr_plain(args.in[I_WGLU], DSSM, DSSM, (bf16*)(ws + WS_WGLU), DSSM, 0, r, scr, lane); return; } r -= IT_GLU;
    if (r < IT_OA) { tr_plain(args.in[I_WOA], DLRU, D, (bf16*)(ws + WS_WOUT), D, 0, r, scr, lane); return; } r -= IT_OA;
    if (r < IT_OA) { tr_plain(args.in[I_WOB], DSSM, D, (bf16*)(ws + WS_WOUT), D, DLRU, r, scr, lane); return; } r -= IT_OA;
    if (r < IT_WO) { tr_plain(args.in[I_WO], D, D, (bf16*)(ws + WS_WO), D, 0, r, scr, lane); return; } r -= IT_WO;
    if (r < IT_GU) { tr_gu(args.in[I_F2G], (bf16*)(ws + WS_WGU2), 0, r, scr, lane); return; } r -= IT_GU;
    if (r < IT_GU) { tr_gu(args.in[I_F2U], (bf16*)(ws + WS_WGU2), 1, r, scr, lane); return; } r -= IT_GU;
    if (r < IT_DN) { tr_plain(args.in[I_F2D], DFF, D, (bf16*)(ws + WS_WD2), DFF, 0, r, scr, lane); return; } r -= IT_DN;
    { const int ig = r >= IT_RG ? 1 : 0; const int q = r - ig * IT_RG, h = q >> 3, sub = q & 7, kb = sub >> 2, nb = sub & 3;
      const float* W = (ig ? args.in[I_WIG] : args.in[I_WRG]) + (size_t)h * 128 * 128;
      transpose_item(W, 128, (bf16*)(ws + WS_WG) + (size_t)h * 256 * 128, 128, 64 * kb, 32 * nb, ig * 128 + 32 * nb, 0, scr, lane); }
}
constexpr int CW_Q = 60000, Q_CHUNK = 4;
__device__ __forceinline__ void convert_queue(const Args& args, int qid, int first, int n, LAS unsigned char* lds, int wave, int lane) {
    LAS float* scr = (LAS float*)(lds + RING_OFF + wave * 16384);
    unsigned* ctr = (unsigned*)(args.ws + WS_CTL) + CW_Q + 64 * qid;
    for (;;) {
        int base = 0;
        if (lane == 0) base = (int)__hip_atomic_fetch_add(ctr, (unsigned)Q_CHUNK, __ATOMIC_RELAXED, __HIP_MEMORY_SCOPE_AGENT);
        base = __builtin_amdgcn_readfirstlane(base);
        if (base >= n) break;
        const int e = (base + Q_CHUNK < n) ? base + Q_CHUNK : n;
        for (int it = base; it < e; ++it) convert_item(args, first + it, scr, lane);
    }
}

__device__ __forceinline__ void p0_prologue(const Args& args, LAS unsigned char* lds, int wave, int lane, int gw, int ngw) {
    unsigned char* ws = args.ws;
    LAS float* scr = (LAS float*)(lds + RING_OFF + wave * 16384);
#if defined(NO_TAIL_CONVERT)
    for (int it = gw; it < IT_TOTAL; it += ngw) convert_item(args, it, scr, lane);
#else
    for (int it = gw; it < 2 * IT_GU; it += ngw) convert_item(args, ITB_GU1 + it, scr, lane);
    for (int it = gw; it < 2 * IT_RG; it += ngw) convert_item(args, ITB_RG + it, scr, lane);
#endif
    {
        const int gt = gw * 64 + lane;
        if (gt < NGRP * SP) {
            const int g = gt >> 6, p = gt & 63;
            const double dt = exp((double)args.in[I_LDT][g]);
            const double ar = (double)args.in[I_ARE][gt], ai = (double)args.in[I_AIM][gt];
            const double mag = exp(ar * dt);
            double th = ai * dt; th -= 6.283185307179586476925 * rint(th * 0.15915494309189533577);
            const double x = 0.25 * th, x2 = x * x;
            double s = x * (1.0 + x2 * (-1.0 / 6 + x2 * (1.0 / 120 + x2 * (-1.0 / 5040 + x2 * (1.0 / 362880 + x2 * (-1.0 / 39916800 + x2 * (1.0 / 6227020800.0)))))));
            double c = 1.0 + x2 * (-0.5 + x2 * (1.0 / 24 + x2 * (-1.0 / 720 + x2 * (1.0 / 40320 + x2 * (-1.0 / 3628800 + x2 * (1.0 / 479001600.0 + x2 * (-1.0 / 87178291200.0)))))));
            { const double s2 = 2.0 * s * c, c2 = 1.0 - 2.0 * s * s; s = s2; c = c2; }
            { const double s2 = 2.0 * s * c, c2 = 1.0 - 2.0 * s * s; s = s2; c = c2; }
            const double abr = mag * c, abi = mag * s;
            const double den = ar * ar + ai * ai, nr = abr - 1.0, ni = abi;
            const double cre = (nr * ar + ni * ai) / den, cim = (ni * ar - nr * ai) / den;
            float* AB = (float*)(ws + WS_ABAR); AB[2 * gt] = (float)abr; AB[2 * gt + 1] = (float)abi;
            bf16* BB = (bf16*)(ws + WS_BB); bf16* CC = (bf16*)(ws + WS_CC);
            const float* bre = args.in[I_BRE] + (size_t)gt * SCG; const float* bim = args.in[I_BIM] + (size_t)gt * SCG;
#pragma unroll 4
            for (int ch = 0; ch < SCG; ++ch) {
                const double br = (double)bre[ch], bi = (double)bim[ch];
                const float vre = (float)(cre * br - cim * bi), vim = (float)(cre * bi + cim * br);
#pragma unroll
                for (int ri = 0; ri < 2; ++ri) { const int col = 2 * p + ri, j = col >> 4, ln = (col & 15) + 16 * (ch >> 3);
                    BB[((size_t)(g * 8 + j) * 64 + ln) * 8 + (ch & 7)] = (bf16)f2bf(ri ? vim : vre); }
                const float c_re = args.in[I_CRE][((size_t)g * SCG + ch) * SP + p], c_im = args.in[I_CIM][((size_t)g * SCG + ch) * SP + p];
#pragma unroll
                for (int ri = 0; ri < 2; ++ri) { const int k = 2 * p + ri, kk = k >> 5, ln = ch + 16 * ((k & 31) >> 3);
                    CC[((size_t)(g * 4 + kk) * 64 + ln) * 8 + (k & 7)] = (bf16)f2bf(ri ? -c_im : c_re); }
            }
        }
    }
    thin_rows<0>(args, gw, ngw, lane);
}

template <int MODE> __device__ __forceinline__ void thin_rows(const Args& args, int gw, int ngw, int lane) {
    const float* gA = MODE == 1 ? args.in[I_F1POST] : (MODE == 2 ? args.in[I_MPOST] : args.in[I_F2POST]);
    const float* gB = MODE == 0 ? args.in[I_F1PRE] : (MODE == 1 ? args.in[I_MPRE] : args.in[I_F2PRE]);
    const float sc = MODE == 2 ? 1.0f : 0.5f;
    float* Y = args.out + O_Y; const float* Fb = (const float*)(args.ws + WS_F); bf16* XN = (bf16*)(args.ws + WS_XN);
    for (int m = gw; m < M; m += ngw) {
        const float* xin = (MODE <= 1) ? (m < MP ? args.in[I_XP] + (size_t)m * D : args.in[I_XS] + (size_t)(m - MP) * D) : Y + (size_t)m * D;
        const GAS f32x4* xr = (const GAS f32x4*)xin + lane;
        f32x4 v[16];
#pragma unroll
        for (int j = 0; j < 16; ++j) v[j] = xr[64 * j];
        if (MODE >= 1) {
            const GAS f32x4* fr = (const GAS f32x4*)(Fb + (size_t)m * D) + lane;
            f32x4 f[16]; float s = 0.f;
#pragma unroll
            for (int j = 0; j < 16; ++j) f[j] = fr[64 * j];
            if (m >= MP) {
#pragma unroll
                for (int q = 0; q < 3; ++q) { const GAS f32x4* sr = (const GAS f32x4*)((const float*)(args.ws + WS_SLAB) + q * SLAB_FLOATS + (size_t)(m - MP) * D) + lane;
#pragma unroll
                    for (int j = 0; j < 16; ++j) f[j] = f[j] + sr[64 * j]; } }
#pragma unroll
            for (int j = 0; j < 16; ++j) s += (f[j].x * f[j].x + f[j].y * f[j].y) + (f[j].z * f[j].z + f[j].w * f[j].w);
            const float rstd = sc / sqrtf(wave_sum(s) * (1.f / D) + EPS);
            const GAS f32x4* gr = (const GAS f32x4*)gA + lane;
            GAS f32x4* yo = (GAS f32x4*)(Y + (size_t)m * D) + lane;
#pragma unroll
            for (int j = 0; j < 16; ++j) { const f32x4 g = gr[64 * j]; v[j] = v[j] + f[j] * rstd * g; yo[64 * j] = v[j]; }
        }
        if (MODE <= 2) {
            float s = 0.f;
#pragma unroll
            for (int j = 0; j < 16; ++j) s += (v[j].x * v[j].x + v[j].y * v[j].y) + (v[j].z * v[j].z + v[j].w * v[j].w);
            const float rstd = 1.0f / sqrtf(wave_sum(s) * (1.f / D) + EPS);
            const GAS f32x4* gr = (const GAS f32x4*)gB + lane;
            GAS v2u* o8 = (GAS v2u*)(XN + (size_t)m * D) + lane;
#pragma unroll
            for (int j = 0; j < 16; ++j) { const f32x4 g = gr[64 * j]; const f32x4 o = v[j] * rstd * g; v2u w; w.x = pk2(o.x, o.y); w.y = pk2(o.z, o.w); o8[64 * j] = w; }
        }
    }
}

constexpr int L_WSL = 0, L_XCB = 17408, L_XCF = 34816, L_LA = 43264, L_LB = 51712, L_LH = 60160, L_END = 68608;
constexpr int LP = 33;
template <bool SAMPLE> __device__ __forceinline__ void lru_task(const Args& args, LAS unsigned char* lds, int tid, int wave, int lane, int chain, int head, int q) {
    unsigned char* ws = args.ws;
    const float* XA = (const float*)(ws + WS_XA); const bf16* GA = (const bf16*)(ws + WS_GA); bf16* YAB = (bf16*)(ws + WS_YAB);
    const int chb = head * 128;
    { const bf16* WG = (const bf16*)(ws + WS_WG) + (size_t)head * 256 * 128;
      for (int i = tid; i < 1024; i += 512) { const int r = i >> 4, c16 = i & 15; const int srow = (r < 32) ? (32 * q + r) : (128 + 32 * q + (r - 32));
          *(LAS v4u*)(lds + L_WSL + r * 272 + c16 * 16) = *(const GAS v4u*)(WG + (size_t)srow * 128 + c16 * 8); } }
    const int cg = tid & 31, tg = tid >> 5;
    const f32x4 cw0 = *(const f32x4*)(args.in[I_CONVW] + 0 * DLRU + chb + 4 * cg), cw1 = *(const f32x4*)(args.in[I_CONVW] + 1 * DLRU + chb + 4 * cg),
                cw2 = *(const f32x4*)(args.in[I_CONVW] + 2 * DLRU + chb + 4 * cg), cw3 = *(const f32x4*)(args.in[I_CONVW] + 3 * DLRU + chb + 4 * cg),
                cbv = *(const f32x4*)(args.in[I_CONVB] + chb + 4 * cg);
    const int tb = wave & 3, ct = wave >> 2, l15 = lane & 15, lq = lane >> 4;
    const int chg = chb + 32 * q + 16 * ct + l15;
    const float brg = args.in[I_BRG][chg], big = args.in[I_BIG][chg];
    const float lam = args.in[I_LAM][chg];
    const float sp8 = -8.0f * log1pf(expf(-lam));
    float hcar = 0.f;
    const int ntile = SAMPLE ? 1 : 32;
    for (int k = 0; k < ntile; ++k) {
        const size_t rbase = SAMPLE ? (size_t)MP + 64 * chain : (size_t)chain * TP + 64 * k;
        {
            f32x4 v[7];
#pragma unroll
            for (int i = 0; i < 7; ++i) {
                if (SAMPLE) { const int ts = 4 * (tg & 1) - 3 + i, sl = tg >> 1;
                    v[i] = (ts >= 0) ? *(const GAS f32x4*)(XA + (rbase + 8 * sl + ts) * DLRU + chb + 4 * cg)
                                     : *(const GAS f32x4*)(args.in[I_SCONV] + ((size_t)(8 * chain + sl) * 3 + (3 + ts)) * DLRU + chb + 4 * cg);
                } else { const int tt = 4 * tg - 3 + i;
                    v[i] = (k > 0 || tt >= 0) ? *(const GAS f32x4*)(XA + (rbase + tt) * DLRU + chb + 4 * cg) : (f32x4){0.f, 0.f, 0.f, 0.f}; }
            }
#pragma unroll
            for (int o = 0; o < 4; ++o) { const f32x4 xc = cbv + cw0 * v[o] + cw1 * v[o + 1] + cw2 * v[o + 2] + cw3 * v[o + 3];
                v2u w; w.x = pk2(xc.x, xc.y); w.y = pk2(xc.z, xc.w);
                *(LAS v2u*)(lds + L_XCB + (4 * tg + o) * 272 + cg * 8) = w;
                if ((cg >> 3) == q) { LAS float* xf = (LAS float*)(lds + L_XCF) + (4 * tg + o) * LP + 4 * (cg & 7); xf[0] = xc.x; xf[1] = xc.y; xf[2] = xc.z; xf[3] = xc.w; } }
        }
        __syncthreads();
        pg8::f32x4 accr = {0.f, 0.f, 0.f, 0.f}, acci = {0.f, 0.f, 0.f, 0.f};
#pragma unroll
        for (int kk = 0; kk < 4; ++kk) {
            const bf16x8 a = *(const LAS bf16x8*)(lds + L_XCB + (16 * tb + l15) * 272 + kk * 64 + lq * 16);
            const bf16x8 br = *(const LAS bf16x8*)(lds + L_WSL + (16 * ct + l15) * 272 + kk * 64 + lq * 16);
            const bf16x8 bi = *(const LAS bf16x8*)(lds + L_WSL + (32 + 16 * ct + l15) * 272 + kk * 64 + lq * 16);
            accr = __builtin_amdgcn_mfma_f32_16x16x32_bf16(a, br, accr, 0, 0, 0);
            acci = __builtin_amdgcn_mfma_f32_16x16x32_bf16(a, bi, acci, 0, 0, 0);
        }
#pragma unroll
        for (int r = 0; r < 4; ++r) { const int tt = 16 * tb + 4 * lq + r, cl = 16 * ct + l15;
            const float rg = fast_sigmoid(accr[r] + brg), ig = fast_sigmoid(acci[r] + big);
            const float la = sp8 * rg;
            const float a = __builtin_amdgcn_exp2f(la * 1.4426950408889634f);
            const float x2 = 2.0f * la;
            const float em = (x2 > -0.25f) ? -x2 * (1.0f + x2 * (0.5f + x2 * (1.0f / 6 + x2 * (1.0f / 24 + x2 * (1.0f / 120 + x2 * (1.0f / 720))))))
                                           : 1.0f - __builtin_amdgcn_exp2f(x2 * 1.4426950408889634f);
            const float xcv = ((const LAS float*)(lds + L_XCF))[tt * LP + cl];
            ((LAS float*)(lds + L_LA))[tt * LP + cl] = a;
            ((LAS float*)(lds + L_LB))[tt * LP + cl] = sqrtf(em) * ig * xcv; }
        __syncthreads();
        if (tid < 32) {
            const LAS float* la = (const LAS float*)(lds + L_LA) + tid; const LAS float* lb = (const LAS float*)(lds + L_LB) + tid; LAS float* lh = (LAS float*)(lds + L_LH) + tid;
            const int ch = chb + 32 * q + tid;
#pragma unroll 8
            for (int tt = 0; tt < 64; ++tt) {
                if (SAMPLE && (tt & 7) == 0) hcar = args.in[I_SLRU][(size_t)(8 * chain + (tt >> 3)) * DLRU + ch];
                hcar = la[tt * LP] * hcar + lb[tt * LP]; lh[tt * LP] = hcar;
                if (SAMPLE && (tt & 7) == 7) args.out[O_SLRU + (size_t)(8 * chain + (tt >> 3)) * DLRU + ch] = hcar;
            }
            if (!SAMPLE && k == ntile - 1) args.out[O_PLRU + (size_t)chain * DLRU + ch] = hcar;
        }
        __syncthreads();
        { const int t = tid >> 3, c4 = (tid & 7) * 4; const LAS float* lh = (const LAS float*)(lds + L_LH) + t * LP + c4;
          const v2u gw = *(const GAS v2u*)(GA + (rbase + t) * DLRU + chb + 32 * q + c4);
          v2u o; o.x = pk2(lh[0] * bf_lo(gw.x), lh[1] * bf_hi(gw.x)); o.y = pk2(lh[2] * bf_lo(gw.y), lh[3] * bf_hi(gw.y));
          *(GAS v2u*)(YAB + (rbase + t) * D + chb + 32 * q + c4) = o; }
    }
    __syncthreads();
}

constexpr int S5_WAVE_LDS = 12800, S5_BU = 0, S5_HS = 8448;
template <bool SAMPLE> __device__ __forceinline__ void s5_task(const Args& args, LAS unsigned char* wl, int lane, int chain, int g) {
    unsigned char* ws = args.ws;
    const bf16* XB = (const bf16*)(ws + WS_XB); bf16* G2 = (bf16*)(ws + WS_G2);
    const int l15 = lane & 15, lq = lane >> 4;
    const f32x2 ab = *(const GAS f32x2*)((const float*)(ws + WS_ABAR) + 2 * (g * SP + lane));
    bf16x8 bfrag[8], cfrag[4];
#pragma unroll
    for (int j = 0; j < 8; ++j) { bfrag[j] = (bf16x8){0, 0, 0, 0, 0, 0, 0, 0}; if (lane < 32) bfrag[j] = *(const GAS bf16x8*)((const bf16*)(ws + WS_BB) + ((size_t)(g * 8 + j) * 64 + lane) * 8); }
#pragma unroll
    for (int kk = 0; kk < 4; ++kk) cfrag[kk] = *(const GAS bf16x8*)((const bf16*)(ws + WS_CC) + ((size_t)(g * 4 + kk) * 64 + lane) * 8);
    const f32x4 dsk = *(const GAS f32x4*)(args.in[I_DSK] + g * SCG + 4 * lq);
    float hr = 0.f, hi = 0.f;
    const int ntile = SAMPLE ? 1 : 32;
    for (int k = 0; k < ntile; ++k) {
        const size_t rbase = SAMPLE ? (size_t)MP + 64 * chain : (size_t)chain * TP + 64 * k;
#pragma unroll 1
        for (int tb = 0; tb < 4; ++tb) {
            const size_t row0 = rbase + 16 * tb;
            bf16x8 a = (bf16x8){0, 0, 0, 0, 0, 0, 0, 0};
            if (lane < 32) a = *(const GAS bf16x8*)(XB + (row0 + l15) * DSSM + g * SCG + 8 * lq);
#pragma unroll
            for (int j = 0; j < 8; ++j) { const pg8::f32x4 c = __builtin_amdgcn_mfma_f32_16x16x32_bf16(a, bfrag[j], (pg8::f32x4){0.f, 0.f, 0.f, 0.f}, 0, 0, 0);
#pragma unroll
                for (int r = 0; r < 4; ++r) ((LAS float*)(wl + S5_BU))[(4 * lq + r) * 132 + 16 * j + l15] = c[r]; }
            LDS_WAIT();
            f32x2 bu[16];
#pragma unroll
            for (int t = 0; t < 16; ++t) bu[t] = *(const LAS f32x2*)(wl + S5_BU + (t * 132 + 2 * lane) * 4);
#pragma unroll
            for (int t = 0; t < 16; ++t) {
                if (SAMPLE && (t & 7) == 0) { const size_t si = ((size_t)(8 * chain + 2 * tb + (t >> 3)) * NGRP + g) * SP + lane; hr = args.in[I_SRE][si]; hi = args.in[I_SIM][si]; }
                const float nr = ab.x * hr - ab.y * hi + bu[t].x, ni = ab.x * hi + ab.y * hr + bu[t].y; hr = nr; hi = ni;
                *(LAS unsigned*)(wl + S5_HS + t * 272 + 4 * lane) = pk2(hr, hi);
                if (SAMPLE && (t & 7) == 7) { const size_t si = ((size_t)(8 * chain + 2 * tb + (t >> 3)) * NGRP + g) * SP + lane; args.out[O_SRE + si] = hr; args.out[O_SIM + si] = hi; }
            }
            LDS_WAIT();
            pg8::f32x4 y = {0.f, 0.f, 0.f, 0.f};
#pragma unroll
            for (int kk = 0; kk < 4; ++kk) { const bf16x8 hb = *(const LAS bf16x8*)(wl + S5_HS + l15 * 272 + kk * 64 + lq * 16);
                y = __builtin_amdgcn_mfma_f32_16x16x32_bf16(cfrag[kk], hb, y, 0, 0, 0); }
            LDS_WAIT();
            const v2u uw = *(const GAS v2u*)(XB + (row0 + l15) * DSSM + g * SCG + 4 * lq);
            const float y0 = y[0] + dsk.x * bf_lo(uw.x), y1 = y[1] + dsk.y * bf_hi(uw.x), y2 = y[2] + dsk.z * bf_lo(uw.y), y3 = y[3] + dsk.w * bf_hi(uw.y);
            v2u o; o.x = pk2(gelu_tanh_f(y0), gelu_tanh_f(y1)); o.y = pk2(gelu_tanh_f(y2), gelu_tanh_f(y3));
            *(GAS v2u*)(G2 + (row0 + l15) * DSSM + g * SCG + 4 * lq) = o;
        }
    }
    if (!SAMPLE) { const size_t si = ((size_t)chain * NGRP + g) * SP + lane; args.out[O_PRE + si] = hr; args.out[O_PIM + si] = hi; }
}

__device__ __forceinline__ void p5_mixer(const Args& args, LAS unsigned char* lds, int tid, int wave, int lane, int bx, int G) {
    { const float* XA = (const float*)(args.ws + WS_XA);
      const int nv = (NP + NS) * 3 * (DLRU / 4);
      for (int i = bx * 512 + tid; i < nv; i += G * 512) { const int c4 = i % (DLRU / 4), rj = i / (DLRU / 4), s = rj / 3, j = rj % 3;
          if (s < NP) *(GAS f32x4*)(args.out + O_PCONV + ((size_t)s * 3 + j) * DLRU + 4 * c4) = *(const GAS f32x4*)(XA + ((size_t)s * TP + TP - 3 + j) * DLRU + 4 * c4);
          else { const int ss = s - NP; *(GAS f32x4*)(args.out + O_SCONV + ((size_t)ss * 3 + j) * DLRU + 4 * c4) = *(const GAS f32x4*)(XA + ((size_t)MP + 8 * ss + 5 + j) * DLRU + 4 * c4); } } }
#if !defined(SKIP_LRU)
    for (int t = bx; t < NP * 64; t += G) lru_task<false>(args, lds, tid, wave, lane, t >> 6, (t >> 2) & 15, t & 3);
    for (int t = bx; t < 16 * 64; t += G) lru_task<true>(args, lds, tid, wave, lane, t >> 6, (t >> 2) & 15, t & 3);
#endif
#if defined(S5_PROBE)
    { const bf16* CCp = (const bf16*)(args.ws + WS_CC); const bf16* BBp = (const bf16*)(args.ws + WS_BB); const float* ABp = (const float*)(args.ws + WS_ABAR); const bf16* XBp = (const bf16*)(args.ws + WS_XB);
      for (int i = bx * 512 + tid; i < 32768; i += G * 512) { float s = 0.f, s2 = 0.f;
          for (int e = 0; e < 8; ++e) { s += __uint_as_float((unsigned)CCp[(size_t)i * 8 + e] << 16); s2 += __uint_as_float((unsigned)BBp[((size_t)(i >> 5) * 64 + (i & 31)) * 8 + e] << 16); }
          args.out[O_PRE + i] = s; args.out[O_PIM + i] = s2; if (i < 16384) args.out[O_SRE + i] = ABp[i]; }
      for (int i = bx * 512 + tid; i < 1048576; i += G * 512) { float s = 0.f; for (int e = 0; e < 18; ++e) s += __uint_as_float((unsigned)XBp[(size_t)i * 18 + e] << 16); args.out[O_SIM + i] = s; } }
#endif
#if !defined(SKIP_S5)
    LAS unsigned char* wl = lds + wave * S5_WAVE_LDS;
    const int gw = bx * NWAVES + wave, ngw = G * NWAVES;
    if (ngw >= 1024) {
        if (gw < NP * NGRP) s5_task<false>(args, wl, lane, gw >> 7, gw & 127);
        else for (int t = gw - NP * NGRP; t < 16 * NGRP; t += ngw - NP * NGRP) s5_task<true>(args, wl, lane, t >> 7, t & 127);
    } else {
        for (int t = gw; t < NP * NGRP; t += ngw) s5_task<false>(args, wl, lane, t >> 7, t & 127);
        for (int t = gw; t < 16 * NGRP; t += ngw) s5_task<true>(args, wl, lane, t >> 7, t & 127);
    }
#endif
    __syncthreads();
}

__global__ void __launch_bounds__(NWAVES * 64, 2) hawk_fwd(Args args) {
    extern __shared__ __attribute__((aligned(16))) unsigned char lds_raw[];
    LAS unsigned char* lds = (LAS unsigned char*)lds_raw;
    volatile LAS unsigned* MISC = (volatile LAS unsigned*)(lds + MISC_OFF);
    const int tid = threadIdx.x, lane = tid & 63, wave = __builtin_amdgcn_readfirstlane(tid >> 6);
    const int G = gridDim.x, bx = blockIdx.x;
    const int gw = bx * NWAVES + wave, ngw = G * NWAVES;
    unsigned char* ws = args.ws;
    gu32* ctl = (gu32*)(ws + WS_CTL);
    for (int u = tid; u < (LDS_BYTES - LDSCTL_OFF) / 4; u += NWAVES * 64) ((LAS unsigned*)(lds + LDSCTL_OFF))[u] = 0u;
#if defined(XCHK) && XCHK
    for (int u = tid; u < RING_BYTES / 4; u += NWAVES * 64) ((LAS unsigned*)lds)[u] = 0xFFFFFFFFu;
#endif
    __syncthreads();
    XcdBarrier bar = xcd_barrier_post((unsigned*)(ctl + CW_BAR) + args.li * XCD_BAR_WORDS, MISC + 8);
    const int lo = args.ph_lo, hi = args.ph_hi;
#ifndef PHMASK
#define PHMASK 0x1fff
#endif
#define IN(k) ((((PHMASK) >> (k)) & 1) && lo <= (k) && (k) < hi)
#define BOTH(k) (IN(k) && IN((k) + 1))
#define SEAM(k) do { if (BOTH(k)) xcd_barrier(bar); } while (0)
    bf16* XN = (bf16*)(ws + WS_XN); bf16* HID = (bf16*)(ws + WS_HID); float* Fb = (float*)(ws + WS_F); bf16* YAB = (bf16*)(ws + WS_YAB);

#if defined(XCHK) && XCHK
    if (lo == 0) {
        GAS v4u* w4 = (GAS v4u*)(ws + 2 * MiB); const size_t n4 = (WS_END - 2 * MiB) / 16; const v4u q = {0xFFFFFFFFu, 0xFFFFFFFFu, 0xFFFFFFFFu, 0xFFFFFFFFu};
        for (size_t i = (size_t)bx * 512 + tid; i < n4; i += (size_t)G * 512) w4[i] = q;
        GAS v4u* o4 = (GAS v4u*)args.out; const size_t m4 = O_END / 4;
        for (size_t i = (size_t)bx * 512 + tid; i < m4; i += (size_t)G * 512) o4[i] = q;
        if (hi > 1) xcd_barrier(bar);
    }
#endif
    if (IN(0)) { p0_prologue(args, lds, wave, lane, gw, ngw);
#if defined(REP_PHASE) && REP_PHASE == 0
        xcd_barrier(bar); p0_prologue(args, lds, wave, lane, gw, ngw);
#endif
        SEAM(0); }
    if (IN(1)) { pg8::Gemm g{XN, (const bf16*)(ws + WS_WGU1), M, 2 * DFF, D, D}; pg8::StaticOrder S; S.init(M, 2 * DFF, D, G, bx);
        pg8::EpiSwiglu E{HID, DFF};
        pg8::gemm_phase<pg8::EpiSwiglu, pg8::StaticOrder, PG8_ALIGN, PG8_SP2>(lds + RING_OFF, g, S, E);
#if defined(REP_PHASE) && REP_PHASE == 1
        xcd_barrier(bar); pg8::gemm_phase<pg8::EpiSwiglu, pg8::StaticOrder, PG8_ALIGN, PG8_SP2>(lds + RING_OFF, g, S, E);
#endif
#if !defined(NO_TAIL_CONVERT)
        convert_queue(args, 1, ITB_DN1, IT_DN + IT_IN, lds, wave, lane);
#endif
        SEAM(1); }
    if (IN(2)) { pg8::Gemm g{HID, (const bf16*)(ws + WS_WD1), M, D, DFF, DFF}; pg8::TailOrder S; S.init(D, DFF, G, bx);
        pg8::EpiF32 E{Fb, D, (float*)(ws + WS_SLAB), SLAB_FLOATS, MP};
        pg8::gemm_phase<pg8::EpiF32, pg8::TailOrder, PG8_ALIGN, PG8_SP2>(lds + RING_OFF, g, S, E);
#if defined(REP_PHASE) && REP_PHASE == 2
        xcd_barrier(bar); pg8::gemm_phase<pg8::EpiF32, pg8::TailOrder, PG8_ALIGN, PG8_SP2>(lds + RING_OFF, g, S, E);
#endif
        SEAM(2); }
    if (IN(3)) { thin_rows<1>(args, gw, ngw, lane);
#if defined(REP_PHASE) && REP_PHASE == 3
        xcd_barrier(bar); thin_rows<1>(args, gw, ngw, lane);
#endif
        SEAM(3); }
    if (IN(4)) { pg8::Gemm g{XN, (const bf16*)(ws + WS_WIN), M, DIN, D, D}; pg8::StaticOrder S; S.init(M, DIN, D, G, bx);
        pg8::EpiWin E{(float*)(ws + WS_XA), (bf16*)(ws + WS_GA), (bf16*)(ws + WS_XB), (bf16*)(ws + WS_G)};
        pg8::gemm_phase<pg8::EpiWin, pg8::StaticOrder, PG8_ALIGN, PG8_SP2>(lds + RING_OFF, g, S, E);
#if !defined(NO_TAIL_CONVERT)
        convert_queue(args, 4, ITB_GLU, IT_GLU, lds, wave, lane);
#endif
        SEAM(4); }
    if (IN(5)) { p5_mixer(args, lds, tid, wave, lane, bx, G);
#if defined(REP_PHASE) && REP_PHASE == 5
        xcd_barrier(bar); p5_mixer(args, lds, tid, wave, lane, bx, G);
#endif
        SEAM(5); }
    if (IN(6)) { pg8::Gemm g{(const bf16*)(ws + WS_G2), (const bf16*)(ws + WS_WGLU), M, DSSM, DSSM, DSSM}; pg8::StaticOrder S; S.init(M, DSSM, DSSM, G, bx);
        pg8::EpiGlu E{(const bf16*)(ws + WS_G2), args.in[I_BGLU], YAB + DLRU};
        pg8::gemm_phase<pg8::EpiGlu, pg8::StaticOrder, PG8_ALIGN, PG8_SP2>(lds + RING_OFF, g, S, E);
#if !defined(NO_TAIL_CONVERT)
        convert_queue(args, 6, ITB_OA, 2 * IT_OA + IT_WO, lds, wave, lane);
#endif
        SEAM(6); }
    if (IN(7)) { pg8::Gemm g{YAB, (const bf16*)(ws + WS_WOUT), M, D, D, D}; pg8::SegOrder S; S.init(M, D, D, G, bx);
        pg8::EpiOut E{(const bf16*)(ws + WS_G), XN};
        pg8::gemm_phase<pg8::EpiOut, pg8::SegOrder, PG8_ALIGN, PG8_SP2>(lds + RING_OFF, g, S, E);
#if !defined(NO_TAIL_CONVERT)
        convert_queue(args, 7, ITB_GU2, 2 * IT_GU, lds, wave, lane);
#endif
        SEAM(7); }
    if (IN(8)) { pg8::Gemm g{XN, (const bf16*)(ws + WS_WO), M, D, D, D}; pg8::TailOrder S; S.init(D, D, G, bx);
        pg8::EpiF32 E{Fb, D, (float*)(ws + WS_SLAB), SLAB_FLOATS, MP};
        pg8::gemm_phase<pg8::EpiF32, pg8::TailOrder, PG8_ALIGN, PG8_SP2>(lds + RING_OFF, g, S, E);
#if defined(REP_PHASE) && REP_PHASE == 8
        xcd_barrier(bar); pg8::gemm_phase<pg8::EpiF32, pg8::TailOrder, PG8_ALIGN, PG8_SP2>(lds + RING_OFF, g, S, E);
#endif
        SEAM(8); }
    if (IN(9)) { thin_rows<2>(args, gw, ngw, lane); SEAM(9); }
    if (IN(10)) { pg8::Gemm g{XN, (const bf16*)(ws + WS_WGU2), M, 2 * DFF, D, D}; pg8::StaticOrder S; S.init(M, 2 * DFF, D, G, bx);
        pg8::EpiSwiglu E{HID, DFF};
        pg8::gemm_phase<pg8::EpiSwiglu, pg8::StaticOrder, PG8_ALIGN, PG8_SP2>(lds + RING_OFF, g, S, E);
#if !defined(NO_TAIL_CONVERT)
        convert_queue(args, 10, ITB_DN2, IT_DN, lds, wave, lane);
#endif
        SEAM(10); }
    if (IN(11)) { pg8::Gemm g{HID, (const bf16*)(ws + WS_WD2), M, D, DFF, DFF}; pg8::TailOrder S; S.init(D, DFF, G, bx);
        pg8::EpiF32 E{Fb, D, (float*)(ws + WS_SLAB), SLAB_FLOATS, MP};
        pg8::gemm_phase<pg8::EpiF32, pg8::TailOrder, PG8_ALIGN, PG8_SP2>(lds + RING_OFF, g, S, E); SEAM(11); }
    if (IN(12)) { thin_rows<3>(args, gw, ngw, lane); }
#undef IN
#undef BOTH
#undef SEAM
}

extern "C" void kernel_launch(void* const* d_in, const int* in_sizes, int n_in, void* d_out, int out_size, void* d_ws, size_t ws_size, hipStream_t stream) {
    static int grid = 0;
    if (grid == 0) {
        if (n_in != 39 || in_sizes[0] != MP * D || out_size != (int)O_END || ws_size < WS_END) { fprintf(stderr, "kernel_launch: unexpected shapes (n_in %d, in0 %d, out %d, ws %zu); nothing launched\n", n_in, n_in > 0 ? in_sizes[0] : -1, out_size, ws_size); grid = -1; return; }
        int dev = 0, cus = 0, per_cu = 0;
        if (hipGetDevice(&dev) != hipSuccess || hipDeviceGetAttribute(&cus, hipDeviceAttributeMultiprocessorCount, dev) != hipSuccess) { grid = -1; return; }
        if (hipFuncSetAttribute((const void*)hawk_fwd, hipFuncAttributeMaxDynamicSharedMemorySize, LDS_BYTES) != hipSuccess) { fprintf(stderr, "kernel_launch: hipFuncSetAttribute failed\n"); grid = -1; return; }
        if (hipOccupancyMaxActiveBlocksPerMultiprocessor(&per_cu, (const void*)hawk_fwd, NWAVES * 64, LDS_BYTES) != hipSuccess || per_cu < 1)
            fprintf(stderr, "kernel_launch: note: occupancy query reports %d workgroups per CU\n", per_cu);
        (void)hipGetLastError();
        grid = cus;
    }
    if (grid < 0) return;
    if (hipMemsetAsync((char*)d_ws + WS_CTL, 0, CTL_ZERO_BYTES, stream) != hipSuccess) return;
    Args a{};
    for (int i = 0; i < 39; ++i) a.in[i] = (const float*)d_in[i];
    a.out = (float*)d_out; a.ws = (unsigned char*)d_ws;
    static_assert(N_LAUNCHES == 1 || N_LAUNCHES == N_PHASES, "MK_N_LAUNCHES: 1 or one launch per phase");
    for (int li = 0; li < N_LAUNCHES; ++li) {
        a.ph_lo = (N_LAUNCHES == 1) ? 0 : li; a.ph_hi = (N_LAUNCHES == 1) ? N_PHASES : li + 1; a.li = li; a.pad = 0;
        hipLaunchKernelGGL(hawk_fwd, dim3(grid), dim3(NWAVES * 64), LDS_BYTES, stream, a);
        const hipError_t le = hipPeekAtLastError();
        if (le != hipSuccess) { fprintf(stderr, "kernel_launch: launch %d failed: %s\n", li, hipGetErrorName(le)); break; }
    }
}
```

```cpp
#define NO_VIRT_C 1
#include <hip/hip_runtime.h>
#include <cstdio>
#include <cstdint>
namespace pg8 {
#define PG8_LAS __attribute__((address_space(3)))
typedef unsigned short bf16_t;
typedef short bf16x8 __attribute__((ext_vector_type(8)));
typedef float f32x4 __attribute__((ext_vector_type(4)));
typedef unsigned u32x4 __attribute__((ext_vector_type(4)));
constexpr int BM = 256, BK = 64, HALF = 128, HTB = HALF * BK * 2  , STAGE_BYTES = 8 * HTB, NXCD = 8, WGM = 8;

__host__ __device__ __forceinline__ int lds_byte(int r, int c) { const int st = (r >> 4) * 2 + (c >> 5), rr = r & 15, cc = c & 31, ob = rr * 64 + cc * 2; return st * 1024 + (ob ^ (((ob >> 9) & 1) << 5)); }
__host__ __device__ __forceinline__ void stage_rc(int b, int& R, int& C) { const int st = b / 1024, sb = b % 1024, swz = sb ^ (((sb >> 9) & 1) << 5); R = (st >> 1) * 16 + swz / 64; C = (st & 1) * 32 + (swz % 64) / 2; }
__host__ __device__ __forceinline__ int perm32(int rho) { const int n = rho >> 4, i = rho & 15; return 8 * (i >> 2) + 4 * n + (i & 3); }

struct Unit { int pm, pn, seg, k0, nt, slab, round; };
struct Gemm { const bf16_t* A; const bf16_t* Bt; int M, N, K, ld; };

struct XSync {
    unsigned* cnt; unsigned nloc; int nrounds;
    __device__ __forceinline__ void wait(int round) const {
        if (nloc == 0u || round < 1 || round >= nrounds) return;
        if (threadIdx.x < 64) {
            if (threadIdx.x == 0) (void)__hip_atomic_fetch_add(cnt, 1u, __ATOMIC_RELAXED, __HIP_MEMORY_SCOPE_AGENT);
            const unsigned target = (unsigned)round * nloc; unsigned sp = 0;
            while ((unsigned)__builtin_amdgcn_readfirstlane(__hip_atomic_load(cnt, __ATOMIC_RELAXED, __HIP_MEMORY_SCOPE_AGENT)) < target) { __builtin_amdgcn_s_sleep(1); if (++sp > 200000u) break; }
        }
        asm volatile("" ::: "memory"); __builtin_amdgcn_s_barrier(); asm volatile("" ::: "memory");
    }
};
struct StaticOrder {
    XSync xs;
    int nM, nN, nwg, G, c, ntk;
    __host__ __device__ __forceinline__ void init(int M, int N, int K, int G_, int c_) { nM = M / BM; nN = N / BM; nwg = nM * nN; G = G_; c = c_; ntk = K / BK; }
    __host__ __device__ __forceinline__ bool next(int i, Unit& u) const {
        const long L = (long)i * G + c; if (L >= nwg) return false;
        int wgid = (int)L; { const int q = nwg / NXCD, r = nwg % NXCD, xcd = wgid % NXCD, off = wgid / NXCD; wgid = (xcd < r ? xcd * (q + 1) : r * (q + 1) + (xcd - r) * q) + off; }
        const int nig = WGM * nN, gid = wgid / nig, fm = gid * WGM, gsz = (nM - fm) < WGM ? (nM - fm) : WGM;
        u.pm = fm + ((wgid % nig) % gsz); u.pn = (wgid % nig) / gsz; u.seg = 0; u.k0 = 0; u.nt = ntk; u.slab = 0; u.round = i; return true;
    }
    __device__ __forceinline__ void a_ready(const Unit& u) const { xs.wait(u.round); }
    __device__ __forceinline__ void done(const Unit&) const {}
};
struct SegOrder : StaticOrder {
    __host__ __device__ __forceinline__ bool next(int i, Unit& u) const { const bool ok = StaticOrder::next(i >> 1, u); u.seg = i & 1; u.nt = ntk >> 1; u.k0 = (i & 1) * (ntk >> 1); return ok; }
    __device__ __forceinline__ void a_ready(const Unit& u) const { if (u.seg == 0) xs.wait(u.round); }
};
struct TailOrder {
    StaticOrder base; int c, ntk;
    __host__ __device__ __forceinline__ void init(int N, int K, int G_, int c_) { base.init(32 * BM, N, K, G_, c_); c = c_; ntk = K / BK; }
    __host__ __device__ __forceinline__ bool next(int i, Unit& u) const {
        const bool full = i < 2; Unit b; const bool okb = base.next(full ? i : 0, b);
        const int x = c & 7, j = c >> 3, q = x & 3;
        const int qa = ((ntk >> 2) + 1) & ~1, qb = (ntk - 2 * qa) >> 1;
        u.pm = full ? b.pm : 32 + (j >> 3); u.pn = full ? b.pn : 8 * (x >> 2) + (j & 7); u.seg = 0; u.slab = full ? 0 : q;
        u.k0 = full ? 0 : (q < 2 ? q * qa : 2 * qa + (q - 2) * qb); u.nt = full ? ntk : (q < 2 ? qa : qb); u.round = i;
        return full ? okb : (i == 2 && base.G == 256 && base.nN == 16);
    }
    __device__ __forceinline__ void a_ready(const Unit& u) const { base.xs.wait(u.round); }
    __device__ __forceinline__ void done(const Unit&) const {}
};

typedef float cvt_f32x2_t __attribute__((ext_vector_type(2)));
typedef __bf16 cvt_bf16x2_t __attribute__((ext_vector_type(2)));
__device__ __forceinline__ unsigned cvt_pk_bf16(float lo, float hi) { const cvt_f32x2_t v = {lo, hi}; const cvt_bf16x2_t b = __builtin_convertvector(v, cvt_bf16x2_t); return __builtin_bit_cast(unsigned, b); }
typedef float f32x2 __attribute__((ext_vector_type(2)));
__device__ __forceinline__ f32x2 gelu_pk(f32x2 v) {
    const f32x2 av = __builtin_elementwise_abs(v), d = av * 0.2316418882f + 1.0f;
    f32x2 t; t.x = __builtin_amdgcn_rcpf(d.x); t.y = __builtin_amdgcn_rcpf(d.y);
    f32x2 q = t * 0.5307027145f + (-0.7265760135f); q = q * t + 0.7107068705f; q = q * t + (-0.142248368f); q = q * t + 0.127414796f; q = q * t;
    const f32x2 s = (v * v) * (-0.72134752044f);
    f32x2 e; e.x = __builtin_amdgcn_exp2f(s.x); e.y = __builtin_amdgcn_exp2f(s.y);
    const f32x2 m = v * (q * e), r = v - m;
    f32x2 o; o.x = v.x < 0.f ? m.x : r.x; o.y = v.y < 0.f ? m.y : r.y; return o;
}


__device__ __forceinline__ float bf_lo(unsigned w) { return __uint_as_float(w << 16); }
__device__ __forceinline__ float bf_hi(unsigned w) { return __uint_as_float(w & 0xffff0000u); }
__device__ __forceinline__ float fast_sigmoid(float x) { return __builtin_amdgcn_rcpf(1.0f + __builtin_amdgcn_exp2f(-1.4426950408889634f * x)); }
__device__ __forceinline__ float silu_f(float x) { return x * fast_sigmoid(x); }
__device__ __forceinline__ float gelu_tanh_f(float x) { const float z = 1.5957691216057308f * (x + 0.044715f * x * x * x); return x * fast_sigmoid(z); }
__device__ __forceinline__ u32x4 pack8(const f32x4& v0, const f32x4& v1) { u32x4 w; w.x = cvt_pk_bf16(v0[0], v0[1]); w.y = cvt_pk_bf16(v0[2], v0[3]); w.z = cvt_pk_bf16(v1[0], v1[1]); w.w = cvt_pk_bf16(v1[2], v1[3]); return w; }

struct EpiSwiglu {
    static constexpr bool PERM = true, AFTER_DRAIN = false, SEG = false;
    bf16_t* O; int ldc;
    __device__ __forceinline__ void operator()(f32x4 (&acc)[2][2][4][2], const Unit& u, int wr, int wc, int fr, int fq) const {
        const int row0 = u.pm * BM + wr * 64 + fr, col0 = u.pn * HALF + wc * 32 + 8 * fq;
#pragma unroll
        for (int ai = 0; ai < 2; ++ai)
#pragma unroll
            for (int m = 0; m < 4; ++m) { bf16_t* rowp = O + (size_t)(row0 + ai * HALF + m * 16) * ldc + col0;
                f32x4 v0, v1;
#pragma unroll
                for (int j = 0; j < 4; ++j) { v0[j] = silu_f(acc[ai][0][m][0][j]) * acc[ai][1][m][0][j]; v1[j] = silu_f(acc[ai][0][m][1][j]) * acc[ai][1][m][1][j]; }
                *(u32x4*)rowp = pack8(v0, v1); }
    }
};
struct EpiF32 {
    static constexpr bool PERM = true, AFTER_DRAIN = false, SEG = false;
    float* C; int ldc; float* S; size_t slab_stride; int slab_row0;
    __device__ __forceinline__ void operator()(f32x4 (&acc)[2][2][4][2], const Unit& u, int wr, int wc, int fr, int fq) const {
        const int row0 = u.pm * BM + wr * 64 + fr, col0 = u.pn * BM + wc * 32 + 8 * fq;
        float* base = u.slab == 0 ? C : S + (size_t)(u.slab - 1) * slab_stride - (size_t)slab_row0 * ldc;
#pragma unroll
        for (int ai = 0; ai < 2; ++ai)
#pragma unroll
            for (int m = 0; m < 4; ++m) { float* rowp = base + (size_t)(row0 + ai * HALF + m * 16) * ldc + col0;
#pragma unroll
                for (int bj = 0; bj < 2; ++bj)
#pragma unroll
                    for (int n = 0; n < 2; ++n) *(f32x4*)(rowp + bj * HALF + n * 4) = acc[ai][bj][m][n]; }
    }
};
struct EpiWin {
    static constexpr bool PERM = true, AFTER_DRAIN = false, SEG = false;
    float* XA; bf16_t* GA; bf16_t* XB; bf16_t* G;
    __device__ __forceinline__ void operator()(f32x4 (&acc)[2][2][4][2], const Unit& u, int wr, int wc, int fr, int fq) const {
        const int row0 = u.pm * BM + wr * 64 + fr, cw = wc * 32 + 8 * fq;
        if (u.pn < 8) {
            const int col0 = u.pn * BM + cw;
#pragma unroll
            for (int ai = 0; ai < 2; ++ai)
#pragma unroll
                for (int m = 0; m < 4; ++m) { float* rowp = XA + (size_t)(row0 + ai * HALF + m * 16) * 2048 + col0;
#pragma unroll
                    for (int bj = 0; bj < 2; ++bj)
#pragma unroll
                        for (int n = 0; n < 2; ++n) *(f32x4*)(rowp + bj * HALF + n * 4) = acc[ai][bj][m][n]; }
        } else if (u.pn < 16) {
            const int col0 = (u.pn - 8) * BM + cw;
#pragma unroll
            for (int ai = 0; ai < 2; ++ai)
#pragma unroll
                for (int m = 0; m < 4; ++m) { bf16_t* rowp = GA + (size_t)(row0 + ai * HALF + m * 16) * 2048 + col0;
#pragma unroll
                    for (int bj = 0; bj < 2; ++bj) { f32x4 v0, v1;
#pragma unroll
                        for (int j = 0; j < 4; ++j) { v0[j] = gelu_tanh_f(acc[ai][bj][m][0][j]); v1[j] = gelu_tanh_f(acc[ai][bj][m][1][j]); }
                        *(u32x4*)(rowp + bj * HALF) = pack8(v0, v1); } }
        } else if (u.pn < 24) {
            const int col0 = (u.pn - 16) * BM + cw;
#pragma unroll
            for (int ai = 0; ai < 2; ++ai)
#pragma unroll
                for (int m = 0; m < 4; ++m) { bf16_t* rowp = XB + (size_t)(row0 + ai * HALF + m * 16) * 2048 + col0;
#pragma unroll
                    for (int bj = 0; bj < 2; ++bj) *(u32x4*)(rowp + bj * HALF) = pack8(acc[ai][bj][m][0], acc[ai][bj][m][1]); }
        } else {
            const int col0 = (u.pn - 24) * BM + cw;
#pragma unroll
            for (int ai = 0; ai < 2; ++ai)
#pragma unroll
                for (int m = 0; m < 4; ++m) { bf16_t* rowp = G + (size_t)(row0 + ai * HALF + m * 16) * 8192 + col0;
#pragma unroll
                    for (int bj = 0; bj < 2; ++bj) { f32x4 v0, v1;
#pragma unroll
                        for (int j = 0; j < 4; ++j) { v0[j] = fast_sigmoid(acc[ai][bj][m][0][j]); v1[j] = fast_sigmoid(acc[ai][bj][m][1][j]); }
                        *(u32x4*)(rowp + bj * HALF) = pack8(v0, v1); } }
        }
    }
};
struct EpiGlu {
    static constexpr bool PERM = true, AFTER_DRAIN = false, SEG = false;
    const bf16_t* G2; const float* bias; bf16_t* O;
    __device__ __forceinline__ void operator()(f32x4 (&acc)[2][2][4][2], const Unit& u, int wr, int wc, int fr, int fq) const {
        const int row0 = u.pm * BM + wr * 64 + fr, col0 = u.pn * BM + wc * 32 + 8 * fq;
        f32x4 bv[2][2];
#pragma unroll
        for (int bj = 0; bj < 2; ++bj)
#pragma unroll
            for (int n = 0; n < 2; ++n) bv[bj][n] = *(const f32x4*)(bias + col0 + bj * HALF + 4 * n);
#pragma unroll
        for (int ai = 0; ai < 2; ++ai)
#pragma unroll
            for (int m = 0; m < 4; ++m) { const size_t r = (size_t)(row0 + ai * HALF + m * 16);
#pragma unroll
                for (int bj = 0; bj < 2; ++bj) { const u32x4 gw = *(const u32x4*)(G2 + r * 2048 + col0 + bj * HALF);
                    const f32x4 a0 = acc[ai][bj][m][0] + bv[bj][0], a1 = acc[ai][bj][m][1] + bv[bj][1]; f32x4 v0, v1;
                    v0[0] = bf_lo(gw.x) * fast_sigmoid(a0[0]); v0[1] = bf_hi(gw.x) * fast_sigmoid(a0[1]); v0[2] = bf_lo(gw.y) * fast_sigmoid(a0[2]); v0[3] = bf_hi(gw.y) * fast_sigmoid(a0[3]);
                    v1[0] = bf_lo(gw.z) * fast_sigmoid(a1[0]); v1[1] = bf_hi(gw.z) * fast_sigmoid(a1[1]); v1[2] = bf_lo(gw.w) * fast_sigmoid(a1[2]); v1[3] = bf_hi(gw.w) * fast_sigmoid(a1[3]);
                    *(u32x4*)(O + r * 4096 + col0 + bj * HALF) = pack8(v0, v1); } }
    }
};
struct EpiOut {
    static constexpr bool PERM = true, AFTER_DRAIN = false, SEG = true;
    const bf16_t* G; bf16_t* O;
    __device__ __forceinline__ void seg0(f32x4 (&acc)[2][2][4][2], const Unit& u, int wr, int wc, int fr, int fq) const {
        const int row0 = u.pm * BM + wr * 64 + fr, col0 = u.pn * BM + wc * 32 + 8 * fq;
#pragma unroll
        for (int ai = 0; ai < 2; ++ai)
#pragma unroll
            for (int m = 0; m < 4; ++m) { const bf16_t* gp = G + (size_t)(row0 + ai * HALF + m * 16) * 8192 + col0;
#pragma unroll
                for (int bj = 0; bj < 2; ++bj) { const u32x4 a = *(const u32x4*)(gp + bj * HALF), b = *(const u32x4*)(gp + 4096 + bj * HALF);
                    f32x4 r0, r1;
                    r0[0] = bf_lo(a.x) * __builtin_amdgcn_rcpf(fmaxf(bf_lo(b.x), 1e-30f)); r0[1] = bf_hi(a.x) * __builtin_amdgcn_rcpf(fmaxf(bf_hi(b.x), 1e-30f));
                    r0[2] = bf_lo(a.y) * __builtin_amdgcn_rcpf(fmaxf(bf_lo(b.y), 1e-30f)); r0[3] = bf_hi(a.y) * __builtin_amdgcn_rcpf(fmaxf(bf_hi(b.y), 1e-30f));
                    r1[0] = bf_lo(a.z) * __builtin_amdgcn_rcpf(fmaxf(bf_lo(b.z), 1e-30f)); r1[1] = bf_hi(a.z) * __builtin_amdgcn_rcpf(fmaxf(bf_hi(b.z), 1e-30f));
                    r1[2] = bf_lo(a.w) * __builtin_amdgcn_rcpf(fmaxf(bf_lo(b.w), 1e-30f)); r1[3] = bf_hi(a.w) * __builtin_amdgcn_rcpf(fmaxf(bf_hi(b.w), 1e-30f));
                    acc[ai][bj][m][0] = acc[ai][bj][m][0] * r0; acc[ai][bj][m][1] = acc[ai][bj][m][1] * r1; }
                asm volatile("" ::: "memory"); }
    }
    __device__ __forceinline__ void operator()(f32x4 (&acc)[2][2][4][2], const Unit& u, int wr, int wc, int fr, int fq) const { if (u.seg == 0) seg0(acc, u, wr, wc, fr, fq); else seg1(acc, u, wr, wc, fr, fq); }
    __device__ __forceinline__ void seg1(const f32x4 (&acc)[2][2][4][2], const Unit& u, int wr, int wc, int fr, int fq) const {
        const int row0 = u.pm * BM + wr * 64 + fr, col0 = u.pn * BM + wc * 32 + 8 * fq;
#pragma unroll
        for (int ai = 0; ai < 2; ++ai)
#pragma unroll
            for (int m = 0; m < 4; ++m) { const size_t r = (size_t)(row0 + ai * HALF + m * 16);
#pragma unroll
                for (int bj = 0; bj < 2; ++bj) { const u32x4 b = *(const u32x4*)(G + r * 8192 + 4096 + col0 + bj * HALF);
                    f32x4 g0, g1;
                    g0[0] = fmaxf(bf_lo(b.x), 1e-30f); g0[1] = fmaxf(bf_hi(b.x), 1e-30f); g0[2] = fmaxf(bf_lo(b.y), 1e-30f); g0[3] = fmaxf(bf_hi(b.y), 1e-30f);
                    g1[0] = fmaxf(bf_lo(b.z), 1e-30f); g1[1] = fmaxf(bf_hi(b.z), 1e-30f); g1[2] = fmaxf(bf_lo(b.w), 1e-30f); g1[3] = fmaxf(bf_hi(b.w), 1e-30f);
                    *(u32x4*)(O + r * 4096 + col0 + bj * HALF) = pack8(acc[ai][bj][m][0] * g0, acc[ai][bj][m][1] * g1); } }
    }
};

template <class Epi, class Sched, bool ALIGN_EPI = false, bool SP2 = false>
__device__ __forceinline__ void gemm_phase(PG8_LAS unsigned char* lds, const Gemm g, const Sched& S, const Epi& E) {
    const int tid = threadIdx.x, wid = __builtin_amdgcn_readfirstlane(tid >> 6), lane = tid & 63, wr = wid >> 2, wc = wid & 3, fr = lane & 15, fq = lane >> 4;
    const int LD = g.ld;
    unsigned voffA[2], voffB[2];
#pragma unroll
    for (int i = 0; i < 2; ++i) { int R, C; stage_rc(tid * 16 + i * 8192, R, C); const int Rb = Epi::PERM ? ((R & ~31) + perm32(R & 31)) : R;
        voffA[i] = (unsigned)(R * LD + C) * 2u; voffB[i] = (unsigned)(Rb * LD + C) * 2u; }
    const size_t kstep = (size_t)(BK * 2);
    const size_t hstep = (size_t)HALF * LD * 2;
    const size_t tstep = 2 * hstep;
    const unsigned ldsw = (unsigned)wid * 1024u;
    const int aoff = lds_byte(wr * 64 + fr, fq * 8), boff = lds_byte(wc * 32 + fr, fq * 8);
#define PG8_SA(b, h) (((b) * 2 + (h)) * HTB)
#define PG8_SB(b, h) ((4 + (b) * 2 + (h)) * HTB)
#define PG8_STAGE(bufoff, gbase, voff) do { _Pragma("unroll") for (int _i = 0; _i < 2; ++_i) \
        __builtin_amdgcn_global_load_lds((const unsigned*)((const char*)(gbase) + (voff)[_i]), (PG8_LAS unsigned*)(lds + (bufoff) + ldsw + _i * 8192), 16, 0, 0); } while (0)
#define PG8_LDA(dst, b, h) do { _Pragma("unroll") for (int m = 0; m < 4; ++m) _Pragma("unroll") for (int k = 0; k < 2; ++k) dst[m][k] = *(const PG8_LAS bf16x8*)(lds + PG8_SA(b, h) + aoff + m * 2048 + k * 1024); } while (0)
#define PG8_LDB(dst, b, h) do { _Pragma("unroll") for (int n = 0; n < 2; ++n) _Pragma("unroll") for (int k = 0; k < 2; ++k) dst[n][k] = *(const PG8_LAS bf16x8*)(lds + PG8_SB(b, h) + boff + n * 2048 + k * 1024); } while (0)
#define PG8_MMA(ai, bj, At, Bt) do { __builtin_amdgcn_s_setprio(1); _Pragma("unroll") for (int m = 0; m < 4; ++m) _Pragma("unroll") for (int n = 0; n < 2; ++n) _Pragma("unroll") for (int k = 0; k < 2; ++k) \
        acc[ai][bj][m][n] = __builtin_amdgcn_mfma_f32_16x16x32_bf16(Bt[n][k], At[m][k], acc[ai][bj][m][n], 0, 0, 0); __builtin_amdgcn_s_setprio(0); } while (0)
#define PG8_WAIT_V(n) asm volatile("s_waitcnt vmcnt(" #n ")" ::: "memory")
#define PG8_WAIT_L(n) asm volatile("s_waitcnt lgkmcnt(" #n ")" ::: "memory")
#define PG8_BAR __builtin_amdgcn_s_barrier()
#define PG8_SCHED __builtin_amdgcn_sched_barrier(0)
    Unit cur, nxt; int ui = 0;
    if (!S.next(0, cur)) return;
    f32x4 acc[2][2][4][2];
#pragma unroll
    for (int a = 0; a < 2; ++a)
#pragma unroll
        for (int b = 0; b < 2; ++b)
#pragma unroll
            for (int m = 0; m < 4; ++m)
#pragma unroll
                for (int n = 0; n < 2; ++n) acc[a][b][m][n] = (f32x4){0.f, 0.f, 0.f, 0.f};
    bf16x8 At[4][2], B0[2][2], B1[2][2];
    const char* cA = (const char*)g.A + (size_t)cur.pm * tstep + (size_t)cur.k0 * kstep; const char* cB = (const char*)g.Bt + (size_t)cur.pn * tstep + (size_t)cur.k0 * kstep;
    S.a_ready(cur);
    if constexpr (SP2) {
        PG8_STAGE(PG8_SB(0, 0), cB, voffB); PG8_STAGE(PG8_SB(0, 1), cB + hstep, voffB); PG8_STAGE(PG8_SA(0, 0), cA, voffA); PG8_STAGE(PG8_SA(0, 1), cA + hstep, voffA);
        if (wr == 1) PG8_BAR;
        PG8_WAIT_V(2); PG8_BAR;
        PG8_STAGE(PG8_SB(1, 0), cB + kstep, voffB); PG8_STAGE(PG8_SA(1, 0), cA + kstep, voffA); PG8_STAGE(PG8_SB(1, 1), cB + hstep + kstep, voffB);
        PG8_WAIT_V(6); PG8_BAR;
    } else {
        PG8_STAGE(PG8_SB(0, 0), cB, voffB); PG8_STAGE(PG8_SA(0, 0), cA, voffA); PG8_STAGE(PG8_SB(0, 1), cB + hstep, voffB); PG8_STAGE(PG8_SA(0, 1), cA + hstep, voffA);
        if (wr == 1) PG8_BAR;
        PG8_WAIT_V(4); PG8_BAR;
        PG8_STAGE(PG8_SB(1, 0), cB + kstep, voffB); PG8_STAGE(PG8_SA(1, 0), cA + kstep, voffA); PG8_STAGE(PG8_SB(1, 1), cB + hstep + kstep, voffB);
        PG8_WAIT_V(6); PG8_BAR;
    }
    for (;;) {
        const bool has_next = S.next(ui + 1, nxt);
        const char* nA = has_next ? (const char*)g.A + (size_t)nxt.pm * tstep + (size_t)nxt.k0 * kstep : cA; const char* nB = has_next ? (const char*)g.Bt + (size_t)nxt.pn * tstep + (size_t)nxt.k0 * kstep : cB;
        const int nt = cur.nt;
        for (int t = 0; t < nt; t += 2) {
            const bool last = (t == nt - 2);
            const char* a1 = cA + (size_t)(t + 1) * kstep;
            const char* a2 = last ? nA : cA + (size_t)(t + 2) * kstep; const char* b2 = last ? nB : cB + (size_t)(t + 2) * kstep;
            const char* a3 = a2 + kstep; const char* b3 = b2 + kstep;
            if (last && has_next) S.a_ready(nxt);
            if constexpr (SP2) {
            PG8_LDB(B0, 0, 0); PG8_LDB(B1, 0, 1); PG8_SCHED; PG8_LDA(At, 0, 0); PG8_STAGE(PG8_SA(1, 1), a1 + hstep, voffA);
            PG8_WAIT_V(8); PG8_WAIT_L(0); PG8_BAR; PG8_MMA(0, 0, At, B0); PG8_MMA(0, 1, At, B1); PG8_BAR; PG8_SCHED;
            PG8_LDA(At, 0, 1); PG8_STAGE(PG8_SB(0, 0), b2, voffB); PG8_STAGE(PG8_SB(0, 1), b2 + hstep, voffB); PG8_STAGE(PG8_SA(0, 0), a2, voffA);
            PG8_WAIT_V(8); PG8_WAIT_L(0); PG8_BAR; PG8_MMA(1, 0, At, B0); PG8_MMA(1, 1, At, B1); PG8_BAR; PG8_SCHED;
            PG8_LDB(B0, 1, 0); PG8_LDB(B1, 1, 1); PG8_SCHED; PG8_LDA(At, 1, 0); PG8_STAGE(PG8_SA(0, 1), a2 + hstep, voffA);
            PG8_WAIT_V(8); PG8_WAIT_L(0); PG8_BAR; PG8_MMA(0, 0, At, B0); PG8_MMA(0, 1, At, B1); PG8_BAR; PG8_SCHED;
            PG8_LDA(At, 1, 1); PG8_STAGE(PG8_SB(1, 0), b3, voffB); PG8_STAGE(PG8_SB(1, 1), b3 + hstep, voffB); PG8_STAGE(PG8_SA(1, 0), a3, voffA);
            PG8_WAIT_V(8); PG8_WAIT_L(0); PG8_BAR; PG8_MMA(1, 0, At, B0); PG8_MMA(1, 1, At, B1); PG8_BAR; PG8_SCHED;
            } else {
            PG8_LDB(B0, 0, 0); PG8_SCHED; PG8_LDA(At, 0, 0); PG8_STAGE(PG8_SA(1, 1), a1 + hstep, voffA);
            PG8_WAIT_L(8); PG8_BAR; PG8_WAIT_L(0); PG8_MMA(0, 0, At, B0); PG8_BAR; PG8_SCHED;
            PG8_LDB(B1, 0, 1); PG8_STAGE(PG8_SB(0, 0), b2, voffB);
            PG8_BAR; PG8_WAIT_L(0); PG8_MMA(0, 1, At, B1); PG8_BAR;
            PG8_LDA(At, 0, 1); PG8_STAGE(PG8_SA(0, 0), a2, voffA);
            PG8_BAR; PG8_WAIT_L(0); PG8_MMA(1, 0, At, B0); PG8_BAR; PG8_SCHED;
            PG8_STAGE(PG8_SB(0, 1), b2 + hstep, voffB);
            PG8_WAIT_V(6); PG8_BAR; PG8_MMA(1, 1, At, B1); PG8_BAR;
            PG8_LDB(B0, 1, 0); PG8_SCHED; PG8_LDA(At, 1, 0); PG8_STAGE(PG8_SA(0, 1), a2 + hstep, voffA);
            PG8_WAIT_L(8); PG8_BAR; PG8_WAIT_L(0); PG8_MMA(0, 0, At, B0); PG8_BAR; PG8_SCHED;
            PG8_LDB(B1, 1, 1); PG8_STAGE(PG8_SB(1, 0), b3, voffB);
            PG8_BAR; PG8_WAIT_L(0); PG8_MMA(0, 1, At, B1); PG8_BAR;
            PG8_LDA(At, 1, 1); PG8_STAGE(PG8_SA(1, 0), a3, voffA);
            PG8_BAR; PG8_WAIT_L(0); PG8_MMA(1, 0, At, B0); PG8_BAR; PG8_SCHED;
            PG8_STAGE(PG8_SB(1, 1), b3 + hstep, voffB);
            PG8_WAIT_V(6); PG8_BAR; PG8_MMA(1, 1, At, B1); PG8_BAR;
            }
        }
        if constexpr (ALIGN_EPI) { if (wr == 0) PG8_BAR; }
        if constexpr (!Epi::AFTER_DRAIN) { E(acc, cur, wr, wc, fr, fq); S.done(cur); }
        if (!has_next) break;
        if (!Epi::SEG || nxt.seg == 0) {
#pragma unroll
        for (int a = 0; a < 2; ++a)
#pragma unroll
            for (int b = 0; b < 2; ++b)
#pragma unroll
                for (int m = 0; m < 4; ++m)
#pragma unroll
                    for (int n = 0; n < 2; ++n) acc[a][b][m][n] = (f32x4){0.f, 0.f, 0.f, 0.f};
        }
        cur = nxt; cA = nA; cB = nB; ++ui;
        if constexpr (ALIGN_EPI) { if (wr == 1) PG8_BAR; }
    }
    PG8_WAIT_V(0);
    if constexpr (!ALIGN_EPI) { if (wr == 0) PG8_BAR; }
    PG8_BAR;
    if constexpr (Epi::AFTER_DRAIN) { E.fused(acc, cur, wr, wc, fr, fq, lds, wid, lane); S.done(cur); }
#undef PG8_SA
#undef PG8_SB
#undef PG8_STAGE
#undef PG8_LDA
#undef PG8_LDB
#undef PG8_MMA
#undef PG8_WAIT_V
#undef PG8_WAIT_L
#undef PG8_BAR
#undef PG8_SCHED
}
}

#ifndef PG8_SP2
#define PG8_SP2 true
#endif
#ifndef PG8_ALIGN
#define PG8_ALIGN true
#endif

constexpr int NWAVES = 8;
#ifndef MK_N_LAUNCHES
#define MK_N_LAUNCHES 1
#endif
constexpr int N_PHASES = 13;
constexpr int N_LAUNCHES = MK_N_LAUNCHES;

constexpr int D = 4096, DFF = 11008, DLRU = 2048, DSSM = 2048, DIN = 14336;
constexpr int NP = 4, TP = 2048, NS = 128, TS = 8;
constexpr int MP = NP * TP, MS = NS * TS, M = MP + MS;
constexpr int NGRP = 128, SP = 64, SCG = 16;
constexpr float EPS = 1e-6f;

constexpr size_t MiB = 1u << 20;
constexpr size_t WS_CTL = 0, CTL_ZERO_BYTES = 1 * MiB;
constexpr size_t WS_ABAR = 2 * MiB;
constexpr size_t WS_BB = 3 * MiB;
constexpr size_t WS_CC = 4 * MiB;
constexpr size_t WS_WG = 5 * MiB;
constexpr size_t WS_WGU1 = 8 * MiB, WS_WD1 = 180 * MiB, WS_WIN = 266 * MiB, WS_WGLU = 378 * MiB, WS_WOUT = 386 * MiB, WS_WO = 418 * MiB, WS_WGU2 = 450 * MiB, WS_WD2 = 622 * MiB;
constexpr size_t WS_XN = 708 * MiB;
constexpr size_t WS_HID = 780 * MiB;
constexpr size_t WS_XA = WS_HID, WS_GA = WS_HID + 72 * MiB, WS_XB = WS_HID + 108 * MiB, WS_G2 = WS_HID + 144 * MiB;
constexpr size_t WS_F = 974 * MiB;
constexpr size_t WS_G = WS_F;
constexpr size_t WS_YAB = 1118 * MiB, WS_END = 1190 * MiB;
constexpr size_t WS_SLAB = WS_YAB, SLAB_FLOATS = (size_t)MS * D;
static_assert(3 * SLAB_FLOATS * 4 <= (size_t)M * D * 2, "slabs inside YAB");
static_assert(WS_WGU1 + (size_t)2 * DFF * D * 2 <= WS_WD1 && WS_WD1 + (size_t)D * DFF * 2 <= WS_WIN && WS_WIN + (size_t)DIN * D * 2 <= WS_WGLU && WS_WGLU + (size_t)DSSM * DSSM * 2 <= WS_WOUT, "ws map 1");
static_assert(WS_WOUT + (size_t)D * D * 2 <= WS_WO && WS_WO + (size_t)D * D * 2 <= WS_WGU2 && WS_WGU2 + (size_t)2 * DFF * D * 2 <= WS_WD2 && WS_WD2 + (size_t)D * DFF * 2 <= WS_XN, "ws map 2");
static_assert(WS_XN + (size_t)M * D * 2 <= WS_HID && WS_HID + (size_t)M * DFF * 2 <= WS_F && WS_G2 + (size_t)M * DSSM * 2 <= WS_F && WS_F + (size_t)M * D * 4 <= WS_YAB && WS_YAB + (size_t)M * D * 2 <= WS_END, "ws map 3");
constexpr int CW_TMO = 0, CW_CODE = 1;
constexpr int CW_XS = 100000;
constexpr int CW_BAR = 4096;

constexpr int RING_OFF = 0, RING_BYTES = 131072;
constexpr int LDSCTL_OFF = RING_BYTES, MISC_OFF = LDSCTL_OFF + 320;
constexpr int LDS_BYTES = 147456;
static_assert(MISC_OFF + 128 <= LDS_BYTES, "LDS map");

#define GAS __attribute__((address_space(1)))
#define LAS __attribute__((address_space(3)))
typedef unsigned short bf16;
typedef unsigned v4u __attribute__((ext_vector_type(4)));
typedef unsigned v2u __attribute__((ext_vector_type(2)));
typedef float f32x4 __attribute__((ext_vector_type(4)));
typedef float f32x2 __attribute__((ext_vector_type(2)));
typedef short bf16x8 __attribute__((ext_vector_type(8)));
typedef GAS unsigned gu32;
typedef GAS unsigned long long gu64;
#define RLX_AGENT __ATOMIC_RELAXED, __HIP_MEMORY_SCOPE_AGENT
#define LDS_WAIT() asm volatile("s_waitcnt lgkmcnt(0)" ::: "memory")
#define VM_WAIT() asm volatile("s_waitcnt vmcnt(0)" ::: "memory")
__device__ __forceinline__ unsigned f2bf(float f) { unsigned u = __builtin_bit_cast(unsigned, f); return (u + 0x7fffu + ((u >> 16) & 1u)) >> 16; }
__device__ __forceinline__ unsigned pk2(float lo, float hi) { return pg8::cvt_pk_bf16(lo, hi); }
using pg8::bf_lo; using pg8::bf_hi; using pg8::fast_sigmoid; using pg8::gelu_tanh_f;
#define XB_TMO      128
#define XB_XCNT(j)  (256  + 64 * (j))
#define XB_XSUB(j)  (1280 + 64 * (j))
#define XB_XGEN(j)  (2304 + 64 * (j))
#define XB_TOP      3328
#define XB_TOPGEN   3392
#define XCD_BAR_WORDS 3456
#define XB_SPIN_CAP (1u << 18)

__device__ __forceinline__ unsigned xb_ld(unsigned* p)              { return __hip_atomic_load(p, __ATOMIC_RELAXED, __HIP_MEMORY_SCOPE_AGENT); }
__device__ __forceinline__ unsigned xb_add(unsigned* p, unsigned v) { return __hip_atomic_fetch_add(p, v, __ATOMIC_RELAXED, __HIP_MEMORY_SCOPE_AGENT); }
__device__ __forceinline__ unsigned xb_xcc_id() { return (unsigned)__builtin_amdgcn_s_getreg((3 << 11) | 20) & 0xFu; }
#define XB_SPIN(cond, bar) do { unsigned _sp = 0; while (cond) { __builtin_amdgcn_s_sleep(1); \
    if ((++_sp & 255u) == 0u) { if (xb_ld(&(bar)[XB_TMO])) break; if (_sp > XB_SPIN_CAP) { atomicAdd(&(bar)[XB_TMO], 1u); break; } } } } while (0)

struct XcdBarrier {
    unsigned* bar; unsigned x;
    volatile LAS unsigned* st;
};

__device__ __forceinline__ XcdBarrier xcd_barrier_post(unsigned* bar, volatile LAS unsigned* st) {
    XcdBarrier b; b.bar = bar; b.x = xb_xcc_id(); b.st = st;
    if (threadIdx.x == 0) st[2] = xb_add(&bar[XB_XCNT(b.x)], 1u);
    return b;
}
__device__ __forceinline__ void xcd_barrier_complete(unsigned* bar, unsigned x, unsigned& nloc, unsigned& nx) {
    const unsigned G = gridDim.x * gridDim.y * gridDim.z;
    unsigned sum, cnt, mine, sp = 0u;
    for (;;) {
        sum = 0u; cnt = 0u; mine = 0u;
#pragma unroll
        for (unsigned j = 0; j < 16; ++j) { const unsigned c = xb_ld(&bar[XB_XCNT(j)]); sum += c; cnt += (c > 0u) ? 1u : 0u; mine = (j == x) ? c : mine; }
        if (sum == G) break;
        __builtin_amdgcn_s_sleep(1);
        if ((++sp & 255u) == 0u) { if (xb_ld(&bar[XB_TMO])) break; if (sp > XB_SPIN_CAP) { atomicAdd(&bar[XB_TMO], 1u); break; } }
    }
    nloc = mine > 0u ? mine : 1u; nx = cnt > 0u ? cnt : 1u;
}

__device__ __forceinline__ void xcd_barrier(const XcdBarrier& b) {
    asm volatile("s_waitcnt vmcnt(0)" ::: "memory");
    __syncthreads();
    if (threadIdx.x == 0) {
        unsigned* bar = b.bar;
        __builtin_amdgcn_s_waitcnt(0);
        unsigned nloc = b.st[0], nx = b.st[1];
        if (nloc == 0u) { xcd_barrier_complete(bar, b.x, nloc, nx); b.st[0] = nloc; b.st[1] = nx; }
        const unsigned old = xb_add(&bar[XB_XSUB(b.x)], 1u);
        const unsigned gen = old / nloc;
        if (old + 1u == (gen + 1u) * nloc) {
            __builtin_amdgcn_fence(__ATOMIC_RELEASE, "agent");
            asm volatile("s_waitcnt vmcnt(0)" ::: "memory");
            const unsigned og = xb_add(&bar[XB_TOP], 1u);
            const unsigned tg = og / nx;
            if (og + 1u == (tg + 1u) * nx) xb_add(&bar[XB_TOPGEN], 1u);
            else XB_SPIN(xb_ld(&bar[XB_TOPGEN]) == tg, bar);
            __builtin_amdgcn_fence(__ATOMIC_ACQUIRE, "agent");
            xb_add(&bar[XB_XGEN(b.x)], 1u);
            asm volatile("s_waitcnt vmcnt(0)" ::: "memory");
        } else {
            XB_SPIN(xb_ld(&bar[XB_XGEN(b.x)]) == gen, bar);
            __builtin_amdgcn_fence(__ATOMIC_ACQUIRE, "agent");
            asm volatile("s_waitcnt vmcnt(0)" ::: "memory");
        }
    }
    __syncthreads();
}

__device__ __forceinline__ float wave_sum(float v) {
#pragma unroll
    for (int o = 1; o < 64; o <<= 1) v += __shfl_xor(v, o);
    return v;
}
constexpr size_t O_Y = 0, O_PLRU = (size_t)M * D, O_PCONV = O_PLRU + NP * DLRU, O_PRE = O_PCONV + NP * 3 * DLRU, O_PIM = O_PRE + NP * NGRP * SP, O_SLRU = O_PIM + NP * NGRP * SP,
                 O_SCONV = O_SLRU + NS * DLRU, O_SRE = O_SCONV + NS * 3 * DLRU, O_SIM = O_SRE + NS * NGRP * SP, O_END = O_SIM + NS * NGRP * SP;
static_assert(O_END == 40992768, "output size");

struct Args { const float* in[39]; float* out; unsigned char* ws; int ph_lo, ph_hi, li, pad; };
enum { I_XP = 0, I_XS, I_SLRU, I_SCONV, I_SRE, I_SIM, I_F1PRE, I_F1POST, I_F1G, I_F1U, I_F1D, I_MPRE, I_MPOST, I_WIN, I_CONVW, I_CONVB, I_WRG, I_BRG, I_WIG, I_BIG, I_LAM,
       I_ARE, I_AIM, I_LDT, I_BRE, I_BIM, I_CRE, I_CIM, I_DSK, I_WGLU, I_BGLU, I_WOA, I_WOB, I_WO, I_F2PRE, I_F2POST, I_F2G, I_F2U, I_F2D };

__device__ __forceinline__ void transpose_item(const float* W, int N, bf16* WT, int pitch, int k0, int n0, int drow, int dcol, LAS float* scr, int lane) {
#pragma unroll 8
    for (int i = 0; i < 32; ++i) { const int kk = 2 * i + (lane >> 5); scr[kk * 33 + (lane & 31)] = W[(size_t)(k0 + kk) * N + n0 + (lane & 31)]; }
    LDS_WAIT(); asm volatile("" ::: "memory");
    const int c = lane & 7;
#pragma unroll
    for (int j = 0; j < 4; ++j) { const int n = (lane >> 3) + 8 * j; const LAS float* s = scr + (8 * c) * 33 + n;
        v4u o; o.x = pk2(s[0 * 33], s[1 * 33]); o.y = pk2(s[2 * 33], s[3 * 33]); o.z = pk2(s[4 * 33], s[5 * 33]); o.w = pk2(s[6 * 33], s[7 * 33]);
        *(GAS v4u*)(WT + (size_t)(drow + n) * pitch + dcol + k0 + 8 * c) = o; }
    LDS_WAIT(); asm volatile("" ::: "memory");
}
__device__ __forceinline__ void tr_plain(const float* W, int K, int N, bf16* WT, int pitch, int dcol, int item, LAS float* scr, int lane) {
    const int nblk = N / 32, kb = item / nblk, nb = item - kb * nblk; (void)K;
    transpose_item(W, N, WT, pitch, 64 * kb, 32 * nb, 32 * nb, dcol, scr, lane);
}
__device__ __forceinline__ void tr_gu(const float* W, bf16* WT, int up, int item, LAS float* scr, int lane) {
    const int nblk = DFF / 32, kb = item / nblk, nb = item - kb * nblk, n0 = 32 * nb;
    transpose_item(W, DFF, WT, D, 64 * kb, n0, 256 * (n0 >> 7) + up * 128 + (n0 & 127), 0, scr, lane);
}
constexpr int IT_GU = (D / 64) * (DFF / 32), IT_DN = (DFF / 64) * (D / 32), IT_IN = (D / 64) * (DIN / 32), IT_GLU = (DSSM / 64) * (DSSM / 32), IT_OA = (DLRU / 64) * (D / 32), IT_WO = (D / 64) * (D / 32), IT_RG = 16 * 2 * 4;
constexpr int IT_TOTAL = 4 * IT_GU + 2 * IT_DN + IT_IN + IT_GLU + 2 * IT_OA + IT_WO + 2 * IT_RG;

template <int MODE> __device__ __forceinline__ void thin_rows(const Args& args, int gw, int ngw, int lane);

constexpr int ITB_GU1 = 0, ITB_DN1 = ITB_GU1 + 2 * IT_GU, ITB_IN = ITB_DN1 + IT_DN, ITB_GLU = ITB_IN + IT_IN, ITB_OA = ITB_GLU + IT_GLU, ITB_OB = ITB_OA + IT_OA, ITB_WO = ITB_OB + IT_OA,
              ITB_GU2 = ITB_WO + IT_WO, ITB_DN2 = ITB_GU2 + 2 * IT_GU, ITB_RG = ITB_DN2 + IT_DN, ITB_END = ITB_RG + 2 * IT_RG;
static_assert(ITB_END == IT_TOTAL, "item numbering");
__device__ __forceinline__ void convert_item(const Args& args, int it, LAS float* scr, int lane) {
    unsigned char* ws = args.ws; int r = it;
    if (r < IT_GU) { tr_gu(args.in[I_F1G], (bf16*)(ws + WS_WGU1), 0, r, scr, lane); return; } r -= IT_GU;
    if (r < IT_GU) { tr_gu(args.in[I_F1U], (bf16*)(ws + WS_WGU1), 1, r, scr, lane); return; } r -= IT_GU;
    if (r < IT_DN) { tr_plain(args.in[I_F1D], DFF, D, (bf16*)(ws + WS_WD1), DFF, 0, r, scr, lane); return; } r -= IT_DN;
    if (r < IT_IN) { tr_plain(args.in[I_WIN], D, DIN, (bf16*)(ws + WS_WIN), D, 0, r, scr, lane); return; } r -= IT_IN;
    if (r < IT_GLU) { tr_plain(args.in[I_WGLU], DSSM, DSSM, (bf16*)(ws + WS_WGLU), DSSM, 0, r, scr, lane); return; } r -= IT_GLU;
    if (r < IT_OA) { tr_plain(args.in[I_WOA], DLRU, D, (bf16*)(ws + WS_WOUT), D, 0, r, scr, lane); return; } r -= IT_OA;
    if (r < IT_OA) { tr_plain(args.in[I_WOB], DSSM, D, (bf16*)(ws + WS_WOUT), D, DLRU, r, scr, lane); return; } r -= IT_OA;
    if (r < IT_WO) { tr_plain(args.in[I_WO], D, D, (bf16*)(ws + WS_WO), D, 0, r, scr, lane); return; } r -= IT_WO;
    if (r < IT_GU) { tr_gu(args.in[I_F2G], (bf16*)(ws + WS_WGU2), 0, r, scr, lane); return; } r -= IT_GU;
    if (r < IT_GU) { tr_gu(args.in[I_F2U], (bf16*)(ws + WS_WGU2), 1, r, scr, lane); return; } r -= IT_GU;
    if (r < IT_DN) { tr_plain(args.in[I_F2D], DFF, D, (bf16*)(ws + WS_WD2), DFF, 0, r, scr, lane); return; } r -= IT_DN;
    { const int ig = r >= IT_RG ? 1 : 0; const int q = r - ig * IT_RG, h = q >> 3, sub = q & 7, kb = sub >> 2, nb = sub & 3;
      const float* W = (ig ? args.in[I_WIG] : args.in[I_WRG]) + (size_t)h * 128 * 128;
      transpose_item(W, 128, (bf16*)(ws + WS_WG) + (size_t)h * 256 * 128, 128, 64 * kb, 32 * nb, ig * 128 + 32 * nb, 0, scr, lane); }
}
constexpr int CW_Q = 60000, Q_CHUNK = 4;
__device__ __forceinline__ void convert_queue(const Args& args, int qid, int first, int n, LAS unsigned char* lds, int wave, int lane) {
    LAS float* scr = (LAS float*)(lds + RING_OFF + wave * 16384);
    unsigned* ctr = (unsigned*)(args.ws + WS_CTL) + CW_Q + 64 * qid;
    for (;;) {
        int base = 0;
        if (lane == 0) base = (int)__hip_atomic_fetch_add(ctr, (unsigned)Q_CHUNK, __ATOMIC_RELAXED, __HIP_MEMORY_SCOPE_AGENT);
        base = __builtin_amdgcn_readfirstlane(base);
        if (base >= n) break;
        const int e = (base + Q_CHUNK < n) ? base + Q_CHUNK : n;
        for (int it = base; it < e; ++it) convert_item(args, first + it, scr, lane);
    }
}

__device__ __forceinline__ void p0_prologue(const Args& args, LAS unsigned char* lds, int wave, int lane, int gw, int ngw) {
    unsigned char* ws = args.ws;
    LAS float* scr = (LAS float*)(lds + RING_OFF + wave * 16384);
#if defined(NO_TAIL_CONVERT)
    for (int it = gw; it < IT_TOTAL; it += ngw) convert_item(args, it, scr, lane);
#else
    for (int it = gw; it < 2 * IT_GU; it += ngw) convert_item(args, ITB_GU1 + it, scr, lane);
    for (int it = gw; it < 2 * IT_RG; it += ngw) convert_item(args, ITB_RG + it, scr, lane);
#endif
    {
        const int gt = gw * 64 + lane;
        if (gt < NGRP * SP) {
            const int g = gt >> 6, p = gt & 63;
            const double dt = exp((double)args.in[I_LDT][g]);
            const double ar = (double)args.in[I_ARE][gt], ai = (double)args.in[I_AIM][gt];
            const double mag = exp(ar * dt);
            double th = ai * dt; th -= 6.283185307179586476925 * rint(th * 0.15915494309189533577);
            const double x = 0.25 * th, x2 = x * x;
            double s = x * (1.0 + x2 * (-1.0 / 6 + x2 * (1.0 / 120 + x2 * (-1.0 / 5040 + x2 * (1.0 / 362880 + x2 * (-1.0 / 39916800 + x2 * (1.0 / 6227020800.0)))))));
            double c = 1.0 + x2 * (-0.5 + x2 * (1.0 / 24 + x2 * (-1.0 / 720 + x2 * (1.0 / 40320 + x2 * (-1.0 / 3628800 + x2 * (1.0 / 479001600.0 + x2 * (-1.0 / 87178291200.0)))))));
            { const double s2 = 2.0 * s * c, c2 = 1.0 - 2.0 * s * s; s = s2; c = c2; }
            { const double s2 = 2.0 * s * c, c2 = 1.0 - 2.0 * s * s; s = s2; c = c2; }
            const double abr = mag * c, abi = mag * s;
            const double den = ar * ar + ai * ai, nr = abr - 1.0, ni = abi;
            const double cre = (nr * ar + ni * ai) / den, cim = (ni * ar - nr * ai) / den;
            float* AB = (float*)(ws + WS_ABAR); AB[2 * gt] = (float)abr; AB[2 * gt + 1] = (float)abi;
            bf16* BB = (bf16*)(ws + WS_BB); bf16* CC = (bf16*)(ws + WS_CC);
            const float* bre = args.in[I_BRE] + (size_t)gt * SCG; const float* bim = args.in[I_BIM] + (size_t)gt * SCG;
#pragma unroll 4
            for (int ch = 0; ch < SCG; ++ch) {
                const double br = (double)bre[ch], bi = (double)bim[ch];
                const float vre = (float)(cre * br - cim * bi), vim = (float)(cre * bi + cim * br);
#pragma unroll
                for (int ri = 0; ri < 2; ++ri) { const int col = 2 * p + ri, j = col >> 4, ln = (col & 15) + 16 * (ch >> 3);
                    BB[((size_t)(g * 8 + j) * 64 + ln) * 8 + (ch & 7)] = (bf16)f2bf(ri ? vim : vre); }
                const float c_re = args.in[I_CRE][((size_t)g * SCG + ch) * SP + p], c_im = args.in[I_CIM][((size_t)g * SCG + ch) * SP + p];
#pragma unroll
                for (int ri = 0; ri < 2; ++ri) { const int k = 2 * p + ri, kk = k >> 5, ln = ch + 16 * ((k & 31) >> 3);
                    CC[((size_t)(g * 4 + kk) * 64 + ln) * 8 + (k & 7)] = (bf16)f2bf(ri ? -c_im : c_re); }
            }
        }
    }
    thin_rows<0>(args, gw, ngw, lane);
}

template <int MODE> __device__ __forceinline__ void thin_rows(const Args& args, int gw, int ngw, int lane) {
    const float* gA = MODE == 1 ? args.in[I_F1POST] : (MODE == 2 ? args.in[I_MPOST] : args.in[I_F2POST]);
    const float* gB = MODE == 0 ? args.in[I_F1PRE] : (MODE == 1 ? args.in[I_MPRE] : args.in[I_F2PRE]);
    const float sc = MODE == 2 ? 1.0f : 0.5f;
    float* Y = args.out + O_Y; const float* Fb = (const float*)(args.ws + WS_F); bf16* XN = (bf16*)(args.ws + WS_XN);
    for (int m = gw; m < M; m += ngw) {
        const float* xin = (MODE <= 1) ? (m < MP ? args.in[I_XP] + (size_t)m * D : args.in[I_XS] + (size_t)(m - MP) * D) : Y + (size_t)m * D;
        const GAS f32x4* xr = (const GAS f32x4*)xin + lane;
        f32x4 v[16];
#pragma unroll
        for (int j = 0; j < 16; ++j) v[j] = xr[64 * j];
        if (MODE >= 1) {
            const GAS f32x4* fr = (const GAS f32x4*)(Fb + (size_t)m * D) + lane;
            f32x4 f[16]; float s = 0.f;
#pragma unroll
            for (int j = 0; j < 16; ++j) f[j] = fr[64 * j];
            if (m >= MP) {
#pragma unroll
                for (int q = 0; q < 3; ++q) { const GAS f32x4* sr = (const GAS f32x4*)((const float*)(args.ws + WS_SLAB) + q * SLAB_FLOATS + (size_t)(m - MP) * D) + lane;
#pragma unroll
                    for (int j = 0; j < 16; ++j) f[j] = f[j] + sr[64 * j]; } }
#pragma unroll
            for (int j = 0; j < 16; ++j) s += (f[j].x * f[j].x + f[j].y * f[j].y) + (f[j].z * f[j].z + f[j].w * f[j].w);
            const float rstd = sc / sqrtf(wave_sum(s) * (1.f / D) + EPS);
            const GAS f32x4* gr = (const GAS f32x4*)gA + lane;
            GAS f32x4* yo = (GAS f32x4*)(Y + (size_t)m * D) + lane;
#pragma unroll
            for (int j = 0; j < 16; ++j) { const f32x4 g = gr[64 * j]; v[j] = v[j] + f[j] * rstd * g; yo[64 * j] = v[j]; }
        }
        if (MODE <= 2) {
            float s = 0.f;
#pragma unroll
            for (int j = 0; j < 16; ++j) s += (v[j].x * v[j].x + v[j].y * v[j].y) + (v[j].z * v[j].z + v[j].w * v[j].w);
            const float rstd = 1.0f / sqrtf(wave_sum(s) * (1.f / D) + EPS);
            const GAS f32x4* gr = (const GAS f32x4*)gB + lane;
            GAS v2u* o8 = (GAS v2u*)(XN + (size_t)m * D) + lane;
#pragma unroll
            for (int j = 0; j < 16; ++j) { const f32x4 g = gr[64 * j]; const f32x4 o = v[j] * rstd * g; v2u w; w.x = pk2(o.x, o.y); w.y = pk2(o.z, o.w); o8[64 * j] = w; }
        }
    }
}

constexpr int L_WSL = 0, L_XCB = 17408, L_XCF = 34816, L_LA = 43264, L_LB = 51712, L_LH = 60160, L_END = 68608;
constexpr int LP = 33;
#define LBAR() do { asm volatile("s_waitcnt lgkmcnt(0)" ::: "memory"); __builtin_amdgcn_s_barrier(); asm volatile("" ::: "memory"); } while (0)
template <bool SAMPLE> __device__ __forceinline__ void lru_load_tile(const Args& args, const float* XA, const bf16* GA, int chain, int k, int tg, int cg, int chb, int q, int tid, f32x4 (&v)[7], v2u& gaw) {
    const size_t rbase = SAMPLE ? (size_t)MP + 64 * chain : (size_t)chain * TP + 64 * k;
#pragma unroll
    for (int i = 0; i < 7; ++i) {
        if (SAMPLE) { const int ts = 4 * (tg & 1) - 3 + i, sl = tg >> 1;
            v[i] = (ts >= 0) ? *(const GAS f32x4*)(XA + (rbase + 8 * sl + ts) * DLRU + chb + 4 * cg)
                             : *(const GAS f32x4*)(args.in[I_SCONV] + ((size_t)(8 * chain + sl) * 3 + (3 + ts)) * DLRU + chb + 4 * cg);
        } else { const int tt = 4 * tg - 3 + i;
            v[i] = (k > 0 || tt >= 0) ? *(const GAS f32x4*)(XA + (rbase + tt) * DLRU + chb + 4 * cg) : (f32x4){0.f, 0.f, 0.f, 0.f}; }
    }
    gaw = *(const GAS v2u*)(GA + (rbase + (tid >> 3)) * DLRU + chb + 32 * q + (tid & 7) * 4);
}
template <bool SAMPLE> __device__ __forceinline__ void lru_task(const Args& args, LAS unsigned char* lds, int tid, int wave, int lane, int chain, int head, int q) {
    unsigned char* ws = args.ws;
    const float* XA = (const float*)(ws + WS_XA); const bf16* GA = (const bf16*)(ws + WS_GA); bf16* YAB = (bf16*)(ws + WS_YAB);
    const int chb = head * 128;
    const int cg = tid & 31, tg = tid >> 5;
    f32x4 v[7]; v2u gaw;
    lru_load_tile<SAMPLE>(args, XA, GA, chain, 0, tg, cg, chb, q, tid, v, gaw);
    { const bf16* WG = (const bf16*)(ws + WS_WG) + (size_t)head * 256 * 128;
      for (int i = tid; i < 1024; i += 512) { const int r = i >> 4, c16 = i & 15; const int srow = (r < 32) ? (32 * q + r) : (128 + 32 * q + (r - 32));
          *(LAS v4u*)(lds + L_WSL + r * 272 + c16 * 16) = *(const GAS v4u*)(WG + (size_t)srow * 128 + c16 * 8); } }
    const f32x4 cw0 = *(const f32x4*)(args.in[I_CONVW] + 0 * DLRU + chb + 4 * cg), cw1 = *(const f32x4*)(args.in[I_CONVW] + 1 * DLRU + chb + 4 * cg),
                cw2 = *(const f32x4*)(args.in[I_CONVW] + 2 * DLRU + chb + 4 * cg), cw3 = *(const f32x4*)(args.in[I_CONVW] + 3 * DLRU + chb + 4 * cg),
                cbv = *(const f32x4*)(args.in[I_CONVB] + chb + 4 * cg);
    const int tb = wave & 3, ct = wave >> 2, l15 = lane & 15, lq = lane >> 4;
    const int chg = chb + 32 * q + 16 * ct + l15;
    const float brg = args.in[I_BRG][chg], big = args.in[I_BIG][chg];
    const float lam = args.in[I_LAM][chg];
    const float sp8 = -8.0f * log1pf(expf(-lam));
    float hcar = 0.f;
    float h0s[8];
#pragma unroll
    for (int s = 0; s < 8; ++s) h0s[s] = 0.f;
    if (SAMPLE && tid < 32) {
#pragma unroll
        for (int s = 0; s < 8; ++s) h0s[s] = args.in[I_SLRU][(size_t)(8 * chain + s) * DLRU + chb + 32 * q + tid];
    }
    const int ntile = SAMPLE ? 1 : 32;
    for (int k = 0; k < ntile; ++k) {
        const size_t rbase = SAMPLE ? (size_t)MP + 64 * chain : (size_t)chain * TP + 64 * k;
#pragma unroll
        for (int o = 0; o < 4; ++o) { const f32x4 xc = cbv + cw0 * v[o] + cw1 * v[o + 1] + cw2 * v[o + 2] + cw3 * v[o + 3];
            v2u w; w.x = pk2(xc.x, xc.y); w.y = pk2(xc.z, xc.w);
            *(LAS v2u*)(lds + L_XCB + (4 * tg + o) * 272 + cg * 8) = w;
            if ((cg >> 3) == q) { LAS float* xf = (LAS float*)(lds + L_XCF) + (4 * tg + o) * LP + 4 * (cg & 7); xf[0] = xc.x; xf[1] = xc.y; xf[2] = xc.z; xf[3] = xc.w; } }
        const v2u gcur = gaw;
        if (k + 1 < ntile) lru_load_tile<SAMPLE>(args, XA, GA, chain, k + 1, tg, cg, chb, q, tid, v, gaw);
        LBAR();
        pg8::f32x4 accr = {0.f, 0.f, 0.f, 0.f}, acci = {0.f, 0.f, 0.f, 0.f};
#pragma unroll
        for (int kk = 0; kk < 4; ++kk) {
            const bf16x8 a = *(const LAS bf16x8*)(lds + L_XCB + (16 * tb + l15) * 272 + kk * 64 + lq * 16);
            const bf16x8 br = *(const LAS bf16x8*)(lds + L_WSL + (16 * ct + l15) * 272 + kk * 64 + lq * 16);
            const bf16x8 bi = *(const LAS bf16x8*)(lds + L_WSL + (32 + 16 * ct + l15) * 272 + kk * 64 + lq * 16);
            accr = __builtin_amdgcn_mfma_f32_16x16x32_bf16(a, br, accr, 0, 0, 0);
            acci = __builtin_amdgcn_mfma_f32_16x16x32_bf16(a, bi, acci, 0, 0, 0);
        }
#pragma unroll
        for (int r = 0; r < 4; ++r) { const int tt = 16 * tb + 4 * lq + r, cl = 16 * ct + l15;
            const float rg = fast_sigmoid(accr[r] + brg), ig = fast_sigmoid(acci[r] + big);
            const float la = sp8 * rg;
            const float a = __builtin_amdgcn_exp2f(la * 1.4426950408889634f);
            const float x2 = 2.0f * la;
            const float em = (x2 > -0.25f) ? -x2 * (1.0f + x2 * (0.5f + x2 * (1.0f / 6 + x2 * (1.0f / 24 + x2 * (1.0f / 120 + x2 * (1.0f / 720))))))
                                           : 1.0f - __builtin_amdgcn_exp2f(x2 * 1.4426950408889634f);
            const float xcv = ((const LAS float*)(lds + L_XCF))[tt * LP + cl];
            ((LAS float*)(lds + L_LA))[tt * LP + cl] = a;
            ((LAS float*)(lds + L_LB))[tt * LP + cl] = sqrtf(em) * ig * xcv; }
        LBAR();
        if (tid < 32) {
            const LAS float* la = (const LAS float*)(lds + L_LA) + tid; const LAS float* lb = (const LAS float*)(lds + L_LB) + tid; LAS float* lh = (LAS float*)(lds + L_LH) + tid;
            const int ch = chb + 32 * q + tid;
#pragma unroll
            for (int s = 0; s < 8; ++s) {
                if (SAMPLE) hcar = h0s[s];
#pragma unroll
                for (int t8 = 0; t8 < 8; ++t8) { const int tt = 8 * s + t8; hcar = la[tt * LP] * hcar + lb[tt * LP]; lh[tt * LP] = hcar; }
                if (SAMPLE) args.out[O_SLRU + (size_t)(8 * chain + s) * DLRU + ch] = hcar;
            }
            if (!SAMPLE && k == ntile - 1) args.out[O_PLRU + (size_t)chain * DLRU + ch] = hcar;
        }
        LBAR();
        { const int t = tid >> 3, c4 = (tid & 7) * 4; const LAS float* lh = (const LAS float*)(lds + L_LH) + t * LP + c4;
          v2u o; o.x = pk2(lh[0] * bf_lo(gcur.x), lh[1] * bf_hi(gcur.x)); o.y = pk2(lh[2] * bf_lo(gcur.y), lh[3] * bf_hi(gcur.y));
          *(GAS v2u*)(YAB + (rbase + t) * D + chb + 32 * q + c4) = o; }
    }
    LBAR();
}

constexpr int S5_WAVE_LDS = 12800, S5_BU = 0, S5_HS = 8448;
template <bool SAMPLE> __device__ __forceinline__ void s5_task(const Args& args, LAS unsigned char* wl, int lane, int chain, int g) {
    unsigned char* ws = args.ws;
    const bf16* XB = (const bf16*)(ws + WS_XB); bf16* G2 = (bf16*)(ws + WS_G2);
    const int l15 = lane & 15, lq = lane >> 4;
    const f32x2 ab = *(const GAS f32x2*)((const float*)(ws + WS_ABAR) + 2 * (g * SP + lane));
    bf16x8 bfrag[8], cfrag[4];
#pragma unroll
    for (int j = 0; j < 8; ++j) { bfrag[j] = (bf16x8){0, 0, 0, 0, 0, 0, 0, 0}; if (lane < 32) bfrag[j] = *(const GAS bf16x8*)((const bf16*)(ws + WS_BB) + ((size_t)(g * 8 + j) * 64 + lane) * 8); }
#pragma unroll
    for (int kk = 0; kk < 4; ++kk) cfrag[kk] = *(const GAS bf16x8*)((const bf16*)(ws + WS_CC) + ((size_t)(g * 4 + kk) * 64 + lane) * 8);
    const f32x4 dsk = *(const GAS f32x4*)(args.in[I_DSK] + g * SCG + 4 * lq);
    float hr = 0.f, hi = 0.f;
    const int ntile = SAMPLE ? 1 : 32;
    for (int k = 0; k < ntile; ++k) {
        const size_t rbase = SAMPLE ? (size_t)MP + 64 * chain : (size_t)chain * TP + 64 * k;
#pragma unroll 1
        for (int tb = 0; tb < 4; ++tb) {
            const size_t row0 = rbase + 16 * tb;
            bf16x8 a = (bf16x8){0, 0, 0, 0, 0, 0, 0, 0};
            if (lane < 32) a = *(const GAS bf16x8*)(XB + (row0 + l15) * DSSM + g * SCG + 8 * lq);
#pragma unroll
            for (int j = 0; j < 8; ++j) { const pg8::f32x4 c = __builtin_amdgcn_mfma_f32_16x16x32_bf16(a, bfrag[j], (pg8::f32x4){0.f, 0.f, 0.f, 0.f}, 0, 0, 0);
#pragma unroll
                for (int r = 0; r < 4; ++r) ((LAS float*)(wl + S5_BU))[(4 * lq + r) * 132 + 16 * j + l15] = c[r]; }
            LDS_WAIT();
            f32x2 bu[16];
#pragma unroll
            for (int t = 0; t < 16; ++t) bu[t] = *(const LAS f32x2*)(wl + S5_BU + (t * 132 + 2 * lane) * 4);
#pragma unroll
            for (int t = 0; t < 16; ++t) {
                if (SAMPLE && (t & 7) == 0) { const size_t si = ((size_t)(8 * chain + 2 * tb + (t >> 3)) * NGRP + g) * SP + lane; hr = args.in[I_SRE][si]; hi = args.in[I_SIM][si]; }
                const float nr = ab.x * hr - ab.y * hi + bu[t].x, ni = ab.x * hi + ab.y * hr + bu[t].y; hr = nr; hi = ni;
                *(LAS unsigned*)(wl + S5_HS + t * 272 + 4 * lane) = pk2(hr, hi);
                if (SAMPLE && (t & 7) == 7) { const size_t si = ((size_t)(8 * chain + 2 * tb + (t >> 3)) * NGRP + g) * SP + lane; args.out[O_SRE + si] = hr; args.out[O_SIM + si] = hi; }
            }
            LDS_WAIT();
            pg8::f32x4 y = {0.f, 0.f, 0.f, 0.f};
#pragma unroll
            for (int kk = 0; kk < 4; ++kk) { const bf16x8 hb = *(const LAS bf16x8*)(wl + S5_HS + l15 * 272 + kk * 64 + lq * 16);
                y = __builtin_amdgcn_mfma_f32_16x16x32_bf16(cfrag[kk], hb, y, 0, 0, 0); }
            LDS_WAIT();
            const v2u uw = *(const GAS v2u*)(XB + (row0 + l15) * DSSM + g * SCG + 4 * lq);
            const float y0 = y[0] + dsk.x * bf_lo(uw.x), y1 = y[1] + dsk.y * bf_hi(uw.x), y2 = y[2] + dsk.z * bf_lo(uw.y), y3 = y[3] + dsk.w * bf_hi(uw.y);
            v2u o; o.x = pk2(gelu_tanh_f(y0), gelu_tanh_f(y1)); o.y = pk2(gelu_tanh_f(y2), gelu_tanh_f(y3));
            *(GAS v2u*)(G2 + (row0 + l15) * DSSM + g * SCG + 4 * lq) = o;
        }
    }
    if (!SAMPLE) { const size_t si = ((size_t)chain * NGRP + g) * SP + lane; args.out[O_PRE + si] = hr; args.out[O_PIM + si] = hi; }
}

__device__ __forceinline__ void p5_mixer(const Args& args, LAS unsigned char* lds, int tid, int wave, int lane, int bx, int G) {
    { const float* XA = (const float*)(args.ws + WS_XA);
      const int nv = (NP + NS) * 3 * (DLRU / 4);
      for (int i = bx * 512 + tid; i < nv; i += G * 512) { const int c4 = i % (DLRU / 4), rj = i / (DLRU / 4), s = rj / 3, j = rj % 3;
          if (s < NP) *(GAS f32x4*)(args.out + O_PCONV + ((size_t)s * 3 + j) * DLRU + 4 * c4) = *(const GAS f32x4*)(XA + ((size_t)s * TP + TP - 3 + j) * DLRU + 4 * c4);
          else { const int ss = s - NP; *(GAS f32x4*)(args.out + O_SCONV + ((size_t)ss * 3 + j) * DLRU + 4 * c4) = *(const GAS f32x4*)(XA + ((size_t)MP + 8 * ss + 5 + j) * DLRU + 4 * c4); } } }
#if !defined(SKIP_LRU)
    for (int t = bx; t < NP * 64; t += G) lru_task<false>(args, lds, tid, wave, lane, t >> 6, (t >> 2) & 15, t & 3);
    for (int t = bx; t < 16 * 64; t += G) lru_task<true>(args, lds, tid, wave, lane, t >> 6, (t >> 2) & 15, t & 3);
#endif
#if defined(S5_PROBE)
    { const bf16* CCp = (const bf16*)(args.ws + WS_CC); const bf16* BBp = (const bf16*)(args.ws + WS_BB); const float* ABp = (const float*)(args.ws + WS_ABAR); const bf16* XBp = (const bf16*)(args.ws + WS_XB);
      for (int i = bx * 512 + tid; i < 32768; i += G * 512) { float s = 0.f, s2 = 0.f;
          for (int e = 0; e < 8; ++e) { s += __uint_as_float((unsigned)CCp[(size_t)i * 8 + e] << 16); s2 += __uint_as_float((unsigned)BBp[((size_t)(i >> 5) * 64 + (i & 31)) * 8 + e] << 16); }
          args.out[O_PRE + i] = s; args.out[O_PIM + i] = s2; if (i < 16384) args.out[O_SRE + i] = ABp[i]; }
      for (int i = bx * 512 + tid; i < 1048576; i += G * 512) { float s = 0.f; for (int e = 0; e < 18; ++e) s += __uint_as_float((unsigned)XBp[(size_t)i * 18 + e] << 16); args.out[O_SIM + i] = s; } }
#endif
#if !defined(SKIP_S5)
    LAS unsigned char* wl = lds + wave * S5_WAVE_LDS;
    const int gw = bx * NWAVES + wave, ngw = G * NWAVES;
    if (ngw >= 1024) {
        if (gw < NP * NGRP) s5_task<false>(args, wl, lane, gw >> 7, gw & 127);
        else for (int t = gw - NP * NGRP; t < 16 * NGRP; t += ngw - NP * NGRP) s5_task<true>(args, wl, lane, t >> 7, t & 127);
    } else {
        for (int t = gw; t < NP * NGRP; t += ngw) s5_task<false>(args, wl, lane, t >> 7, t & 127);
        for (int t = gw; t < 16 * NGRP; t += ngw) s5_task<true>(args, wl, lane, t >> 7, t & 127);
    }
#endif
    __syncthreads();
}

__global__ void __launch_bounds__(NWAVES * 64, 2) hawk_fwd(Args args) {
    extern __shared__ __attribute__((aligned(16))) unsigned char lds_raw[];
    LAS unsigned char* lds = (LAS unsigned char*)lds_raw;
    volatile LAS unsigned* MISC = (volatile LAS unsigned*)(lds + MISC_OFF);
    const int tid = threadIdx.x, lane = tid & 63, wave = __builtin_amdgcn_readfirstlane(tid >> 6);
    const int G = gridDim.x, bx = blockIdx.x;
    const int gw = bx * NWAVES + wave, ngw = G * NWAVES;
    unsigned char* ws = args.ws;
    gu32* ctl = (gu32*)(ws + WS_CTL);
    for (int u = tid; u < (LDS_BYTES - LDSCTL_OFF) / 4; u += NWAVES * 64) ((LAS unsigned*)(lds + LDSCTL_OFF))[u] = 0u;
#if defined(XCHK) && XCHK
    for (int u = tid; u < RING_BYTES / 4; u += NWAVES * 64) ((LAS unsigned*)lds)[u] = 0xFFFFFFFFu;
#endif
    __syncthreads();
    XcdBarrier bar = xcd_barrier_post((unsigned*)(ctl + CW_BAR) + args.li * XCD_BAR_WORDS, MISC + 8);
    const int lo = args.ph_lo, hi = args.ph_hi;
#ifndef PHMASK
#define PHMASK 0x1fff
#endif
#define IN(k) ((((PHMASK) >> (k)) & 1) && lo <= (k) && (k) < hi)
#define BOTH(k) (IN(k) && IN((k) + 1))
#define SEAM(k) do { if (BOTH(k)) xcd_barrier(bar); } while (0)
    bf16* XN = (bf16*)(ws + WS_XN); bf16* HID = (bf16*)(ws + WS_HID); float* Fb = (float*)(ws + WS_F); bf16* YAB = (bf16*)(ws + WS_YAB);
#ifndef XS_ON
#define XS_ON 0
#endif
#define XS_CNT(ph) ((unsigned*)(ctl + CW_XS) + (ph) * 1024 + 64 * bar.x)
#define xs_nloc ((unsigned)MISC[8])

#if defined(XCHK) && XCHK
    if (lo == 0) {
        GAS v4u* w4 = (GAS v4u*)(ws + 2 * MiB); const size_t n4 = (WS_END - 2 * MiB) / 16; const v4u q = {0xFFFFFFFFu, 0xFFFFFFFFu, 0xFFFFFFFFu, 0xFFFFFFFFu};
        for (size_t i = (size_t)bx * 512 + tid; i < n4; i += (size_t)G * 512) w4[i] = q;
        GAS v4u* o4 = (GAS v4u*)args.out; const size_t m4 = O_END / 4;
        for (size_t i = (size_t)bx * 512 + tid; i < m4; i += (size_t)G * 512) o4[i] = q;
        if (hi > 1) xcd_barrier(bar);
    }
#endif
    if (IN(0)) { p0_prologue(args, lds, wave, lane, gw, ngw);
#if defined(REP_PHASE) && REP_PHASE == 0
        xcd_barrier(bar); p0_prologue(args, lds, wave, lane, gw, ngw);
#endif
        SEAM(0); }
    int cv = bx;
#if !defined(NO_VIRT_C)
    if (lo == 0 && hi > 1) {
        if (tid == 0) { unsigned ok = (G % 8 == 0) ? 1u : 0u;
            for (unsigned j = 0; j < 16; ++j) { const unsigned cn = xb_ld(&bar.bar[XB_XCNT(j)]); ok &= (cn == (j < 8 ? (unsigned)G / 8u : 0u)) ? 1u : 0u; }
            MISC[11] = ok; }
        __syncthreads();
        if (MISC[11] != 0u && MISC[10] < (unsigned)G / 8u && bar.x < 8u) cv = (int)(MISC[10] * 8u + bar.x);
    }
#endif
    if (IN(1)) { pg8::Gemm g{XN, (const bf16*)(ws + WS_WGU1), M, 2 * DFF, D, D}; pg8::StaticOrder S; S.init(M, 2 * DFF, D, G, cv); S.xs = pg8::XSync{XS_CNT(1), xs_nloc, XS_ON ? S.nwg / G : 0};
        pg8::EpiSwiglu E{HID, DFF};
        pg8::gemm_phase<pg8::EpiSwiglu, pg8::StaticOrder, PG8_ALIGN, PG8_SP2>(lds + RING_OFF, g, S, E);
#if defined(REP_PHASE) && REP_PHASE == 1
        xcd_barrier(bar); pg8::gemm_phase<pg8::EpiSwiglu, pg8::StaticOrder, PG8_ALIGN, PG8_SP2>(lds + RING_OFF, g, S, E);
#endif
#if !defined(NO_TAIL_CONVERT)
        convert_queue(args, 1, ITB_DN1, IT_DN + IT_IN, lds, wave, lane);
#endif
        SEAM(1); }
    if (IN(2)) { pg8::Gemm g{HID, (const bf16*)(ws + WS_WD1), M, D, DFF, DFF}; pg8::TailOrder S; S.init(D, DFF, G, cv); S.base.xs = pg8::XSync{XS_CNT(2), xs_nloc, XS_ON ? 3 : 0};
        pg8::EpiF32 E{Fb, D, (float*)(ws + WS_SLAB), SLAB_FLOATS, MP};
        pg8::gemm_phase<pg8::EpiF32, pg8::TailOrder, PG8_ALIGN, PG8_SP2>(lds + RING_OFF, g, S, E);
#if defined(REP_PHASE) && REP_PHASE == 2
        xcd_barrier(bar); pg8::gemm_phase<pg8::EpiF32, pg8::TailOrder, PG8_ALIGN, PG8_SP2>(lds + RING_OFF, g, S, E);
#endif
        SEAM(2); }
    if (IN(3)) { thin_rows<1>(args, gw, ngw, lane);
#if defined(REP_PHASE) && REP_PHASE == 3
        xcd_barrier(bar); thin_rows<1>(args, gw, ngw, lane);
#endif
        SEAM(3); }
    if (IN(4)) { pg8::Gemm g{XN, (const bf16*)(ws + WS_WIN), M, DIN, D, D}; pg8::StaticOrder S; S.init(M, DIN, D, G, cv); S.xs = pg8::XSync{XS_CNT(4), xs_nloc, XS_ON ? S.nwg / G : 0};
        pg8::EpiWin E{(float*)(ws + WS_XA), (bf16*)(ws + WS_GA), (bf16*)(ws + WS_XB), (bf16*)(ws + WS_G)};
        pg8::gemm_phase<pg8::EpiWin, pg8::StaticOrder, PG8_ALIGN, PG8_SP2>(lds + RING_OFF, g, S, E);
#if !defined(NO_TAIL_CONVERT)
        convert_queue(args, 4, ITB_GLU, IT_GLU, lds, wave, lane);
#endif
        SEAM(4); }
    if (IN(5)) { p5_mixer(args, lds, tid, wave, lane, bx, G);
#if defined(REP_PHASE) && REP_PHASE == 5
        xcd_barrier(bar); p5_mixer(args, lds, tid, wave, lane, bx, G);
#endif
        SEAM(5); }
    if (IN(6)) { pg8::Gemm g{(const bf16*)(ws + WS_G2), (const bf16*)(ws + WS_WGLU), M, DSSM, DSSM, DSSM}; pg8::StaticOrder S; S.init(M, DSSM, DSSM, G, cv); S.xs = pg8::XSync{XS_CNT(6), xs_nloc, XS_ON ? S.nwg / G : 0};
        pg8::EpiGlu E{(const bf16*)(ws + WS_G2), args.in[I_BGLU], YAB + DLRU};
        pg8::gemm_phase<pg8::EpiGlu, pg8::StaticOrder, PG8_ALIGN, PG8_SP2>(lds + RING_OFF, g, S, E);
#if !defined(NO_TAIL_CONVERT)
        convert_queue(args, 6, ITB_OA, 2 * IT_OA + IT_WO, lds, wave, lane);
#endif
        SEAM(6); }
    if (IN(7)) { pg8::Gemm g{YAB, (const bf16*)(ws + WS_WOUT), M, D, D, D}; pg8::SegOrder S; S.init(M, D, D, G, cv); S.xs = pg8::XSync{XS_CNT(7), xs_nloc, XS_ON ? S.nwg / G : 0};
        pg8::EpiOut E{(const bf16*)(ws + WS_G), XN};
        pg8::gemm_phase<pg8::EpiOut, pg8::SegOrder, PG8_ALIGN, PG8_SP2>(lds + RING_OFF, g, S, E);
#if !defined(NO_TAIL_CONVERT)
        convert_queue(args, 7, ITB_GU2, 2 * IT_GU, lds, wave, lane);
#endif
        SEAM(7); }
    if (IN(8)) { pg8::Gemm g{XN, (const bf16*)(ws + WS_WO), M, D, D, D}; pg8::TailOrder S; S.init(D, D, G, cv); S.base.xs = pg8::XSync{XS_CNT(8), xs_nloc, XS_ON ? 3 : 0};
        pg8::EpiF32 E{Fb, D, (float*)(ws + WS_SLAB), SLAB_FLOATS, MP};
        pg8::gemm_phase<pg8::EpiF32, pg8::TailOrder, PG8_ALIGN, PG8_SP2>(lds + RING_OFF, g, S, E);
#if defined(REP_PHASE) && REP_PHASE == 8
        xcd_barrier(bar); pg8::gemm_phase<pg8::EpiF32, pg8::TailOrder, PG8_ALIGN, PG8_SP2>(lds + RING_OFF, g, S, E);
#endif
        SEAM(8); }
    if (IN(9)) { thin_rows<2>(args, gw, ngw, lane); SEAM(9); }
    if (IN(10)) { pg8::Gemm g{XN, (const bf16*)(ws + WS_WGU2), M, 2 * DFF, D, D}; pg8::StaticOrder S; S.init(M, 2 * DFF, D, G, cv); S.xs = pg8::XSync{XS_CNT(10), xs_nloc, XS_ON ? S.nwg / G : 0};
        pg8::EpiSwiglu E{HID, DFF};
        pg8::gemm_phase<pg8::EpiSwiglu, pg8::StaticOrder, PG8_ALIGN, PG8_SP2>(lds + RING_OFF, g, S, E);
#if !defined(NO_TAIL_CONVERT)
        convert_queue(args, 10, ITB_DN2, IT_DN, lds, wave, lane);
#endif
        SEAM(10); }
    if (IN(11)) { pg8::Gemm g{HID, (const bf16*)(ws + WS_WD2), M, D, DFF, DFF}; pg8::TailOrder S; S.init(D, DFF, G, cv); S.base.xs = pg8::XSync{XS_CNT(11), xs_nloc, XS_ON ? 3 : 0};
        pg8::EpiF32 E{Fb, D, (float*)(ws + WS_SLAB), SLAB_FLOATS, MP};
        pg8::gemm_phase<pg8::EpiF32, pg8::TailOrder, PG8_ALIGN, PG8_SP2>(lds + RING_OFF, g, S, E); SEAM(11); }
    if (IN(12)) { thin_rows<3>(args, gw, ngw, lane); }
#undef IN
#undef BOTH
#undef SEAM
}

extern "C" void kernel_launch(void* const* d_in, const int* in_sizes, int n_in, void* d_out, int out_size, void* d_ws, size_t ws_size, hipStream_t stream) {
    static int grid = 0;
    if (grid == 0) {
        if (n_in != 39 || in_sizes[0] != MP * D || out_size != (int)O_END || ws_size < WS_END) { fprintf(stderr, "kernel_launch: unexpected shapes (n_in %d, in0 %d, out %d, ws %zu); nothing launched\n", n_in, n_in > 0 ? in_sizes[0] : -1, out_size, ws_size); grid = -1; return; }
        int dev = 0, cus = 0, per_cu = 0;
        if (hipGetDevice(&dev) != hipSuccess || hipDeviceGetAttribute(&cus, hipDeviceAttributeMultiprocessorCount, dev) != hipSuccess) { grid = -1; return; }
        if (hipFuncSetAttribute((const void*)hawk_fwd, hipFuncAttributeMaxDynamicSharedMemorySize, LDS_BYTES) != hipSuccess) { fprintf(stderr, "kernel_launch: hipFuncSetAttribute failed\n"); grid = -1; return; }
        if (hipOccupancyMaxActiveBlocksPerMultiprocessor(&per_cu, (const void*)hawk_fwd, NWAVES * 64, LDS_BYTES) != hipSuccess || per_cu < 1)
            fprintf(stderr, "kernel_launch: note: occupancy query reports %d workgroups per CU\n", per_cu);
        (void)hipGetLastError();
        grid = cus;
    }
    if (grid < 0) return;
    if (hipMemsetAsync((char*)d_ws + WS_CTL, 0, CTL_ZERO_BYTES, stream) != hipSuccess) return;
    Args a{};
    for (int i = 0; i < 39; ++i) a.in[i] = (const float*)d_in[i];
    a.out = (float*)d_out; a.ws = (unsigned char*)d_ws;
    static_assert(N_LAUNCHES == 1 || N_LAUNCHES == N_PHASES, "MK_N_LAUNCHES: 1 or one launch per phase");
    for (int li = 0; li < N_LAUNCHES; ++li) {
        a.ph_lo = (N_LAUNCHES == 1) ? 0 : li; a.ph_hi = (N_LAUNCHES == 1) ? N_PHASES : li + 1; a.li = li; a.pad = 0;
        hipLaunchKernelGGL(hawk_fwd, dim3(grid), dim3(NWAVES * 64), LDS_BYTES, stream, a);
        const hipError_t le = hipPeekAtLastError();
        if (le != hipSuccess) { fprintf(stderr, "kernel_launch: launch %d failed: %s\n", li, hipGetErrorName(le)); break; }
    }
}
```

```cpp
#define NO_VIRT_C 1
#include <hip/hip_runtime.h>
#include <cstdio>
#include <cstdint>
namespace pg8 {
#define PG8_LAS __attribute__((address_space(3)))
typedef unsigned short bf16_t;
typedef short bf16x8 __attribute__((ext_vector_type(8)));
typedef float f32x4 __attribute__((ext_vector_type(4)));
typedef unsigned u32x4 __attribute__((ext_vector_type(4)));
constexpr int BM = 256, BK = 64, HALF = 128, HTB = HALF * BK * 2  , STAGE_BYTES = 8 * HTB, NXCD = 8, WGM = 8;

__host__ __device__ __forceinline__ int lds_byte(int r, int c) { const int st = (r >> 4) * 2 + (c >> 5), rr = r & 15, cc = c & 31, ob = rr * 64 + cc * 2; return st * 1024 + (ob ^ (((ob >> 9) & 1) << 5)); }
__host__ __device__ __forceinline__ void stage_rc(int b, int& R, int& C) { const int st = b / 1024, sb = b % 1024, swz = sb ^ (((sb >> 9) & 1) << 5); R = (st >> 1) * 16 + swz / 64; C = (st & 1) * 32 + (swz % 64) / 2; }
__host__ __device__ __forceinline__ int perm32(int rho) { const int n = rho >> 4, i = rho & 15; return 8 * (i >> 2) + 4 * n + (i & 3); }

struct Unit { int pm, pn, seg, k0, nt, slab, round; };
struct Gemm { const bf16_t* A; const bf16_t* Bt; int M, N, K, ld; };

struct XSync {
    unsigned* cnt; unsigned nloc; int nrounds;
    __device__ __forceinline__ void wait(int round) const {
        if (nloc == 0u || round < 1 || round >= nrounds) return;
        if (threadIdx.x < 64) {
            if (threadIdx.x == 0) (void)__hip_atomic_fetch_add(cnt, 1u, __ATOMIC_RELAXED, __HIP_MEMORY_SCOPE_AGENT);
            const unsigned target = (unsigned)round * nloc; unsigned sp = 0;
            while ((unsigned)__builtin_amdgcn_readfirstlane(__hip_atomic_load(cnt, __ATOMIC_RELAXED, __HIP_MEMORY_SCOPE_AGENT)) < target) { __builtin_amdgcn_s_sleep(1); if (++sp > 200000u) break; }
        }
        asm volatile("" ::: "memory"); __builtin_amdgcn_s_barrier(); asm volatile("" ::: "memory");
    }
};
struct StaticOrder {
    XSync xs;
    int nM, nN, nwg, G, c, ntk;
    __host__ __device__ __forceinline__ void init(int M, int N, int K, int G_, int c_) { nM = M / BM; nN = N / BM; nwg = nM * nN; G = G_; c = c_; ntk = K / BK; }
    __host__ __device__ __forceinline__ bool next(int i, Unit& u) const {
        const long L = (long)i * G + c; if (L >= nwg) return false;
        int wgid = (int)L; { const int q = nwg / NXCD, r = nwg % NXCD, xcd = wgid % NXCD, off = wgid / NXCD; wgid = (xcd < r ? xcd * (q + 1) : r * (q + 1) + (xcd - r) * q) + off; }
        const int nig = WGM * nN, gid = wgid / nig, fm = gid * WGM, gsz = (nM - fm) < WGM ? (nM - fm) : WGM;
        u.pm = fm + ((wgid % nig) % gsz); u.pn = (wgid % nig) / gsz; u.seg = 0; u.k0 = 0; u.nt = ntk; u.slab = 0; u.round = i; return true;
    }
    __device__ __forceinline__ void a_ready(const Unit& u) const { xs.wait(u.round); }
    __device__ __forceinline__ void done(const Unit&) const {}
};
struct SegOrder : StaticOrder {
    __host__ __device__ __forceinline__ bool next(int i, Unit& u) const { const bool ok = StaticOrder::next(i >> 1, u); u.seg = i & 1; u.nt = ntk >> 1; u.k0 = (i & 1) * (ntk >> 1); return ok; }
    __device__ __forceinline__ void a_ready(const Unit& u) const { if (u.seg == 0) xs.wait(u.round); }
};
struct TailOrder {
    StaticOrder base; int c, ntk;
    __host__ __device__ __forceinline__ void init(int N, int K, int G_, int c_) { base.init(32 * BM, N, K, G_, c_); c = c_; ntk = K / BK; }
    __host__ __device__ __forceinline__ bool next(int i, Unit& u) const {
        const bool full = i < 2; Unit b; const bool okb = base.next(full ? i : 0, b);
        const int x = c & 7, j = c >> 3, q = x & 3;
        const int qa = ((ntk >> 2) + 1) & ~1, qb = (ntk - 2 * qa) >> 1;
        u.pm = full ? b.pm : 32 + (j >> 3); u.pn = full ? b.pn : 8 * (x >> 2) + (j & 7); u.seg = 0; u.slab = full ? 0 : q + 1;
        u.k0 = full ? 0 : (q < 2 ? q * qa : 2 * qa + (q - 2) * qb); u.nt = full ? ntk : (q < 2 ? qa : qb); u.round = i;
        return full ? okb : (i == 2 && base.G == 256 && base.nN == 16);
    }
    __device__ __forceinline__ void a_ready(const Unit& u) const { base.xs.wait(u.round); }
    __device__ __forceinline__ void done(const Unit&) const {}
};

typedef float cvt_f32x2_t __attribute__((ext_vector_type(2)));
typedef __bf16 cvt_bf16x2_t __attribute__((ext_vector_type(2)));
__device__ __forceinline__ unsigned cvt_pk_bf16(float lo, float hi) { const cvt_f32x2_t v = {lo, hi}; const cvt_bf16x2_t b = __builtin_convertvector(v, cvt_bf16x2_t); return __builtin_bit_cast(unsigned, b); }
typedef float f32x2 __attribute__((ext_vector_type(2)));
__device__ __forceinline__ f32x2 gelu_pk(f32x2 v) {
    const f32x2 av = __builtin_elementwise_abs(v), d = av * 0.2316418882f + 1.0f;
    f32x2 t; t.x = __builtin_amdgcn_rcpf(d.x); t.y = __builtin_amdgcn_rcpf(d.y);
    f32x2 q = t * 0.5307027145f + (-0.7265760135f); q = q * t + 0.7107068705f; q = q * t + (-0.142248368f); q = q * t + 0.127414796f; q = q * t;
    const f32x2 s = (v * v) * (-0.72134752044f);
    f32x2 e; e.x = __builtin_amdgcn_exp2f(s.x); e.y = __builtin_amdgcn_exp2f(s.y);
    const f32x2 m = v * (q * e), r = v - m;
    f32x2 o; o.x = v.x < 0.f ? m.x : r.x; o.y = v.y < 0.f ? m.y : r.y; return o;
}


__device__ __forceinline__ float bf_lo(unsigned w) { return __uint_as_float(w << 16); }
__device__ __forceinline__ float bf_hi(unsigned w) { return __uint_as_float(w & 0xffff0000u); }
__device__ __forceinline__ float fast_sigmoid(float x) { return __builtin_amdgcn_rcpf(1.0f + __builtin_amdgcn_exp2f(-1.4426950408889634f * x)); }
__device__ __forceinline__ float silu_f(float x) { return x * fast_sigmoid(x); }
__device__ __forceinline__ float gelu_tanh_f(float x) { const float z = 1.5957691216057308f * (x + 0.044715f * x * x * x); return x * fast_sigmoid(z); }
__device__ __forceinline__ u32x4 pack8(const f32x4& v0, const f32x4& v1) { u32x4 w; w.x = cvt_pk_bf16(v0[0], v0[1]); w.y = cvt_pk_bf16(v0[2], v0[3]); w.z = cvt_pk_bf16(v1[0], v1[1]); w.w = cvt_pk_bf16(v1[2], v1[3]); return w; }

struct EpiSwiglu {
    static constexpr bool PERM = true, AFTER_DRAIN = false, SEG = false;
    bf16_t* O; int ldc;
    __device__ __forceinline__ void operator()(f32x4 (&acc)[2][2][4][2], const Unit& u, int wr, int wc, int fr, int fq) const {
        const int row0 = u.pm * BM + wr * 64 + fr, col0 = u.pn * HALF + wc * 32 + 8 * fq;
#pragma unroll
        for (int ai = 0; ai < 2; ++ai)
#pragma unroll
            for (int m = 0; m < 4; ++m) { bf16_t* rowp = O + (size_t)(row0 + ai * HALF + m * 16) * ldc + col0;
                f32x4 v0, v1;
#pragma unroll
                for (int j = 0; j < 4; ++j) { v0[j] = silu_f(acc[ai][0][m][0][j]) * acc[ai][1][m][0][j]; v1[j] = silu_f(acc[ai][0][m][1][j]) * acc[ai][1][m][1][j]; }
                *(u32x4*)rowp = pack8(v0, v1); }
    }
};
struct EpiF32 {
    static constexpr bool PERM = true, AFTER_DRAIN = false, SEG = false;
    bf16_t* C; int ldc; float* S; size_t slab_stride; int slab_row0;
    __device__ __forceinline__ void operator()(f32x4 (&acc)[2][2][4][2], const Unit& u, int wr, int wc, int fr, int fq) const {
        const int row0 = u.pm * BM + wr * 64 + fr, col0 = u.pn * BM + wc * 32 + 8 * fq;
        if (u.slab == 0) {
#pragma unroll
            for (int ai = 0; ai < 2; ++ai)
#pragma unroll
                for (int m = 0; m < 4; ++m) { bf16_t* rowp = C + (size_t)(row0 + ai * HALF + m * 16) * ldc + col0;
#pragma unroll
                    for (int bj = 0; bj < 2; ++bj) *(u32x4*)(rowp + bj * HALF) = pack8(acc[ai][bj][m][0], acc[ai][bj][m][1]); }
        } else {
            float* base = S + (size_t)(u.slab - 1) * slab_stride - (size_t)slab_row0 * ldc;
#pragma unroll
            for (int ai = 0; ai < 2; ++ai)
#pragma unroll
                for (int m = 0; m < 4; ++m) { float* rowp = base + (size_t)(row0 + ai * HALF + m * 16) * ldc + col0;
#pragma unroll
                    for (int bj = 0; bj < 2; ++bj)
#pragma unroll
                        for (int n = 0; n < 2; ++n) *(f32x4*)(rowp + bj * HALF + n * 4) = acc[ai][bj][m][n]; }
        }
    }
};
struct EpiWin {
    static constexpr bool PERM = true, AFTER_DRAIN = false, SEG = false;
    float* XA; bf16_t* GA; bf16_t* XB; bf16_t* G;
    __device__ __forceinline__ void operator()(f32x4 (&acc)[2][2][4][2], const Unit& u, int wr, int wc, int fr, int fq) const {
        const int row0 = u.pm * BM + wr * 64 + fr, cw = wc * 32 + 8 * fq;
        if (u.pn < 8) {
            const int col0 = u.pn * BM + cw;
#pragma unroll
            for (int ai = 0; ai < 2; ++ai)
#pragma unroll
                for (int m = 0; m < 4; ++m) { float* rowp = XA + (size_t)(row0 + ai * HALF + m * 16) * 2048 + col0;
#pragma unroll
                    for (int bj = 0; bj < 2; ++bj)
#pragma unroll
                        for (int n = 0; n < 2; ++n) *(f32x4*)(rowp + bj * HALF + n * 4) = acc[ai][bj][m][n]; }
        } else if (u.pn < 16) {
            const int col0 = (u.pn - 8) * BM + cw;
#pragma unroll
            for (int ai = 0; ai < 2; ++ai)
#pragma unroll
                for (int m = 0; m < 4; ++m) { bf16_t* rowp = GA + (size_t)(row0 + ai * HALF + m * 16) * 2048 + col0;
#pragma unroll
                    for (int bj = 0; bj < 2; ++bj) { f32x4 v0, v1;
#pragma unroll
                        for (int j = 0; j < 4; ++j) { v0[j] = gelu_tanh_f(acc[ai][bj][m][0][j]); v1[j] = gelu_tanh_f(acc[ai][bj][m][1][j]); }
                        *(u32x4*)(rowp + bj * HALF) = pack8(v0, v1); } }
        } else if (u.pn < 24) {
            const int col0 = (u.pn - 16) * BM + cw;
#pragma unroll
            for (int ai = 0; ai < 2; ++ai)
#pragma unroll
                for (int m = 0; m < 4; ++m) { bf16_t* rowp = XB + (size_t)(row0 + ai * HALF + m * 16) * 2048 + col0;
#pragma unroll
                    for (int bj = 0; bj < 2; ++bj) *(u32x4*)(rowp + bj * HALF) = pack8(acc[ai][bj][m][0], acc[ai][bj][m][1]); }
        } else {
            const int col0 = (u.pn - 24) * BM + cw;
#pragma unroll
            for (int ai = 0; ai < 2; ++ai)
#pragma unroll
                for (int m = 0; m < 4; ++m) { bf16_t* rowp = G + (size_t)(row0 + ai * HALF + m * 16) * 8192 + col0;
#pragma unroll
                    for (int bj = 0; bj < 2; ++bj) { f32x4 v0, v1;
#pragma unroll
                        for (int j = 0; j < 4; ++j) { v0[j] = fast_sigmoid(acc[ai][bj][m][0][j]); v1[j] = fast_sigmoid(acc[ai][bj][m][1][j]); }
                        *(u32x4*)(rowp + bj * HALF) = pack8(v0, v1); } }
        }
    }
};
struct EpiGlu {
    static constexpr bool PERM = true, AFTER_DRAIN = false, SEG = false;
    const bf16_t* G2; const float* bias; bf16_t* O;
    __device__ __forceinline__ void operator()(f32x4 (&acc)[2][2][4][2], const Unit& u, int wr, int wc, int fr, int fq) const {
        const int row0 = u.pm * BM + wr * 64 + fr, col0 = u.pn * BM + wc * 32 + 8 * fq;
        f32x4 bv[2][2];
#pragma unroll
        for (int bj = 0; bj < 2; ++bj)
#pragma unroll
            for (int n = 0; n < 2; ++n) bv[bj][n] = *(const f32x4*)(bias + col0 + bj * HALF + 4 * n);
#pragma unroll
        for (int ai = 0; ai < 2; ++ai)
#pragma unroll
            for (int m = 0; m < 4; ++m) { const size_t r = (size_t)(row0 + ai * HALF + m * 16);
#pragma unroll
                for (int bj = 0; bj < 2; ++bj) { const u32x4 gw = *(const u32x4*)(G2 + r * 2048 + col0 + bj * HALF);
                    const f32x4 a0 = acc[ai][bj][m][0] + bv[bj][0], a1 = acc[ai][bj][m][1] + bv[bj][1]; f32x4 v0, v1;
                    v0[0] = bf_lo(gw.x) * fast_sigmoid(a0[0]); v0[1] = bf_hi(gw.x) * fast_sigmoid(a0[1]); v0[2] = bf_lo(gw.y) * fast_sigmoid(a0[2]); v0[3] = bf_hi(gw.y) * fast_sigmoid(a0[3]);
                    v1[0] = bf_lo(gw.z) * fast_sigmoid(a1[0]); v1[1] = bf_hi(gw.z) * fast_sigmoid(a1[1]); v1[2] = bf_lo(gw.w) * fast_sigmoid(a1[2]); v1[3] = bf_hi(gw.w) * fast_sigmoid(a1[3]);
                    *(u32x4*)(O + r * 4096 + col0 + bj * HALF) = pack8(v0, v1); } }
    }
};
struct EpiOut {
    static constexpr bool PERM = true, AFTER_DRAIN = false, SEG = true;
    const bf16_t* G; bf16_t* O;
    __device__ __forceinline__ void seg0(f32x4 (&acc)[2][2][4][2], const Unit& u, int wr, int wc, int fr, int fq) const {
        const int row0 = u.pm * BM + wr * 64 + fr, col0 = u.pn * BM + wc * 32 + 8 * fq;
#pragma unroll
        for (int ai = 0; ai < 2; ++ai)
#pragma unroll
            for (int m = 0; m < 4; ++m) { const bf16_t* gp = G + (size_t)(row0 + ai * HALF + m * 16) * 8192 + col0;
#pragma unroll
                for (int bj = 0; bj < 2; ++bj) { const u32x4 a = *(const u32x4*)(gp + bj * HALF), b = *(const u32x4*)(gp + 4096 + bj * HALF);
                    f32x4 r0, r1;
                    r0[0] = bf_lo(a.x) * __builtin_amdgcn_rcpf(fmaxf(bf_lo(b.x), 1e-30f)); r0[1] = bf_hi(a.x) * __builtin_amdgcn_rcpf(fmaxf(bf_hi(b.x), 1e-30f));
                    r0[2] = bf_lo(a.y) * __builtin_amdgcn_rcpf(fmaxf(bf_lo(b.y), 1e-30f)); r0[3] = bf_hi(a.y) * __builtin_amdgcn_rcpf(fmaxf(bf_hi(b.y), 1e-30f));
                    r1[0] = bf_lo(a.z) * __builtin_amdgcn_rcpf(fmaxf(bf_lo(b.z), 1e-30f)); r1[1] = bf_hi(a.z) * __builtin_amdgcn_rcpf(fmaxf(bf_hi(b.z), 1e-30f));
                    r1[2] = bf_lo(a.w) * __builtin_amdgcn_rcpf(fmaxf(bf_lo(b.w), 1e-30f)); r1[3] = bf_hi(a.w) * __builtin_amdgcn_rcpf(fmaxf(bf_hi(b.w), 1e-30f));
                    acc[ai][bj][m][0] = acc[ai][bj][m][0] * r0; acc[ai][bj][m][1] = acc[ai][bj][m][1] * r1; }
                asm volatile("" ::: "memory"); }
    }
    __device__ __forceinline__ void operator()(f32x4 (&acc)[2][2][4][2], const Unit& u, int wr, int wc, int fr, int fq) const { if (u.seg == 0) seg0(acc, u, wr, wc, fr, fq); else seg1(acc, u, wr, wc, fr, fq); }
    __device__ __forceinline__ void seg1(const f32x4 (&acc)[2][2][4][2], const Unit& u, int wr, int wc, int fr, int fq) const {
        const int row0 = u.pm * BM + wr * 64 + fr, col0 = u.pn * BM + wc * 32 + 8 * fq;
#pragma unroll
        for (int ai = 0; ai < 2; ++ai)
#pragma unroll
            for (int m = 0; m < 4; ++m) { const size_t r = (size_t)(row0 + ai * HALF + m * 16);
#pragma unroll
                for (int bj = 0; bj < 2; ++bj) { const u32x4 b = *(const u32x4*)(G + r * 8192 + 4096 + col0 + bj * HALF);
                    f32x4 g0, g1;
                    g0[0] = fmaxf(bf_lo(b.x), 1e-30f); g0[1] = fmaxf(bf_hi(b.x), 1e-30f); g0[2] = fmaxf(bf_lo(b.y), 1e-30f); g0[3] = fmaxf(bf_hi(b.y), 1e-30f);
                    g1[0] = fmaxf(bf_lo(b.z), 1e-30f); g1[1] = fmaxf(bf_hi(b.z), 1e-30f); g1[2] = fmaxf(bf_lo(b.w), 1e-30f); g1[3] = fmaxf(bf_hi(b.w), 1e-30f);
                    *(u32x4*)(O + r * 4096 + col0 + bj * HALF) = pack8(acc[ai][bj][m][0] * g0, acc[ai][bj][m][1] * g1); } }
    }
};

template <class Epi, class Sched, bool ALIGN_EPI = false, bool SP2 = false>
__device__ __forceinline__ void gemm_phase(PG8_LAS unsigned char* lds, const Gemm g, const Sched& S, const Epi& E) {
    const int tid = threadIdx.x, wid = __builtin_amdgcn_readfirstlane(tid >> 6), lane = tid & 63, wr = wid >> 2, wc = wid & 3, fr = lane & 15, fq = lane >> 4;
    const int LD = g.ld;
    unsigned voffA[2], voffB[2];
#pragma unroll
    for (int i = 0; i < 2; ++i) { int R, C; stage_rc(tid * 16 + i * 8192, R, C); const int Rb = Epi::PERM ? ((R & ~31) + perm32(R & 31)) : R;
        voffA[i] = (unsigned)(R * LD + C) * 2u; voffB[i] = (unsigned)(Rb * LD + C) * 2u; }
    const size_t kstep = (size_t)(BK * 2);
    const size_t hstep = (size_t)HALF * LD * 2;
    const size_t tstep = 2 * hstep;
    const unsigned ldsw = (unsigned)wid * 1024u;
    const int aoff = lds_byte(wr * 64 + fr, fq * 8), boff = lds_byte(wc * 32 + fr, fq * 8);
#define PG8_SA(b, h) (((b) * 2 + (h)) * HTB)
#define PG8_SB(b, h) ((4 + (b) * 2 + (h)) * HTB)
#define PG8_STAGE(bufoff, gbase, voff) do { _Pragma("unroll") for (int _i = 0; _i < 2; ++_i) \
        __builtin_amdgcn_global_load_lds((const unsigned*)((const char*)(gbase) + (voff)[_i]), (PG8_LAS unsigned*)(lds + (bufoff) + ldsw + _i * 8192), 16, 0, 0); } while (0)
#define PG8_LDA(dst, b, h) do { _Pragma("unroll") for (int m = 0; m < 4; ++m) _Pragma("unroll") for (int k = 0; k < 2; ++k) dst[m][k] = *(const PG8_LAS bf16x8*)(lds + PG8_SA(b, h) + aoff + m * 2048 + k * 1024); } while (0)
#define PG8_LDB(dst, b, h) do { _Pragma("unroll") for (int n = 0; n < 2; ++n) _Pragma("unroll") for (int k = 0; k < 2; ++k) dst[n][k] = *(const PG8_LAS bf16x8*)(lds + PG8_SB(b, h) + boff + n * 2048 + k * 1024); } while (0)
#define PG8_MMA(ai, bj, At, Bt) do { __builtin_amdgcn_s_setprio(1); _Pragma("unroll") for (int m = 0; m < 4; ++m) _Pragma("unroll") for (int n = 0; n < 2; ++n) _Pragma("unroll") for (int k = 0; k < 2; ++k) \
        acc[ai][bj][m][n] = __builtin_amdgcn_mfma_f32_16x16x32_bf16(Bt[n][k], At[m][k], acc[ai][bj][m][n], 0, 0, 0); __builtin_amdgcn_s_setprio(0); } while (0)
#define PG8_WAIT_V(n) asm volatile("s_waitcnt vmcnt(" #n ")" ::: "memory")
#define PG8_WAIT_L(n) asm volatile("s_waitcnt lgkmcnt(" #n ")" ::: "memory")
#define PG8_BAR __builtin_amdgcn_s_barrier()
#define PG8_SCHED __builtin_amdgcn_sched_barrier(0)
    Unit cur, nxt; int ui = 0;
    if (!S.next(0, cur)) return;
    f32x4 acc[2][2][4][2];
#pragma unroll
    for (int a = 0; a < 2; ++a)
#pragma unroll
        for (int b = 0; b < 2; ++b)
#pragma unroll
            for (int m = 0; m < 4; ++m)
#pragma unroll
                for (int n = 0; n < 2; ++n) acc[a][b][m][n] = (f32x4){0.f, 0.f, 0.f, 0.f};
    bf16x8 At[4][2], B0[2][2], B1[2][2];
    const char* cA = (const char*)g.A + (size_t)cur.pm * tstep + (size_t)cur.k0 * kstep; const char* cB = (const char*)g.Bt + (size_t)cur.pn * tstep + (size_t)cur.k0 * kstep;
    S.a_ready(cur);
    if constexpr (SP2) {
        PG8_STAGE(PG8_SB(0, 0), cB, voffB); PG8_STAGE(PG8_SB(0, 1), cB + hstep, voffB); PG8_STAGE(PG8_SA(0, 0), cA, voffA); PG8_STAGE(PG8_SA(0, 1), cA + hstep, voffA);
        if (wr == 1) PG8_BAR;
        PG8_WAIT_V(2); PG8_BAR;
        PG8_STAGE(PG8_SB(1, 0), cB + kstep, voffB); PG8_STAGE(PG8_SA(1, 0), cA + kstep, voffA); PG8_STAGE(PG8_SB(1, 1), cB + hstep + kstep, voffB);
        PG8_WAIT_V(6); PG8_BAR;
    } else {
        PG8_STAGE(PG8_SB(0, 0), cB, voffB); PG8_STAGE(PG8_SA(0, 0), cA, voffA); PG8_STAGE(PG8_SB(0, 1), cB + hstep, voffB); PG8_STAGE(PG8_SA(0, 1), cA + hstep, voffA);
        if (wr == 1) PG8_BAR;
        PG8_WAIT_V(4); PG8_BAR;
        PG8_STAGE(PG8_SB(1, 0), cB + kstep, voffB); PG8_STAGE(PG8_SA(1, 0), cA + kstep, voffA); PG8_STAGE(PG8_SB(1, 1), cB + hstep + kstep, voffB);
        PG8_WAIT_V(6); PG8_BAR;
    }
    for (;;) {
        const bool has_next = S.next(ui + 1, nxt);
        const char* nA = has_next ? (const char*)g.A + (size_t)nxt.pm * tstep + (size_t)nxt.k0 * kstep : cA; const char* nB = has_next ? (const char*)g.Bt + (size_t)nxt.pn * tstep + (size_t)nxt.k0 * kstep : cB;
        const int nt = cur.nt;
        for (int t = 0; t < nt; t += 2) {
            const bool last = (t == nt - 2);
            const char* a1 = cA + (size_t)(t + 1) * kstep;
            const char* a2 = last ? nA : cA + (size_t)(t + 2) * kstep; const char* b2 = last ? nB : cB + (size_t)(t + 2) * kstep;
            const char* a3 = a2 + kstep; const char* b3 = b2 + kstep;
            if (last && has_next) S.a_ready(nxt);
            if constexpr (SP2) {
            PG8_LDB(B0, 0, 0); PG8_LDB(B1, 0, 1); PG8_SCHED; PG8_LDA(At, 0, 0); PG8_STAGE(PG8_SA(1, 1), a1 + hstep, voffA);
            PG8_WAIT_V(8); PG8_WAIT_L(0); PG8_BAR; PG8_MMA(0, 0, At, B0); PG8_MMA(0, 1, At, B1); PG8_BAR; PG8_SCHED;
            PG8_LDA(At, 0, 1); PG8_STAGE(PG8_SB(0, 0), b2, voffB); PG8_STAGE(PG8_SB(0, 1), b2 + hstep, voffB); PG8_STAGE(PG8_SA(0, 0), a2, voffA);
            PG8_WAIT_V(8); PG8_WAIT_L(0); PG8_BAR; PG8_MMA(1, 0, At, B0); PG8_MMA(1, 1, At, B1); PG8_BAR; PG8_SCHED;
            PG8_LDB(B0, 1, 0); PG8_LDB(B1, 1, 1); PG8_SCHED; PG8_LDA(At, 1, 0); PG8_STAGE(PG8_SA(0, 1), a2 + hstep, voffA);
            PG8_WAIT_V(8); PG8_WAIT_L(0); PG8_BAR; PG8_MMA(0, 0, At, B0); PG8_MMA(0, 1, At, B1); PG8_BAR; PG8_SCHED;
            PG8_LDA(At, 1, 1); PG8_STAGE(PG8_SB(1, 0), b3, voffB); PG8_STAGE(PG8_SB(1, 1), b3 + hstep, voffB); PG8_STAGE(PG8_SA(1, 0), a3, voffA);
            PG8_WAIT_V(8); PG8_WAIT_L(0); PG8_BAR; PG8_MMA(1, 0, At, B0); PG8_MMA(1, 1, At, B1); PG8_BAR; PG8_SCHED;
            } else {
            PG8_LDB(B0, 0, 0); PG8_SCHED; PG8_LDA(At, 0, 0); PG8_STAGE(PG8_SA(1, 1), a1 + hstep, voffA);
            PG8_WAIT_L(8); PG8_BAR; PG8_WAIT_L(0); PG8_MMA(0, 0, At, B0); PG8_BAR; PG8_SCHED;
            PG8_LDB(B1, 0, 1); PG8_STAGE(PG8_SB(0, 0), b2, voffB);
            PG8_BAR; PG8_WAIT_L(0); PG8_MMA(0, 1, At, B1); PG8_BAR;
            PG8_LDA(At, 0, 1); PG8_STAGE(PG8_SA(0, 0), a2, voffA);
            PG8_BAR; PG8_WAIT_L(0); PG8_MMA(1, 0, At, B0); PG8_BAR; PG8_SCHED;
            PG8_STAGE(PG8_SB(0, 1), b2 + hstep, voffB);
            PG8_WAIT_V(6); PG8_BAR; PG8_MMA(1, 1, At, B1); PG8_BAR;
            PG8_LDB(B0, 1, 0); PG8_SCHED; PG8_LDA(At, 1, 0); PG8_STAGE(PG8_SA(0, 1), a2 + hstep, voffA);
            PG8_WAIT_L(8); PG8_BAR; PG8_WAIT_L(0); PG8_MMA(0, 0, At, B0); PG8_BAR; PG8_SCHED;
            PG8_LDB(B1, 1, 1); PG8_STAGE(PG8_SB(1, 0), b3, voffB);
            PG8_BAR; PG8_WAIT_L(0); PG8_MMA(0, 1, At, B1); PG8_BAR;
            PG8_LDA(At, 1, 1); PG8_STAGE(PG8_SA(1, 0), a3, voffA);
            PG8_BAR; PG8_WAIT_L(0); PG8_MMA(1, 0, At, B0); PG8_BAR; PG8_SCHED;
            PG8_STAGE(PG8_SB(1, 1), b3 + hstep, voffB);
            PG8_WAIT_V(6); PG8_BAR; PG8_MMA(1, 1, At, B1); PG8_BAR;
            }
        }
        if constexpr (ALIGN_EPI) { if (wr == 0) PG8_BAR; }
        if constexpr (!Epi::AFTER_DRAIN) { E(acc, cur, wr, wc, fr, fq); S.done(cur); }
        if (!has_next) break;
        if (!Epi::SEG || nxt.seg == 0) {
#pragma unroll
        for (int a = 0; a < 2; ++a)
#pragma unroll
            for (int b = 0; b < 2; ++b)
#pragma unroll
                for (int m = 0; m < 4; ++m)
#pragma unroll
                    for (int n = 0; n < 2; ++n) acc[a][b][m][n] = (f32x4){0.f, 0.f, 0.f, 0.f};
        }
        cur = nxt; cA = nA; cB = nB; ++ui;
        if constexpr (ALIGN_EPI) { if (wr == 1) PG8_BAR; }
    }
    PG8_WAIT_V(0);
    if constexpr (!ALIGN_EPI) { if (wr == 0) PG8_BAR; }
    PG8_BAR;
    if constexpr (Epi::AFTER_DRAIN) { E.fused(acc, cur, wr, wc, fr, fq, lds, wid, lane); S.done(cur); }
#undef PG8_SA
#undef PG8_SB
#undef PG8_STAGE
#undef PG8_LDA
#undef PG8_LDB
#undef PG8_MMA
#undef PG8_WAIT_V
#undef PG8_WAIT_L
#undef PG8_BAR
#undef PG8_SCHED
}
}

#ifndef PG8_SP2
#define PG8_SP2 true
#endif
#ifndef PG8_ALIGN
#define PG8_ALIGN true
#endif

constexpr int NWAVES = 8;
#ifndef MK_N_LAUNCHES
#define MK_N_LAUNCHES 1
#endif
constexpr int N_PHASES = 13;
constexpr int N_LAUNCHES = MK_N_LAUNCHES;

constexpr int D = 4096, DFF = 11008, DLRU = 2048, DSSM = 2048, DIN = 14336;
constexpr int NP = 4, TP = 2048, NS = 128, TS = 8;
constexpr int MP = NP * TP, MS = NS * TS, M = MP + MS;
constexpr int NGRP = 128, SP = 64, SCG = 16;
constexpr float EPS = 1e-6f;

constexpr size_t MiB = 1u << 20;
constexpr size_t WS_CTL = 0, CTL_ZERO_BYTES = 1 * MiB;
constexpr size_t WS_ABAR = 2 * MiB;
constexpr size_t WS_BB = 3 * MiB;
constexpr size_t WS_CC = 4 * MiB;
constexpr size_t WS_WG = 5 * MiB;
constexpr size_t WS_WGU1 = 8 * MiB, WS_WD1 = 180 * MiB, WS_WIN = 266 * MiB, WS_WGLU = 378 * MiB, WS_WOUT = 386 * MiB, WS_WO = 418 * MiB, WS_WGU2 = 450 * MiB, WS_WD2 = 622 * MiB;
constexpr size_t WS_XN = 708 * MiB;
constexpr size_t WS_HID = 780 * MiB;
constexpr size_t WS_XA = WS_HID, WS_GA = WS_HID + 72 * MiB, WS_XB = WS_HID + 108 * MiB, WS_G2 = WS_HID + 144 * MiB;
constexpr size_t WS_F = 974 * MiB;
constexpr size_t WS_G = WS_F;
constexpr size_t WS_YAB = 1118 * MiB, WS_END = 1190 * MiB;
constexpr size_t WS_SLAB = WS_YAB, SLAB_FLOATS = (size_t)MS * D;
static_assert(4 * SLAB_FLOATS * 4 <= (size_t)M * D * 2, "slabs inside YAB");
static_assert(WS_WGU1 + (size_t)2 * DFF * D * 2 <= WS_WD1 && WS_WD1 + (size_t)D * DFF * 2 <= WS_WIN && WS_WIN + (size_t)DIN * D * 2 <= WS_WGLU && WS_WGLU + (size_t)DSSM * DSSM * 2 <= WS_WOUT, "ws map 1");
static_assert(WS_WOUT + (size_t)D * D * 2 <= WS_WO && WS_WO + (size_t)D * D * 2 <= WS_WGU2 && WS_WGU2 + (size_t)2 * DFF * D * 2 <= WS_WD2 && WS_WD2 + (size_t)D * DFF * 2 <= WS_XN, "ws map 2");
static_assert(WS_XN + (size_t)M * D * 2 <= WS_HID && WS_HID + (size_t)M * DFF * 2 <= WS_F && WS_G2 + (size_t)M * DSSM * 2 <= WS_F && WS_F + (size_t)M * D * 4 <= WS_YAB && WS_YAB + (size_t)M * D * 2 <= WS_END, "ws map 3");
constexpr int CW_TMO = 0, CW_CODE = 1;
constexpr int CW_XS = 100000;
constexpr int CW_BAR = 4096;

constexpr int RING_OFF = 0, RING_BYTES = 131072;
constexpr int LDSCTL_OFF = RING_BYTES, MISC_OFF = LDSCTL_OFF + 320;
constexpr int LDS_BYTES = 147456;
static_assert(MISC_OFF + 128 <= LDS_BYTES, "LDS map");

#define GAS __attribute__((address_space(1)))
#define LAS __attribute__((address_space(3)))
typedef unsigned short bf16;
typedef unsigned v4u __attribute__((ext_vector_type(4)));
typedef unsigned v2u __attribute__((ext_vector_type(2)));
typedef float f32x4 __attribute__((ext_vector_type(4)));
typedef float f32x2 __attribute__((ext_vector_type(2)));
typedef short bf16x8 __attribute__((ext_vector_type(8)));
typedef GAS unsigned gu32;
typedef GAS unsigned long long gu64;
#define RLX_AGENT __ATOMIC_RELAXED, __HIP_MEMORY_SCOPE_AGENT
#define LDS_WAIT() asm volatile("s_waitcnt lgkmcnt(0)" ::: "memory")
#define VM_WAIT() asm volatile("s_waitcnt vmcnt(0)" ::: "memory")
__device__ __forceinline__ unsigned f2bf(float f) { unsigned u = __builtin_bit_cast(unsigned, f); return (u + 0x7fffu + ((u >> 16) & 1u)) >> 16; }
__device__ __forceinline__ unsigned pk2(float lo, float hi) { return pg8::cvt_pk_bf16(lo, hi); }
using pg8::bf_lo; using pg8::bf_hi; using pg8::fast_sigmoid; using pg8::gelu_tanh_f;
#define XB_TMO      128
#define XB_XCNT(j)  (256  + 64 * (j))
#define XB_XSUB(j)  (1280 + 64 * (j))
#define XB_XGEN(j)  (2304 + 64 * (j))
#define XB_TOP      3328
#define XB_TOPGEN   3392
#define XCD_BAR_WORDS 3456
#define XB_SPIN_CAP (1u << 18)

__device__ __forceinline__ unsigned xb_ld(unsigned* p)              { return __hip_atomic_load(p, __ATOMIC_RELAXED, __HIP_MEMORY_SCOPE_AGENT); }
__device__ __forceinline__ unsigned xb_add(unsigned* p, unsigned v) { return __hip_atomic_fetch_add(p, v, __ATOMIC_RELAXED, __HIP_MEMORY_SCOPE_AGENT); }
__device__ __forceinline__ unsigned xb_xcc_id() { return (unsigned)__builtin_amdgcn_s_getreg((3 << 11) | 20) & 0xFu; }
#define XB_SPIN(cond, bar) do { unsigned _sp = 0; while (cond) { __builtin_amdgcn_s_sleep(1); \
    if ((++_sp & 255u) == 0u) { if (xb_ld(&(bar)[XB_TMO])) break; if (_sp > XB_SPIN_CAP) { atomicAdd(&(bar)[XB_TMO], 1u); break; } } } } while (0)

struct XcdBarrier {
    unsigned* bar; unsigned x;
    volatile LAS unsigned* st;
};

__device__ __forceinline__ XcdBarrier xcd_barrier_post(unsigned* bar, volatile LAS unsigned* st) {
    XcdBarrier b; b.bar = bar; b.x = xb_xcc_id(); b.st = st;
    if (threadIdx.x == 0) st[2] = xb_add(&bar[XB_XCNT(b.x)], 1u);
    return b;
}
__device__ __forceinline__ void xcd_barrier_complete(unsigned* bar, unsigned x, unsigned& nloc, unsigned& nx) {
    const unsigned G = gridDim.x * gridDim.y * gridDim.z;
    unsigned sum, cnt, mine, sp = 0u;
    for (;;) {
        sum = 0u; cnt = 0u; mine = 0u;
#pragma unroll
        for (unsigned j = 0; j < 16; ++j) { const unsigned c = xb_ld(&bar[XB_XCNT(j)]); sum += c; cnt += (c > 0u) ? 1u : 0u; mine = (j == x) ? c : mine; }
        if (sum == G) break;
        __builtin_amdgcn_s_sleep(1);
        if ((++sp & 255u) == 0u) { if (xb_ld(&bar[XB_TMO])) break; if (sp > XB_SPIN_CAP) { atomicAdd(&bar[XB_TMO], 1u); break; } }
    }
    nloc = mine > 0u ? mine : 1u; nx = cnt > 0u ? cnt : 1u;
}

__device__ __forceinline__ void xcd_barrier(const XcdBarrier& b) {
    asm volatile("s_waitcnt vmcnt(0)" ::: "memory");
    __syncthreads();
    if (threadIdx.x == 0) {
        unsigned* bar = b.bar;
        __builtin_amdgcn_s_waitcnt(0);
        unsigned nloc = b.st[0], nx = b.st[1];
        if (nloc == 0u) { xcd_barrier_complete(bar, b.x, nloc, nx); b.st[0] = nloc; b.st[1] = nx; }
        const unsigned old = xb_add(&bar[XB_XSUB(b.x)], 1u);
        const unsigned gen = old / nloc;
        if (old + 1u == (gen + 1u) * nloc) {
            __builtin_amdgcn_fence(__ATOMIC_RELEASE, "agent");
            asm volatile("s_waitcnt vmcnt(0)" ::: "memory");
            const unsigned og = xb_add(&bar[XB_TOP], 1u);
            const unsigned tg = og / nx;
            if (og + 1u == (tg + 1u) * nx) xb_add(&bar[XB_TOPGEN], 1u);
            else XB_SPIN(xb_ld(&bar[XB_TOPGEN]) == tg, bar);
            __builtin_amdgcn_fence(__ATOMIC_ACQUIRE, "agent");
            xb_add(&bar[XB_XGEN(b.x)], 1u);
            asm volatile("s_waitcnt vmcnt(0)" ::: "memory");
        } else {
            XB_SPIN(xb_ld(&bar[XB_XGEN(b.x)]) == gen, bar);
            __builtin_amdgcn_fence(__ATOMIC_ACQUIRE, "agent");
            asm volatile("s_waitcnt vmcnt(0)" ::: "memory");
        }
    }
    __syncthreads();
}

__device__ __forceinline__ float wave_sum(float v) {
#pragma unroll
    for (int o = 1; o < 64; o <<= 1) v += __shfl_xor(v, o);
    return v;
}
constexpr size_t O_Y = 0, O_PLRU = (size_t)M * D, O_PCONV = O_PLRU + NP * DLRU, O_PRE = O_PCONV + NP * 3 * DLRU, O_PIM = O_PRE + NP * NGRP * SP, O_SLRU = O_PIM + NP * NGRP * SP,
                 O_SCONV = O_SLRU + NS * DLRU, O_SRE = O_SCONV + NS * 3 * DLRU, O_SIM = O_SRE + NS * NGRP * SP, O_END = O_SIM + NS * NGRP * SP;
static_assert(O_END == 40992768, "output size");

struct Args { const float* in[39]; float* out; unsigned char* ws; int ph_lo, ph_hi, li, pad; };
enum { I_XP = 0, I_XS, I_SLRU, I_SCONV, I_SRE, I_SIM, I_F1PRE, I_F1POST, I_F1G, I_F1U, I_F1D, I_MPRE, I_MPOST, I_WIN, I_CONVW, I_CONVB, I_WRG, I_BRG, I_WIG, I_BIG, I_LAM,
       I_ARE, I_AIM, I_LDT, I_BRE, I_BIM, I_CRE, I_CIM, I_DSK, I_WGLU, I_BGLU, I_WOA, I_WOB, I_WO, I_F2PRE, I_F2POST, I_F2G, I_F2U, I_F2D };

__device__ __forceinline__ void transpose_item(const float* W, int N, bf16* WT, int pitch, int k0, int n0, int drow, int dcol, LAS float* scr, int lane) {
    { f32x4 v[8]; const int rr = lane >> 3, c4 = (lane & 7) * 4;
#pragma unroll
      for (int i = 0; i < 8; ++i) v[i] = *(const GAS f32x4*)(W + (size_t)(k0 + 8 * i + rr) * N + n0 + c4);
#pragma unroll
      for (int i = 0; i < 8; ++i) { LAS float* d = scr + (8 * i + rr) * 33 + c4; d[0] = v[i].x; d[1] = v[i].y; d[2] = v[i].z; d[3] = v[i].w; } }
    LDS_WAIT(); asm volatile("" ::: "memory");
    const int c = lane & 7;
#pragma unroll
    for (int j = 0; j < 4; ++j) { const int n = (lane >> 3) + 8 * j; const LAS float* s = scr + (8 * c) * 33 + n;
        v4u o; o.x = pk2(s[0 * 33], s[1 * 33]); o.y = pk2(s[2 * 33], s[3 * 33]); o.z = pk2(s[4 * 33], s[5 * 33]); o.w = pk2(s[6 * 33], s[7 * 33]);
        *(GAS v4u*)(WT + (size_t)(drow + n) * pitch + dcol + k0 + 8 * c) = o; }
    LDS_WAIT(); asm volatile("" ::: "memory");
}
__device__ __forceinline__ void tr_plain(const float* W, int K, int N, bf16* WT, int pitch, int dcol, int item, LAS float* scr, int lane) {
    const int nblk = N / 32, kb = item / nblk, nb = item - kb * nblk; (void)K;
    transpose_item(W, N, WT, pitch, 64 * kb, 32 * nb, 32 * nb, dcol, scr, lane);
}
__device__ __forceinline__ void tr_gu(const float* W, bf16* WT, int up, int item, LAS float* scr, int lane) {
    const int nblk = DFF / 32, kb = item / nblk, nb = item - kb * nblk, n0 = 32 * nb;
    transpose_item(W, DFF, WT, D, 64 * kb, n0, 256 * (n0 >> 7) + up * 128 + (n0 & 127), 0, scr, lane);
}
constexpr int IT_GU = (D / 64) * (DFF / 32), IT_DN = (DFF / 64) * (D / 32), IT_IN = (D / 64) * (DIN / 32), IT_GLU = (DSSM / 64) * (DSSM / 32), IT_OA = (DLRU / 64) * (D / 32), IT_WO = (D / 64) * (D / 32), IT_RG = 16 * 2 * 4;
constexpr int IT_TOTAL = 4 * IT_GU + 2 * IT_DN + IT_IN + IT_GLU + 2 * IT_OA + IT_WO + 2 * IT_RG;

template <int MODE> __device__ __forceinline__ void thin_rows(const Args& args, int gw, int ngw, int lane);

constexpr int ITB_GU1 = 0, ITB_DN1 = ITB_GU1 + 2 * IT_GU, ITB_IN = ITB_DN1 + IT_DN, ITB_GLU = ITB_IN + IT_IN, ITB_OA = ITB_GLU + IT_GLU, ITB_OB = ITB_OA + IT_OA, ITB_WO = ITB_OB + IT_OA,
              ITB_GU2 = ITB_WO + IT_WO, ITB_DN2 = ITB_GU2 + 2 * IT_GU, ITB_RG = ITB_DN2 + IT_DN, ITB_END = ITB_RG + 2 * IT_RG;
static_assert(ITB_END == IT_TOTAL, "item numbering");
__device__ __forceinline__ void convert_item(const Args& args, int it, LAS float* scr, int lane) {
    unsigned char* ws = args.ws; int r = it;
    if (r < IT_GU) { tr_gu(args.in[I_F1G], (bf16*)(ws + WS_WGU1), 0, r, scr, lane); return; } r -= IT_GU;
    if (r < IT_GU) { tr_gu(args.in[I_F1U], (bf16*)(ws + WS_WGU1), 1, r, scr, lane); return; } r -= IT_GU;
    if (r < IT_DN) { tr_plain(args.in[I_F1D], DFF, D, (bf16*)(ws + WS_WD1), DFF, 0, r, scr, lane); return; } r -= IT_DN;
    if (r < IT_IN) { tr_plain(args.in[I_WIN], D, DIN, (bf16*)(ws + WS_WIN), D, 0, r, scr, lane); return; } r -= IT_IN;
    if (r < IT_GLU) { tr_plain(args.in[I_WGLU], DSSM, DSSM, (bf16*)(ws + WS_WGLU), DSSM, 0, r, scr, lane); return; } r -= IT_GLU;
    if (r < IT_OA) { tr_plain(args.in[I_WOA], DLRU, D, (bf16*)(ws + WS_WOUT), D, 0, r, scr, lane); return; } r -= IT_OA;
    if (r < IT_OA) { tr_plain(args.in[I_WOB], DSSM, D, (bf16*)(ws + WS_WOUT), D, DLRU, r, scr, lane); return; } r -= IT_OA;
    if (r < IT_WO) { tr_plain(args.in[I_WO], D, D, (bf16*)(ws + WS_WO), D, 0, r, scr, lane); return; } r -= IT_WO;
    if (r < IT_GU) { tr_gu(args.in[I_F2G], (bf16*)(ws + WS_WGU2), 0, r, scr, lane); return; } r -= IT_GU;
    if (r < IT_GU) { tr_gu(args.in[I_F2U], (bf16*)(ws + WS_WGU2), 1, r, scr, lane); return; } r -= IT_GU;
    if (r < IT_DN) { tr_plain(args.in[I_F2D], DFF, D, (bf16*)(ws + WS_WD2), DFF, 0, r, scr, lane); return; } r -= IT_DN;
    { const int ig = r >= IT_RG ? 1 : 0; const int q = r - ig * IT_RG, h = q >> 3, sub = q & 7, kb = sub >> 2, nb = sub & 3;
      const float* W = (ig ? args.in[I_WIG] : args.in[I_WRG]) + (size_t)h * 128 * 128;
      transpose_item(W, 128, (bf16*)(ws + WS_WG) + (size_t)h * 256 * 128, 128, 64 * kb, 32 * nb, ig * 128 + 32 * nb, 0, scr, lane); }
}
constexpr int CW_Q = 60000, Q_CHUNK = 4;
__device__ __forceinline__ void convert_queue(const Args& args, int qid, int first, int n, LAS unsigned char* lds, int wave, int lane) {
    LAS float* scr = (LAS float*)(lds + RING_OFF + wave * 16384);
    unsigned* ctr = (unsigned*)(args.ws + WS_CTL) + CW_Q + 64 * qid;
    for (;;) {
        int base = 0;
        if (lane == 0) base = (int)__hip_atomic_fetch_add(ctr, (unsigned)Q_CHUNK, __ATOMIC_RELAXED, __HIP_MEMORY_SCOPE_AGENT);
        base = __builtin_amdgcn_readfirstlane(base);
        if (base >= n) break;
        const int e = (base + Q_CHUNK < n) ? base + Q_CHUNK : n;
        for (int it = base; it < e; ++it) convert_item(args, first + it, scr, lane);
    }
}

__device__ __forceinline__ void p0_prologue(const Args& args, LAS unsigned char* lds, int wave, int lane, int gw, int ngw) {
    unsigned char* ws = args.ws;
    LAS float* scr = (LAS float*)(lds + RING_OFF + wave * 16384);
#if defined(NO_TAIL_CONVERT)
    for (int it = gw; it < IT_TOTAL; it += ngw) convert_item(args, it, scr, lane);
#else
    for (int it = gw; it < 2 * IT_GU; it += ngw) convert_item(args, ITB_GU1 + it, scr, lane);
    for (int it = gw; it < 2 * IT_RG; it += ngw) convert_item(args, ITB_RG + it, scr, lane);
#endif
    {
        const int gt = gw * 64 + lane;
        if (gt < NGRP * SP) {
            const int g = gt >> 6, p = gt & 63;
            const double dt = exp((double)args.in[I_LDT][g]);
            const double ar = (double)args.in[I_ARE][gt], ai = (double)args.in[I_AIM][gt];
            const double mag = exp(ar * dt);
            double th = ai * dt; th -= 6.283185307179586476925 * rint(th * 0.15915494309189533577);
            const double x = 0.25 * th, x2 = x * x;
            double s = x * (1.0 + x2 * (-1.0 / 6 + x2 * (1.0 / 120 + x2 * (-1.0 / 5040 + x2 * (1.0 / 362880 + x2 * (-1.0 / 39916800 + x2 * (1.0 / 6227020800.0)))))));
            double c = 1.0 + x2 * (-0.5 + x2 * (1.0 / 24 + x2 * (-1.0 / 720 + x2 * (1.0 / 40320 + x2 * (-1.0 / 3628800 + x2 * (1.0 / 479001600.0 + x2 * (-1.0 / 87178291200.0)))))));
            { const double s2 = 2.0 * s * c, c2 = 1.0 - 2.0 * s * s; s = s2; c = c2; }
            { const double s2 = 2.0 * s * c, c2 = 1.0 - 2.0 * s * s; s = s2; c = c2; }
            const double abr = mag * c, abi = mag * s;
            const double den = ar * ar + ai * ai, nr = abr - 1.0, ni = abi;
            const double cre = (nr * ar + ni * ai) / den, cim = (ni * ar - nr * ai) / den;
            float* AB = (float*)(ws + WS_ABAR); AB[2 * gt] = (float)abr; AB[2 * gt + 1] = (float)abi;
            bf16* BB = (bf16*)(ws + WS_BB); bf16* CC = (bf16*)(ws + WS_CC);
            const float* bre = args.in[I_BRE] + (size_t)gt * SCG; const float* bim = args.in[I_BIM] + (size_t)gt * SCG;
#pragma unroll 4
            for (int ch = 0; ch < SCG; ++ch) {
                const double br = (double)bre[ch], bi = (double)bim[ch];
                const float vre = (float)(cre * br - cim * bi), vim = (float)(cre * bi + cim * br);
#pragma unroll
                for (int ri = 0; ri < 2; ++ri) { const int col = 2 * p + ri, j = col >> 4, ln = (col & 15) + 16 * (ch >> 3);
                    BB[((size_t)(g * 8 + j) * 64 + ln) * 8 + (ch & 7)] = (bf16)f2bf(ri ? vim : vre); }
                const float c_re = args.in[I_CRE][((size_t)g * SCG + ch) * SP + p], c_im = args.in[I_CIM][((size_t)g * SCG + ch) * SP + p];
#pragma unroll
                for (int ri = 0; ri < 2; ++ri) { const int k = 2 * p + ri, kk = k >> 5, ln = ch + 16 * ((k & 31) >> 3);
                    CC[((size_t)(g * 4 + kk) * 64 + ln) * 8 + (k & 7)] = (bf16)f2bf(ri ? -c_im : c_re); }
            }
        }
    }
    thin_rows<0>(args, gw, ngw, lane);
}

template <int MODE> __device__ __forceinline__ void thin_rows(const Args& args, int gw, int ngw, int lane) {
    const float* gA = MODE == 1 ? args.in[I_F1POST] : (MODE == 2 ? args.in[I_MPOST] : args.in[I_F2POST]);
    const float* gB = MODE == 0 ? args.in[I_F1PRE] : (MODE == 1 ? args.in[I_MPRE] : args.in[I_F2PRE]);
    const float sc = MODE == 2 ? 1.0f : 0.5f;
    float* Y = args.out + O_Y; const bf16* Fb = (const bf16*)(args.ws + WS_F); bf16* XN = (bf16*)(args.ws + WS_XN);
    for (int m = gw; m < M; m += ngw) {
        const float* xin = (MODE <= 1) ? (m < MP ? args.in[I_XP] + (size_t)m * D : args.in[I_XS] + (size_t)(m - MP) * D) : Y + (size_t)m * D;
        const GAS f32x4* xr = (const GAS f32x4*)xin + lane;
        f32x4 v[16];
#pragma unroll
        for (int j = 0; j < 16; ++j) v[j] = xr[64 * j];
        if (MODE >= 1) {
            f32x4 f[16]; float s = 0.f;
            if (m < MP) {
                const GAS v2u* fr = (const GAS v2u*)(Fb + (size_t)m * D) + lane;
#pragma unroll
                for (int j = 0; j < 16; ++j) { const v2u w = fr[64 * j]; f[j] = (f32x4){bf_lo(w.x), bf_hi(w.x), bf_lo(w.y), bf_hi(w.y)}; }
            } else {
#pragma unroll
                for (int q = 0; q < 4; ++q) { const GAS f32x4* sr = (const GAS f32x4*)((const float*)(args.ws + WS_SLAB) + q * SLAB_FLOATS + (size_t)(m - MP) * D) + lane;
#pragma unroll
                    for (int j = 0; j < 16; ++j) f[j] = q == 0 ? sr[64 * j] : f[j] + sr[64 * j]; } }
#pragma unroll
            for (int j = 0; j < 16; ++j) s += (f[j].x * f[j].x + f[j].y * f[j].y) + (f[j].z * f[j].z + f[j].w * f[j].w);
            const float rstd = sc / sqrtf(wave_sum(s) * (1.f / D) + EPS);
            const GAS f32x4* gr = (const GAS f32x4*)gA + lane;
            GAS f32x4* yo = (GAS f32x4*)(Y + (size_t)m * D) + lane;
#pragma unroll
            for (int j = 0; j < 16; ++j) { const f32x4 g = gr[64 * j]; v[j] = v[j] + f[j] * rstd * g; yo[64 * j] = v[j]; }
        }
        if (MODE <= 2) {
            float s = 0.f;
#pragma unroll
            for (int j = 0; j < 16; ++j) s += (v[j].x * v[j].x + v[j].y * v[j].y) + (v[j].z * v[j].z + v[j].w * v[j].w);
            const float rstd = 1.0f / sqrtf(wave_sum(s) * (1.f / D) + EPS);
            const GAS f32x4* gr = (const GAS f32x4*)gB + lane;
            GAS v2u* o8 = (GAS v2u*)(XN + (size_t)m * D) + lane;
#pragma unroll
            for (int j = 0; j < 16; ++j) { const f32x4 g = gr[64 * j]; const f32x4 o = v[j] * rstd * g; v2u w; w.x = pk2(o.x, o.y); w.y = pk2(o.z, o.w); o8[64 * j] = w; }
        }
    }
}

constexpr int L_WSL = 0, L_XCB = 17408, L_XCF = 34816, L_LA = 43264, L_LB = 51712, L_LH = 60160, L_END = 68608;
constexpr int LP = 33;
#define LBAR() do { asm volatile("s_waitcnt lgkmcnt(0)" ::: "memory"); __builtin_amdgcn_s_barrier(); asm volatile("" ::: "memory"); } while (0)
template <bool SAMPLE> __device__ __forceinline__ void lru_load_tile(const Args& args, const float* XA, const bf16* GA, int chain, int k, int tg, int cg, int chb, int q, int tid, f32x4 (&v)[7], v2u& gaw) {
    const size_t rbase = SAMPLE ? (size_t)MP + 64 * chain : (size_t)chain * TP + 64 * k;
#pragma unroll
    for (int i = 0; i < 7; ++i) {
        if (SAMPLE) { const int ts = 4 * (tg & 1) - 3 + i, sl = tg >> 1;
            v[i] = (ts >= 0) ? *(const GAS f32x4*)(XA + (rbase + 8 * sl + ts) * DLRU + chb + 4 * cg)
                             : *(const GAS f32x4*)(args.in[I_SCONV] + ((size_t)(8 * chain + sl) * 3 + (3 + ts)) * DLRU + chb + 4 * cg);
        } else { const int tt = 4 * tg - 3 + i;
            v[i] = (k > 0 || tt >= 0) ? *(const GAS f32x4*)(XA + (rbase + tt) * DLRU + chb + 4 * cg) : (f32x4){0.f, 0.f, 0.f, 0.f}; }
    }
    gaw = *(const GAS v2u*)(GA + (rbase + (tid >> 3)) * DLRU + chb + 32 * q + (tid & 7) * 4);
}
template <bool SAMPLE> __device__ __forceinline__ void lru_task(const Args& args, LAS unsigned char* lds, int tid, int wave, int lane, int chain, int head, int q) {
    unsigned char* ws = args.ws;
    const float* XA = (const float*)(ws + WS_XA); const bf16* GA = (const bf16*)(ws + WS_GA); bf16* YAB = (bf16*)(ws + WS_YAB);
    const int chb = head * 128;
    const int cg = tid & 31, tg = tid >> 5;
    f32x4 v[7]; v2u gaw;
    lru_load_tile<SAMPLE>(args, XA, GA, chain, 0, tg, cg, chb, q, tid, v, gaw);
    { const bf16* WG = (const bf16*)(ws + WS_WG) + (size_t)head * 256 * 128;
      for (int i = tid; i < 1024; i += 512) { const int r = i >> 4, c16 = i & 15; const int srow = (r < 32) ? (32 * q + r) : (128 + 32 * q + (r - 32));
          *(LAS v4u*)(lds + L_WSL + r * 272 + c16 * 16) = *(const GAS v4u*)(WG + (size_t)srow * 128 + c16 * 8); } }
    const f32x4 cw0 = *(const f32x4*)(args.in[I_CONVW] + 0 * DLRU + chb + 4 * cg), cw1 = *(const f32x4*)(args.in[I_CONVW] + 1 * DLRU + chb + 4 * cg),
                cw2 = *(const f32x4*)(args.in[I_CONVW] + 2 * DLRU + chb + 4 * cg), cw3 = *(const f32x4*)(args.in[I_CONVW] + 3 * DLRU + chb + 4 * cg),
                cbv = *(const f32x4*)(args.in[I_CONVB] + chb + 4 * cg);
    const int tb = wave & 3, ct = wave >> 2, l15 = lane & 15, lq = lane >> 4;
    const int chg = chb + 32 * q + 16 * ct + l15;
    const float brg = args.in[I_BRG][chg], big = args.in[I_BIG][chg];
    const float lam = args.in[I_LAM][chg];
    const float sp8 = -8.0f * log1pf(expf(-lam));
    float hcar = 0.f;
    float h0s[8];
#pragma unroll
    for (int s = 0; s < 8; ++s) h0s[s] = 0.f;
    if (SAMPLE && tid < 32) {
#pragma unroll
        for (int s = 0; s < 8; ++s) h0s[s] = args.in[I_SLRU][(size_t)(8 * chain + s) * DLRU + chb + 32 * q + tid];
    }
    const int ntile = SAMPLE ? 1 : 32;
    for (int k = 0; k < ntile; ++k) {
        const size_t rbase = SAMPLE ? (size_t)MP + 64 * chain : (size_t)chain * TP + 64 * k;
#pragma unroll
        for (int o = 0; o < 4; ++o) { const f32x4 xc = cbv + cw0 * v[o] + cw1 * v[o + 1] + cw2 * v[o + 2] + cw3 * v[o + 3];
            v2u w; w.x = pk2(xc.x, xc.y); w.y = pk2(xc.z, xc.w);
            *(LAS v2u*)(lds + L_XCB + (4 * tg + o) * 272 + cg * 8) = w;
            if ((cg >> 3) == q) { LAS float* xf = (LAS float*)(lds + L_XCF) + (4 * tg + o) * LP + 4 * (cg & 7); xf[0] = xc.x; xf[1] = xc.y; xf[2] = xc.z; xf[3] = xc.w; } }
        const v2u gcur = gaw;
        if (k + 1 < ntile) lru_load_tile<SAMPLE>(args, XA, GA, chain, k + 1, tg, cg, chb, q, tid, v, gaw);
        LBAR();
        pg8::f32x4 accr = {0.f, 0.f, 0.f, 0.f}, acci = {0.f, 0.f, 0.f, 0.f};
#pragma unroll
        for (int kk = 0; kk < 4; ++kk) {
            const bf16x8 a = *(const LAS bf16x8*)(lds + L_XCB + (16 * tb + l15) * 272 + kk * 64 + lq * 16);
            const bf16x8 br = *(const LAS bf16x8*)(lds + L_WSL + (16 * ct + l15) * 272 + kk * 64 + lq * 16);
            const bf16x8 bi = *(const LAS bf16x8*)(lds + L_WSL + (32 + 16 * ct + l15) * 272 + kk * 64 + lq * 16);
            accr = __builtin_amdgcn_mfma_f32_16x16x32_bf16(a, br, accr, 0, 0, 0);
            acci = __builtin_amdgcn_mfma_f32_16x16x32_bf16(a, bi, acci, 0, 0, 0);
        }
#pragma unroll
        for (int r = 0; r < 4; ++r) { const int tt = 16 * tb + 4 * lq + r, cl = 16 * ct + l15;
            const float rg = fast_sigmoid(accr[r] + brg), ig = fast_sigmoid(acci[r] + big);
            const float la = sp8 * rg;
            const float a = __builtin_amdgcn_exp2f(la * 1.4426950408889634f);
            const float x2 = 2.0f * la;
            const float em = (x2 > -0.25f) ? -x2 * (1.0f + x2 * (0.5f + x2 * (1.0f / 6 + x2 * (1.0f / 24 + x2 * (1.0f / 120 + x2 * (1.0f / 720))))))
                                           : 1.0f - __builtin_amdgcn_exp2f(x2 * 1.4426950408889634f);
            const float xcv = ((const LAS float*)(lds + L_XCF))[tt * LP + cl];
            ((LAS float*)(lds + L_LA))[tt * LP + cl] = a;
            ((LAS float*)(lds + L_LB))[tt * LP + cl] = sqrtf(em) * ig * xcv; }
        LBAR();
        if (tid < 32) {
            const LAS float* la = (const LAS float*)(lds + L_LA) + tid; const LAS float* lb = (const LAS float*)(lds + L_LB) + tid; LAS float* lh = (LAS float*)(lds + L_LH) + tid;
            const int ch = chb + 32 * q + tid;
#pragma unroll
            for (int s = 0; s < 8; ++s) {
                if (SAMPLE) hcar = h0s[s];
#pragma unroll
                for (int t8 = 0; t8 < 8; ++t8) { const int tt = 8 * s + t8; hcar = la[tt * LP] * hcar + lb[tt * LP]; lh[tt * LP] = hcar; }
                if (SAMPLE) args.out[O_SLRU + (size_t)(8 * chain + s) * DLRU + ch] = hcar;
            }
            if (!SAMPLE && k == ntile - 1) args.out[O_PLRU + (size_t)chain * DLRU + ch] = hcar;
        }
        LBAR();
        { const int t = tid >> 3, c4 = (tid & 7) * 4; const LAS float* lh = (const LAS float*)(lds + L_LH) + t * LP + c4;
          v2u o; o.x = pk2(lh[0] * bf_lo(gcur.x), lh[1] * bf_hi(gcur.x)); o.y = pk2(lh[2] * bf_lo(gcur.y), lh[3] * bf_hi(gcur.y));
          *(GAS v2u*)(YAB + (rbase + t) * D + chb + 32 * q + c4) = o; }
    }
    LBAR();
}

constexpr int S5_WAVE_LDS = 12800, S5_BU = 0, S5_HS = 8448;
template <bool SAMPLE> __device__ __forceinline__ void s5_task(const Args& args, LAS unsigned char* wl, int lane, int chain, int g) {
    unsigned char* ws = args.ws;
    const bf16* XB = (const bf16*)(ws + WS_XB); bf16* G2 = (bf16*)(ws + WS_G2);
    const int l15 = lane & 15, lq = lane >> 4;
    const f32x2 ab = *(const GAS f32x2*)((const float*)(ws + WS_ABAR) + 2 * (g * SP + lane));
    bf16x8 bfrag[8], cfrag[4];
#pragma unroll
    for (int j = 0; j < 8; ++j) { bfrag[j] = (bf16x8){0, 0, 0, 0, 0, 0, 0, 0}; if (lane < 32) bfrag[j] = *(const GAS bf16x8*)((const bf16*)(ws + WS_BB) + ((size_t)(g * 8 + j) * 64 + lane) * 8); }
#pragma unroll
    for (int kk = 0; kk < 4; ++kk) cfrag[kk] = *(const GAS bf16x8*)((const bf16*)(ws + WS_CC) + ((size_t)(g * 4 + kk) * 64 + lane) * 8);
    const f32x4 dsk = *(const GAS f32x4*)(args.in[I_DSK] + g * SCG + 4 * lq);
    float hr = 0.f, hi = 0.f;
    const int ntile = SAMPLE ? 1 : 32;
    for (int k = 0; k < ntile; ++k) {
        const size_t rbase = SAMPLE ? (size_t)MP + 64 * chain : (size_t)chain * TP + 64 * k;
#pragma unroll 1
        for (int tb = 0; tb < 4; ++tb) {
            const size_t row0 = rbase + 16 * tb;
            bf16x8 a = (bf16x8){0, 0, 0, 0, 0, 0, 0, 0};
            if (lane < 32) a = *(const GAS bf16x8*)(XB + (row0 + l15) * DSSM + g * SCG + 8 * lq);
#pragma unroll
            for (int j = 0; j < 8; ++j) { const pg8::f32x4 c = __builtin_amdgcn_mfma_f32_16x16x32_bf16(a, bfrag[j], (pg8::f32x4){0.f, 0.f, 0.f, 0.f}, 0, 0, 0);
#pragma unroll
                for (int r = 0; r < 4; ++r) ((LAS float*)(wl + S5_BU))[(4 * lq + r) * 132 + 16 * j + l15] = c[r]; }
            LDS_WAIT();
            f32x2 bu[16];
#pragma unroll
            for (int t = 0; t < 16; ++t) bu[t] = *(const LAS f32x2*)(wl + S5_BU + (t * 132 + 2 * lane) * 4);
#pragma unroll
            for (int t = 0; t < 16; ++t) {
                if (SAMPLE && (t & 7) == 0) { const size_t si = ((size_t)(8 * chain + 2 * tb + (t >> 3)) * NGRP + g) * SP + lane; hr = args.in[I_SRE][si]; hi = args.in[I_SIM][si]; }
                const float nr = ab.x * hr - ab.y * hi + bu[t].x, ni = ab.x * hi + ab.y * hr + bu[t].y; hr = nr; hi = ni;
                *(LAS unsigned*)(wl + S5_HS + t * 272 + 4 * lane) = pk2(hr, hi);
                if (SAMPLE && (t & 7) == 7) { const size_t si = ((size_t)(8 * chain + 2 * tb + (t >> 3)) * NGRP + g) * SP + lane; args.out[O_SRE + si] = hr; args.out[O_SIM + si] = hi; }
            }
            LDS_WAIT();
            pg8::f32x4 y = {0.f, 0.f, 0.f, 0.f};
#pragma unroll
            for (int kk = 0; kk < 4; ++kk) { const bf16x8 hb = *(const LAS bf16x8*)(wl + S5_HS + l15 * 272 + kk * 64 + lq * 16);
                y = __builtin_amdgcn_mfma_f32_16x16x32_bf16(cfrag[kk], hb, y, 0, 0, 0); }
            LDS_WAIT();
            const v2u uw = *(const GAS v2u*)(XB + (row0 + l15) * DSSM + g * SCG + 4 * lq);
            const float y0 = y[0] + dsk.x * bf_lo(uw.x), y1 = y[1] + dsk.y * bf_hi(uw.x), y2 = y[2] + dsk.z * bf_lo(uw.y), y3 = y[3] + dsk.w * bf_hi(uw.y);
            v2u o; o.x = pk2(gelu_tanh_f(y0), gelu_tanh_f(y1)); o.y = pk2(gelu_tanh_f(y2), gelu_tanh_f(y3));
            *(GAS v2u*)(G2 + (row0 + l15) * DSSM + g * SCG + 4 * lq) = o;
        }
    }
    if (!SAMPLE) { const size_t si = ((size_t)chain * NGRP + g) * SP + lane; args.out[O_PRE + si] = hr; args.out[O_PIM + si] = hi; }
}

__device__ __forceinline__ void p5_mixer(const Args& args, LAS unsigned char* lds, int tid, int wave, int lane, int bx, int G) {
    { const float* XA = (const float*)(args.ws + WS_XA);
      const int nv = (NP + NS) * 3 * (DLRU / 4);
      for (int i = bx * 512 + tid; i < nv; i += G * 512) { const int c4 = i % (DLRU / 4), rj = i / (DLRU / 4), s = rj / 3, j = rj % 3;
          if (s < NP) *(GAS f32x4*)(args.out + O_PCONV + ((size_t)s * 3 + j) * DLRU + 4 * c4) = *(const GAS f32x4*)(XA + ((size_t)s * TP + TP - 3 + j) * DLRU + 4 * c4);
          else { const int ss = s - NP; *(GAS f32x4*)(args.out + O_SCONV + ((size_t)ss * 3 + j) * DLRU + 4 * c4) = *(const GAS f32x4*)(XA + ((size_t)MP + 8 * ss + 5 + j) * DLRU + 4 * c4); } } }
#if !defined(SKIP_LRU)
    for (int t = bx; t < NP * 64; t += G) lru_task<false>(args, lds, tid, wave, lane, t >> 6, (t >> 2) & 15, t & 3);
    for (int t = bx; t < 16 * 64; t += G) lru_task<true>(args, lds, tid, wave, lane, t >> 6, (t >> 2) & 15, t & 3);
#endif
#if defined(S5_PROBE)
    { const bf16* CCp = (const bf16*)(args.ws + WS_CC); const bf16* BBp = (const bf16*)(args.ws + WS_BB); const float* ABp = (const float*)(args.ws + WS_ABAR); const bf16* XBp = (const bf16*)(args.ws + WS_XB);
      for (int i = bx * 512 + tid; i < 32768; i += G * 512) { float s = 0.f, s2 = 0.f;
          for (int e = 0; e < 8; ++e) { s += __uint_as_float((unsigned)CCp[(size_t)i * 8 + e] << 16); s2 += __uint_as_float((unsigned)BBp[((size_t)(i >> 5) * 64 + (i & 31)) * 8 + e] << 16); }
          args.out[O_PRE + i] = s; args.out[O_PIM + i] = s2; if (i < 16384) args.out[O_SRE + i] = ABp[i]; }
      for (int i = bx * 512 + tid; i < 1048576; i += G * 512) { float s = 0.f; for (int e = 0; e < 18; ++e) s += __uint_as_float((unsigned)XBp[(size_t)i * 18 + e] << 16); args.out[O_SIM + i] = s; } }
#endif
#if !defined(SKIP_S5)
    LAS unsigned char* wl = lds + wave * S5_WAVE_LDS;
    const int gw = bx * NWAVES + wave, ngw = G * NWAVES;
    if (ngw >= 1024) {
        if (gw < NP * NGRP) s5_task<false>(args, wl, lane, gw >> 7, gw & 127);
        else for (int t = gw - NP * NGRP; t < 16 * NGRP; t += ngw - NP * NGRP) s5_task<true>(args, wl, lane, t >> 7, t & 127);
    } else {
        for (int t = gw; t < NP * NGRP; t += ngw) s5_task<false>(args, wl, lane, t >> 7, t & 127);
        for (int t = gw; t < 16 * NGRP; t += ngw) s5_task<true>(args, wl, lane, t >> 7, t & 127);
    }
#endif
    __syncthreads();
}

__global__ void __launch_bounds__(NWAVES * 64, 2) hawk_fwd(Args args) {
    extern __shared__ __attribute__((aligned(16))) unsigned char lds_raw[];
    LAS unsigned char* lds = (LAS unsigned char*)lds_raw;
    volatile LAS unsigned* MISC = (volatile LAS unsigned*)(lds + MISC_OFF);
    const int tid = threadIdx.x, lane = tid & 63, wave = __builtin_amdgcn_readfirstlane(tid >> 6);
    const int G = gridDim.x, bx = blockIdx.x;
    const int gw = bx * NWAVES + wave, ngw = G * NWAVES;
    unsigned char* ws = args.ws;
    gu32* ctl = (gu32*)(ws + WS_CTL);
    for (int u = tid; u < (LDS_BYTES - LDSCTL_OFF) / 4; u += NWAVES * 64) ((LAS unsigned*)(lds + LDSCTL_OFF))[u] = 0u;
#if defined(XCHK) && XCHK
    for (int u = tid; u < RING_BYTES / 4; u += NWAVES * 64) ((LAS unsigned*)lds)[u] = 0xFFFFFFFFu;
#endif
    __syncthreads();
    XcdBarrier bar = xcd_barrier_post((unsigned*)(ctl + CW_BAR) + args.li * XCD_BAR_WORDS, MISC + 8);
    const int lo = args.ph_lo, hi = args.ph_hi;
#ifndef PHMASK
#define PHMASK 0x1fff
#endif
#define IN(k) ((((PHMASK) >> (k)) & 1) && lo <= (k) && (k) < hi)
#define BOTH(k) (IN(k) && IN((k) + 1))
#define SEAM(k) do { if (BOTH(k)) xcd_barrier(bar); } while (0)
    bf16* XN = (bf16*)(ws + WS_XN); bf16* HID = (bf16*)(ws + WS_HID); float* Fb = (float*)(ws + WS_F); bf16* YAB = (bf16*)(ws + WS_YAB);
#ifndef XS_ON
#define XS_ON 0
#endif
#define XS_CNT(ph) ((unsigned*)(ctl + CW_XS) + (ph) * 1024 + 64 * bar.x)
#define xs_nloc ((unsigned)MISC[8])

#if defined(XCHK) && XCHK
    if (lo == 0) {
        GAS v4u* w4 = (GAS v4u*)(ws + 2 * MiB); const size_t n4 = (WS_END - 2 * MiB) / 16; const v4u q = {0xFFFFFFFFu, 0xFFFFFFFFu, 0xFFFFFFFFu, 0xFFFFFFFFu};
        for (size_t i = (size_t)bx * 512 + tid; i < n4; i += (size_t)G * 512) w4[i] = q;
        GAS v4u* o4 = (GAS v4u*)args.out; const size_t m4 = O_END / 4;
        for (size_t i = (size_t)bx * 512 + tid; i < m4; i += (size_t)G * 512) o4[i] = q;
        if (hi > 1) xcd_barrier(bar);
    }
#endif
    if (IN(0)) { p0_prologue(args, lds, wave, lane, gw, ngw);
#if defined(REP_PHASE) && REP_PHASE == 0
        xcd_barrier(bar); p0_prologue(args, lds, wave, lane, gw, ngw);
#endif
        SEAM(0); }
    int cv = bx;
#if !defined(NO_VIRT_C)
    if (lo == 0 && hi > 1) {
        if (tid == 0) { unsigned ok = (G % 8 == 0) ? 1u : 0u;
            for (unsigned j = 0; j < 16; ++j) { const unsigned cn = xb_ld(&bar.bar[XB_XCNT(j)]); ok &= (cn == (j < 8 ? (unsigned)G / 8u : 0u)) ? 1u : 0u; }
            MISC[11] = ok; }
        __syncthreads();
        if (MISC[11] != 0u && MISC[10] < (unsigned)G / 8u && bar.x < 8u) cv = (int)(MISC[10] * 8u + bar.x);
    }
#endif
    if (IN(1)) { pg8::Gemm g{XN, (const bf16*)(ws + WS_WGU1), M, 2 * DFF, D, D}; pg8::StaticOrder S; S.init(M, 2 * DFF, D, G, cv); S.xs = pg8::XSync{XS_CNT(1), xs_nloc, XS_ON ? S.nwg / G : 0};
        pg8::EpiSwiglu E{HID, DFF};
        pg8::gemm_phase<pg8::EpiSwiglu, pg8::StaticOrder, PG8_ALIGN, PG8_SP2>(lds + RING_OFF, g, S, E);
#if defined(REP_PHASE) && REP_PHASE == 1
        xcd_barrier(bar); pg8::gemm_phase<pg8::EpiSwiglu, pg8::StaticOrder, PG8_ALIGN, PG8_SP2>(lds + RING_OFF, g, S, E);
#endif
#if !defined(NO_TAIL_CONVERT)
        convert_queue(args, 1, ITB_DN1, IT_DN + IT_IN, lds, wave, lane);
#endif
        SEAM(1); }
    if (IN(2)) { pg8::Gemm g{HID, (const bf16*)(ws + WS_WD1), M, D, DFF, DFF}; pg8::TailOrder S; S.init(D, DFF, G, cv); S.base.xs = pg8::XSync{XS_CNT(2), xs_nloc, XS_ON ? 3 : 0};
        pg8::EpiF32 E{(bf16*)(ws + WS_F), D, (float*)(ws + WS_SLAB), SLAB_FLOATS, MP};
        pg8::gemm_phase<pg8::EpiF32, pg8::TailOrder, PG8_ALIGN, PG8_SP2>(lds + RING_OFF, g, S, E);
#if defined(REP_PHASE) && REP_PHASE == 2
        xcd_barrier(bar); pg8::gemm_phase<pg8::EpiF32, pg8::TailOrder, PG8_ALIGN, PG8_SP2>(lds + RING_OFF, g, S, E);
#endif
        SEAM(2); }
    if (IN(3)) { thin_rows<1>(args, gw, ngw, lane);
#if defined(REP_PHASE) && REP_PHASE == 3
        xcd_barrier(bar); thin_rows<1>(args, gw, ngw, lane);
#endif
        SEAM(3); }
    if (IN(4)) { pg8::Gemm g{XN, (const bf16*)(ws + WS_WIN), M, DIN, D, D}; pg8::StaticOrder S; S.init(M, DIN, D, G, cv); S.xs = pg8::XSync{XS_CNT(4), xs_nloc, XS_ON ? S.nwg / G : 0};
        pg8::EpiWin E{(float*)(ws + WS_XA), (bf16*)(ws + WS_GA), (bf16*)(ws + WS_XB), (bf16*)(ws + WS_G)};
        pg8::gemm_phase<pg8::EpiWin, pg8::StaticOrder, PG8_ALIGN, PG8_SP2>(lds + RING_OFF, g, S, E);
#if !defined(NO_TAIL_CONVERT)
        convert_queue(args, 4, ITB_GLU, IT_GLU, lds, wave, lane);
#endif
        SEAM(4); }
    if (IN(5)) { p5_mixer(args, lds, tid, wave, lane, bx, G);
#if defined(REP_PHASE) && REP_PHASE == 5
        xcd_barrier(bar); p5_mixer(args, lds, tid, wave, lane, bx, G);
#endif
        SEAM(5); }
    if (IN(6)) { pg8::Gemm g{(const bf16*)(ws + WS_G2), (const bf16*)(ws + WS_WGLU), M, DSSM, DSSM, DSSM}; pg8::StaticOrder S; S.init(M, DSSM, DSSM, G, cv); S.xs = pg8::XSync{XS_CNT(6), xs_nloc, XS_ON ? S.nwg / G : 0};
        pg8::EpiGlu E{(const bf16*)(ws + WS_G2), args.in[I_BGLU], YAB + DLRU};
        pg8::gemm_phase<pg8::EpiGlu, pg8::StaticOrder, PG8_ALIGN, PG8_SP2>(lds + RING_OFF, g, S, E);
#if !defined(NO_TAIL_CONVERT)
        convert_queue(args, 6, ITB_OA, 2 * IT_OA + IT_WO, lds, wave, lane);
#endif
        SEAM(6); }
    if (IN(7)) { pg8::Gemm g{YAB, (const bf16*)(ws + WS_WOUT), M, D, D, D}; pg8::SegOrder S; S.init(M, D, D, G, cv); S.xs = pg8::XSync{XS_CNT(7), xs_nloc, XS_ON ? S.nwg / G : 0};
        pg8::EpiOut E{(const bf16*)(ws + WS_G), XN};
        pg8::gemm_phase<pg8::EpiOut, pg8::SegOrder, PG8_ALIGN, PG8_SP2>(lds + RING_OFF, g, S, E);
#if !defined(NO_TAIL_CONVERT)
        convert_queue(args, 7, ITB_GU2, 2 * IT_GU, lds, wave, lane);
#endif
        SEAM(7); }
    if (IN(8)) { pg8::Gemm g{XN, (const bf16*)(ws + WS_WO), M, D, D, D}; pg8::TailOrder S; S.init(D, D, G, cv); S.base.xs = pg8::XSync{XS_CNT(8), xs_nloc, XS_ON ? 3 : 0};
        pg8::EpiF32 E{(bf16*)(ws + WS_F), D, (float*)(ws + WS_SLAB), SLAB_FLOATS, MP};
        pg8::gemm_phase<pg8::EpiF32, pg8::TailOrder, PG8_ALIGN, PG8_SP2>(lds + RING_OFF, g, S, E);
#if defined(REP_PHASE) && REP_PHASE == 8
        xcd_barrier(bar); pg8::gemm_phase<pg8::EpiF32, pg8::TailOrder, PG8_ALIGN, PG8_SP2>(lds + RING_OFF, g, S, E);
#endif
        SEAM(8); }
    if (IN(9)) { thin_rows<2>(args, gw, ngw, lane); SEAM(9); }
    if (IN(10)) { pg8::Gemm g{XN, (const bf16*)(ws + WS_WGU2), M, 2 * DFF, D, D}; pg8::StaticOrder S; S.init(M, 2 * DFF, D, G, cv); S.xs = pg8::XSync{XS_CNT(10), xs_nloc, XS_ON ? S.nwg / G : 0};
        pg8::EpiSwiglu E{HID, DFF};
        pg8::gemm_phase<pg8::EpiSwiglu, pg8::StaticOrder, PG8_ALIGN, PG8_SP2>(lds + RING_OFF, g, S, E);
#if !defined(NO_TAIL_CONVERT)
        convert_queue(args, 10, ITB_DN2, IT_DN, lds, wave, lane);
#endif
        SEAM(10); }
    if (IN(11)) { pg8::Gemm g{HID, (const bf16*)(ws + WS_WD2), M, D, DFF, DFF}; pg8::TailOrder S; S.init(D, DFF, G, cv); S.base.xs = pg8::XSync{XS_CNT(11), xs_nloc, XS_ON ? 3 : 0};
        pg8::EpiF32 E{(bf16*)(ws + WS_F), D, (float*)(ws + WS_SLAB), SLAB_FLOATS, MP};
        pg8::gemm_phase<pg8::EpiF32, pg8::TailOrder, PG8_ALIGN, PG8_SP2>(lds + RING_OFF, g, S, E); SEAM(11); }
    if (IN(12)) { thin_rows<3>(args, gw, ngw, lane); }
#undef IN
#undef BOTH
#undef SEAM
}

extern "C" void kernel_launch(void* const* d_in, const int* in_sizes, int n_in, void* d_out, int out_size, void* d_ws, size_t ws_size, hipStream_t stream) {
    static int grid = 0;
    if (grid == 0) {
        if (n_in != 39 || in_sizes[0] != MP * D || out_size != (int)O_END || ws_size < WS_END) { fprintf(stderr, "kernel_launch: unexpected shapes (n_in %d, in0 %d, out %d, ws %zu); nothing launched\n", n_in, n_in > 0 ? in_sizes[0] : -1, out_size, ws_size); grid = -1; return; }
        int dev = 0, cus = 0, per_cu = 0;
        if (hipGetDevice(&dev) != hipSuccess || hipDeviceGetAttribute(&cus, hipDeviceAttributeMultiprocessorCount, dev) != hipSuccess) { grid = -1; return; }
        if (hipFuncSetAttribute((const void*)hawk_fwd, hipFuncAttributeMaxDynamicSharedMemorySize, LDS_BYTES) != hipSuccess) { fprintf(stderr, "kernel_launch: hipFuncSetAttribute failed\n"); grid = -1; return; }
        if (hipOccupancyMaxActiveBlocksPerMultiprocessor(&per_cu, (const void*)hawk_fwd, NWAVES * 64, LDS_BYTES) != hipSuccess || per_cu < 1)
            fprintf(stderr, "kernel_launch: note: occupancy query reports %d workgroups per CU\n", per_cu);
        (void)hipGetLastError();
        grid = cus;
    }
    if (grid < 0) return;
    if (hipMemsetAsync((char*)d_ws + WS_CTL, 0, CTL_ZERO_BYTES, stream) != hipSuccess) return;
    Args a{};
    for (int i = 0; i < 39; ++i) a.in[i] = (const float*)d_in[i];
    a.out = (float*)d_out; a.ws = (unsigned char*)d_ws;
    static_assert(N_LAUNCHES == 1 || N_LAUNCHES == N_PHASES, "MK_N_LAUNCHES: 1 or one launch per phase");
    for (int li = 0; li < N_LAUNCHES; ++li) {
        a.ph_lo = (N_LAUNCHES == 1) ? 0 : li; a.ph_hi = (N_LAUNCHES == 1) ? N_PHASES : li + 1; a.li = li; a.pad = 0;
        hipLaunchKernelGGL(hawk_fwd, dim3(grid), dim3(NWAVES * 64), LDS_BYTES, stream, a);
        const hipError_t le = hipPeekAtLastError();
        if (le != hipSuccess) { fprintf(stderr, "kernel_launch: launch %d failed: %s\n", li, hipGetErrorName(le)); break; }
    }
}
```

```cpp
#define NO_VIRT_C 1
#define EPI_NT 1
#define STREAM_NT 1
#define CONV_NT 1
#define LRU64 1
#define S5_SPREAD 1
#define S5_CONV 1
#define MK_GU2_N5 20000
#define SWIGLU_FOLD 1
#define HID_CACHED 1
#include <hip/hip_runtime.h>
#include <cstdio>
#include <cstdint>
namespace pg8 {
#define PG8_LAS __attribute__((address_space(3)))
typedef unsigned short bf16_t;
typedef short bf16x8 __attribute__((ext_vector_type(8)));
typedef float f32x4 __attribute__((ext_vector_type(4)));
typedef unsigned u32x4 __attribute__((ext_vector_type(4)));
constexpr int BM = 256, BK = 64, HALF = 128, HTB = HALF * BK * 2  , STAGE_BYTES = 8 * HTB, NXCD = 8,
#ifdef MK_WGM
    WGM = MK_WGM;
#else
    WGM = 8;
#endif

__host__ __device__ __forceinline__ int lds_byte(int r, int c) { const int st = (r >> 4) * 2 + (c >> 5), rr = r & 15, cc = c & 31, ob = rr * 64 + cc * 2; return st * 1024 + (ob ^ (((ob >> 9) & 1) << 5)); }
__host__ __device__ __forceinline__ void stage_rc(int b, int& R, int& C) { const int st = b / 1024, sb = b % 1024, swz = sb ^ (((sb >> 9) & 1) << 5); R = (st >> 1) * 16 + swz / 64; C = (st & 1) * 32 + (swz % 64) / 2; }
__host__ __device__ __forceinline__ int perm32(int rho) { const int n = rho >> 4, i = rho & 15; return 8 * (i >> 2) + 4 * n + (i & 3); }

struct Unit { int pm, pn, seg, k0, nt, slab, round; };
struct Gemm { const bf16_t* A; const bf16_t* Bt; int M, N, K, ld; };

struct XSync {
    unsigned* cnt; unsigned nloc; int nrounds;
    __device__ __forceinline__ void wait(int round) const {
        if (nloc == 0u || round < 1 || round >= nrounds) return;
        if (threadIdx.x < 64) {
            if (threadIdx.x == 0) (void)__hip_atomic_fetch_add(cnt, 1u, __ATOMIC_RELAXED, __HIP_MEMORY_SCOPE_AGENT);
            const unsigned target = (unsigned)round * nloc; unsigned sp = 0;
            while ((unsigned)__builtin_amdgcn_readfirstlane(__hip_atomic_load(cnt, __ATOMIC_RELAXED, __HIP_MEMORY_SCOPE_AGENT)) < target) { __builtin_amdgcn_s_sleep(1); if (++sp > 200000u) break; }
        }
        asm volatile("" ::: "memory"); __builtin_amdgcn_s_barrier(); asm volatile("" ::: "memory");
    }
};
struct StaticOrder {
    XSync xs;
    int nM, nN, nwg, G, c, ntk;
    __host__ __device__ __forceinline__ void init(int M, int N, int K, int G_, int c_) { nM = M / BM; nN = N / BM; nwg = nM * nN; G = G_; c = c_; ntk = K / BK; }
    __host__ __device__ __forceinline__ bool next(int i, Unit& u) const {
        const long L = (long)i * G + c; if (L >= nwg) return false;
        int wgid = (int)L; { const int q = nwg / NXCD, r = nwg % NXCD, xcd = wgid % NXCD, off = wgid / NXCD; wgid = (xcd < r ? xcd * (q + 1) : r * (q + 1) + (xcd - r) * q) + off; }
        const int nig = WGM * nN, gid = wgid / nig, fm = gid * WGM, gsz = (nM - fm) < WGM ? (nM - fm) : WGM;
        u.pm = fm + ((wgid % nig) % gsz); u.pn = (wgid % nig) / gsz; u.seg = 0; u.k0 = 0; u.nt = ntk; u.slab = 0; u.round = i; return true;
    }
    __device__ __forceinline__ void a_ready(const Unit& u) const { xs.wait(u.round); }
    __device__ __forceinline__ void done(const Unit&) const {}
};
struct SegOrder : StaticOrder {
    __host__ __device__ __forceinline__ bool next(int i, Unit& u) const { const bool ok = StaticOrder::next(i >> 1, u); u.seg = i & 1; u.nt = ntk >> 1; u.k0 = (i & 1) * (ntk >> 1); return ok; }
    __device__ __forceinline__ void a_ready(const Unit& u) const { if (u.seg == 0) xs.wait(u.round); }
};
struct TailOrder {
    StaticOrder base; int c, ntk;
    __host__ __device__ __forceinline__ void init(int N, int K, int G_, int c_) { base.init(32 * BM, N, K, G_, c_); c = c_; ntk = K / BK; }
    __host__ __device__ __forceinline__ bool next(int i, Unit& u) const {
        const bool full = i < 2; Unit b; const bool okb = base.next(full ? i : 0, b);
        const int x = c & 7, j = c >> 3, q = x & 3;
        const int qa = ((ntk >> 2) + 1) & ~1, qb = (ntk - 2 * qa) >> 1;
        u.pm = full ? b.pm : 32 + (j >> 3); u.pn = full ? b.pn : 8 * (x >> 2) + (j & 7); u.seg = 0; u.slab = full ? 0 : q + 1;
        u.k0 = full ? 0 : (q < 2 ? q * qa : 2 * qa + (q - 2) * qb); u.nt = full ? ntk : (q < 2 ? qa : qb); u.round = i;
        return full ? okb : (i == 2 && base.G == 256 && base.nN == 16);
    }
    __device__ __forceinline__ void a_ready(const Unit& u) const { base.xs.wait(u.round); }
    __device__ __forceinline__ void done(const Unit&) const {}
};

typedef float cvt_f32x2_t __attribute__((ext_vector_type(2)));
typedef __bf16 cvt_bf16x2_t __attribute__((ext_vector_type(2)));
__device__ __forceinline__ unsigned cvt_pk_bf16(float lo, float hi) { const cvt_f32x2_t v = {lo, hi}; const cvt_bf16x2_t b = __builtin_convertvector(v, cvt_bf16x2_t); return __builtin_bit_cast(unsigned, b); }
typedef float f32x2 __attribute__((ext_vector_type(2)));
__device__ __forceinline__ f32x2 gelu_pk(f32x2 v) {
    const f32x2 av = __builtin_elementwise_abs(v), d = av * 0.2316418882f + 1.0f;
    f32x2 t; t.x = __builtin_amdgcn_rcpf(d.x); t.y = __builtin_amdgcn_rcpf(d.y);
    f32x2 q = t * 0.5307027145f + (-0.7265760135f); q = q * t + 0.7107068705f; q = q * t + (-0.142248368f); q = q * t + 0.127414796f; q = q * t;
    const f32x2 s = (v * v) * (-0.72134752044f);
    f32x2 e; e.x = __builtin_amdgcn_exp2f(s.x); e.y = __builtin_amdgcn_exp2f(s.y);
    const f32x2 m = v * (q * e), r = v - m;
    f32x2 o; o.x = v.x < 0.f ? m.x : r.x; o.y = v.y < 0.f ? m.y : r.y; return o;
}

#if defined(EPI_LD_NT)
#define EPI_LD(P) __builtin_nontemporal_load(P)
#else
#define EPI_LD(P) (*(P))
#endif
#if defined(EPI_NT) && !defined(F_CACHED)
#define EPI_ST_F(TY, ADDR, VAL) __builtin_nontemporal_store((VAL), (TY*)(ADDR))
#else
#define EPI_ST_F(TY, ADDR, VAL) (*(TY*)(ADDR) = (VAL))
#endif
#if defined(EPI_NT) && !defined(XA_CACHED)
#define EPI_ST_XA(TY, ADDR, VAL) __builtin_nontemporal_store((VAL), (TY*)(ADDR))
#else
#define EPI_ST_XA(TY, ADDR, VAL) (*(TY*)(ADDR) = (VAL))
#endif
#if defined(EPI_NT) && !defined(HID_CACHED)
#define EPI_ST_H(TY, ADDR, VAL) __builtin_nontemporal_store((VAL), (TY*)(ADDR))
#else
#define EPI_ST_H(TY, ADDR, VAL) (*(TY*)(ADDR) = (VAL))
#endif
#if defined(EPI_NT)
#define EPI_ST(TY, ADDR, VAL) __builtin_nontemporal_store((VAL), (TY*)(ADDR))
#else
#define EPI_ST(TY, ADDR, VAL) (*(TY*)(ADDR) = (VAL))
#endif

__device__ __forceinline__ float bf_lo(unsigned w) { return __uint_as_float(w << 16); }
__device__ __forceinline__ float bf_hi(unsigned w) { return __uint_as_float(w & 0xffff0000u); }
__device__ __forceinline__ float fast_sigmoid(float x) { return __builtin_amdgcn_rcpf(1.0f + __builtin_amdgcn_exp2f(-1.4426950408889634f * x)); }
__device__ __forceinline__ float silu_f(float x) { return x * fast_sigmoid(x); }
__device__ __forceinline__ float gelu_tanh_f(float x) { const float z = 1.5957691216057308f * (x + 0.044715f * x * x * x); return x * fast_sigmoid(z); }
__device__ __forceinline__ u32x4 pack8(const f32x4& v0, const f32x4& v1) { u32x4 w; w.x = cvt_pk_bf16(v0[0], v0[1]); w.y = cvt_pk_bf16(v0[2], v0[3]); w.z = cvt_pk_bf16(v1[0], v1[1]); w.w = cvt_pk_bf16(v1[2], v1[3]); return w; }

__device__ __forceinline__ void scale_rows(f32x4 (&acc)[2][2][4][2], const float* RS, int row0) {
#pragma unroll
    for (int ai = 0; ai < 2; ++ai)
#pragma unroll
        for (int m = 0; m < 4; ++m) { const float s = RS[row0 + ai * HALF + m * 16];
#pragma unroll
            for (int bj = 0; bj < 2; ++bj)
#pragma unroll
                for (int n = 0; n < 2; ++n) acc[ai][bj][m][n] = acc[ai][bj][m][n] * s; }
}
struct EpiSwiglu {
    static constexpr bool PERM = true, AFTER_DRAIN = false, SEG = false;
    bf16_t* O; int ldc; const float* RS;
    __device__ __forceinline__ void operator()(f32x4 (&acc)[2][2][4][2], const Unit& u, int wr, int wc, int fr, int fq) const {
        const int row0 = u.pm * BM + wr * 64 + fr, col0 = u.pn * HALF + wc * 32 + 8 * fq;
#if defined(SWIGLU_FOLD)
#pragma unroll
        for (int ai = 0; ai < 2; ++ai)
#pragma unroll
            for (int m = 0; m < 4; ++m) { bf16_t* rowp = O + (size_t)(row0 + ai * HALF + m * 16) * ldc + col0;
                const float sr = RS[row0 + ai * HALF + m * 16], c1 = -1.4426950408889634f * sr, s2 = sr * sr;
                f32x4 v0, v1;
#pragma unroll
                for (int j = 0; j < 4; ++j) {
                    const float g0 = acc[ai][0][m][0][j], g1 = acc[ai][0][m][1][j];
                    v0[j] = (g0 * acc[ai][1][m][0][j]) * (s2 * __builtin_amdgcn_rcpf(1.0f + __builtin_amdgcn_exp2f(c1 * g0)));
                    v1[j] = (g1 * acc[ai][1][m][1][j]) * (s2 * __builtin_amdgcn_rcpf(1.0f + __builtin_amdgcn_exp2f(c1 * g1))); }
                EPI_ST_H(u32x4, rowp, pack8(v0, v1)); }
#else
        scale_rows(acc, RS, row0);
#pragma unroll
        for (int ai = 0; ai < 2; ++ai)
#pragma unroll
            for (int m = 0; m < 4; ++m) { bf16_t* rowp = O + (size_t)(row0 + ai * HALF + m * 16) * ldc + col0;
                f32x4 v0, v1;
#pragma unroll
                for (int j = 0; j < 4; ++j) { v0[j] = silu_f(acc[ai][0][m][0][j]) * acc[ai][1][m][0][j]; v1[j] = silu_f(acc[ai][0][m][1][j]) * acc[ai][1][m][1][j]; }
                EPI_ST_H(u32x4, rowp, pack8(v0, v1)); }
#endif
    }
};
struct EpiF32 {
    static constexpr bool PERM = true, AFTER_DRAIN = false, SEG = false;
    bf16_t* C; int ldc; float* S; size_t slab_stride; int slab_row0;
    __device__ __forceinline__ void operator()(f32x4 (&acc)[2][2][4][2], const Unit& u, int wr, int wc, int fr, int fq) const {
        const int row0 = u.pm * BM + wr * 64 + fr, col0 = u.pn * BM + wc * 32 + 8 * fq;
        if (u.slab == 0) {
#pragma unroll
            for (int ai = 0; ai < 2; ++ai)
#pragma unroll
                for (int m = 0; m < 4; ++m) { bf16_t* rowp = C + (size_t)(row0 + ai * HALF + m * 16) * ldc + col0;
#pragma unroll
                    for (int bj = 0; bj < 2; ++bj) EPI_ST_F(u32x4, (rowp + bj * HALF), pack8(acc[ai][bj][m][0], acc[ai][bj][m][1])); }
        } else {
#if defined(SLAB_F32)
            float* base = S + (size_t)(u.slab - 1) * slab_stride - (size_t)slab_row0 * ldc;
#pragma unroll
            for (int ai = 0; ai < 2; ++ai)
#pragma unroll
                for (int m = 0; m < 4; ++m) { float* rowp = base + (size_t)(row0 + ai * HALF + m * 16) * ldc + col0;
#pragma unroll
                    for (int bj = 0; bj < 2; ++bj)
#pragma unroll
                        for (int n = 0; n < 2; ++n) EPI_ST_F(f32x4, (rowp + bj * HALF + n * 4), acc[ai][bj][m][n]); }
#else
            bf16_t* base = (bf16_t*)S + (size_t)(u.slab - 1) * slab_stride - (size_t)slab_row0 * ldc;
#pragma unroll
            for (int ai = 0; ai < 2; ++ai)
#pragma unroll
                for (int m = 0; m < 4; ++m) { bf16_t* rowp = base + (size_t)(row0 + ai * HALF + m * 16) * ldc + col0;
#pragma unroll
                    for (int bj = 0; bj < 2; ++bj) EPI_ST_F(u32x4, (rowp + bj * HALF), pack8(acc[ai][bj][m][0], acc[ai][bj][m][1])); }
#endif
        }
    }
};
struct EpiWin {
    static constexpr bool PERM = true, AFTER_DRAIN = false, SEG = false;
    float* XA; bf16_t* GA; bf16_t* XB; bf16_t* G; const float* RS;
    __device__ __forceinline__ void operator()(f32x4 (&acc)[2][2][4][2], const Unit& u, int wr, int wc, int fr, int fq) const {
        const int row0 = u.pm * BM + wr * 64 + fr, cw = wc * 32 + 8 * fq;
        scale_rows(acc, RS, row0);
        if (u.pn < 8) {
            const int col0 = u.pn * BM + cw;
#pragma unroll
            for (int ai = 0; ai < 2; ++ai)
#pragma unroll
#if defined(XA_BF16)
                for (int m = 0; m < 4; ++m) { bf16_t* rowp = (bf16_t*)XA + (size_t)(row0 + ai * HALF + m * 16) * 2048 + col0;
#pragma unroll
                    for (int bj = 0; bj < 2; ++bj) EPI_ST(u32x4, (rowp + bj * HALF), pack8(acc[ai][bj][m][0], acc[ai][bj][m][1])); }
#else
                for (int m = 0; m < 4; ++m) { float* rowp = XA + (size_t)(row0 + ai * HALF + m * 16) * 2048 + col0;
#pragma unroll
                    for (int bj = 0; bj < 2; ++bj)
#pragma unroll
                        for (int n = 0; n < 2; ++n) EPI_ST_XA(f32x4, (rowp + bj * HALF + n * 4), acc[ai][bj][m][n]); }
#endif
        } else if (u.pn < 16) {
            const int col0 = (u.pn - 8) * BM + cw;
#pragma unroll
            for (int ai = 0; ai < 2; ++ai)
#pragma unroll
                for (int m = 0; m < 4; ++m) { bf16_t* rowp = GA + (size_t)(row0 + ai * HALF + m * 16) * 2048 + col0;
#pragma unroll
                    for (int bj = 0; bj < 2; ++bj) { f32x4 v0, v1;
#pragma unroll
                        for (int j = 0; j < 4; ++j) { v0[j] = gelu_tanh_f(acc[ai][bj][m][0][j]); v1[j] = gelu_tanh_f(acc[ai][bj][m][1][j]); }
                        EPI_ST(u32x4, (rowp + bj * HALF), pack8(v0, v1)); } }
        } else if (u.pn < 24) {
            const int col0 = (u.pn - 16) * BM + cw;
#pragma unroll
            for (int ai = 0; ai < 2; ++ai)
#pragma unroll
                for (int m = 0; m < 4; ++m) { bf16_t* rowp = XB + (size_t)(row0 + ai * HALF + m * 16) * 2048 + col0;
#pragma unroll
                    for (int bj = 0; bj < 2; ++bj) EPI_ST(u32x4, (rowp + bj * HALF), pack8(acc[ai][bj][m][0], acc[ai][bj][m][1])); }
        } else {
            const int col0 = (u.pn - 24) * BM + cw;
#pragma unroll
            for (int ai = 0; ai < 2; ++ai)
#pragma unroll
                for (int m = 0; m < 4; ++m) { bf16_t* rowp = G + (size_t)(row0 + ai * HALF + m * 16) * 8192 + col0;
#pragma unroll
                    for (int bj = 0; bj < 2; ++bj) { f32x4 v0, v1;
#pragma unroll
                        for (int j = 0; j < 4; ++j) { v0[j] = fast_sigmoid(acc[ai][bj][m][0][j]); v1[j] = fast_sigmoid(acc[ai][bj][m][1][j]); }
                        EPI_ST(u32x4, (rowp + bj * HALF), pack8(v0, v1)); } }
        }
    }
};
struct EpiGlu {
    static constexpr bool PERM = true, AFTER_DRAIN = false, SEG = false;
    const bf16_t* G2; const float* bias; bf16_t* O;
    __device__ __forceinline__ void operator()(f32x4 (&acc)[2][2][4][2], const Unit& u, int wr, int wc, int fr, int fq) const {
        const int row0 = u.pm * BM + wr * 64 + fr, col0 = u.pn * BM + wc * 32 + 8 * fq;
        f32x4 bv[2][2];
#pragma unroll
        for (int bj = 0; bj < 2; ++bj)
#pragma unroll
            for (int n = 0; n < 2; ++n) bv[bj][n] = *(const f32x4*)(bias + col0 + bj * HALF + 4 * n);
#pragma unroll
        for (int ai = 0; ai < 2; ++ai)
#pragma unroll
            for (int m = 0; m < 4; ++m) { const size_t r = (size_t)(row0 + ai * HALF + m * 16);
#pragma unroll
                for (int bj = 0; bj < 2; ++bj) { const u32x4 gw = *(const u32x4*)(G2 + r * 2048 + col0 + bj * HALF);
                    const f32x4 a0 = acc[ai][bj][m][0] + bv[bj][0], a1 = acc[ai][bj][m][1] + bv[bj][1]; f32x4 v0, v1;
                    v0[0] = bf_lo(gw.x) * fast_sigmoid(a0[0]); v0[1] = bf_hi(gw.x) * fast_sigmoid(a0[1]); v0[2] = bf_lo(gw.y) * fast_sigmoid(a0[2]); v0[3] = bf_hi(gw.y) * fast_sigmoid(a0[3]);
                    v1[0] = bf_lo(gw.z) * fast_sigmoid(a1[0]); v1[1] = bf_hi(gw.z) * fast_sigmoid(a1[1]); v1[2] = bf_lo(gw.w) * fast_sigmoid(a1[2]); v1[3] = bf_hi(gw.w) * fast_sigmoid(a1[3]);
                    EPI_ST(u32x4, (O + r * 4096 + col0 + bj * HALF), pack8(v0, v1)); } }
    }
};
struct EpiOut {
    static constexpr bool PERM = true, AFTER_DRAIN = false, SEG = true;
    const bf16_t* G; bf16_t* O;
    __device__ __forceinline__ void seg0(f32x4 (&acc)[2][2][4][2], const Unit& u, int wr, int wc, int fr, int fq) const {
        const int row0 = u.pm * BM + wr * 64 + fr, col0 = u.pn * BM + wc * 32 + 8 * fq;
#pragma unroll
        for (int ai = 0; ai < 2; ++ai)
#pragma unroll
            for (int m = 0; m < 4; ++m) { const bf16_t* gp = G + (size_t)(row0 + ai * HALF + m * 16) * 8192 + col0;
#pragma unroll
                for (int bj = 0; bj < 2; ++bj) { const u32x4 a = EPI_LD((const u32x4*)(gp + bj * HALF)), b = EPI_LD((const u32x4*)(gp + 4096 + bj * HALF));
                    f32x4 r0, r1;
                    r0[0] = bf_lo(a.x) * __builtin_amdgcn_rcpf(fmaxf(bf_lo(b.x), 1e-30f)); r0[1] = bf_hi(a.x) * __builtin_amdgcn_rcpf(fmaxf(bf_hi(b.x), 1e-30f));
                    r0[2] = bf_lo(a.y) * __builtin_amdgcn_rcpf(fmaxf(bf_lo(b.y), 1e-30f)); r0[3] = bf_hi(a.y) * __builtin_amdgcn_rcpf(fmaxf(bf_hi(b.y), 1e-30f));
                    r1[0] = bf_lo(a.z) * __builtin_amdgcn_rcpf(fmaxf(bf_lo(b.z), 1e-30f)); r1[1] = bf_hi(a.z) * __builtin_amdgcn_rcpf(fmaxf(bf_hi(b.z), 1e-30f));
                    r1[2] = bf_lo(a.w) * __builtin_amdgcn_rcpf(fmaxf(bf_lo(b.w), 1e-30f)); r1[3] = bf_hi(a.w) * __builtin_amdgcn_rcpf(fmaxf(bf_hi(b.w), 1e-30f));
                    acc[ai][bj][m][0] = acc[ai][bj][m][0] * r0; acc[ai][bj][m][1] = acc[ai][bj][m][1] * r1; }
                asm volatile("" ::: "memory"); }
    }
    __device__ __forceinline__ void operator()(f32x4 (&acc)[2][2][4][2], const Unit& u, int wr, int wc, int fr, int fq) const { if (u.seg == 0) seg0(acc, u, wr, wc, fr, fq); else seg1(acc, u, wr, wc, fr, fq); }
    __device__ __forceinline__ void seg1(const f32x4 (&acc)[2][2][4][2], const Unit& u, int wr, int wc, int fr, int fq) const {
        const int row0 = u.pm * BM + wr * 64 + fr, col0 = u.pn * BM + wc * 32 + 8 * fq;
#pragma unroll
        for (int ai = 0; ai < 2; ++ai)
#pragma unroll
            for (int m = 0; m < 4; ++m) { const size_t r = (size_t)(row0 + ai * HALF + m * 16);
#pragma unroll
                for (int bj = 0; bj < 2; ++bj) { const u32x4 b = EPI_LD((const u32x4*)(G + r * 8192 + 4096 + col0 + bj * HALF));
                    f32x4 g0, g1;
                    g0[0] = fmaxf(bf_lo(b.x), 1e-30f); g0[1] = fmaxf(bf_hi(b.x), 1e-30f); g0[2] = fmaxf(bf_lo(b.y), 1e-30f); g0[3] = fmaxf(bf_hi(b.y), 1e-30f);
                    g1[0] = fmaxf(bf_lo(b.z), 1e-30f); g1[1] = fmaxf(bf_hi(b.z), 1e-30f); g1[2] = fmaxf(bf_lo(b.w), 1e-30f); g1[3] = fmaxf(bf_hi(b.w), 1e-30f);
                    EPI_ST(u32x4, (O + r * 4096 + col0 + bj * HALF), pack8(acc[ai][bj][m][0] * g0, acc[ai][bj][m][1] * g1)); } }
    }
};

template <class Epi, class Sched, bool ALIGN_EPI = false, bool SP2 = false>
__device__ __forceinline__ void gemm_phase(PG8_LAS unsigned char* lds, const Gemm g, const Sched& S, const Epi& E) {
    const int tid = threadIdx.x, wid = __builtin_amdgcn_readfirstlane(tid >> 6), lane = tid & 63, wr = wid >> 2, wc = wid & 3, fr = lane & 15, fq = lane >> 4;
    const int LD = g.ld;
    unsigned voffA[2], voffB[2];
#pragma unroll
    for (int i = 0; i < 2; ++i) { int R, C; stage_rc(tid * 16 + i * 8192, R, C); const int Rb = Epi::PERM ? ((R & ~31) + perm32(R & 31)) : R;
        voffA[i] = (unsigned)(R * LD + C) * 2u; voffB[i] = (unsigned)(Rb * LD + C) * 2u; }
    const size_t kstep = (size_t)(BK * 2);
    const size_t hstep = (size_t)HALF * LD * 2;
    const size_t tstep = 2 * hstep;
    const unsigned ldsw = (unsigned)wid * 1024u;
    const int aoff = lds_byte(wr * 64 + fr, fq * 8), boff = lds_byte(wc * 32 + fr, fq * 8);
#define PG8_SA(b, h) (((b) * 2 + (h)) * HTB)
#define PG8_SB(b, h) ((4 + (b) * 2 + (h)) * HTB)
#if defined(DMA_BUF)
    const __amdgpu_buffer_rsrc_t sr_voffA = __builtin_amdgcn_make_buffer_rsrc((void*)g.A, (short)0, (int)0x7fffffff, 0x00020000);
    const __amdgpu_buffer_rsrc_t sr_voffB = __builtin_amdgcn_make_buffer_rsrc((void*)g.Bt, (short)0, (int)0x7fffffff, 0x00020000);
    const char* const base_voffA = (const char*)g.A; const char* const base_voffB = (const char*)g.Bt;
    const unsigned ldsm0 = __builtin_amdgcn_readfirstlane((unsigned)(size_t)lds + ldsw);
#define PG8_STAGE(bufoff, gbase, voff) do { const unsigned _so = __builtin_amdgcn_readfirstlane((unsigned)((const char*)(gbase) - base_##voff)); _Pragma("unroll") for (int _i = 0; _i < 2; ++_i) \
        asm volatile("s_mov_b32 m0, %0\n\ts_nop 0\n\tbuffer_load_dwordx4 %1, %2, %3 offen lds" :: "s"(ldsm0 + (unsigned)(bufoff) + (unsigned)_i * 8192u), "v"((voff)[_i]), "s"(sr_##voff), "s"(_so) : "m0", "memory"); } while (0)
#else
#define PG8_STAGE(bufoff, gbase, voff) do { _Pragma("unroll") for (int _i = 0; _i < 2; ++_i) \
        __builtin_amdgcn_global_load_lds((const unsigned*)((const char*)(gbase) + (voff)[_i]), (PG8_LAS unsigned*)(lds + (bufoff) + ldsw + _i * 8192), 16, 0, 0); } while (0)
#endif
#define PG8_LDA(dst, b, h) do { _Pragma("unroll") for (int m = 0; m < 4; ++m) _Pragma("unroll") for (int k = 0; k < 2; ++k) dst[m][k] = *(const PG8_LAS bf16x8*)(lds + PG8_SA(b, h) + aoff + m * 2048 + k * 1024); } while (0)
#define PG8_LDB(dst, b, h) do { _Pragma("unroll") for (int n = 0; n < 2; ++n) _Pragma("unroll") for (int k = 0; k < 2; ++k) dst[n][k] = *(const PG8_LAS bf16x8*)(lds + PG8_SB(b, h) + boff + n * 2048 + k * 1024); } while (0)
#define PG8_MMA(ai, bj, At, Bt) do { __builtin_amdgcn_s_setprio(1); _Pragma("unroll") for (int m = 0; m < 4; ++m) _Pragma("unroll") for (int n = 0; n < 2; ++n) _Pragma("unroll") for (int k = 0; k < 2; ++k) \
        acc[ai][bj][m][n] = __builtin_amdgcn_mfma_f32_16x16x32_bf16(Bt[n][k], At[m][k], acc[ai][bj][m][n], 0, 0, 0); __builtin_amdgcn_s_setprio(0); } while (0)
#define PG8_WAIT_V(n) asm volatile("s_waitcnt vmcnt(" #n ")" ::: "memory")
#define PG8_WAIT_L(n) asm volatile("s_waitcnt lgkmcnt(" #n ")" ::: "memory")
#define PG8_BAR __builtin_amdgcn_s_barrier()
#define PG8_SCHED __builtin_amdgcn_sched_barrier(0)
    Unit cur, nxt; int ui = 0;
    if (!S.next(0, cur)) return;
    f32x4 acc[2][2][4][2];
#pragma unroll
    for (int a = 0; a < 2; ++a)
#pragma unroll
        for (int b = 0; b < 2; ++b)
#pragma unroll
            for (int m = 0; m < 4; ++m)
#pragma unroll
                for (int n = 0; n < 2; ++n) acc[a][b][m][n] = (f32x4){0.f, 0.f, 0.f, 0.f};
    bf16x8 At[4][2], B0[2][2], B1[2][2];
    const char* cA = (const char*)g.A + (size_t)cur.pm * tstep + (size_t)cur.k0 * kstep; const char* cB = (const char*)g.Bt + (size_t)cur.pn * tstep + (size_t)cur.k0 * kstep;
    S.a_ready(cur);
    if constexpr (SP2) {
        PG8_STAGE(PG8_SB(0, 0), cB, voffB); PG8_STAGE(PG8_SB(0, 1), cB + hstep, voffB); PG8_STAGE(PG8_SA(0, 0), cA, voffA); PG8_STAGE(PG8_SA(0, 1), cA + hstep, voffA);
        if (wr == 1) PG8_BAR;
        PG8_WAIT_V(2); PG8_BAR;
        PG8_STAGE(PG8_SB(1, 0), cB + kstep, voffB); PG8_STAGE(PG8_SA(1, 0), cA + kstep, voffA); PG8_STAGE(PG8_SB(1, 1), cB + hstep + kstep, voffB);
        PG8_WAIT_V(6); PG8_BAR;
    } else {
        PG8_STAGE(PG8_SB(0, 0), cB, voffB); PG8_STAGE(PG8_SA(0, 0), cA, voffA); PG8_STAGE(PG8_SB(0, 1), cB + hstep, voffB); PG8_STAGE(PG8_SA(0, 1), cA + hstep, voffA);
        if (wr == 1) PG8_BAR;
        PG8_WAIT_V(4); PG8_BAR;
        PG8_STAGE(PG8_SB(1, 0), cB + kstep, voffB); PG8_STAGE(PG8_SA(1, 0), cA + kstep, voffA); PG8_STAGE(PG8_SB(1, 1), cB + hstep + kstep, voffB);
        PG8_WAIT_V(6); PG8_BAR;
    }
    for (;;) {
        const bool has_next = S.next(ui + 1, nxt);
        const char* nA = has_next ? (const char*)g.A + (size_t)nxt.pm * tstep + (size_t)nxt.k0 * kstep : cA; const char* nB = has_next ? (const char*)g.Bt + (size_t)nxt.pn * tstep + (size_t)nxt.k0 * kstep : cB;
        const int nt = cur.nt;
        for (int t = 0; t < nt; t += 2) {
            const bool last = (t == nt - 2);
            const char* a1 = cA + (size_t)(t + 1) * kstep;
            const char* a2 = last ? nA : cA + (size_t)(t + 2) * kstep; const char* b2 = last ? nB : cB + (size_t)(t + 2) * kstep;
            const char* a3 = a2 + kstep; const char* b3 = b2 + kstep;
            if (last && has_next) S.a_ready(nxt);
            if constexpr (SP2) {
            PG8_LDB(B0, 0, 0); PG8_LDB(B1, 0, 1); PG8_SCHED; PG8_LDA(At, 0, 0); PG8_STAGE(PG8_SA(1, 1), a1 + hstep, voffA);
            PG8_WAIT_V(8); PG8_WAIT_L(0); PG8_BAR; PG8_MMA(0, 0, At, B0); PG8_MMA(0, 1, At, B1); PG8_BAR; PG8_SCHED;
            PG8_LDA(At, 0, 1); PG8_STAGE(PG8_SB(0, 0), b2, voffB); PG8_STAGE(PG8_SB(0, 1), b2 + hstep, voffB); PG8_STAGE(PG8_SA(0, 0), a2, voffA);
            PG8_WAIT_V(8); PG8_WAIT_L(0); PG8_BAR; PG8_MMA(1, 0, At, B0); PG8_MMA(1, 1, At, B1); PG8_BAR; PG8_SCHED;
            PG8_LDB(B0, 1, 0); PG8_LDB(B1, 1, 1); PG8_SCHED; PG8_LDA(At, 1, 0); PG8_STAGE(PG8_SA(0, 1), a2 + hstep, voffA);
            PG8_WAIT_V(8); PG8_WAIT_L(0); PG8_BAR; PG8_MMA(0, 0, At, B0); PG8_MMA(0, 1, At, B1); PG8_BAR; PG8_SCHED;
            PG8_LDA(At, 1, 1); PG8_STAGE(PG8_SB(1, 0), b3, voffB); PG8_STAGE(PG8_SB(1, 1), b3 + hstep, voffB); PG8_STAGE(PG8_SA(1, 0), a3, voffA);
            PG8_WAIT_V(8); PG8_WAIT_L(0); PG8_BAR; PG8_MMA(1, 0, At, B0); PG8_MMA(1, 1, At, B1); PG8_BAR; PG8_SCHED;
            } else {
            PG8_LDB(B0, 0, 0); PG8_SCHED; PG8_LDA(At, 0, 0); PG8_STAGE(PG8_SA(1, 1), a1 + hstep, voffA);
            PG8_WAIT_L(8); PG8_BAR; PG8_WAIT_L(0); PG8_MMA(0, 0, At, B0); PG8_BAR; PG8_SCHED;
            PG8_LDB(B1, 0, 1); PG8_STAGE(PG8_SB(0, 0), b2, voffB);
            PG8_BAR; PG8_WAIT_L(0); PG8_MMA(0, 1, At, B1); PG8_BAR;
            PG8_LDA(At, 0, 1); PG8_STAGE(PG8_SA(0, 0), a2, voffA);
            PG8_BAR; PG8_WAIT_L(0); PG8_MMA(1, 0, At, B0); PG8_BAR; PG8_SCHED;
            PG8_STAGE(PG8_SB(0, 1), b2 + hstep, voffB);
            PG8_WAIT_V(6); PG8_BAR; PG8_MMA(1, 1, At, B1); PG8_BAR;
            PG8_LDB(B0, 1, 0); PG8_SCHED; PG8_LDA(At, 1, 0); PG8_STAGE(PG8_SA(0, 1), a2 + hstep, voffA);
            PG8_WAIT_L(8); PG8_BAR; PG8_WAIT_L(0); PG8_MMA(0, 0, At, B0); PG8_BAR; PG8_SCHED;
            PG8_LDB(B1, 1, 1); PG8_STAGE(PG8_SB(1, 0), b3, voffB);
            PG8_BAR; PG8_WAIT_L(0); PG8_MMA(0, 1, At, B1); PG8_BAR;
            PG8_LDA(At, 1, 1); PG8_STAGE(PG8_SA(1, 0), a3, voffA);
            PG8_BAR; PG8_WAIT_L(0); PG8_MMA(1, 0, At, B0); PG8_BAR; PG8_SCHED;
            PG8_STAGE(PG8_SB(1, 1), b3 + hstep, voffB);
            PG8_WAIT_V(6); PG8_BAR; PG8_MMA(1, 1, At, B1); PG8_BAR;
            }
        }
        if constexpr (ALIGN_EPI) { if (wr == 0) PG8_BAR; }
        if constexpr (!Epi::AFTER_DRAIN) { E(acc, cur, wr, wc, fr, fq); S.done(cur); }
        if (!has_next) break;
        if (!Epi::SEG || nxt.seg == 0) {
#pragma unroll
        for (int a = 0; a < 2; ++a)
#pragma unroll
            for (int b = 0; b < 2; ++b)
#pragma unroll
                for (int m = 0; m < 4; ++m)
#pragma unroll
                    for (int n = 0; n < 2; ++n) acc[a][b][m][n] = (f32x4){0.f, 0.f, 0.f, 0.f};
        }
        cur = nxt; cA = nA; cB = nB; ++ui;
        if constexpr (ALIGN_EPI) { if (wr == 1) PG8_BAR; }
    }
    PG8_WAIT_V(0);
    if constexpr (!ALIGN_EPI) { if (wr == 0) PG8_BAR; }
    PG8_BAR;
    if constexpr (Epi::AFTER_DRAIN) { E.fused(acc, cur, wr, wc, fr, fq, lds, wid, lane); S.done(cur); }
#undef PG8_SA
#undef PG8_SB
#undef PG8_STAGE
#undef PG8_LDA
#undef PG8_LDB
#undef PG8_MMA
#undef PG8_WAIT_V
#undef PG8_WAIT_L
#undef PG8_BAR
#undef PG8_SCHED
}
}

#ifndef PG8_SP2
#define PG8_SP2 true
#endif
#ifndef PG8_ALIGN
#define PG8_ALIGN true
#endif

constexpr int NWAVES = 8;
#ifndef MK_N_LAUNCHES
#define MK_N_LAUNCHES 1
#endif
constexpr int N_PHASES = 13;
constexpr int N_LAUNCHES = MK_N_LAUNCHES;

constexpr int D = 4096, DFF = 11008, DLRU = 2048, DSSM = 2048, DIN = 14336;
constexpr int NP = 4, TP = 2048, NS = 128, TS = 8;
constexpr int MP = NP * TP, MS = NS * TS, M = MP + MS;
constexpr int NGRP = 128, SP = 64, SCG = 16;
constexpr float EPS = 1e-6f;

constexpr size_t MiB = 1u << 20;
constexpr size_t WS_CTL = 0, CTL_ZERO_BYTES = 1 * MiB;
constexpr size_t WS_ABAR = 2 * MiB;
constexpr size_t WS_RSTD = WS_ABAR + 256 * 1024;
constexpr size_t WS_ONES = WS_ABAR + 512 * 1024;
constexpr size_t WS_BB = 3 * MiB;
constexpr size_t WS_CC = 4 * MiB;
constexpr size_t WS_WG = 5 * MiB;
constexpr size_t WS_WGU1 = 8 * MiB, WS_WD1 = 180 * MiB, WS_WIN = 266 * MiB, WS_WGLU = 378 * MiB, WS_WOUT = 386 * MiB, WS_WO = 418 * MiB, WS_WGU2 = 450 * MiB, WS_WD2 = 622 * MiB;
constexpr size_t WS_XN = 708 * MiB;
constexpr size_t WS_HID = 780 * MiB;
constexpr size_t WS_XA = WS_HID, WS_GA = WS_HID + 72 * MiB, WS_XB = WS_HID + 108 * MiB, WS_G2 = WS_HID + 144 * MiB;
constexpr size_t WS_F = 974 * MiB;
constexpr size_t WS_G = WS_F;
constexpr size_t WS_YAB = 1118 * MiB, WS_XR = 1190 * MiB, WS_END = 1262 * MiB;
constexpr size_t WS_SLAB = WS_YAB, SLAB_FLOATS = (size_t)MS * D;
static_assert(4 * SLAB_FLOATS * 4 <= (size_t)M * D * 2, "slabs inside YAB");
static_assert(WS_WGU1 + (size_t)2 * DFF * D * 2 <= WS_WD1 && WS_WD1 + (size_t)D * DFF * 2 <= WS_WIN && WS_WIN + (size_t)DIN * D * 2 <= WS_WGLU && WS_WGLU + (size_t)DSSM * DSSM * 2 <= WS_WOUT, "ws map 1");
static_assert(WS_WOUT + (size_t)D * D * 2 <= WS_WO && WS_WO + (size_t)D * D * 2 <= WS_WGU2 && WS_WGU2 + (size_t)2 * DFF * D * 2 <= WS_WD2 && WS_WD2 + (size_t)D * DFF * 2 <= WS_XN, "ws map 2");
static_assert(WS_XN + (size_t)M * D * 2 <= WS_HID && WS_HID + (size_t)M * DFF * 2 <= WS_F && WS_G2 + (size_t)M * DSSM * 2 <= WS_F && WS_F + (size_t)M * D * 4 <= WS_YAB && WS_YAB + (size_t)M * D * 2 <= WS_XR && WS_XR + (size_t)M * D * 2 <= WS_END, "ws map 3");
constexpr int CW_TMO = 0, CW_CODE = 1;
constexpr int CW_XS = 100000;
constexpr int CW_BAR = 4096;

constexpr int RING_OFF = 0, RING_BYTES = 131072;
constexpr int LDSCTL_OFF = RING_BYTES + 2048, MISC_OFF = LDSCTL_OFF + 320;
constexpr int LDS_BYTES = 147456;
static_assert(MISC_OFF + 128 <= LDS_BYTES, "LDS map");

#define GAS __attribute__((address_space(1)))
#define LAS __attribute__((address_space(3)))
typedef unsigned short bf16;
typedef unsigned v4u __attribute__((ext_vector_type(4)));
typedef unsigned v2u __attribute__((ext_vector_type(2)));
typedef float f32x4 __attribute__((ext_vector_type(4)));
typedef float f32x2 __attribute__((ext_vector_type(2)));
typedef short bf16x8 __attribute__((ext_vector_type(8)));
typedef GAS unsigned gu32;
typedef GAS unsigned long long gu64;
#define RLX_AGENT __ATOMIC_RELAXED, __HIP_MEMORY_SCOPE_AGENT
#define LDS_WAIT() asm volatile("s_waitcnt lgkmcnt(0)" ::: "memory")
#define VM_WAIT() asm volatile("s_waitcnt vmcnt(0)" ::: "memory")
__device__ __forceinline__ unsigned f2bf(float f) { unsigned u = __builtin_bit_cast(unsigned, f); return (u + 0x7fffu + ((u >> 16) & 1u)) >> 16; }
__device__ __forceinline__ unsigned pk2(float lo, float hi) { return pg8::cvt_pk_bf16(lo, hi); }
using pg8::bf_lo; using pg8::bf_hi; using pg8::fast_sigmoid; using pg8::gelu_tanh_f;
#define XB_TMO      128
#define XB_XCNT(j)  (256  + 64 * (j))
#define XB_XSUB(j)  (1280 + 64 * (j))
#define XB_XGEN(j)  (2304 + 64 * (j))
#define XB_TOP      3328
#define XB_TOPGEN   3392
#define XCD_BAR_WORDS 3456
#define XB_SPIN_CAP (1u << 18)

__device__ __forceinline__ unsigned xb_ld(unsigned* p)              { return __hip_atomic_load(p, __ATOMIC_RELAXED, __HIP_MEMORY_SCOPE_AGENT); }
__device__ __forceinline__ unsigned xb_add(unsigned* p, unsigned v) { return __hip_atomic_fetch_add(p, v, __ATOMIC_RELAXED, __HIP_MEMORY_SCOPE_AGENT); }
__device__ __forceinline__ unsigned xb_xcc_id() { return (unsigned)__builtin_amdgcn_s_getreg((3 << 11) | 20) & 0xFu; }
#ifndef XB_SLEEP
#define XB_SLEEP 1
#endif
#define XB_SPIN(cond, bar) do { unsigned _sp = 0; while (cond) { __builtin_amdgcn_s_sleep(XB_SLEEP); \
    if ((++_sp & 255u) == 0u) { if (xb_ld(&(bar)[XB_TMO])) break; if (_sp > XB_SPIN_CAP) { atomicAdd(&(bar)[XB_TMO], 1u); break; } } } } while (0)

struct XcdBarrier {
    unsigned* bar; unsigned x;
    volatile LAS unsigned* st;
};

__device__ __forceinline__ XcdBarrier xcd_barrier_post(unsigned* bar, volatile LAS unsigned* st) {
    XcdBarrier b; b.bar = bar; b.x = xb_xcc_id(); b.st = st;
    if (threadIdx.x == 0) st[2] = xb_add(&bar[XB_XCNT(b.x)], 1u);
    return b;
}
__device__ __forceinline__ void xcd_barrier_complete(unsigned* bar, unsigned x, unsigned& nloc, unsigned& nx) {
    const unsigned G = gridDim.x * gridDim.y * gridDim.z;
    unsigned sum, cnt, mine, sp = 0u;
    for (;;) {
        sum = 0u; cnt = 0u; mine = 0u;
#pragma unroll
        for (unsigned j = 0; j < 16; ++j) { const unsigned c = xb_ld(&bar[XB_XCNT(j)]); sum += c; cnt += (c > 0u) ? 1u : 0u; mine = (j == x) ? c : mine; }
        if (sum == G) break;
        __builtin_amdgcn_s_sleep(1);
        if ((++sp & 255u) == 0u) { if (xb_ld(&bar[XB_TMO])) break; if (sp > XB_SPIN_CAP) { atomicAdd(&bar[XB_TMO], 1u); break; } }
    }
    nloc = mine > 0u ? mine : 1u; nx = cnt > 0u ? cnt : 1u;
}

__device__ __forceinline__ void xcd_barrier(const XcdBarrier& b) {
    asm volatile("s_waitcnt vmcnt(0)" ::: "memory");
    __syncthreads();
    if (threadIdx.x == 0) {
        unsigned* bar = b.bar;
        __builtin_amdgcn_s_waitcnt(0);
        unsigned nloc = b.st[0], nx = b.st[1];
        if (nloc == 0u) { xcd_barrier_complete(bar, b.x, nloc, nx); b.st[0] = nloc; b.st[1] = nx; }
        const unsigned old = xb_add(&bar[XB_XSUB(b.x)], 1u);
        const unsigned gen = old / nloc;
        if (old + 1u == (gen + 1u) * nloc) {
            __builtin_amdgcn_fence(__ATOMIC_RELEASE, "agent");
            asm volatile("s_waitcnt vmcnt(0)" ::: "memory");
            const unsigned og = xb_add(&bar[XB_TOP], 1u);
            const unsigned tg = og / nx;
            if (og + 1u == (tg + 1u) * nx) xb_add(&bar[XB_TOPGEN], 1u);
            else XB_SPIN(xb_ld(&bar[XB_TOPGEN]) == tg, bar);
            __builtin_amdgcn_fence(__ATOMIC_ACQUIRE, "agent");
            xb_add(&bar[XB_XGEN(b.x)], 1u);
            asm volatile("s_waitcnt vmcnt(0)" ::: "memory");
        } else {
            XB_SPIN(xb_ld(&bar[XB_XGEN(b.x)]) == gen, bar);
            __builtin_amdgcn_fence(__ATOMIC_ACQUIRE, "agent");
            asm volatile("s_waitcnt vmcnt(0)" ::: "memory");
        }
    }
    __syncthreads();
}

#if defined(CONV_NT)
#define CONV_ST(V, P) __builtin_nontemporal_store((V), (P))
#else
#define CONV_ST(V, P) (*(P) = (V))
#endif
#if defined(RES_NT)
#define RES_ST(V, P) __builtin_nontemporal_store((V), (P))
#else
#define RES_ST(V, P) (*(P) = (V))
#endif
#if defined(MIX_NT)
#define MIX_ST(V, P) __builtin_nontemporal_store((V), (P))
#else
#define MIX_ST(V, P) (*(P) = (V))
#endif
#if defined(DEAD_NT)
#define DEAD_LD(P) __builtin_nontemporal_load(P)
#else
#define DEAD_LD(P) (*(P))
#endif
#if defined(STREAM_NT)
#define STREAM_LD(P) __builtin_nontemporal_load(P)
#define STREAM_ST(V, P) __builtin_nontemporal_store((V), (P))
#else
#define STREAM_LD(P) (*(P))
#define STREAM_ST(V, P) (*(P) = (V))
#endif

__device__ __forceinline__ float wave_sum(float v) {
#pragma unroll
    for (int o = 1; o < 64; o <<= 1) v += __shfl_xor(v, o);
    return v;
}
constexpr size_t O_Y = 0, O_PLRU = (size_t)M * D, O_PCONV = O_PLRU + NP * DLRU, O_PRE = O_PCONV + NP * 3 * DLRU, O_PIM = O_PRE + NP * NGRP * SP, O_SLRU = O_PIM + NP * NGRP * SP,
                 O_SCONV = O_SLRU + NS * DLRU, O_SRE = O_SCONV + NS * 3 * DLRU, O_SIM = O_SRE + NS * NGRP * SP, O_END = O_SIM + NS * NGRP * SP;
static_assert(O_END == 40992768, "output size");

struct Args { const float* in[39]; float* out; unsigned char* ws; int ph_lo, ph_hi, li, pad; };
enum { I_XP = 0, I_XS, I_SLRU, I_SCONV, I_SRE, I_SIM, I_F1PRE, I_F1POST, I_F1G, I_F1U, I_F1D, I_MPRE, I_MPOST, I_WIN, I_CONVW, I_CONVB, I_WRG, I_BRG, I_WIG, I_BIG, I_LAM,
       I_ARE, I_AIM, I_LDT, I_BRE, I_BIM, I_CRE, I_CIM, I_DSK, I_WGLU, I_BGLU, I_WOA, I_WOB, I_WO, I_F2PRE, I_F2POST, I_F2G, I_F2U, I_F2D };

__device__ __forceinline__ void transpose_item(const float* W, int N, bf16* WT, int pitch, int k0, int n0, int drow, int dcol, LAS float* scr, int lane) {
    { f32x4 v[8]; const int rr = lane >> 3, c4 = (lane & 7) * 4;
#pragma unroll
      for (int i = 0; i < 8; ++i) v[i] = *(const GAS f32x4*)(W + (size_t)(k0 + 8 * i + rr) * N + n0 + c4);
#pragma unroll
      for (int i = 0; i < 8; ++i) { LAS float* d = scr + (8 * i + rr) * 33 + c4; d[0] = v[i].x; d[1] = v[i].y; d[2] = v[i].z; d[3] = v[i].w; } }
    LDS_WAIT(); asm volatile("" ::: "memory");
    const int c = lane & 7;
#pragma unroll
    for (int j = 0; j < 4; ++j) { const int n = (lane >> 3) + 8 * j; const LAS float* s = scr + (8 * c) * 33 + n;
        v4u o; o.x = pk2(s[0 * 33], s[1 * 33]); o.y = pk2(s[2 * 33], s[3 * 33]); o.z = pk2(s[4 * 33], s[5 * 33]); o.w = pk2(s[6 * 33], s[7 * 33]);
        *(GAS v4u*)(WT + (size_t)(drow + n) * pitch + dcol + k0 + 8 * c) = o; }
    LDS_WAIT(); asm volatile("" ::: "memory");
}
__device__ __forceinline__ void tr_plain(const float* W, int K, int N, bf16* WT, int pitch, int dcol, int item, LAS float* scr, int lane) {
    const int nkb = K / 64, nb = item / nkb, kb = item - nb * nkb;
    transpose_item(W, N, WT, pitch, 64 * kb, 32 * nb, 32 * nb, dcol, scr, lane);
}
__device__ __forceinline__ void tr_gu(const float* W, bf16* WT, int up, int item, LAS float* scr, int lane) {
    const int nkb = D / 64, nb = item / nkb, kb = item - nb * nkb, n0 = 32 * nb;
    transpose_item(W, DFF, WT, D, 64 * kb, n0, 256 * (n0 >> 7) + up * 128 + (n0 & 127), 0, scr, lane);
}
#if defined(CONV64)
constexpr int CNW = 64;
#else
constexpr int CNW = 32;
#endif
constexpr int CONV_SCR = 64 * (CNW + 1) * 4, CONV_SCR_STRIDE = CONV_SCR > 16384 ? CONV_SCR : 16384;
constexpr int IT_GU = (D / 64) * (DFF / CNW), IT_DN = (DFF / 64) * (D / CNW), IT_IN = (D / 64) * (DIN / CNW), IT_GLU = (DSSM / 64) * (DSSM / CNW), IT_OA = (DLRU / 64) * (D / CNW), IT_WO = (D / 64) * (D / CNW), IT_RG = 16 * 2 * 4;
constexpr int IT_TOTAL = 4 * IT_GU + 2 * IT_DN + IT_IN + IT_GLU + 2 * IT_OA + IT_WO + 2 * IT_RG;

template <int MODE> __device__ __forceinline__ void thin_rows(const Args& args, int gw, int ngw, int lane);

constexpr int ITB_GU1 = 0, ITB_DN1 = ITB_GU1 + 2 * IT_GU, ITB_IN = ITB_DN1 + IT_DN, ITB_GLU = ITB_IN + IT_IN, ITB_OA = ITB_GLU + IT_GLU, ITB_OB = ITB_OA + IT_OA, ITB_WO = ITB_OB + IT_OA,
              ITB_GU2 = ITB_WO + IT_WO, ITB_DN2 = ITB_GU2 + 2 * IT_GU, ITB_RG = ITB_DN2 + IT_DN, ITB_END = ITB_RG + 2 * IT_RG;
static_assert(ITB_END == IT_TOTAL, "item numbering");
__device__ __forceinline__ void convert_item(const Args& args, int it, LAS float* scr, int lane) {
    unsigned char* ws = args.ws; int r = it;
    if (r < IT_GU) { tr_gu(args.in[I_F1G], (bf16*)(ws + WS_WGU1), 0, r, scr, lane); return; } r -= IT_GU;
    if (r < IT_GU) { tr_gu(args.in[I_F1U], (bf16*)(ws + WS_WGU1), 1, r, scr, lane); return; } r -= IT_GU;
    if (r < IT_DN) { tr_plain(args.in[I_F1D], DFF, D, (bf16*)(ws + WS_WD1), DFF, 0, r, scr, lane); return; } r -= IT_DN;
    if (r < IT_IN) { tr_plain(args.in[I_WIN], D, DIN, (bf16*)(ws + WS_WIN), D, 0, r, scr, lane); return; } r -= IT_IN;
    if (r < IT_GLU) { tr_plain(args.in[I_WGLU], DSSM, DSSM, (bf16*)(ws + WS_WGLU), DSSM, 0, r, scr, lane); return; } r -= IT_GLU;
    if (r < IT_OA) { tr_plain(args.in[I_WOA], DLRU, D, (bf16*)(ws + WS_WOUT), D, 0, r, scr, lane); return; } r -= IT_OA;
    if (r < IT_OA) { tr_plain(args.in[I_WOB], DSSM, D, (bf16*)(ws + WS_WOUT), D, DLRU, r, scr, lane); return; } r -= IT_OA;
    if (r < IT_WO) { tr_plain(args.in[I_WO], D, D, (bf16*)(ws + WS_WO), D, 0, r, scr, lane); return; } r -= IT_WO;
    if (r < IT_GU) { tr_gu(args.in[I_F2G], (bf16*)(ws + WS_WGU2), 0, r, scr, lane); return; } r -= IT_GU;
    if (r < IT_GU) { tr_gu(args.in[I_F2U], (bf16*)(ws + WS_WGU2), 1, r, scr, lane); return; } r -= IT_GU;
    if (r < IT_DN) { tr_plain(args.in[I_F2D], DFF, D, (bf16*)(ws + WS_WD2), DFF, 0, r, scr, lane); return; } r -= IT_DN;
    { const int ig = r >= IT_RG ? 1 : 0; const int q = r - ig * IT_RG, h = q >> 3, sub = q & 7, kb = sub >> 2, nb = sub & 3;
      const float* W = (ig ? args.in[I_WIG] : args.in[I_WRG]) + (size_t)h * 128 * 128;
      transpose_item(W, 128, (bf16*)(ws + WS_WG) + (size_t)h * 256 * 128, 128, 64 * kb, 32 * nb, ig * 128 + 32 * nb, 0, scr, lane); }
}
struct ItemD { const float* src; bf16* dst; const float* gk; int N, pitch, k0, n0, drow, dcol; };
__device__ __forceinline__ ItemD item_desc(const Args& args, int it) {
    unsigned char* ws = args.ws; int r = it; bool hit = false;
    const float* ones = (const float*)(ws + WS_ONES);
    const float* src = nullptr; bf16* dst = nullptr; const float* gk = ones; int K = 64, N = 128, pitch = 128, dcol = 0, gu = 0, up = 0;
#define ITEM_CASE(CNT, SRC, DST, K_, N_, PITCH, DCOL, GU, UP, GK) { if (!hit && r < (CNT)) { hit = true; src = (SRC); dst = (bf16*)(DST); K = (K_); N = (N_); pitch = (PITCH); dcol = (DCOL); gu = (GU); up = (UP); gk = (GK); } else if (!hit) r -= (CNT); }
    ITEM_CASE(IT_GU, args.in[I_F1G], ws + WS_WGU1, D, DFF, D, 0, 1, 0, args.in[I_F1PRE])
    ITEM_CASE(IT_GU, args.in[I_F1U], ws + WS_WGU1, D, DFF, D, 0, 1, 1, args.in[I_F1PRE])
    ITEM_CASE(IT_DN, args.in[I_F1D], ws + WS_WD1, DFF, D, DFF, 0, 0, 0, ones)
    ITEM_CASE(IT_IN, args.in[I_WIN], ws + WS_WIN, D, DIN, D, 0, 0, 0, args.in[I_MPRE])
    ITEM_CASE(IT_GLU, args.in[I_WGLU], ws + WS_WGLU, DSSM, DSSM, DSSM, 0, 0, 0, ones)
    ITEM_CASE(IT_OA, args.in[I_WOA], ws + WS_WOUT, DLRU, D, D, 0, 0, 0, ones)
    ITEM_CASE(IT_OA, args.in[I_WOB], ws + WS_WOUT, DSSM, D, D, DLRU, 0, 0, ones)
    ITEM_CASE(IT_WO, args.in[I_WO], ws + WS_WO, D, D, D, 0, 0, 0, ones)
    ITEM_CASE(IT_GU, args.in[I_F2G], ws + WS_WGU2, D, DFF, D, 0, 1, 0, args.in[I_F2PRE])
    ITEM_CASE(IT_GU, args.in[I_F2U], ws + WS_WGU2, D, DFF, D, 0, 1, 1, args.in[I_F2PRE])
    ITEM_CASE(IT_DN, args.in[I_F2D], ws + WS_WD2, DFF, D, DFF, 0, 0, 0, ones)
#undef ITEM_CASE
    ItemD d;
    if (hit) { const int nkb = K / 64, nb = r / nkb, kb = r - nb * nkb, n0 = CNW * nb;
        d.src = src; d.dst = dst; d.gk = gk; d.N = N; d.pitch = pitch; d.k0 = 64 * kb; d.n0 = n0; d.dcol = dcol;
        d.drow = gu ? 256 * (n0 >> 7) + up * 128 + (n0 & 127) : n0;
    } else { const int ig = r >= IT_RG ? 1 : 0; const int q = r - ig * IT_RG, h = q >> 3, sub = q & 7, kb = sub >> 2, nb = sub & 3;
        d.src = (ig ? args.in[I_WIG] : args.in[I_WRG]) + (size_t)h * 128 * 128; d.dst = (bf16*)(ws + WS_WG) + (size_t)h * 256 * 128; d.gk = ones; d.N = 128; d.pitch = 128; d.k0 = 64 * kb; d.n0 = 32 * nb; d.drow = ig * 128 + 32 * nb; d.dcol = 0; }
    return d;
}
#if defined(CONV64)
constexpr int CNL = 16;
__device__ __forceinline__ void item_load(const ItemD& d, int lane, f32x4 (&v)[CNL], float (&gs)[CNL]) {
    const int rr = lane >> 4, c4 = (lane & 15) * 4;
#pragma unroll
    for (int i = 0; i < CNL; ++i) gs[i] = d.gk[d.k0 + 4 * i + rr];
#pragma unroll
    for (int i = 0; i < CNL; ++i) v[i] = STREAM_LD((const GAS f32x4*)(d.src + (size_t)(d.k0 + 4 * i + rr) * d.N + d.n0 + c4));
}
__device__ __forceinline__ void item_finish(const ItemD& d, const f32x4 (&v)[CNL], const float (&gs)[CNL], LAS float* scr, int lane) {
    { const int rr = lane >> 4, c4 = (lane & 15) * 4;
#pragma unroll
      for (int i = 0; i < CNL; ++i) { LAS float* q = scr + (4 * i + rr) * 65 + c4; q[0] = v[i].x * gs[i]; q[1] = v[i].y * gs[i]; q[2] = v[i].z * gs[i]; q[3] = v[i].w * gs[i]; } }
    LDS_WAIT(); asm volatile("" ::: "memory");
    const int c = lane & 7;
#pragma unroll
    for (int j = 0; j < 8; ++j) { const int n = (lane >> 3) + 8 * j; const LAS float* s = scr + (8 * c) * 65 + n;
        v4u o; o.x = pk2(s[0 * 65], s[1 * 65]); o.y = pk2(s[2 * 65], s[3 * 65]); o.z = pk2(s[4 * 65], s[5 * 65]); o.w = pk2(s[6 * 65], s[7 * 65]);
        CONV_ST(o, (GAS v4u*)(d.dst + (size_t)(d.drow + n) * d.pitch + d.dcol + d.k0 + 8 * c)); }
    LDS_WAIT(); asm volatile("" ::: "memory");
}
__device__ __forceinline__ void convert_run(const Args& args, int b, int e, LAS float* scr, int lane) {
    for (int it = b; it < e; ++it) { const ItemD d = item_desc(args, it); f32x4 v[CNL]; float g[CNL]; item_load(d, lane, v, g); item_finish(d, v, g, scr, lane); }
}
#else
__device__ __forceinline__ void item_load(const ItemD& d, int lane, f32x4 (&v)[8], float (&gs)[8]) {
    const int rr = lane >> 3, c4 = (lane & 7) * 4;
#pragma unroll
    for (int i = 0; i < 8; ++i) gs[i] = d.gk[d.k0 + 8 * i + rr];
#pragma unroll
    for (int i = 0; i < 8; ++i) v[i] = STREAM_LD((const GAS f32x4*)(d.src + (size_t)(d.k0 + 8 * i + rr) * d.N + d.n0 + c4));
}
__device__ __forceinline__ void item_finish(const ItemD& d, const f32x4 (&v)[8], const float (&gs)[8], LAS float* scr, int lane) {
    { const int rr = lane >> 3, c4 = (lane & 7) * 4;
#pragma unroll
      for (int i = 0; i < 8; ++i) { LAS float* q = scr + (8 * i + rr) * 33 + c4; q[0] = v[i].x * gs[i]; q[1] = v[i].y * gs[i]; q[2] = v[i].z * gs[i]; q[3] = v[i].w * gs[i]; } }
    LDS_WAIT(); asm volatile("" ::: "memory");
    const int c = lane & 7;
#pragma unroll
    for (int j = 0; j < 4; ++j) { const int n = (lane >> 3) + 8 * j; const LAS float* s = scr + (8 * c) * 33 + n;
        v4u o; o.x = pk2(s[0 * 33], s[1 * 33]); o.y = pk2(s[2 * 33], s[3 * 33]); o.z = pk2(s[4 * 33], s[5 * 33]); o.w = pk2(s[6 * 33], s[7 * 33]);
        CONV_ST(o, (GAS v4u*)(d.dst + (size_t)(d.drow + n) * d.pitch + d.dcol + d.k0 + 8 * c)); }
    LDS_WAIT(); asm volatile("" ::: "memory");
}
__device__ __forceinline__ void convert_run(const Args& args, int b, int e, LAS float* scr, int lane) {
    if (b >= e) return;
    ItemD dA = item_desc(args, b), dB = dA; f32x4 vA[8], vB[8]; float gA[8], gB[8]; item_load(dA, lane, vA, gA);
    for (int it = b;; it += 2) {
        if (it + 1 < e) { dB = item_desc(args, it + 1); item_load(dB, lane, vB, gB); item_finish(dA, vA, gA, scr, lane); } else { item_finish(dA, vA, gA, scr, lane); break; }
        if (it + 2 < e) { dA = item_desc(args, it + 2); item_load(dA, lane, vA, gA); item_finish(dB, vB, gB, scr, lane); } else { item_finish(dB, vB, gB, scr, lane); break; }
    }
}
#endif
#ifndef MK_QCHUNK
#define MK_QCHUNK (512 / CNW)
#endif
constexpr int CW_Q = 60000, Q_CHUNK = MK_QCHUNK;
#ifndef MK_GU2_N4
#define MK_GU2_N4 (96256 / CNW)
#endif
#ifndef MK_GU2_N5
#define MK_GU2_N5 (384000 / CNW)
#endif
constexpr int GU2_N4 = MK_GU2_N4, GU2_N5 = MK_GU2_N5;
#if defined(QREBAL)
constexpr int Q14_FIRST = ITB_GU2 + 2 * IT_GU - GU2_N4, Q14_N = GU2_N4;
constexpr int Q5_FIRST = ITB_WO, Q5_N = IT_WO + GU2_N5;
constexpr int Q6_FIRST = ITB_OA, Q6_N = 2 * IT_OA;
constexpr int Q7_FIRST = ITB_GU2 + GU2_N5, Q7_N = 2 * IT_GU - GU2_N4 - GU2_N5;
#else
constexpr int Q14_FIRST = ITB_GU2, Q14_N = GU2_N4;
constexpr int Q5_FIRST = ITB_GU2 + GU2_N4, Q5_N = GU2_N5;
constexpr int Q6_FIRST = ITB_OA, Q6_N = 2 * IT_OA + IT_WO;
constexpr int Q7_FIRST = ITB_GU2 + GU2_N4 + GU2_N5, Q7_N = 2 * IT_GU - GU2_N4 - GU2_N5;
#endif
static_assert(ITB_WO + IT_WO == ITB_GU2, "W_O and W_GU2 are neighbours in the item numbering");
__device__ __forceinline__ void convert_queue(const Args& args, int qid, int first, int n, LAS unsigned char* lds, int wave, int lane) {
    LAS float* scr = (LAS float*)(lds + RING_OFF + wave * CONV_SCR_STRIDE);
    unsigned* ctr = (unsigned*)(args.ws + WS_CTL) + CW_Q + 64 * qid;
    for (;;) {
        int base = 0;
        if (lane == 0) base = (int)__hip_atomic_fetch_add(ctr, (unsigned)Q_CHUNK, __ATOMIC_RELAXED, __HIP_MEMORY_SCOPE_AGENT);
        base = __builtin_amdgcn_readfirstlane(base);
        if (base >= n) break;
        const int e = (base + Q_CHUNK < n) ? base + Q_CHUNK : n;
        convert_run(args, first + base, first + e, scr, lane);
    }
}

__device__ __forceinline__ void p0_prologue(const Args& args, LAS unsigned char* lds, int wave, int lane, int gw, int ngw) {
    unsigned char* ws = args.ws;
    LAS float* scr = (LAS float*)(lds + RING_OFF + wave * CONV_SCR_STRIDE);
#if defined(NO_TAIL_CONVERT)
    for (int it = gw; it < IT_TOTAL; it += ngw) convert_run(args, it, it + 1, scr, lane);
#else
#ifndef MK_P0CHUNK
#define MK_P0CHUNK (704 / CNW)
#endif
    constexpr int P0_CHUNK = MK_P0CHUNK;
    for (int base = gw * P0_CHUNK; base < 2 * IT_GU; base += ngw * P0_CHUNK)
        convert_run(args, ITB_GU1 + base, ITB_GU1 + ((base + P0_CHUNK < 2 * IT_GU) ? base + P0_CHUNK : 2 * IT_GU), scr, lane);
    for (int it = gw; it < 2 * IT_RG; it += ngw) convert_item(args, ITB_RG + it, scr, lane);
#endif
    for (int i = gw * 64 + lane; i < DFF; i += ngw * 64) ((float*)(ws + WS_ONES))[i] = 1.0f;
    {
        const int gt = gw * 64 + lane;
        if (gt < NGRP * SP) {
            const int g = gt >> 6, p = gt & 63;
            const double dt = exp((double)args.in[I_LDT][g]);
            const double ar = (double)args.in[I_ARE][gt], ai = (double)args.in[I_AIM][gt];
            const double mag = exp(ar * dt);
            double th = ai * dt; th -= 6.283185307179586476925 * rint(th * 0.15915494309189533577);
            const double x = 0.25 * th, x2 = x * x;
            double s = x * (1.0 + x2 * (-1.0 / 6 + x2 * (1.0 / 120 + x2 * (-1.0 / 5040 + x2 * (1.0 / 362880 + x2 * (-1.0 / 39916800 + x2 * (1.0 / 6227020800.0)))))));
            double c = 1.0 + x2 * (-0.5 + x2 * (1.0 / 24 + x2 * (-1.0 / 720 + x2 * (1.0 / 40320 + x2 * (-1.0 / 3628800 + x2 * (1.0 / 479001600.0 + x2 * (-1.0 / 87178291200.0)))))));
            { const double s2 = 2.0 * s * c, c2 = 1.0 - 2.0 * s * s; s = s2; c = c2; }
            { const double s2 = 2.0 * s * c, c2 = 1.0 - 2.0 * s * s; s = s2; c = c2; }
            const double abr = mag * c, abi = mag * s;
            const double den = ar * ar + ai * ai, nr = abr - 1.0, ni = abi;
            const double cre = (nr * ar + ni * ai) / den, cim = (ni * ar - nr * ai) / den;
            float* AB = (float*)(ws + WS_ABAR); AB[2 * gt] = (float)abr; AB[2 * gt + 1] = (float)abi;
            bf16* BB = (bf16*)(ws + WS_BB); bf16* CC = (bf16*)(ws + WS_CC);
            const float* bre = args.in[I_BRE] + (size_t)gt * SCG; const float* bim = args.in[I_BIM] + (size_t)gt * SCG;
#pragma unroll 4
            for (int ch = 0; ch < SCG; ++ch) {
                const double br = (double)bre[ch], bi = (double)bim[ch];
                const float vre = (float)(cre * br - cim * bi), vim = (float)(cre * bi + cim * br);
#pragma unroll
                for (int ri = 0; ri < 2; ++ri) { const int col = 2 * p + ri, j = col >> 4, ln = (col & 15) + 16 * (ch >> 3);
                    BB[((size_t)(g * 8 + j) * 64 + ln) * 8 + (ch & 7)] = (bf16)f2bf(ri ? vim : vre); }
                const float c_re = args.in[I_CRE][((size_t)g * SCG + ch) * SP + p], c_im = args.in[I_CIM][((size_t)g * SCG + ch) * SP + p];
#pragma unroll
                for (int ri = 0; ri < 2; ++ri) { const int k = 2 * p + ri, kk = k >> 5, ln = ch + 16 * ((k & 31) >> 3);
                    CC[((size_t)(g * 4 + kk) * 64 + ln) * 8 + (k & 7)] = (bf16)f2bf(ri ? -c_im : c_re); }
            }
        }
    }
    thin_rows<0>(args, gw, ngw, lane);
}

template <int MODE> __device__ __forceinline__ void thin_rows(const Args& args, int gw, int ngw, int lane) {
    const float* gA = MODE == 1 ? args.in[I_F1POST] : (MODE == 2 ? args.in[I_MPOST] : args.in[I_F2POST]);
    const float sc = MODE == 2 ? 1.0f : 0.5f;
    float* Y = args.out + O_Y; const bf16* Fb = (const bf16*)(args.ws + WS_F); bf16* XN = (bf16*)(args.ws + WS_XN); bf16* XR = (bf16*)(args.ws + WS_XR);
    float* RS = (float*)(args.ws + WS_RSTD) + (size_t)(MODE <= 2 ? MODE : 0) * M;
    const int bxl = gw / NWAVES, wvl = gw % NWAVES, Gl = ngw / NWAVES;
    for (int i = wvl; i * Gl + bxl < M; i += NWAVES) { const int m = i * Gl + bxl;
        f32x4 v[16];
        if (MODE == 0) {
            const float* xin = m < MP ? args.in[I_XP] + (size_t)m * D : args.in[I_XS] + (size_t)(m - MP) * D;
            const GAS f32x4* xr = (const GAS f32x4*)xin + lane;
#pragma unroll
            for (int j = 0; j < 16; ++j) v[j] = STREAM_LD(xr + 64 * j);
        } else {
            const GAS v2u* xr = (const GAS v2u*)((MODE == 1 ? XN : XR) + (size_t)m * D) + lane;
#pragma unroll
            for (int j = 0; j < 16; ++j) { const v2u w = (MODE == 2) ? xr[64 * j] : DEAD_LD(xr + 64 * j); v[j] = (f32x4){bf_lo(w.x), bf_hi(w.x), bf_lo(w.y), bf_hi(w.y)}; }
        }
        if (MODE >= 1) {
            f32x4 f[16]; float s = 0.f;
            if (m < MP) {
                const GAS v2u* fr = (const GAS v2u*)(Fb + (size_t)m * D) + lane;
#pragma unroll
                for (int j = 0; j < 16; ++j) { const v2u w = fr[64 * j]; f[j] = (f32x4){bf_lo(w.x), bf_hi(w.x), bf_lo(w.y), bf_hi(w.y)}; }
            } else {
#if defined(SLAB_F32)
                for (int q = 0; q < 4; ++q) { const GAS f32x4* sr = (const GAS f32x4*)((const float*)(args.ws + WS_SLAB) + q * SLAB_FLOATS + (size_t)(m - MP) * D) + lane;
#pragma unroll
                    for (int j = 0; j < 16; ++j) f[j] = q == 0 ? sr[64 * j] : f[j] + sr[64 * j]; }
#else
                for (int q = 0; q < 4; ++q) { const GAS v2u* sr = (const GAS v2u*)((const bf16*)(args.ws + WS_SLAB) + q * SLAB_FLOATS + (size_t)(m - MP) * D) + lane;
#pragma unroll
                    for (int j = 0; j < 16; ++j) { const v2u w = sr[64 * j]; const f32x4 t = (f32x4){bf_lo(w.x), bf_hi(w.x), bf_lo(w.y), bf_hi(w.y)}; f[j] = q == 0 ? t : f[j] + t; } }
#endif
            }
#pragma unroll
            for (int j = 0; j < 16; ++j) s += (f[j].x * f[j].x + f[j].y * f[j].y) + (f[j].z * f[j].z + f[j].w * f[j].w);
            const float rstd = sc / sqrtf(wave_sum(s) * (1.f / D) + EPS);
            const GAS f32x4* gr = (const GAS f32x4*)gA + lane;
#pragma unroll
            for (int j = 0; j < 16; ++j) { const f32x4 g = gr[64 * j]; v[j] = v[j] + f[j] * rstd * g; }
            if (MODE == 3) { GAS f32x4* yo = (GAS f32x4*)(Y + (size_t)m * D) + lane;
#pragma unroll
                for (int j = 0; j < 16; ++j) STREAM_ST(v[j], yo + 64 * j);
            }
        }
        if (MODE <= 2) {
            GAS v2u* xo = (GAS v2u*)((MODE == 0 ? XN : XR) + (size_t)m * D) + lane;
            float s = 0.f;
#pragma unroll
            for (int j = 0; j < 16; ++j) { v2u w; w.x = pk2(v[j].x, v[j].y); w.y = pk2(v[j].z, v[j].w); RES_ST(w, xo + 64 * j);
                if (MODE != 0) v[j] = (f32x4){bf_lo(w.x), bf_hi(w.x), bf_lo(w.y), bf_hi(w.y)};
                s += (v[j].x * v[j].x + v[j].y * v[j].y) + (v[j].z * v[j].z + v[j].w * v[j].w); }
            const float rstd = 1.0f / sqrtf(wave_sum(s) * (1.f / D) + EPS);
            if (lane == 0) RS[m] = rstd;
        }
    }
}

#if defined(LRU64)
constexpr int LCH = 64, L_WSL = 0, L_XCB = 34816, L_XCF = 52224, L_LA = 68864, L_LB = 85504, L_LH = 102144, L_END = 118784;
constexpr int LP = 65;
#else
constexpr int LCH = 32, L_WSL = 0, L_XCB = 17408, L_XCF = 34816, L_LA = 43264, L_LB = 51712, L_LH = 60160, L_END = 68608;
constexpr int LP = 33;
#endif
static_assert(L_END <= RING_BYTES, "RG-LRU LDS tables");
#define LBAR() do { asm volatile("s_waitcnt lgkmcnt(0)" ::: "memory"); __builtin_amdgcn_s_barrier(); asm volatile("" ::: "memory"); } while (0)
__device__ __forceinline__ f32x4 xa_ld4(const float* XA, size_t row, int ch) {
#if defined(XA_BF16)
    const v2u w = *(const GAS v2u*)((const bf16*)XA + row * DLRU + ch); return (f32x4){bf_lo(w.x), bf_hi(w.x), bf_lo(w.y), bf_hi(w.y)};
#else
    return *(const GAS f32x4*)(XA + row * DLRU + ch);
#endif
}
#if defined(LRU64)
template <bool SAMPLE> __device__ __forceinline__ void lru_load_tile(const Args& args, const float* XA, const bf16* GA, int chain, int k, int tg, int cg, int chb, int h, int tid, f32x4 (&v)[7], v2u (&gaw)[2]) {
    const size_t rbase = SAMPLE ? (size_t)MP + 64 * chain : (size_t)chain * TP + 64 * k;
#pragma unroll
    for (int i = 0; i < 7; ++i) {
        if (SAMPLE) { const int ts = 4 * (tg & 1) - 3 + i, sl = tg >> 1;
            v[i] = (ts >= 0) ? xa_ld4(XA, rbase + 8 * sl + ts, chb + 4 * cg)
                             : *(const GAS f32x4*)(args.in[I_SCONV] + ((size_t)(8 * chain + sl) * 3 + (3 + ts)) * DLRU + chb + 4 * cg);
        } else { const int tt = 4 * tg - 3 + i;
            v[i] = (k > 0 || tt >= 0) ? xa_ld4(XA, rbase + tt, chb + 4 * cg) : (f32x4){0.f, 0.f, 0.f, 0.f}; }
    }
    const bf16* gp = GA + (rbase + (tid >> 3)) * DLRU + chb + 64 * h + (tid & 7) * 8;
    gaw[0] = *(const GAS v2u*)gp; gaw[1] = *(const GAS v2u*)(gp + 4);
}
template <bool SAMPLE> __device__ __forceinline__ void lru_task(const Args& args, LAS unsigned char* lds, int tid, int wave, int lane, int chain, int head, int h, int nb = 1) {
    unsigned char* ws = args.ws;
    const float* XA = (const float*)(ws + WS_XA); const bf16* GA = (const bf16*)(ws + WS_GA); bf16* YAB = (bf16*)(ws + WS_YAB);
    const int chb = head * 128;
    const int cg = tid & 31, tg = tid >> 5;
    f32x4 v[7]; v2u gaw[2];
    lru_load_tile<SAMPLE>(args, XA, GA, chain, 0, tg, cg, chb, h, tid, v, gaw);
    { const bf16* WG = (const bf16*)(ws + WS_WG) + (size_t)head * 256 * 128;
      for (int i = tid; i < 2048; i += 512) { const int r = i >> 4, c16 = i & 15; const int srow = (r < 64) ? (64 * h + r) : (128 + 64 * h + (r - 64));
          *(LAS v4u*)(lds + L_WSL + r * 272 + c16 * 16) = *(const GAS v4u*)(WG + (size_t)srow * 128 + c16 * 8); } }
    const f32x4 cw0 = *(const f32x4*)(args.in[I_CONVW] + 0 * DLRU + chb + 4 * cg), cw1 = *(const f32x4*)(args.in[I_CONVW] + 1 * DLRU + chb + 4 * cg),
                cw2 = *(const f32x4*)(args.in[I_CONVW] + 2 * DLRU + chb + 4 * cg), cw3 = *(const f32x4*)(args.in[I_CONVW] + 3 * DLRU + chb + 4 * cg),
                cbv = *(const f32x4*)(args.in[I_CONVB] + chb + 4 * cg);
    const int tb = wave & 3, ct = wave >> 2, l15 = lane & 15, lq = lane >> 4;
    float brg[2], big[2], sp8[2];
#pragma unroll
    for (int j = 0; j < 2; ++j) { const int chg = chb + 64 * h + 16 * (ct + 2 * j) + l15;
        brg[j] = args.in[I_BRG][chg]; big[j] = args.in[I_BIG][chg]; const float lam = args.in[I_LAM][chg]; sp8[j] = -8.0f * log1pf(expf(-lam)); }
    float hcar = 0.f;
    float h0s[8];
#pragma unroll
    for (int s = 0; s < 8; ++s) h0s[s] = 0.f;
    const int ntile = SAMPLE ? nb : 32;
    for (int k = 0; k < ntile; ++k) {
        const int chk = SAMPLE ? chain + k : chain;
        const size_t rbase = SAMPLE ? (size_t)MP + 64 * chk : (size_t)chain * TP + 64 * k;
        if (SAMPLE && tid < 64) {
#pragma unroll
            for (int s = 0; s < 8; ++s) h0s[s] = args.in[I_SLRU][(size_t)(8 * chk + s) * DLRU + chb + 64 * h + tid];
        }
#pragma unroll
        for (int o = 0; o < 4; ++o) { const f32x4 xc = cbv + cw0 * v[o] + cw1 * v[o + 1] + cw2 * v[o + 2] + cw3 * v[o + 3];
            v2u w; w.x = pk2(xc.x, xc.y); w.y = pk2(xc.z, xc.w);
            *(LAS v2u*)(lds + L_XCB + (4 * tg + o) * 272 + cg * 8) = w;
            if ((cg >> 4) == h) { LAS float* xf = (LAS float*)(lds + L_XCF) + (4 * tg + o) * LP + 4 * (cg & 15); xf[0] = xc.x; xf[1] = xc.y; xf[2] = xc.z; xf[3] = xc.w; } }
        const v2u gcur0 = gaw[0], gcur1 = gaw[1];
        if (k + 1 < ntile) lru_load_tile<SAMPLE>(args, XA, GA, SAMPLE ? chk + 1 : chain, k + 1, tg, cg, chb, h, tid, v, gaw);
        LBAR();
        pg8::f32x4 accr[2], acci[2];
#pragma unroll
        for (int j = 0; j < 2; ++j) { accr[j] = (pg8::f32x4){0.f, 0.f, 0.f, 0.f}; acci[j] = (pg8::f32x4){0.f, 0.f, 0.f, 0.f}; }
#pragma unroll
        for (int kk = 0; kk < 4; ++kk) {
            const bf16x8 a = *(const LAS bf16x8*)(lds + L_XCB + (16 * tb + l15) * 272 + kk * 64 + lq * 16);
#pragma unroll
            for (int j = 0; j < 2; ++j) {
                const bf16x8 br = *(const LAS bf16x8*)(lds + L_WSL + (16 * (ct + 2 * j) + l15) * 272 + kk * 64 + lq * 16);
                const bf16x8 bi = *(const LAS bf16x8*)(lds + L_WSL + (64 + 16 * (ct + 2 * j) + l15) * 272 + kk * 64 + lq * 16);
                accr[j] = __builtin_amdgcn_mfma_f32_16x16x32_bf16(a, br, accr[j], 0, 0, 0);
                acci[j] = __builtin_amdgcn_mfma_f32_16x16x32_bf16(a, bi, acci[j], 0, 0, 0); }
        }
#pragma unroll
        for (int j = 0; j < 2; ++j)
#pragma unroll
        for (int r = 0; r < 4; ++r) { const int tt = 16 * tb + 4 * lq + r, cl = 16 * (ct + 2 * j) + l15;
            const float rg = fast_sigmoid(accr[j][r] + brg[j]), ig = fast_sigmoid(acci[j][r] + big[j]);
            const float la = sp8[j] * rg;
            const float a = __builtin_amdgcn_exp2f(la * 1.4426950408889634f);
            const float x2 = 2.0f * la;
            const float em = (x2 > -0.25f) ? -x2 * (1.0f + x2 * (0.5f + x2 * (1.0f / 6 + x2 * (1.0f / 24 + x2 * (1.0f / 120 + x2 * (1.0f / 720))))))
                                           : 1.0f - __builtin_amdgcn_exp2f(x2 * 1.4426950408889634f);
            const float xcv = ((const LAS float*)(lds + L_XCF))[tt * LP + cl];
            ((LAS float*)(lds + L_LA))[tt * LP + cl] = a;
            ((LAS float*)(lds + L_LB))[tt * LP + cl] = sqrtf(em) * ig * xcv; }
        LBAR();
        if (tid < 64) {
            const LAS float* la = (const LAS float*)(lds + L_LA) + tid; const LAS float* lb = (const LAS float*)(lds + L_LB) + tid; LAS float* lh = (LAS float*)(lds + L_LH) + tid;
            const int ch = chb + 64 * h + tid;
#pragma unroll
            for (int s = 0; s < 8; ++s) {
                if (SAMPLE) hcar = h0s[s];
#pragma unroll
                for (int t8 = 0; t8 < 8; ++t8) { const int tt = 8 * s + t8; hcar = la[tt * LP] * hcar + lb[tt * LP]; lh[tt * LP] = hcar; }
                if (SAMPLE) args.out[O_SLRU + (size_t)(8 * chk + s) * DLRU + ch] = hcar;
            }
            if (!SAMPLE && k == ntile - 1) args.out[O_PLRU + (size_t)chain * DLRU + ch] = hcar;
        }
        LBAR();
        { const int t = tid >> 3, c8 = (tid & 7) * 8; const LAS float* lh = (const LAS float*)(lds + L_LH) + t * LP + c8;
          v2u o0, o1; o0.x = pk2(lh[0] * bf_lo(gcur0.x), lh[1] * bf_hi(gcur0.x)); o0.y = pk2(lh[2] * bf_lo(gcur0.y), lh[3] * bf_hi(gcur0.y));
          o1.x = pk2(lh[4] * bf_lo(gcur1.x), lh[5] * bf_hi(gcur1.x)); o1.y = pk2(lh[6] * bf_lo(gcur1.y), lh[7] * bf_hi(gcur1.y));
          bf16* yp = YAB + (rbase + t) * D + chb + 64 * h + c8;
          MIX_ST(o0, (GAS v2u*)yp); MIX_ST(o1, (GAS v2u*)(yp + 4)); }
    }
    LBAR();
}
#else
template <bool SAMPLE> __device__ __forceinline__ void lru_load_tile(const Args& args, const float* XA, const bf16* GA, int chain, int k, int tg, int cg, int chb, int q, int tid, f32x4 (&v)[7], v2u& gaw) {
    const size_t rbase = SAMPLE ? (size_t)MP + 64 * chain : (size_t)chain * TP + 64 * k;
#pragma unroll
    for (int i = 0; i < 7; ++i) {
        if (SAMPLE) { const int ts = 4 * (tg & 1) - 3 + i, sl = tg >> 1;
            v[i] = (ts >= 0) ? xa_ld4(XA, rbase + 8 * sl + ts, chb + 4 * cg)
                             : *(const GAS f32x4*)(args.in[I_SCONV] + ((size_t)(8 * chain + sl) * 3 + (3 + ts)) * DLRU + chb + 4 * cg);
        } else { const int tt = 4 * tg - 3 + i;
            v[i] = (k > 0 || tt >= 0) ? xa_ld4(XA, rbase + tt, chb + 4 * cg) : (f32x4){0.f, 0.f, 0.f, 0.f}; }
    }
    gaw = *(const GAS v2u*)(GA + (rbase + (tid >> 3)) * DLRU + chb + 32 * q + (tid & 7) * 4);
}
template <bool SAMPLE> __device__ __forceinline__ void lru_task(const Args& args, LAS unsigned char* lds, int tid, int wave, int lane, int chain, int head, int q) {
    unsigned char* ws = args.ws;
    const float* XA = (const float*)(ws + WS_XA); const bf16* GA = (const bf16*)(ws + WS_GA); bf16* YAB = (bf16*)(ws + WS_YAB);
    const int chb = head * 128;
    const int cg = tid & 31, tg = tid >> 5;
    f32x4 v[7]; v2u gaw;
    lru_load_tile<SAMPLE>(args, XA, GA, chain, 0, tg, cg, chb, q, tid, v, gaw);
    { const bf16* WG = (const bf16*)(ws + WS_WG) + (size_t)head * 256 * 128;
      for (int i = tid; i < 1024; i += 512) { const int r = i >> 4, c16 = i & 15; const int srow = (r < 32) ? (32 * q + r) : (128 + 32 * q + (r - 32));
          *(LAS v4u*)(lds + L_WSL + r * 272 + c16 * 16) = *(const GAS v4u*)(WG + (size_t)srow * 128 + c16 * 8); } }
    const f32x4 cw0 = *(const f32x4*)(args.in[I_CONVW] + 0 * DLRU + chb + 4 * cg), cw1 = *(const f32x4*)(args.in[I_CONVW] + 1 * DLRU + chb + 4 * cg),
                cw2 = *(const f32x4*)(args.in[I_CONVW] + 2 * DLRU + chb + 4 * cg), cw3 = *(const f32x4*)(args.in[I_CONVW] + 3 * DLRU + chb + 4 * cg),
                cbv = *(const f32x4*)(args.in[I_CONVB] + chb + 4 * cg);
    const int tb = wave & 3, ct = wave >> 2, l15 = lane & 15, lq = lane >> 4;
    const int chg = chb + 32 * q + 16 * ct + l15;
    const float brg = args.in[I_BRG][chg], big = args.in[I_BIG][chg];
    const float lam = args.in[I_LAM][chg];
    const float sp8 = -8.0f * log1pf(expf(-lam));
    float hcar = 0.f;
    float h0s[8];
#pragma unroll
    for (int s = 0; s < 8; ++s) h0s[s] = 0.f;
    if (SAMPLE && tid < 32) {
#pragma unroll
        for (int s = 0; s < 8; ++s) h0s[s] = args.in[I_SLRU][(size_t)(8 * chain + s) * DLRU + chb + 32 * q + tid];
    }
    const int ntile = SAMPLE ? 1 : 32;
    for (int k = 0; k < ntile; ++k) {
        const size_t rbase = SAMPLE ? (size_t)MP + 64 * chain : (size_t)chain * TP + 64 * k;
#pragma unroll
        for (int o = 0; o < 4; ++o) { const f32x4 xc = cbv + cw0 * v[o] + cw1 * v[o + 1] + cw2 * v[o + 2] + cw3 * v[o + 3];
            v2u w; w.x = pk2(xc.x, xc.y); w.y = pk2(xc.z, xc.w);
            *(LAS v2u*)(lds + L_XCB + (4 * tg + o) * 272 + cg * 8) = w;
            if ((cg >> 3) == q) { LAS float* xf = (LAS float*)(lds + L_XCF) + (4 * tg + o) * LP + 4 * (cg & 7); xf[0] = xc.x; xf[1] = xc.y; xf[2] = xc.z; xf[3] = xc.w; } }
        const v2u gcur = gaw;
        if (k + 1 < ntile) lru_load_tile<SAMPLE>(args, XA, GA, chain, k + 1, tg, cg, chb, q, tid, v, gaw);
        LBAR();
        pg8::f32x4 accr = {0.f, 0.f, 0.f, 0.f}, acci = {0.f, 0.f, 0.f, 0.f};
#pragma unroll
        for (int kk = 0; kk < 4; ++kk) {
            const bf16x8 a = *(const LAS bf16x8*)(lds + L_XCB + (16 * tb + l15) * 272 + kk * 64 + lq * 16);
            const bf16x8 br = *(const LAS bf16x8*)(lds + L_WSL + (16 * ct + l15) * 272 + kk * 64 + lq * 16);
            const bf16x8 bi = *(const LAS bf16x8*)(lds + L_WSL + (32 + 16 * ct + l15) * 272 + kk * 64 + lq * 16);
            accr = __builtin_amdgcn_mfma_f32_16x16x32_bf16(a, br, accr, 0, 0, 0);
            acci = __builtin_amdgcn_mfma_f32_16x16x32_bf16(a, bi, acci, 0, 0, 0);
        }
#pragma unroll
        for (int r = 0; r < 4; ++r) { const int tt = 16 * tb + 4 * lq + r, cl = 16 * ct + l15;
            const float rg = fast_sigmoid(accr[r] + brg), ig = fast_sigmoid(acci[r] + big);
            const float la = sp8 * rg;
            const float a = __builtin_amdgcn_exp2f(la * 1.4426950408889634f);
            const float x2 = 2.0f * la;
            const float em = (x2 > -0.25f) ? -x2 * (1.0f + x2 * (0.5f + x2 * (1.0f / 6 + x2 * (1.0f / 24 + x2 * (1.0f / 120 + x2 * (1.0f / 720))))))
                                           : 1.0f - __builtin_amdgcn_exp2f(x2 * 1.4426950408889634f);
            const float xcv = ((const LAS float*)(lds + L_XCF))[tt * LP + cl];
            ((LAS float*)(lds + L_LA))[tt * LP + cl] = a;
            ((LAS float*)(lds + L_LB))[tt * LP + cl] = sqrtf(em) * ig * xcv; }
        LBAR();
        if (tid < 32) {
            const LAS float* la = (const LAS float*)(lds + L_LA) + tid; const LAS float* lb = (const LAS float*)(lds + L_LB) + tid; LAS float* lh = (LAS float*)(lds + L_LH) + tid;
            const int ch = chb + 32 * q + tid;
#pragma unroll
            for (int s = 0; s < 8; ++s) {
                if (SAMPLE) hcar = h0s[s];
#pragma unroll
                for (int t8 = 0; t8 < 8; ++t8) { const int tt = 8 * s + t8; hcar = la[tt * LP] * hcar + lb[tt * LP]; lh[tt * LP] = hcar; }
                if (SAMPLE) args.out[O_SLRU + (size_t)(8 * chain + s) * DLRU + ch] = hcar;
            }
            if (!SAMPLE && k == ntile - 1) args.out[O_PLRU + (size_t)chain * DLRU + ch] = hcar;
        }
        LBAR();
        { const int t = tid >> 3, c4 = (tid & 7) * 4; const LAS float* lh = (const LAS float*)(lds + L_LH) + t * LP + c4;
          v2u o; o.x = pk2(lh[0] * bf_lo(gcur.x), lh[1] * bf_hi(gcur.x)); o.y = pk2(lh[2] * bf_lo(gcur.y), lh[3] * bf_hi(gcur.y));
          MIX_ST(o, (GAS v2u*)(YAB + (rbase + t) * D + chb + 32 * q + c4)); }
    }
    LBAR();
}

#endif
constexpr int S5_WAVE_LDS = 12800, S5_BU = 0, S5_HS = 8448;
template <bool SAMPLE, bool FULL, bool STORE> __device__ __forceinline__ f32x2 s5_task(const Args& args, LAS unsigned char* wl, int lane, int chain, int g, int k_lo, int k_hi, float h0r, float h0i) {
    unsigned char* ws = args.ws;
    const bf16* XB = (const bf16*)(ws + WS_XB); bf16* G2 = (bf16*)(ws + WS_G2);
    const int l15 = lane & 15, lq = lane >> 4;
    const f32x2 ab = *(const GAS f32x2*)((const float*)(ws + WS_ABAR) + 2 * (g * SP + lane));
    bf16x8 bfrag[8], cfrag[4];
#pragma unroll
    for (int j = 0; j < 8; ++j) { bfrag[j] = (bf16x8){0, 0, 0, 0, 0, 0, 0, 0}; if (lane < 32) bfrag[j] = *(const GAS bf16x8*)((const bf16*)(ws + WS_BB) + ((size_t)(g * 8 + j) * 64 + lane) * 8); }
#pragma unroll
    for (int kk = 0; kk < 4; ++kk) cfrag[kk] = *(const GAS bf16x8*)((const bf16*)(ws + WS_CC) + ((size_t)(g * 4 + kk) * 64 + lane) * 8);
    const f32x4 dsk = *(const GAS f32x4*)(args.in[I_DSK] + g * SCG + 4 * lq);
    float hr = h0r, hi = h0i;
    bf16x8 a_nx = (bf16x8){0, 0, 0, 0, 0, 0, 0, 0}; v2u uw_nx;
    { const size_t r0 = SAMPLE ? (size_t)MP + 64 * chain : (size_t)chain * TP + 64 * k_lo;
      if (lane < 32) a_nx = *(const GAS bf16x8*)(XB + (r0 + l15) * DSSM + g * SCG + 8 * lq);
      uw_nx = *(const GAS v2u*)(XB + (r0 + l15) * DSSM + g * SCG + 4 * lq); }
    for (int k = k_lo; k < k_hi; ++k) {
        const size_t rbase = SAMPLE ? (size_t)MP + 64 * chain : (size_t)chain * TP + 64 * k;
#pragma unroll 1
        for (int tb = 0; tb < 4; ++tb) {
            const size_t row0 = rbase + 16 * tb;
            const bf16x8 a = a_nx; const v2u uw = uw_nx;
            if (!(k == k_hi - 1 && tb == 3)) {
                a_nx = (bf16x8){0, 0, 0, 0, 0, 0, 0, 0};
                if (lane < 32) a_nx = *(const GAS bf16x8*)(XB + (row0 + 16 + l15) * DSSM + g * SCG + 8 * lq);
                uw_nx = *(const GAS v2u*)(XB + (row0 + 16 + l15) * DSSM + g * SCG + 4 * lq); }
#pragma unroll
            for (int j = 0; j < 8; ++j) { const pg8::f32x4 c = __builtin_amdgcn_mfma_f32_16x16x32_bf16(a, bfrag[j], (pg8::f32x4){0.f, 0.f, 0.f, 0.f}, 0, 0, 0);
#pragma unroll
                for (int r = 0; r < 4; ++r) ((LAS float*)(wl + S5_BU))[(4 * lq + r) * 132 + 16 * j + l15] = c[r]; }
            LDS_WAIT();
            f32x2 bu[16];
#pragma unroll
            for (int t = 0; t < 16; ++t) bu[t] = *(const LAS f32x2*)(wl + S5_BU + (t * 132 + 2 * lane) * 4);
#pragma unroll
            for (int t = 0; t < 16; ++t) {
                if (SAMPLE && (t & 7) == 0) { const size_t si = ((size_t)(8 * chain + 2 * tb + (t >> 3)) * NGRP + g) * SP + lane; hr = args.in[I_SRE][si]; hi = args.in[I_SIM][si]; }
                const float nr = ab.x * hr - ab.y * hi + bu[t].x, ni = ab.x * hi + ab.y * hr + bu[t].y; hr = nr; hi = ni;
                *(LAS unsigned*)(wl + S5_HS + t * 272 + 4 * lane) = pk2(hr, hi);
                if (SAMPLE && (t & 7) == 7) { const size_t si = ((size_t)(8 * chain + 2 * tb + (t >> 3)) * NGRP + g) * SP + lane; args.out[O_SRE + si] = hr; args.out[O_SIM + si] = hi; }
            }
            LDS_WAIT();
            if (FULL) {
            pg8::f32x4 y = {0.f, 0.f, 0.f, 0.f};
#pragma unroll
            for (int kk = 0; kk < 4; ++kk) { const bf16x8 hb = *(const LAS bf16x8*)(wl + S5_HS + l15 * 272 + kk * 64 + lq * 16);
                y = __builtin_amdgcn_mfma_f32_16x16x32_bf16(cfrag[kk], hb, y, 0, 0, 0); }
            LDS_WAIT();
            const float y0 = y[0] + dsk.x * bf_lo(uw.x), y1 = y[1] + dsk.y * bf_hi(uw.x), y2 = y[2] + dsk.z * bf_lo(uw.y), y3 = y[3] + dsk.w * bf_hi(uw.y);
            v2u o; o.x = pk2(gelu_tanh_f(y0), gelu_tanh_f(y1)); o.y = pk2(gelu_tanh_f(y2), gelu_tanh_f(y3));
            MIX_ST(o, (GAS v2u*)(G2 + (row0 + l15) * DSSM + g * SCG + 4 * lq));
            }
        }
    }
    if (!SAMPLE && STORE) { const size_t si = ((size_t)chain * NGRP + g) * SP + lane; args.out[O_PRE + si] = hr; args.out[O_PIM + si] = hi; }
    return (f32x2){hr, hi};
}


constexpr int S5_EX = 8 * S5_WAVE_LDS;
#ifndef S5_P1FULL
#define S5_P1FULL false
#endif
__device__ __forceinline__ void s5_prompt_wg(const Args& args, LAS unsigned char* lds, int wave, int lane, int pair0) {
    LAS unsigned char* wl = lds + wave * S5_WAVE_LDS;
    const int pair = pair0 + (wave >> 2), seq = pair >> 7, g = pair & 127, chunk = wave & 3;
#if defined(S5_X3)
    { f32x2 h = {0.f, 0.f};
      if (chunk > 0) h = s5_task<false, S5_P1FULL, false>(args, wl, lane, seq, g, 0, 8 * chunk, 0.f, 0.f);
      if (chunk == 3) (void)s5_task<false, true, true>(args, wl, lane, seq, g, 24, 32, h.x, h.y);
      else (void)s5_task<false, true, false>(args, wl, lane, seq, g, 8 * chunk, 8 * chunk + 8, h.x, h.y);
      return; }
#endif
#if defined(S5_TWOCHUNK)
    {
      f32x2 e2 = {0.f, 0.f};
      if (chunk == 0) e2 = s5_task<false, false, false>(args, wl, lane, seq, g, 0, 16, 0.f, 0.f);
      *(LAS f32x2*)(lds + S5_EX + (wave * 64 + lane) * 8) = e2;
      LBAR();
      const f32x2 h1 = *(const LAS f32x2*)(lds + S5_EX + (((wave & ~3)) * 64 + lane) * 8);
      if (chunk == 0) (void)s5_task<false, true, false>(args, wl, lane, seq, g, 0, 16, 0.f, 0.f);
      if (chunk == 1) (void)s5_task<false, true, true>(args, wl, lane, seq, g, 16, 32, h1.x, h1.y);
      return; }
#endif
    f32x2 e = {0.f, 0.f};
    if (chunk < 3) e = s5_task<false, S5_P1FULL, false>(args, wl, lane, seq, g, 8 * chunk, 8 * chunk + 8, 0.f, 0.f);
#if defined(S5_EX_GLOBAL)
    float* exg = (float*)(args.ws + WS_HID + 184 * MiB) + (size_t)blockIdx.x * 1024;
    exg[(wave * 64 + lane) * 2] = e.x; exg[(wave * 64 + lane) * 2 + 1] = e.y;
    __threadfence(); __syncthreads();
#else
    *(LAS f32x2*)(lds + S5_EX + (wave * 64 + lane) * 8) = e;
    LBAR();
#endif
    const f32x2 ab = *(const GAS f32x2*)((const float*)(args.ws + WS_ABAR) + 2 * (g * SP + lane));
#define OPQ(x) asm volatile("" : "+v"(x))
    float pr = ab.x, pi = ab.y;
#pragma unroll 1
    for (int s = 0; s < 9; ++s) { float a2 = pr * pr, b2 = pi * pi, ab2 = pr * pi; OPQ(a2); OPQ(b2); OPQ(ab2); float nr = a2 - b2, ni = ab2 + ab2; OPQ(nr); OPQ(ni); pr = nr; pi = ni; }
    float hr = 0.f, hi = 0.f;
#pragma unroll 1
    for (int c = 0; c < chunk; ++c) { const f32x2 ec = *(const LAS f32x2*)(lds + S5_EX + (((wave & ~3) + c) * 64 + lane) * 8);
        float t1 = pr * hr, t2 = pi * hi, t3 = pr * hi, t4 = pi * hr; OPQ(t1); OPQ(t2); OPQ(t3); OPQ(t4);
        float nr = t1 - t2, ni = t3 + t4; OPQ(nr); OPQ(ni); nr += ec.x; ni += ec.y; OPQ(nr); OPQ(ni); hr = nr; hi = ni; }
#undef OPQ
    if (chunk == 3) (void)s5_task<false, true, true>(args, wl, lane, seq, g, 24, 32, hr, hi);
    else (void)s5_task<false, true, false>(args, wl, lane, seq, g, 8 * chunk, 8 * chunk + 8, hr, hi);
}
__device__ __forceinline__ void convert_beside_chains(const Args& args, int qid, int first, int n, LAS unsigned char* lds, int wave, int lane, volatile LAS unsigned* flag) {
    LAS float* scr = (LAS float*)(lds + RING_OFF + wave * CONV_SCR_STRIDE);
    unsigned* ctr = (unsigned*)(args.ws + WS_CTL) + CW_Q + 64 * qid;
    constexpr int QS = 4;
    for (;;) {
        if (*flag >= 4u) break;
        int base = 0;
        if (lane == 0) base = (int)__hip_atomic_fetch_add(ctr, (unsigned)QS, __ATOMIC_RELAXED, __HIP_MEMORY_SCOPE_AGENT);
        base = __builtin_amdgcn_readfirstlane(base);
        if (base >= n) break;
        const int e = (base + QS < n) ? base + QS : n;
        convert_run(args, first + base, first + e, scr, lane);
    }
}
__device__ __forceinline__ void p5_mixer(const Args& args, LAS unsigned char* lds, int tid, int wave, int lane, int bx, int G, int mode = 0) {
    volatile LAS unsigned* cflag = (volatile LAS unsigned*)(lds + RING_BYTES + 128);
#if defined(S5_CONV)
    if (tid == 0) *cflag = 0u;
    __syncthreads();
#endif
    { const float* XA = (const float*)(args.ws + WS_XA);
      const int nv = (NP + NS) * 3 * (DLRU / 4);
      for (int i = bx * 512 + tid; i < nv; i += G * 512) { const int c4 = i % (DLRU / 4), rj = i / (DLRU / 4), s = rj / 3, j = rj % 3;
          if (s < NP) *(GAS f32x4*)(args.out + O_PCONV + ((size_t)s * 3 + j) * DLRU + 4 * c4) = xa_ld4(XA, (size_t)s * TP + TP - 3 + j, 4 * c4);
          else { const int ss = s - NP; *(GAS f32x4*)(args.out + O_SCONV + ((size_t)ss * 3 + j) * DLRU + 4 * c4) = xa_ld4(XA, (size_t)MP + 8 * ss + 5 + j, 4 * c4); } } }
    LAS unsigned char* wl = lds + wave * S5_WAVE_LDS;
    const int NS5 = (G >= 128) ? NP * NGRP / NWAVES : 0;
#if defined(LRU64) && defined(S5_SPREAD)
    if (G >= 2 * NP * 32) {
        const int NW5 = NP * NGRP / 4;
        if (bx < NW5) {
#if defined(S5_CONV2) && !defined(NO_TAIL_CONVERT)
            if (wave < 4) {
                if (mode != 2 && mode != 3) { const int t = bx * 4 + wave; (void)s5_task<false, true, true>(args, wl, lane, t >> 7, t & 127, 0, 32, 0.f, 0.f); }
                if (mode == 0 || mode == 3) for (int t = bx * 4 + wave; t < 16 * NGRP; t += NW5 * 4) (void)s5_task<true, true, false>(args, wl, lane, t >> 7, t & 127, 0, 1, 0.f, 0.f);
            } else if (mode == 0) convert_queue(args, 5, Q5_FIRST, Q5_N, lds, wave, lane);
            __syncthreads();
#else
            if (wave < 4 && mode != 2 && mode != 3) { const int t = bx * 4 + wave;
#if defined(S5_PRIO)
                __builtin_amdgcn_s_setprio(3);
#endif
                (void)s5_task<false, true, true>(args, wl, lane, t >> 7, t & 127, 0, 32, 0.f, 0.f);
#if defined(S5_PRIO)
                __builtin_amdgcn_s_setprio(0);
#endif
#if defined(S5_CONV)
                if (lane == 0) __hip_atomic_fetch_add((LAS unsigned*)cflag, 1u, __ATOMIC_RELAXED, __HIP_MEMORY_SCOPE_WORKGROUP);
#endif
            }
#if defined(S5_CONV) && !defined(NO_TAIL_CONVERT)
            else if (wave >= 4 && mode == 0) convert_beside_chains(args, 5, Q5_FIRST, Q5_N, lds, wave, lane, cflag);
#endif
            __syncthreads();
            if (mode == 0 || mode == 3)
                for (int t = bx * NWAVES + wave; t < 16 * NGRP; t += NW5 * NWAVES) (void)s5_task<true, true, false>(args, wl, lane, t >> 7, t & 127, 0, 1, 0.f, 0.f);
#endif
        } else if (bx < NW5 + NP * 32) { const int t = bx - NW5; if (mode != 1 && mode != 3) lru_task<false>(args, lds, tid, wave, lane, t >> 5, (t >> 1) & 15, t & 1);
            if (mode == 0 || mode == 3) lru_task<true>(args, lds, tid, wave, lane, 4 * (t >> 5), (t >> 1) & 15, t & 1, 4); }
    } else {
        for (int t = bx * NWAVES + wave; t < NP * NGRP; t += G * NWAVES) (void)s5_task<false, true, true>(args, wl, lane, t >> 7, t & 127, 0, 32, 0.f, 0.f);
        __syncthreads();
        for (int t = bx; t < NP * 32; t += G) lru_task<false>(args, lds, tid, wave, lane, t >> 5, (t >> 1) & 15, t & 1);
        for (int t = bx; t < 16 * 32; t += G) lru_task<true>(args, lds, tid, wave, lane, t >> 5, (t >> 1) & 15, t & 1);
        for (int t = bx * NWAVES + wave; t < 16 * NGRP; t += G * NWAVES) (void)s5_task<true, true, false>(args, wl, lane, t >> 7, t & 127, 0, 1, 0.f, 0.f);
    }
#elif defined(LRU64)
    if (bx < NS5) {
        if (mode != 2) for (int t = bx * NWAVES + wave; t < NP * NGRP; t += NS5 * NWAVES) (void)s5_task<false, true, true>(args, wl, lane, t >> 7, t & 127, 0, 32, 0.f, 0.f);
    } else if (bx < NS5 + NP * 32 && G >= NS5 + NP * 32 + 8) {
        const int t = bx - NS5; if (mode != 1) lru_task<false>(args, lds, tid, wave, lane, t >> 5, (t >> 1) & 15, t & 1);
    } else if (mode == 0) {
        const bool wide = G >= NS5 + NP * 32 + 8; const int b4 = wide ? bx - NS5 - NP * 32 : bx - NS5, G4n = wide ? G - NS5 - NP * 32 : G - NS5;
        if (!wide) for (int t = b4; t < NP * 32; t += G4n) lru_task<false>(args, lds, tid, wave, lane, t >> 5, (t >> 1) & 15, t & 1);
        for (int t = b4; t < 16 * 32; t += G4n) lru_task<true>(args, lds, tid, wave, lane, t >> 5, (t >> 1) & 15, t & 1);
        for (int t = b4 * NWAVES + wave; t < 16 * NGRP; t += G4n * NWAVES) (void)s5_task<true, true, false>(args, wl, lane, t >> 7, t & 127, 0, 1, 0.f, 0.f);
        if (NS5 == 0) for (int t = bx * NWAVES + wave; t < NP * NGRP; t += G * NWAVES) (void)s5_task<false, true, true>(args, wl, lane, t >> 7, t & 127, 0, 32, 0.f, 0.f);
    }
#elif defined(S5_CHUNKED)
    { for (int t = bx; t < NP * 64; t += G) lru_task<false>(args, lds, tid, wave, lane, t >> 6, (t >> 2) & 15, t & 3);
      for (int t = bx; t < 16 * 64; t += G) lru_task<true>(args, lds, tid, wave, lane, t >> 6, (t >> 2) & 15, t & 3);
      for (int t = bx; t < NP * NGRP / 2; t += G) { s5_prompt_wg(args, lds, wave, lane, 2 * t); LBAR(); }
      for (int t = bx * NWAVES + wave; t < 16 * NGRP; t += G * NWAVES) (void)s5_task<true, true, false>(args, wl, lane, t >> 7, t & 127, 0, 1, 0.f, 0.f); }
#elif defined(P5_DEAL2)
    if (bx < NS5) {
        for (int t = bx * NWAVES + wave; t < NP * NGRP; t += NS5 * NWAVES) (void)s5_task<false, true, true>(args, wl, lane, t >> 7, t & 127, 0, 32, 0.f, 0.f);
        __syncthreads();
        const int G2n = G - NS5;
        for (int t = G2n + bx; t < NP * 64; t += NS5) lru_task<false>(args, lds, tid, wave, lane, t >> 6, (t >> 2) & 15, t & 3);
    } else {
        const int b2 = bx - NS5, G2n = G - NS5;
        if (b2 < NP * 64) lru_task<false>(args, lds, tid, wave, lane, b2 >> 6, (b2 >> 2) & 15, b2 & 3);
        for (int t = b2; t < 16 * 64; t += G2n) lru_task<true>(args, lds, tid, wave, lane, t >> 6, (t >> 2) & 15, t & 3);
        for (int t = b2 * NWAVES + wave; t < 16 * NGRP; t += G2n * NWAVES) (void)s5_task<true, true, false>(args, wl, lane, t >> 7, t & 127, 0, 1, 0.f, 0.f);
    }
#else
    if (bx < NS5) {
        for (int t = bx * NWAVES + wave; t < NP * NGRP; t += NS5 * NWAVES) (void)s5_task<false, true, true>(args, wl, lane, t >> 7, t & 127, 0, 32, 0.f, 0.f);
    } else {
        const int b2 = bx - NS5, G2n = G - NS5;
        for (int t = b2; t < NP * 64; t += G2n) lru_task<false>(args, lds, tid, wave, lane, t >> 6, (t >> 2) & 15, t & 3);
        const int nsk = (NP * 64 > G2n && 2 * G2n > NP * 64) ? NP * 64 - G2n : 0, b3 = b2 - nsk, G3n = G2n - nsk;
        if (b3 >= 0) {
            for (int t = b3; t < 16 * 64; t += G3n) lru_task<true>(args, lds, tid, wave, lane, t >> 6, (t >> 2) & 15, t & 3);
            for (int t = b3 * NWAVES + wave; t < 16 * NGRP; t += G3n * NWAVES) (void)s5_task<true, true, false>(args, wl, lane, t >> 7, t & 127, 0, 1, 0.f, 0.f);
        }
        if (NS5 == 0) for (int t = bx * NWAVES + wave; t < NP * NGRP; t += G * NWAVES) (void)s5_task<false, true, true>(args, wl, lane, t >> 7, t & 127, 0, 32, 0.f, 0.f);
    }
#endif
    __syncthreads();
}

__global__ void __launch_bounds__(NWAVES * 64, 2) hawk_fwd(Args args) {
    extern __shared__ __attribute__((aligned(16))) unsigned char lds_raw[];
    LAS unsigned char* lds = (LAS unsigned char*)lds_raw;
    volatile LAS unsigned* MISC = (volatile LAS unsigned*)(lds + MISC_OFF);
    const int tid = threadIdx.x, lane = tid & 63, wave = __builtin_amdgcn_readfirstlane(tid >> 6);
    const int G = gridDim.x, bx = blockIdx.x;
    const int gw = bx * NWAVES + wave, ngw = G * NWAVES;
    unsigned char* ws = args.ws;
    gu32* ctl = (gu32*)(ws + WS_CTL);
    for (int u = tid; u < (LDS_BYTES - LDSCTL_OFF) / 4; u += NWAVES * 64) ((LAS unsigned*)(lds + LDSCTL_OFF))[u] = 0u;
#if defined(XCHK) && XCHK
    for (int u = tid; u < RING_BYTES / 4; u += NWAVES * 64) ((LAS unsigned*)lds)[u] = 0xFFFFFFFFu;
#endif
    __syncthreads();
    XcdBarrier bar = xcd_barrier_post((unsigned*)(ctl + CW_BAR) + args.li * XCD_BAR_WORDS, MISC + 8);
    const int lo = args.ph_lo, hi = args.ph_hi;
#ifndef PHMASK
#define PHMASK 0x1fff
#endif
#define IN(k) ((((PHMASK) >> (k)) & 1) && lo <= (k) && (k) < hi)
#define BOTH(k) (IN(k) && IN((k) + 1))
#if defined(CLKPROBE)
#define SEAM(k) do { if ((k) == CLKPROBE) { const unsigned long long c1 = __builtin_amdgcn_s_memtime(), r1 = __builtin_amdgcn_s_memrealtime(); const unsigned long long dc = c1 - cp_t0, dr = r1 - cp_r0; cp_delay = dr ? (10000ull * dc) / dr : 0ull; } if (BOTH(k)) xcd_barrier(bar); } while (0)
#else
#if defined(SEAM_REP)
#define SEAM(k) do { if (BOTH(k)) { for (int _r = 0; _r < SEAM_REP; ++_r) xcd_barrier(bar); } } while (0)
#else
#define SEAM(k) do { if (BOTH(k)) xcd_barrier(bar); } while (0)
#endif
#endif
#if defined(CLKPROBE)
    unsigned long long cp_t0 = 0, cp_r0 = 0, cp_delay = 0;
#endif
    bf16* XN = (bf16*)(ws + WS_XN); bf16* HID = (bf16*)(ws + WS_HID); float* Fb = (float*)(ws + WS_F); bf16* YAB = (bf16*)(ws + WS_YAB);
#ifndef XS_ON
#define XS_ON 0
#endif
#define XS_CNT(ph) ((unsigned*)(ctl + CW_XS) + (ph) * 1024 + 64 * bar.x)
#define xs_nloc ((unsigned)MISC[8])

#if defined(XCHK) && XCHK
    if (lo == 0) {
        GAS v4u* w4 = (GAS v4u*)(ws + 2 * MiB); const size_t n4 = (WS_END - 2 * MiB) / 16; const v4u q = {0xFFFFFFFFu, 0xFFFFFFFFu, 0xFFFFFFFFu, 0xFFFFFFFFu};
        for (size_t i = (size_t)bx * 512 + tid; i < n4; i += (size_t)G * 512) w4[i] = q;
        GAS v4u* o4 = (GAS v4u*)args.out; const size_t m4 = O_END / 4;
        for (size_t i = (size_t)bx * 512 + tid; i < m4; i += (size_t)G * 512) o4[i] = q;
        if (hi > 1) xcd_barrier(bar);
    }
#endif
    if (IN(0)) { p0_prologue(args, lds, wave, lane, gw, ngw);
#if defined(REP_PHASE) && REP_PHASE == 0
        xcd_barrier(bar); p0_prologue(args, lds, wave, lane, gw, ngw);
#endif
        SEAM(0); }
    int cv = bx;
#if !defined(NO_VIRT_C)
    if (lo == 0 && hi > 1) {
        if (tid == 0) { unsigned ok = (G % 8 == 0) ? 1u : 0u;
            for (unsigned j = 0; j < 16; ++j) { const unsigned cn = xb_ld(&bar.bar[XB_XCNT(j)]); ok &= (cn == (j < 8 ? (unsigned)G / 8u : 0u)) ? 1u : 0u; }
            MISC[11] = ok; }
        __syncthreads();
        if (MISC[11] != 0u && MISC[10] < (unsigned)G / 8u && bar.x < 8u) cv = (int)(MISC[10] * 8u + bar.x);
    }
#endif
#if defined(CLKPROBE)
    if (IN(CLKPROBE)) { cp_t0 = __builtin_amdgcn_s_memtime(); cp_r0 = __builtin_amdgcn_s_memrealtime(); }
#endif
    if (IN(1)) { pg8::Gemm g{XN, (const bf16*)(ws + WS_WGU1), M, 2 * DFF, D, D};   pg8::StaticOrder S; S.init(M, 2 * DFF, D, G, cv); S.xs = pg8::XSync{XS_CNT(1), xs_nloc, XS_ON ? S.nwg / G : 0};
        pg8::EpiSwiglu E{HID, DFF, (const float*)(ws + WS_RSTD)};
        pg8::gemm_phase<pg8::EpiSwiglu, pg8::StaticOrder, PG8_ALIGN, PG8_SP2>(lds + RING_OFF, g, S, E);
#if defined(REP_PHASE) && REP_PHASE == 1
        xcd_barrier(bar); pg8::gemm_phase<pg8::EpiSwiglu, pg8::StaticOrder, PG8_ALIGN, PG8_SP2>(lds + RING_OFF, g, S, E);
#endif
#if !defined(NO_TAIL_CONVERT)
        convert_queue(args, 1, ITB_DN1, IT_DN + IT_IN, lds, wave, lane);
#endif
        SEAM(1); }
    if (IN(2)) { pg8::Gemm g{HID, (const bf16*)(ws + WS_WD1), M, D, DFF, DFF}; pg8::TailOrder S; S.init(D, DFF, G, cv); S.base.xs = pg8::XSync{XS_CNT(2), xs_nloc, XS_ON ? 3 : 0};
        pg8::EpiF32 E{(bf16*)(ws + WS_F), D, (float*)(ws + WS_SLAB), SLAB_FLOATS, MP};
        pg8::gemm_phase<pg8::EpiF32, pg8::TailOrder, PG8_ALIGN, PG8_SP2>(lds + RING_OFF, g, S, E);
#if defined(REP_PHASE) && REP_PHASE == 2
        xcd_barrier(bar); pg8::gemm_phase<pg8::EpiF32, pg8::TailOrder, PG8_ALIGN, PG8_SP2>(lds + RING_OFF, g, S, E);
#endif
        SEAM(2); }
    if (IN(3)) { thin_rows<1>(args, gw, ngw, lane);
#if defined(REP_PHASE) && REP_PHASE == 3
        xcd_barrier(bar); thin_rows<1>(args, gw, ngw, lane);
#endif
        SEAM(3); }
    if (IN(4)) { pg8::Gemm g{(const bf16*)(ws + WS_XR), (const bf16*)(ws + WS_WIN), M, DIN, D, D};   pg8::StaticOrder S; S.init(M, DIN, D, G, cv); S.xs = pg8::XSync{XS_CNT(4), xs_nloc, XS_ON ? S.nwg / G : 0};
        pg8::EpiWin E{(float*)(ws + WS_XA), (bf16*)(ws + WS_GA), (bf16*)(ws + WS_XB), (bf16*)(ws + WS_G), (const float*)(ws + WS_RSTD) + M};
        pg8::gemm_phase<pg8::EpiWin, pg8::StaticOrder, PG8_ALIGN, PG8_SP2>(lds + RING_OFF, g, S, E);
#if !defined(NO_TAIL_CONVERT)
        convert_queue(args, 4, ITB_GLU, IT_GLU, lds, wave, lane);
        convert_queue(args, 14, Q14_FIRST, Q14_N, lds, wave, lane);
#endif
        SEAM(4); }
    if (IN(5)) { p5_mixer(args, lds, tid, wave, lane, bx, G);
#if !defined(NO_TAIL_CONVERT)
        convert_queue(args, 5, Q5_FIRST, Q5_N, lds, wave, lane);
#endif
#if defined(REP_PHASE) && REP_PHASE == 5
#ifndef P5_REP_MODE
#define P5_REP_MODE 0
#endif
        xcd_barrier(bar); p5_mixer(args, lds, tid, wave, lane, bx, G, P5_REP_MODE);
#endif
        SEAM(5); }
    if (IN(6)) { pg8::Gemm g{(const bf16*)(ws + WS_G2), (const bf16*)(ws + WS_WGLU), M, DSSM, DSSM, DSSM}; pg8::StaticOrder S; S.init(M, DSSM, DSSM, G, cv); S.xs = pg8::XSync{XS_CNT(6), xs_nloc, XS_ON ? S.nwg / G : 0};
        pg8::EpiGlu E{(const bf16*)(ws + WS_G2), args.in[I_BGLU], YAB + DLRU};
        pg8::gemm_phase<pg8::EpiGlu, pg8::StaticOrder, PG8_ALIGN, PG8_SP2>(lds + RING_OFF, g, S, E);
#if defined(REP_PHASE) && REP_PHASE == 6
        xcd_barrier(bar); pg8::gemm_phase<pg8::EpiGlu, pg8::StaticOrder, PG8_ALIGN, PG8_SP2>(lds + RING_OFF, g, S, E);
#endif
#if !defined(NO_TAIL_CONVERT)
        convert_queue(args, 6, Q6_FIRST, Q6_N, lds, wave, lane);
#endif
        SEAM(6); }
    if (IN(7)) { pg8::Gemm g{YAB, (const bf16*)(ws + WS_WOUT), M, D, D, D}; pg8::SegOrder S; S.init(M, D, D, G, cv); S.xs = pg8::XSync{XS_CNT(7), xs_nloc, XS_ON ? S.nwg / G : 0};
        pg8::EpiOut E{(const bf16*)(ws + WS_G), XN};
        pg8::gemm_phase<pg8::EpiOut, pg8::SegOrder, PG8_ALIGN, PG8_SP2>(lds + RING_OFF, g, S, E);
#if defined(REP_PHASE) && REP_PHASE == 7
        xcd_barrier(bar); pg8::gemm_phase<pg8::EpiOut, pg8::SegOrder, PG8_ALIGN, PG8_SP2>(lds + RING_OFF, g, S, E);
#endif
#if !defined(NO_TAIL_CONVERT)
        convert_queue(args, 7, Q7_FIRST, Q7_N, lds, wave, lane);
#endif
        SEAM(7); }
    if (IN(8)) { pg8::Gemm g{XN, (const bf16*)(ws + WS_WO), M, D, D, D}; pg8::TailOrder S; S.init(D, D, G, cv); S.base.xs = pg8::XSync{XS_CNT(8), xs_nloc, XS_ON ? 3 : 0};
        pg8::EpiF32 E{(bf16*)(ws + WS_F), D, (float*)(ws + WS_SLAB), SLAB_FLOATS, MP};
        pg8::gemm_phase<pg8::EpiF32, pg8::TailOrder, PG8_ALIGN, PG8_SP2>(lds + RING_OFF, g, S, E);
#if defined(REP_PHASE) && REP_PHASE == 8
        xcd_barrier(bar); pg8::gemm_phase<pg8::EpiF32, pg8::TailOrder, PG8_ALIGN, PG8_SP2>(lds + RING_OFF, g, S, E);
#endif
        SEAM(8); }
    if (IN(9)) { thin_rows<2>(args, gw, ngw, lane); SEAM(9); }
    if (IN(10)) { pg8::Gemm g{(const bf16*)(ws + WS_XR), (const bf16*)(ws + WS_WGU2), M, 2 * DFF, D, D};   pg8::StaticOrder S; S.init(M, 2 * DFF, D, G, cv); S.xs = pg8::XSync{XS_CNT(10), xs_nloc, XS_ON ? S.nwg / G : 0};
        pg8::EpiSwiglu E{HID, DFF, (const float*)(ws + WS_RSTD) + 2 * M};
        pg8::gemm_phase<pg8::EpiSwiglu, pg8::StaticOrder, PG8_ALIGN, PG8_SP2>(lds + RING_OFF, g, S, E);
#if !defined(NO_TAIL_CONVERT)
        convert_queue(args, 10, ITB_DN2, IT_DN, lds, wave, lane);
#endif
        SEAM(10); }
    if (IN(11)) { pg8::Gemm g{HID, (const bf16*)(ws + WS_WD2), M, D, DFF, DFF}; pg8::TailOrder S; S.init(D, DFF, G, cv); S.base.xs = pg8::XSync{XS_CNT(11), xs_nloc, XS_ON ? 3 : 0};
        pg8::EpiF32 E{(bf16*)(ws + WS_F), D, (float*)(ws + WS_SLAB), SLAB_FLOATS, MP};
        pg8::gemm_phase<pg8::EpiF32, pg8::TailOrder, PG8_ALIGN, PG8_SP2>(lds + RING_OFF, g, S, E); SEAM(11); }
    if (IN(12)) { thin_rows<3>(args, gw, ngw, lane); }
#if defined(CLKPROBE)
    if (bx == 0 && tid == 0 && cp_delay != 0ull) { const unsigned long long s0 = __builtin_amdgcn_s_memrealtime(); while (__builtin_amdgcn_s_memrealtime() - s0 < cp_delay) __builtin_amdgcn_s_sleep(8); }
#endif
#undef IN
#undef BOTH
#undef SEAM
}

extern "C" void kernel_launch(void* const* d_in, const int* in_sizes, int n_in, void* d_out, int out_size, void* d_ws, size_t ws_size, hipStream_t stream) {
    static int grid = 0;
    if (grid == 0) {
        if (n_in != 39 || in_sizes[0] != MP * D || out_size != (int)O_END || ws_size < WS_END) { fprintf(stderr, "kernel_launch: unexpected shapes (n_in %d, in0 %d, out %d, ws %zu); nothing launched\n", n_in, n_in > 0 ? in_sizes[0] : -1, out_size, ws_size); grid = -1; return; }
        int dev = 0, cus = 0, per_cu = 0;
        if (hipGetDevice(&dev) != hipSuccess || hipDeviceGetAttribute(&cus, hipDeviceAttributeMultiprocessorCount, dev) != hipSuccess) { grid = -1; return; }
        if (hipFuncSetAttribute((const void*)hawk_fwd, hipFuncAttributeMaxDynamicSharedMemorySize, LDS_BYTES) != hipSuccess) { fprintf(stderr, "kernel_launch: hipFuncSetAttribute failed\n"); grid = -1; return; }
        if (hipOccupancyMaxActiveBlocksPerMultiprocessor(&per_cu, (const void*)hawk_fwd, NWAVES * 64, LDS_BYTES) != hipSuccess || per_cu < 1)
            fprintf(stderr, "kernel_launch: note: occupancy query reports %d workgroups per CU\n", per_cu);
        (void)hipGetLastError();
        grid = cus;
    }
    if (grid < 0) return;
    if (hipMemsetAsync((char*)d_ws + WS_CTL, 0, CTL_ZERO_BYTES, stream) != hipSuccess) return;
    Args a{};
    for (int i = 0; i < 39; ++i) a.in[i] = (const float*)d_in[i];
    a.out = (float*)d_out; a.ws = (unsigned char*)d_ws;
    static_assert(N_LAUNCHES == 1 || N_LAUNCHES == N_PHASES, "MK_N_LAUNCHES: 1 or one launch per phase");
    for (int li = 0; li < N_LAUNCHES; ++li) {
        a.ph_lo = (N_LAUNCHES == 1) ? 0 : li; a.ph_hi = (N_LAUNCHES == 1) ? N_PHASES : li + 1; a.li = li; a.pad = 0;
        hipLaunchKernelGGL(hawk_fwd, dim3(grid), dim3(NWAVES * 64), LDS_BYTES, stream, a);
        const hipError_t le = hipPeekAtLastError();
        if (le != hipSuccess) { fprintf(stderr, "kernel_launch: launch %d failed: %s\n", li, hipGetErrorName(le)); break; }
    }
}
```

```cpp
#define NO_VIRT_C 1
#define EPI_NT 1
#define STREAM_NT 1
#define CONV_NT 1
#define LRU64 1
#define S5_SPREAD 1
#define S5_CONV 1
#define MK_GU2_N5 20000
#define SWIGLU_FOLD 1
#define P0_NT 1
#include <hip/hip_runtime.h>
#include <cstdio>
#include <cstdint>
namespace pg8 {
#define PG8_LAS __attribute__((address_space(3)))
typedef unsigned short bf16_t;
typedef short bf16x8 __attribute__((ext_vector_type(8)));
typedef float f32x4 __attribute__((ext_vector_type(4)));
typedef unsigned u32x4 __attribute__((ext_vector_type(4)));
constexpr int BM = 256, BK = 64, HALF = 128, HTB = HALF * BK * 2  , STAGE_BYTES = 8 * HTB, NXCD = 8,
#ifdef MK_WGM
    WGM = MK_WGM;
#else
    WGM = 8;
#endif

__host__ __device__ __forceinline__ int lds_byte(int r, int c) { const int st = (r >> 4) * 2 + (c >> 5), rr = r & 15, cc = c & 31, ob = rr * 64 + cc * 2; return st * 1024 + (ob ^ (((ob >> 9) & 1) << 5)); }
__host__ __device__ __forceinline__ void stage_rc(int b, int& R, int& C) { const int st = b / 1024, sb = b % 1024, swz = sb ^ (((sb >> 9) & 1) << 5); R = (st >> 1) * 16 + swz / 64; C = (st & 1) * 32 + (swz % 64) / 2; }
__host__ __device__ __forceinline__ int perm32(int rho) { const int n = rho >> 4, i = rho & 15; return 8 * (i >> 2) + 4 * n + (i & 3); }

struct Unit { int pm, pn, seg, k0, nt, slab, round; };
struct Gemm { const bf16_t* A; const bf16_t* Bt; int M, N, K, ld; };

struct XSync {
    unsigned* cnt; unsigned nloc; int nrounds;
    __device__ __forceinline__ void wait(int round) const {
        if (nloc == 0u || round < 1 || round >= nrounds) return;
        if (threadIdx.x < 64) {
            if (threadIdx.x == 0) (void)__hip_atomic_fetch_add(cnt, 1u, __ATOMIC_RELAXED, __HIP_MEMORY_SCOPE_AGENT);
            const unsigned target = (unsigned)round * nloc; unsigned sp = 0;
            while ((unsigned)__builtin_amdgcn_readfirstlane(__hip_atomic_load(cnt, __ATOMIC_RELAXED, __HIP_MEMORY_SCOPE_AGENT)) < target) { __builtin_amdgcn_s_sleep(1); if (++sp > 200000u) break; }
        }
        asm volatile("" ::: "memory"); __builtin_amdgcn_s_barrier(); asm volatile("" ::: "memory");
    }
};
struct StaticOrder {
    XSync xs;
    int nM, nN, nwg, G, c, ntk;
    __host__ __device__ __forceinline__ void init(int M, int N, int K, int G_, int c_) { nM = M / BM; nN = N / BM; nwg = nM * nN; G = G_; c = c_; ntk = K / BK; }
    __host__ __device__ __forceinline__ bool next(int i, Unit& u) const {
        const long L = (long)i * G + c; if (L >= nwg) return false;
        int wgid = (int)L; { const int q = nwg / NXCD, r = nwg % NXCD, xcd = wgid % NXCD, off = wgid / NXCD; wgid = (xcd < r ? xcd * (q + 1) : r * (q + 1) + (xcd - r) * q) + off; }
        const int nig = WGM * nN, gid = wgid / nig, fm = gid * WGM, gsz = (nM - fm) < WGM ? (nM - fm) : WGM;
        u.pm = fm + ((wgid % nig) % gsz); u.pn = (wgid % nig) / gsz; u.seg = 0; u.k0 = 0; u.nt = ntk; u.slab = 0; u.round = i; return true;
    }
    __device__ __forceinline__ void a_ready(const Unit& u) const { xs.wait(u.round); }
    __device__ __forceinline__ void done(const Unit&) const {}
};
struct SegOrder : StaticOrder {
    __host__ __device__ __forceinline__ bool next(int i, Unit& u) const { const bool ok = StaticOrder::next(i >> 1, u); u.seg = i & 1; u.nt = ntk >> 1; u.k0 = (i & 1) * (ntk >> 1); return ok; }
    __device__ __forceinline__ void a_ready(const Unit& u) const { if (u.seg == 0) xs.wait(u.round); }
};
struct TailOrder {
    StaticOrder base; int c, ntk;
    __host__ __device__ __forceinline__ void init(int N, int K, int G_, int c_) { base.init(32 * BM, N, K, G_, c_); c = c_; ntk = K / BK; }
    __host__ __device__ __forceinline__ bool next(int i, Unit& u) const {
        const bool full = i < 2; Unit b; const bool okb = base.next(full ? i : 0, b);
        const int x = c & 7, j = c >> 3, q = x & 3;
        const int qa = ((ntk >> 2) + 1) & ~1, qb = (ntk - 2 * qa) >> 1;
        u.pm = full ? b.pm : 32 + (j >> 3); u.pn = full ? b.pn : 8 * (x >> 2) + (j & 7); u.seg = 0; u.slab = full ? 0 : q + 1;
        u.k0 = full ? 0 : (q < 2 ? q * qa : 2 * qa + (q - 2) * qb); u.nt = full ? ntk : (q < 2 ? qa : qb); u.round = i;
        return full ? okb : (i == 2 && base.G == 256 && base.nN == 16);
    }
    __device__ __forceinline__ void a_ready(const Unit& u) const { base.xs.wait(u.round); }
    __device__ __forceinline__ void done(const Unit&) const {}
};

typedef float cvt_f32x2_t __attribute__((ext_vector_type(2)));
typedef __bf16 cvt_bf16x2_t __attribute__((ext_vector_type(2)));
__device__ __forceinline__ unsigned cvt_pk_bf16(float lo, float hi) { const cvt_f32x2_t v = {lo, hi}; const cvt_bf16x2_t b = __builtin_convertvector(v, cvt_bf16x2_t); return __builtin_bit_cast(unsigned, b); }
typedef float f32x2 __attribute__((ext_vector_type(2)));
__device__ __forceinline__ f32x2 gelu_pk(f32x2 v) {
    const f32x2 av = __builtin_elementwise_abs(v), d = av * 0.2316418882f + 1.0f;
    f32x2 t; t.x = __builtin_amdgcn_rcpf(d.x); t.y = __builtin_amdgcn_rcpf(d.y);
    f32x2 q = t * 0.5307027145f + (-0.7265760135f); q = q * t + 0.7107068705f; q = q * t + (-0.142248368f); q = q * t + 0.127414796f; q = q * t;
    const f32x2 s = (v * v) * (-0.72134752044f);
    f32x2 e; e.x = __builtin_amdgcn_exp2f(s.x); e.y = __builtin_amdgcn_exp2f(s.y);
    const f32x2 m = v * (q * e), r = v - m;
    f32x2 o; o.x = v.x < 0.f ? m.x : r.x; o.y = v.y < 0.f ? m.y : r.y; return o;
}

#if defined(EPI_LD_NT)
#define EPI_LD(P) __builtin_nontemporal_load(P)
#else
#define EPI_LD(P) (*(P))
#endif
#if defined(EPI_NT) && !defined(F_CACHED)
#define EPI_ST_F(TY, ADDR, VAL) __builtin_nontemporal_store((VAL), (TY*)(ADDR))
#else
#define EPI_ST_F(TY, ADDR, VAL) (*(TY*)(ADDR) = (VAL))
#endif
#if defined(EPI_NT) && !defined(XA_CACHED)
#define EPI_ST_XA(TY, ADDR, VAL) __builtin_nontemporal_store((VAL), (TY*)(ADDR))
#else
#define EPI_ST_XA(TY, ADDR, VAL) (*(TY*)(ADDR) = (VAL))
#endif
#if defined(EPI_NT) && !defined(HID_CACHED)
#define EPI_ST_H(TY, ADDR, VAL) __builtin_nontemporal_store((VAL), (TY*)(ADDR))
#else
#define EPI_ST_H(TY, ADDR, VAL) (*(TY*)(ADDR) = (VAL))
#endif
#if defined(EPI_NT)
#define EPI_ST(TY, ADDR, VAL) __builtin_nontemporal_store((VAL), (TY*)(ADDR))
#else
#define EPI_ST(TY, ADDR, VAL) (*(TY*)(ADDR) = (VAL))
#endif

__device__ __forceinline__ float bf_lo(unsigned w) { return __uint_as_float(w << 16); }
__device__ __forceinline__ float bf_hi(unsigned w) { return __uint_as_float(w & 0xffff0000u); }
__device__ __forceinline__ float fast_sigmoid(float x) { return __builtin_amdgcn_rcpf(1.0f + __builtin_amdgcn_exp2f(-1.4426950408889634f * x)); }
__device__ __forceinline__ float silu_f(float x) { return x * fast_sigmoid(x); }
__device__ __forceinline__ float gelu_tanh_f(float x) { const float z = 1.5957691216057308f * (x + 0.044715f * x * x * x); return x * fast_sigmoid(z); }
__device__ __forceinline__ u32x4 pack8(const f32x4& v0, const f32x4& v1) { u32x4 w; w.x = cvt_pk_bf16(v0[0], v0[1]); w.y = cvt_pk_bf16(v0[2], v0[3]); w.z = cvt_pk_bf16(v1[0], v1[1]); w.w = cvt_pk_bf16(v1[2], v1[3]); return w; }

__device__ __forceinline__ void scale_rows(f32x4 (&acc)[2][2][4][2], const float* RS, int row0) {
#pragma unroll
    for (int ai = 0; ai < 2; ++ai)
#pragma unroll
        for (int m = 0; m < 4; ++m) { const float s = RS[row0 + ai * HALF + m * 16];
#pragma unroll
            for (int bj = 0; bj < 2; ++bj)
#pragma unroll
                for (int n = 0; n < 2; ++n) acc[ai][bj][m][n] = acc[ai][bj][m][n] * s; }
}
struct EpiSwiglu {
    static constexpr bool PERM = true, AFTER_DRAIN = false, SEG = false;
    bf16_t* O; int ldc; const float* RS;
    __device__ __forceinline__ void operator()(f32x4 (&acc)[2][2][4][2], const Unit& u, int wr, int wc, int fr, int fq) const {
        const int row0 = u.pm * BM + wr * 64 + fr, col0 = u.pn * HALF + wc * 32 + 8 * fq;
#if defined(SWIGLU_FOLD)
#pragma unroll
        for (int ai = 0; ai < 2; ++ai)
#pragma unroll
            for (int m = 0; m < 4; ++m) { bf16_t* rowp = O + (size_t)(row0 + ai * HALF + m * 16) * ldc + col0;
                const float sr = RS[row0 + ai * HALF + m * 16], c1 = -1.4426950408889634f * sr, s2 = sr * sr;
                f32x4 v0, v1;
#pragma unroll
                for (int j = 0; j < 4; ++j) {
                    const float g0 = acc[ai][0][m][0][j], g1 = acc[ai][0][m][1][j];
                    v0[j] = (g0 * acc[ai][1][m][0][j]) * (s2 * __builtin_amdgcn_rcpf(1.0f + __builtin_amdgcn_exp2f(c1 * g0)));
                    v1[j] = (g1 * acc[ai][1][m][1][j]) * (s2 * __builtin_amdgcn_rcpf(1.0f + __builtin_amdgcn_exp2f(c1 * g1))); }
                EPI_ST_H(u32x4, rowp, pack8(v0, v1)); }
#else
        scale_rows(acc, RS, row0);
#pragma unroll
        for (int ai = 0; ai < 2; ++ai)
#pragma unroll
            for (int m = 0; m < 4; ++m) { bf16_t* rowp = O + (size_t)(row0 + ai * HALF + m * 16) * ldc + col0;
                f32x4 v0, v1;
#pragma unroll
                for (int j = 0; j < 4; ++j) { v0[j] = silu_f(acc[ai][0][m][0][j]) * acc[ai][1][m][0][j]; v1[j] = silu_f(acc[ai][0][m][1][j]) * acc[ai][1][m][1][j]; }
                EPI_ST_H(u32x4, rowp, pack8(v0, v1)); }
#endif
    }
};
struct EpiF32 {
    static constexpr bool PERM = true, AFTER_DRAIN = false, SEG = false;
    bf16_t* C; int ldc; float* S; size_t slab_stride; int slab_row0;
    __device__ __forceinline__ void operator()(f32x4 (&acc)[2][2][4][2], const Unit& u, int wr, int wc, int fr, int fq) const {
        const int row0 = u.pm * BM + wr * 64 + fr, col0 = u.pn * BM + wc * 32 + 8 * fq;
        if (u.slab == 0) {
#pragma unroll
            for (int ai = 0; ai < 2; ++ai)
#pragma unroll
                for (int m = 0; m < 4; ++m) { bf16_t* rowp = C + (size_t)(row0 + ai * HALF + m * 16) * ldc + col0;
#pragma unroll
                    for (int bj = 0; bj < 2; ++bj) EPI_ST_F(u32x4, (rowp + bj * HALF), pack8(acc[ai][bj][m][0], acc[ai][bj][m][1])); }
        } else {
#if defined(SLAB_F32)
            float* base = S + (size_t)(u.slab - 1) * slab_stride - (size_t)slab_row0 * ldc;
#pragma unroll
            for (int ai = 0; ai < 2; ++ai)
#pragma unroll
                for (int m = 0; m < 4; ++m) { float* rowp = base + (size_t)(row0 + ai * HALF + m * 16) * ldc + col0;
#pragma unroll
                    for (int bj = 0; bj < 2; ++bj)
#pragma unroll
                        for (int n = 0; n < 2; ++n) EPI_ST_F(f32x4, (rowp + bj * HALF + n * 4), acc[ai][bj][m][n]); }
#else
            bf16_t* base = (bf16_t*)S + (size_t)(u.slab - 1) * slab_stride - (size_t)slab_row0 * ldc;
#pragma unroll
            for (int ai = 0; ai < 2; ++ai)
#pragma unroll
                for (int m = 0; m < 4; ++m) { bf16_t* rowp = base + (size_t)(row0 + ai * HALF + m * 16) * ldc + col0;
#pragma unroll
                    for (int bj = 0; bj < 2; ++bj) EPI_ST_F(u32x4, (rowp + bj * HALF), pack8(acc[ai][bj][m][0], acc[ai][bj][m][1])); }
#endif
        }
    }
};
struct EpiWin {
    static constexpr bool PERM = true, AFTER_DRAIN = false, SEG = false;
    float* XA; bf16_t* GA; bf16_t* XB; bf16_t* G; const float* RS;
    __device__ __forceinline__ void operator()(f32x4 (&acc)[2][2][4][2], const Unit& u, int wr, int wc, int fr, int fq) const {
        const int row0 = u.pm * BM + wr * 64 + fr, cw = wc * 32 + 8 * fq;
        scale_rows(acc, RS, row0);
        if (u.pn < 8) {
            const int col0 = u.pn * BM + cw;
#pragma unroll
            for (int ai = 0; ai < 2; ++ai)
#pragma unroll
#if defined(XA_BF16)
                for (int m = 0; m < 4; ++m) { bf16_t* rowp = (bf16_t*)XA + (size_t)(row0 + ai * HALF + m * 16) * 2048 + col0;
#pragma unroll
                    for (int bj = 0; bj < 2; ++bj) EPI_ST(u32x4, (rowp + bj * HALF), pack8(acc[ai][bj][m][0], acc[ai][bj][m][1])); }
#else
                for (int m = 0; m < 4; ++m) { float* rowp = XA + (size_t)(row0 + ai * HALF + m * 16) * 2048 + col0;
#pragma unroll
                    for (int bj = 0; bj < 2; ++bj)
#pragma unroll
                        for (int n = 0; n < 2; ++n) EPI_ST_XA(f32x4, (rowp + bj * HALF + n * 4), acc[ai][bj][m][n]); }
#endif
        } else if (u.pn < 16) {
            const int col0 = (u.pn - 8) * BM + cw;
#pragma unroll
            for (int ai = 0; ai < 2; ++ai)
#pragma unroll
                for (int m = 0; m < 4; ++m) { bf16_t* rowp = GA + (size_t)(row0 + ai * HALF + m * 16) * 2048 + col0;
#pragma unroll
                    for (int bj = 0; bj < 2; ++bj) { f32x4 v0, v1;
#pragma unroll
                        for (int j = 0; j < 4; ++j) { v0[j] = gelu_tanh_f(acc[ai][bj][m][0][j]); v1[j] = gelu_tanh_f(acc[ai][bj][m][1][j]); }
                        EPI_ST(u32x4, (rowp + bj * HALF), pack8(v0, v1)); } }
        } else if (u.pn < 24) {
            const int col0 = (u.pn - 16) * BM + cw;
#pragma unroll
            for (int ai = 0; ai < 2; ++ai)
#pragma unroll
                for (int m = 0; m < 4; ++m) { bf16_t* rowp = XB + (size_t)(row0 + ai * HALF + m * 16) * 2048 + col0;
#pragma unroll
                    for (int bj = 0; bj < 2; ++bj) EPI_ST(u32x4, (rowp + bj * HALF), pack8(acc[ai][bj][m][0], acc[ai][bj][m][1])); }
        } else {
            const int col0 = (u.pn - 24) * BM + cw;
#pragma unroll
            for (int ai = 0; ai < 2; ++ai)
#pragma unroll
                for (int m = 0; m < 4; ++m) { bf16_t* rowp = G + (size_t)(row0 + ai * HALF + m * 16) * 8192 + col0;
#pragma unroll
                    for (int bj = 0; bj < 2; ++bj) { f32x4 v0, v1;
#pragma unroll
                        for (int j = 0; j < 4; ++j) { v0[j] = fast_sigmoid(acc[ai][bj][m][0][j]); v1[j] = fast_sigmoid(acc[ai][bj][m][1][j]); }
                        EPI_ST(u32x4, (rowp + bj * HALF), pack8(v0, v1)); } }
        }
    }
};
struct EpiGlu {
    static constexpr bool PERM = true, AFTER_DRAIN = false, SEG = false;
    const bf16_t* G2; const float* bias; bf16_t* O;
    __device__ __forceinline__ void operator()(f32x4 (&acc)[2][2][4][2], const Unit& u, int wr, int wc, int fr, int fq) const {
        const int row0 = u.pm * BM + wr * 64 + fr, col0 = u.pn * BM + wc * 32 + 8 * fq;
        f32x4 bv[2][2];
#pragma unroll
        for (int bj = 0; bj < 2; ++bj)
#pragma unroll
            for (int n = 0; n < 2; ++n) bv[bj][n] = *(const f32x4*)(bias + col0 + bj * HALF + 4 * n);
#pragma unroll
        for (int ai = 0; ai < 2; ++ai)
#pragma unroll
            for (int m = 0; m < 4; ++m) { const size_t r = (size_t)(row0 + ai * HALF + m * 16);
#pragma unroll
                for (int bj = 0; bj < 2; ++bj) { const u32x4 gw = *(const u32x4*)(G2 + r * 2048 + col0 + bj * HALF);
                    const f32x4 a0 = acc[ai][bj][m][0] + bv[bj][0], a1 = acc[ai][bj][m][1] + bv[bj][1]; f32x4 v0, v1;
                    v0[0] = bf_lo(gw.x) * fast_sigmoid(a0[0]); v0[1] = bf_hi(gw.x) * fast_sigmoid(a0[1]); v0[2] = bf_lo(gw.y) * fast_sigmoid(a0[2]); v0[3] = bf_hi(gw.y) * fast_sigmoid(a0[3]);
                    v1[0] = bf_lo(gw.z) * fast_sigmoid(a1[0]); v1[1] = bf_hi(gw.z) * fast_sigmoid(a1[1]); v1[2] = bf_lo(gw.w) * fast_sigmoid(a1[2]); v1[3] = bf_hi(gw.w) * fast_sigmoid(a1[3]);
                    EPI_ST(u32x4, (O + r * 4096 + col0 + bj * HALF), pack8(v0, v1)); } }
    }
};
struct EpiOut {
    static constexpr bool PERM = true, AFTER_DRAIN = false, SEG = true;
    const bf16_t* G; bf16_t* O;
    __device__ __forceinline__ void seg0(f32x4 (&acc)[2][2][4][2], const Unit& u, int wr, int wc, int fr, int fq) const {
        const int row0 = u.pm * BM + wr * 64 + fr, col0 = u.pn * BM + wc * 32 + 8 * fq;
#pragma unroll
        for (int ai = 0; ai < 2; ++ai)
#pragma unroll
            for (int m = 0; m < 4; ++m) { const bf16_t* gp = G + (size_t)(row0 + ai * HALF + m * 16) * 8192 + col0;
#pragma unroll
                for (int bj = 0; bj < 2; ++bj) { const u32x4 a = EPI_LD((const u32x4*)(gp + bj * HALF)), b = EPI_LD((const u32x4*)(gp + 4096 + bj * HALF));
                    f32x4 r0, r1;
                    r0[0] = bf_lo(a.x) * __builtin_amdgcn_rcpf(fmaxf(bf_lo(b.x), 1e-30f)); r0[1] = bf_hi(a.x) * __builtin_amdgcn_rcpf(fmaxf(bf_hi(b.x), 1e-30f));
                    r0[2] = bf_lo(a.y) * __builtin_amdgcn_rcpf(fmaxf(bf_lo(b.y), 1e-30f)); r0[3] = bf_hi(a.y) * __builtin_amdgcn_rcpf(fmaxf(bf_hi(b.y), 1e-30f));
                    r1[0] = bf_lo(a.z) * __builtin_amdgcn_rcpf(fmaxf(bf_lo(b.z), 1e-30f)); r1[1] = bf_hi(a.z) * __builtin_amdgcn_rcpf(fmaxf(bf_hi(b.z), 1e-30f));
                    r1[2] = bf_lo(a.w) * __builtin_amdgcn_rcpf(fmaxf(bf_lo(b.w), 1e-30f)); r1[3] = bf_hi(a.w) * __builtin_amdgcn_rcpf(fmaxf(bf_hi(b.w), 1e-30f));
                    acc[ai][bj][m][0] = acc[ai][bj][m][0] * r0; acc[ai][bj][m][1] = acc[ai][bj][m][1] * r1; }
                asm volatile("" ::: "memory"); }
    }
    __device__ __forceinline__ void operator()(f32x4 (&acc)[2][2][4][2], const Unit& u, int wr, int wc, int fr, int fq) const { if (u.seg == 0) seg0(acc, u, wr, wc, fr, fq); else seg1(acc, u, wr, wc, fr, fq); }
    __device__ __forceinline__ void seg1(const f32x4 (&acc)[2][2][4][2], const Unit& u, int wr, int wc, int fr, int fq) const {
        const int row0 = u.pm * BM + wr * 64 + fr, col0 = u.pn * BM + wc * 32 + 8 * fq;
#pragma unroll
        for (int ai = 0; ai < 2; ++ai)
#pragma unroll
            for (int m = 0; m < 4; ++m) { const size_t r = (size_t)(row0 + ai * HALF + m * 16);
#pragma unroll
                for (int bj = 0; bj < 2; ++bj) { const u32x4 b = EPI_LD((const u32x4*)(G + r * 8192 + 4096 + col0 + bj * HALF));
                    f32x4 g0, g1;
                    g0[0] = fmaxf(bf_lo(b.x), 1e-30f); g0[1] = fmaxf(bf_hi(b.x), 1e-30f); g0[2] = fmaxf(bf_lo(b.y), 1e-30f); g0[3] = fmaxf(bf_hi(b.y), 1e-30f);
                    g1[0] = fmaxf(bf_lo(b.z), 1e-30f); g1[1] = fmaxf(bf_hi(b.z), 1e-30f); g1[2] = fmaxf(bf_lo(b.w), 1e-30f); g1[3] = fmaxf(bf_hi(b.w), 1e-30f);
                    EPI_ST(u32x4, (O + r * 4096 + col0 + bj * HALF), pack8(acc[ai][bj][m][0] * g0, acc[ai][bj][m][1] * g1)); } }
    }
};

template <class Epi, class Sched, bool ALIGN_EPI = false, bool SP2 = false>
__device__ __forceinline__ void gemm_phase(PG8_LAS unsigned char* lds, const Gemm g, const Sched& S, const Epi& E) {
    const int tid = threadIdx.x, wid = __builtin_amdgcn_readfirstlane(tid >> 6), lane = tid & 63, wr = wid >> 2, wc = wid & 3, fr = lane & 15, fq = lane >> 4;
    const int LD = g.ld;
    unsigned voffA[2], voffB[2];
#pragma unroll
    for (int i = 0; i < 2; ++i) { int R, C; stage_rc(tid * 16 + i * 8192, R, C); const int Rb = Epi::PERM ? ((R & ~31) + perm32(R & 31)) : R;
        voffA[i] = (unsigned)(R * LD + C) * 2u; voffB[i] = (unsigned)(Rb * LD + C) * 2u; }
    const size_t kstep = (size_t)(BK * 2);
    const size_t hstep = (size_t)HALF * LD * 2;
    const size_t tstep = 2 * hstep;
    const unsigned ldsw = (unsigned)wid * 1024u;
    const int aoff = lds_byte(wr * 64 + fr, fq * 8), boff = lds_byte(wc * 32 + fr, fq * 8);
#define PG8_SA(b, h) (((b) * 2 + (h)) * HTB)
#define PG8_SB(b, h) ((4 + (b) * 2 + (h)) * HTB)
#if defined(DMA_BUF)
    const __amdgpu_buffer_rsrc_t sr_voffA = __builtin_amdgcn_make_buffer_rsrc((void*)g.A, (short)0, (int)0x7fffffff, 0x00020000);
    const __amdgpu_buffer_rsrc_t sr_voffB = __builtin_amdgcn_make_buffer_rsrc((void*)g.Bt, (short)0, (int)0x7fffffff, 0x00020000);
    const char* const base_voffA = (const char*)g.A; const char* const base_voffB = (const char*)g.Bt;
    const unsigned ldsm0 = __builtin_amdgcn_readfirstlane((unsigned)(size_t)lds + ldsw);
#define PG8_STAGE(bufoff, gbase, voff) do { const unsigned _so = __builtin_amdgcn_readfirstlane((unsigned)((const char*)(gbase) - base_##voff)); _Pragma("unroll") for (int _i = 0; _i < 2; ++_i) \
        asm volatile("s_mov_b32 m0, %0\n\ts_nop 0\n\tbuffer_load_dwordx4 %1, %2, %3 offen lds" :: "s"(ldsm0 + (unsigned)(bufoff) + (unsigned)_i * 8192u), "v"((voff)[_i]), "s"(sr_##voff), "s"(_so) : "m0", "memory"); } while (0)
#else
#define PG8_STAGE(bufoff, gbase, voff) do { _Pragma("unroll") for (int _i = 0; _i < 2; ++_i) \
        __builtin_amdgcn_global_load_lds((const unsigned*)((const char*)(gbase) + (voff)[_i]), (PG8_LAS unsigned*)(lds + (bufoff) + ldsw + _i * 8192), 16, 0, 0); } while (0)
#endif
#define PG8_LDA(dst, b, h) do { _Pragma("unroll") for (int m = 0; m < 4; ++m) _Pragma("unroll") for (int k = 0; k < 2; ++k) dst[m][k] = *(const PG8_LAS bf16x8*)(lds + PG8_SA(b, h) + aoff + m * 2048 + k * 1024); } while (0)
#define PG8_LDB(dst, b, h) do { _Pragma("unroll") for (int n = 0; n < 2; ++n) _Pragma("unroll") for (int k = 0; k < 2; ++k) dst[n][k] = *(const PG8_LAS bf16x8*)(lds + PG8_SB(b, h) + boff + n * 2048 + k * 1024); } while (0)
#define PG8_MMA(ai, bj, At, Bt) do { __builtin_amdgcn_s_setprio(1); _Pragma("unroll") for (int m = 0; m < 4; ++m) _Pragma("unroll") for (int n = 0; n < 2; ++n) _Pragma("unroll") for (int k = 0; k < 2; ++k) \
        acc[ai][bj][m][n] = __builtin_amdgcn_mfma_f32_16x16x32_bf16(Bt[n][k], At[m][k], acc[ai][bj][m][n], 0, 0, 0); __builtin_amdgcn_s_setprio(0); } while (0)
#define PG8_WAIT_V(n) asm volatile("s_waitcnt vmcnt(" #n ")" ::: "memory")
#define PG8_WAIT_L(n) asm volatile("s_waitcnt lgkmcnt(" #n ")" ::: "memory")
#define PG8_BAR __builtin_amdgcn_s_barrier()
#define PG8_SCHED __builtin_amdgcn_sched_barrier(0)
    Unit cur, nxt; int ui = 0;
    if (!S.next(0, cur)) return;
    f32x4 acc[2][2][4][2];
#pragma unroll
    for (int a = 0; a < 2; ++a)
#pragma unroll
        for (int b = 0; b < 2; ++b)
#pragma unroll
            for (int m = 0; m < 4; ++m)
#pragma unroll
                for (int n = 0; n < 2; ++n) acc[a][b][m][n] = (f32x4){0.f, 0.f, 0.f, 0.f};
    bf16x8 At[4][2], B0[2][2], B1[2][2];
    const char* cA = (const char*)g.A + (size_t)cur.pm * tstep + (size_t)cur.k0 * kstep; const char* cB = (const char*)g.Bt + (size_t)cur.pn * tstep + (size_t)cur.k0 * kstep;
    S.a_ready(cur);
    if constexpr (SP2) {
        PG8_STAGE(PG8_SB(0, 0), cB, voffB); PG8_STAGE(PG8_SB(0, 1), cB + hstep, voffB); PG8_STAGE(PG8_SA(0, 0), cA, voffA); PG8_STAGE(PG8_SA(0, 1), cA + hstep, voffA);
        if (wr == 1) PG8_BAR;
        PG8_WAIT_V(2); PG8_BAR;
        PG8_STAGE(PG8_SB(1, 0), cB + kstep, voffB); PG8_STAGE(PG8_SA(1, 0), cA + kstep, voffA); PG8_STAGE(PG8_SB(1, 1), cB + hstep + kstep, voffB);
        PG8_WAIT_V(6); PG8_BAR;
    } else {
        PG8_STAGE(PG8_SB(0, 0), cB, voffB); PG8_STAGE(PG8_SA(0, 0), cA, voffA); PG8_STAGE(PG8_SB(0, 1), cB + hstep, voffB); PG8_STAGE(PG8_SA(0, 1), cA + hstep, voffA);
        if (wr == 1) PG8_BAR;
        PG8_WAIT_V(4); PG8_BAR;
        PG8_STAGE(PG8_SB(1, 0), cB + kstep, voffB); PG8_STAGE(PG8_SA(1, 0), cA + kstep, voffA); PG8_STAGE(PG8_SB(1, 1), cB + hstep + kstep, voffB);
        PG8_WAIT_V(6); PG8_BAR;
    }
    for (;;) {
        const bool has_next = S.next(ui + 1, nxt);
        const char* nA = has_next ? (const char*)g.A + (size_t)nxt.pm * tstep + (size_t)nxt.k0 * kstep : cA; const char* nB = has_next ? (const char*)g.Bt + (size_t)nxt.pn * tstep + (size_t)nxt.k0 * kstep : cB;
        const int nt = cur.nt;
        for (int t = 0; t < nt; t += 2) {
            const bool last = (t == nt - 2);
            const char* a1 = cA + (size_t)(t + 1) * kstep;
            const char* a2 = last ? nA : cA + (size_t)(t + 2) * kstep; const char* b2 = last ? nB : cB + (size_t)(t + 2) * kstep;
            const char* a3 = a2 + kstep; const char* b3 = b2 + kstep;
            if (last && has_next) S.a_ready(nxt);
            if constexpr (SP2) {
            PG8_LDB(B0, 0, 0); PG8_LDB(B1, 0, 1); PG8_SCHED; PG8_LDA(At, 0, 0); PG8_STAGE(PG8_SA(1, 1), a1 + hstep, voffA);
            PG8_WAIT_V(8); PG8_WAIT_L(0); PG8_BAR; PG8_MMA(0, 0, At, B0); PG8_MMA(0, 1, At, B1); PG8_BAR; PG8_SCHED;
            PG8_LDA(At, 0, 1); PG8_STAGE(PG8_SB(0, 0), b2, voffB); PG8_STAGE(PG8_SB(0, 1), b2 + hstep, voffB); PG8_STAGE(PG8_SA(0, 0), a2, voffA);
            PG8_WAIT_V(8); PG8_WAIT_L(0); PG8_BAR; PG8_MMA(1, 0, At, B0); PG8_MMA(1, 1, At, B1); PG8_BAR; PG8_SCHED;
            PG8_LDB(B0, 1, 0); PG8_LDB(B1, 1, 1); PG8_SCHED; PG8_LDA(At, 1, 0); PG8_STAGE(PG8_SA(0, 1), a2 + hstep, voffA);
            PG8_WAIT_V(8); PG8_WAIT_L(0); PG8_BAR; PG8_MMA(0, 0, At, B0); PG8_MMA(0, 1, At, B1); PG8_BAR; PG8_SCHED;
            PG8_LDA(At, 1, 1); PG8_STAGE(PG8_SB(1, 0), b3, voffB); PG8_STAGE(PG8_SB(1, 1), b3 + hstep, voffB); PG8_STAGE(PG8_SA(1, 0), a3, voffA);
            PG8_WAIT_V(8); PG8_WAIT_L(0); PG8_BAR; PG8_MMA(1, 0, At, B0); PG8_MMA(1, 1, At, B1); PG8_BAR; PG8_SCHED;
            } else {
            PG8_LDB(B0, 0, 0); PG8_SCHED; PG8_LDA(At, 0, 0); PG8_STAGE(PG8_SA(1, 1), a1 + hstep, voffA);
            PG8_WAIT_L(8); PG8_BAR; PG8_WAIT_L(0); PG8_MMA(0, 0, At, B0); PG8_BAR; PG8_SCHED;
            PG8_LDB(B1, 0, 1); PG8_STAGE(PG8_SB(0, 0), b2, voffB);
            PG8_BAR; PG8_WAIT_L(0); PG8_MMA(0, 1, At, B1); PG8_BAR;
            PG8_LDA(At, 0, 1); PG8_STAGE(PG8_SA(0, 0), a2, voffA);
            PG8_BAR; PG8_WAIT_L(0); PG8_MMA(1, 0, At, B0); PG8_BAR; PG8_SCHED;
            PG8_STAGE(PG8_SB(0, 1), b2 + hstep, voffB);
            PG8_WAIT_V(6); PG8_BAR; PG8_MMA(1, 1, At, B1); PG8_BAR;
            PG8_LDB(B0, 1, 0); PG8_SCHED; PG8_LDA(At, 1, 0); PG8_STAGE(PG8_SA(0, 1), a2 + hstep, voffA);
            PG8_WAIT_L(8); PG8_BAR; PG8_WAIT_L(0); PG8_MMA(0, 0, At, B0); PG8_BAR; PG8_SCHED;
            PG8_LDB(B1, 1, 1); PG8_STAGE(PG8_SB(1, 0), b3, voffB);
            PG8_BAR; PG8_WAIT_L(0); PG8_MMA(0, 1, At, B1); PG8_BAR;
            PG8_LDA(At, 1, 1); PG8_STAGE(PG8_SA(1, 0), a3, voffA);
            PG8_BAR; PG8_WAIT_L(0); PG8_MMA(1, 0, At, B0); PG8_BAR; PG8_SCHED;
            PG8_STAGE(PG8_SB(1, 1), b3 + hstep, voffB);
            PG8_WAIT_V(6); PG8_BAR; PG8_MMA(1, 1, At, B1); PG8_BAR;
            }
        }
        if constexpr (ALIGN_EPI) { if (wr == 0) PG8_BAR; }
        if constexpr (!Epi::AFTER_DRAIN) { E(acc, cur, wr, wc, fr, fq); S.done(cur); }
        if (!has_next) break;
        if (!Epi::SEG || nxt.seg == 0) {
#pragma unroll
        for (int a = 0; a < 2; ++a)
#pragma unroll
            for (int b = 0; b < 2; ++b)
#pragma unroll
                for (int m = 0; m < 4; ++m)
#pragma unroll
                    for (int n = 0; n < 2; ++n) acc[a][b][m][n] = (f32x4){0.f, 0.f, 0.f, 0.f};
        }
        cur = nxt; cA = nA; cB = nB; ++ui;
        if constexpr (ALIGN_EPI) { if (wr == 1) PG8_BAR; }
    }
    PG8_WAIT_V(0);
    if constexpr (!ALIGN_EPI) { if (wr == 0) PG8_BAR; }
    PG8_BAR;
    if constexpr (Epi::AFTER_DRAIN) { E.fused(acc, cur, wr, wc, fr, fq, lds, wid, lane); S.done(cur); }
#undef PG8_SA
#undef PG8_SB
#undef PG8_STAGE
#undef PG8_LDA
#undef PG8_LDB
#undef PG8_MMA
#undef PG8_WAIT_V
#undef PG8_WAIT_L
#undef PG8_BAR
#undef PG8_SCHED
}
}

#ifndef PG8_SP2
#define PG8_SP2 true
#endif
#ifndef PG8_ALIGN
#define PG8_ALIGN true
#endif

constexpr int NWAVES = 8;
#ifndef MK_N_LAUNCHES
#define MK_N_LAUNCHES 1
#endif
constexpr int N_PHASES = 13;
constexpr int N_LAUNCHES = MK_N_LAUNCHES;

constexpr int D = 4096, DFF = 11008, DLRU = 2048, DSSM = 2048, DIN = 14336;
constexpr int NP = 4, TP = 2048, NS = 128, TS = 8;
constexpr int MP = NP * TP, MS = NS * TS, M = MP + MS;
constexpr int NGRP = 128, SP = 64, SCG = 16;
constexpr float EPS = 1e-6f;

constexpr size_t MiB = 1u << 20;
constexpr size_t WS_CTL = 0, CTL_ZERO_BYTES = 1 * MiB;
constexpr size_t WS_ABAR = 2 * MiB;
constexpr size_t WS_RSTD = WS_ABAR + 256 * 1024;
constexpr size_t WS_ONES = WS_ABAR + 512 * 1024;
constexpr size_t WS_BB = 3 * MiB;
constexpr size_t WS_CC = 4 * MiB;
constexpr size_t WS_WG = 5 * MiB;
constexpr size_t WS_WGU1 = 8 * MiB, WS_WD1 = 180 * MiB, WS_WIN = 266 * MiB, WS_WGLU = 378 * MiB, WS_WOUT = 386 * MiB, WS_WO = 418 * MiB, WS_WGU2 = 450 * MiB, WS_WD2 = 622 * MiB;
constexpr size_t WS_XN = 708 * MiB;
constexpr size_t WS_HID = 780 * MiB;
constexpr size_t WS_XA = WS_HID, WS_GA = WS_HID + 72 * MiB, WS_XB = WS_HID + 108 * MiB, WS_G2 = WS_HID + 144 * MiB;
constexpr size_t WS_F = 974 * MiB;
constexpr size_t WS_G = WS_F;
constexpr size_t WS_YAB = 1118 * MiB, WS_XR = 1190 * MiB, WS_END = 1262 * MiB;
constexpr size_t WS_SLAB = WS_YAB, SLAB_FLOATS = (size_t)MS * D;
static_assert(4 * SLAB_FLOATS * 4 <= (size_t)M * D * 2, "slabs inside YAB");
static_assert(WS_WGU1 + (size_t)2 * DFF * D * 2 <= WS_WD1 && WS_WD1 + (size_t)D * DFF * 2 <= WS_WIN && WS_WIN + (size_t)DIN * D * 2 <= WS_WGLU && WS_WGLU + (size_t)DSSM * DSSM * 2 <= WS_WOUT, "ws map 1");
static_assert(WS_WOUT + (size_t)D * D * 2 <= WS_WO && WS_WO + (size_t)D * D * 2 <= WS_WGU2 && WS_WGU2 + (size_t)2 * DFF * D * 2 <= WS_WD2 && WS_WD2 + (size_t)D * DFF * 2 <= WS_XN, "ws map 2");
static_assert(WS_XN + (size_t)M * D * 2 <= WS_HID && WS_HID + (size_t)M * DFF * 2 <= WS_F && WS_G2 + (size_t)M * DSSM * 2 <= WS_F && WS_F + (size_t)M * D * 4 <= WS_YAB && WS_YAB + (size_t)M * D * 2 <= WS_XR && WS_XR + (size_t)M * D * 2 <= WS_END, "ws map 3");
constexpr int CW_TMO = 0, CW_CODE = 1;
constexpr int CW_XS = 100000;
constexpr int CW_BAR = 4096;

constexpr int RING_OFF = 0, RING_BYTES = 131072;
constexpr int LDSCTL_OFF = RING_BYTES + 2048, MISC_OFF = LDSCTL_OFF + 320;
constexpr int LDS_BYTES = 147456;
static_assert(MISC_OFF + 128 <= LDS_BYTES, "LDS map");

#define GAS __attribute__((address_space(1)))
#define LAS __attribute__((address_space(3)))
typedef unsigned short bf16;
typedef unsigned v4u __attribute__((ext_vector_type(4)));
typedef unsigned v2u __attribute__((ext_vector_type(2)));
typedef float f32x4 __attribute__((ext_vector_type(4)));
typedef float f32x2 __attribute__((ext_vector_type(2)));
typedef short bf16x8 __attribute__((ext_vector_type(8)));
typedef GAS unsigned gu32;
typedef GAS unsigned long long gu64;
#define RLX_AGENT __ATOMIC_RELAXED, __HIP_MEMORY_SCOPE_AGENT
#define LDS_WAIT() asm volatile("s_waitcnt lgkmcnt(0)" ::: "memory")
#define VM_WAIT() asm volatile("s_waitcnt vmcnt(0)" ::: "memory")
__device__ __forceinline__ unsigned f2bf(float f) { unsigned u = __builtin_bit_cast(unsigned, f); return (u + 0x7fffu + ((u >> 16) & 1u)) >> 16; }
__device__ __forceinline__ unsigned pk2(float lo, float hi) { return pg8::cvt_pk_bf16(lo, hi); }
using pg8::bf_lo; using pg8::bf_hi; using pg8::fast_sigmoid; using pg8::gelu_tanh_f;
#define XB_TMO      128
#define XB_XCNT(j)  (256  + 64 * (j))
#define XB_XSUB(j)  (1280 + 64 * (j))
#define XB_XGEN(j)  (2304 + 64 * (j))
#define XB_TOP      3328
#define XB_TOPGEN   3392
#define XCD_BAR_WORDS 3456
#define XB_SPIN_CAP (1u << 18)

__device__ __forceinline__ unsigned xb_ld(unsigned* p)              { return __hip_atomic_load(p, __ATOMIC_RELAXED, __HIP_MEMORY_SCOPE_AGENT); }
__device__ __forceinline__ unsigned xb_add(unsigned* p, unsigned v) { return __hip_atomic_fetch_add(p, v, __ATOMIC_RELAXED, __HIP_MEMORY_SCOPE_AGENT); }
__device__ __forceinline__ unsigned xb_xcc_id() { return (unsigned)__builtin_amdgcn_s_getreg((3 << 11) | 20) & 0xFu; }
#ifndef XB_SLEEP
#define XB_SLEEP 1
#endif
#define XB_SPIN(cond, bar) do { unsigned _sp = 0; while (cond) { __builtin_amdgcn_s_sleep(XB_SLEEP); \
    if ((++_sp & 255u) == 0u) { if (xb_ld(&(bar)[XB_TMO])) break; if (_sp > XB_SPIN_CAP) { atomicAdd(&(bar)[XB_TMO], 1u); break; } } } } while (0)

struct XcdBarrier {
    unsigned* bar; unsigned x;
    volatile LAS unsigned* st;
};

__device__ __forceinline__ XcdBarrier xcd_barrier_post(unsigned* bar, volatile LAS unsigned* st) {
    XcdBarrier b; b.bar = bar; b.x = xb_xcc_id(); b.st = st;
    if (threadIdx.x == 0) st[2] = xb_add(&bar[XB_XCNT(b.x)], 1u);
    return b;
}
__device__ __forceinline__ void xcd_barrier_complete(unsigned* bar, unsigned x, unsigned& nloc, unsigned& nx) {
    const unsigned G = gridDim.x * gridDim.y * gridDim.z;
    unsigned sum, cnt, mine, sp = 0u;
    for (;;) {
        sum = 0u; cnt = 0u; mine = 0u;
#pragma unroll
        for (unsigned j = 0; j < 16; ++j) { const unsigned c = xb_ld(&bar[XB_XCNT(j)]); sum += c; cnt += (c > 0u) ? 1u : 0u; mine = (j == x) ? c : mine; }
        if (sum == G) break;
        __builtin_amdgcn_s_sleep(1);
        if ((++sp & 255u) == 0u) { if (xb_ld(&bar[XB_TMO])) break; if (sp > XB_SPIN_CAP) { atomicAdd(&bar[XB_TMO], 1u); break; } }
    }
    nloc = mine > 0u ? mine : 1u; nx = cnt > 0u ? cnt : 1u;
}

__device__ __forceinline__ void xcd_barrier(const XcdBarrier& b) {
    asm volatile("s_waitcnt vmcnt(0)" ::: "memory");
    __syncthreads();
    if (threadIdx.x == 0) {
        unsigned* bar = b.bar;
        __builtin_amdgcn_s_waitcnt(0);
        unsigned nloc = b.st[0], nx = b.st[1];
        if (nloc == 0u) { xcd_barrier_complete(bar, b.x, nloc, nx); b.st[0] = nloc; b.st[1] = nx; }
        const unsigned old = xb_add(&bar[XB_XSUB(b.x)], 1u);
        const unsigned gen = old / nloc;
        if (old + 1u == (gen + 1u) * nloc) {
            __builtin_amdgcn_fence(__ATOMIC_RELEASE, "agent");
            asm volatile("s_waitcnt vmcnt(0)" ::: "memory");
            const unsigned og = xb_add(&bar[XB_TOP], 1u);
            const unsigned tg = og / nx;
            if (og + 1u == (tg + 1u) * nx) xb_add(&bar[XB_TOPGEN], 1u);
            else XB_SPIN(xb_ld(&bar[XB_TOPGEN]) == tg, bar);
            __builtin_amdgcn_fence(__ATOMIC_ACQUIRE, "agent");
            xb_add(&bar[XB_XGEN(b.x)], 1u);
            asm volatile("s_waitcnt vmcnt(0)" ::: "memory");
        } else {
            XB_SPIN(xb_ld(&bar[XB_XGEN(b.x)]) == gen, bar);
            __builtin_amdgcn_fence(__ATOMIC_ACQUIRE, "agent");
            asm volatile("s_waitcnt vmcnt(0)" ::: "memory");
        }
    }
    __syncthreads();
}

#if defined(CONV_NT)
#define CONV_ST(V, P) __builtin_nontemporal_store((V), (P))
#else
#define CONV_ST(V, P) (*(P) = (V))
#endif
#if defined(P0_NT)
#define P0_ST(V, P) __builtin_nontemporal_store((V), (P))
#else
#define P0_ST(V, P) (*(P) = (V))
#endif
#if defined(RES_NT)
#define RES_ST(V, P) __builtin_nontemporal_store((V), (P))
#else
#define RES_ST(V, P) (*(P) = (V))
#endif
#if defined(MIX_NT)
#define MIX_ST(V, P) __builtin_nontemporal_store((V), (P))
#else
#define MIX_ST(V, P) (*(P) = (V))
#endif
#if defined(DEAD_NT)
#define DEAD_LD(P) __builtin_nontemporal_load(P)
#else
#define DEAD_LD(P) (*(P))
#endif
#if defined(STREAM_NT)
#define STREAM_LD(P) __builtin_nontemporal_load(P)
#define STREAM_ST(V, P) __builtin_nontemporal_store((V), (P))
#else
#define STREAM_LD(P) (*(P))
#define STREAM_ST(V, P) (*(P) = (V))
#endif

__device__ __forceinline__ float wave_sum(float v) {
#pragma unroll
    for (int o = 1; o < 64; o <<= 1) v += __shfl_xor(v, o);
    return v;
}
constexpr size_t O_Y = 0, O_PLRU = (size_t)M * D, O_PCONV = O_PLRU + NP * DLRU, O_PRE = O_PCONV + NP * 3 * DLRU, O_PIM = O_PRE + NP * NGRP * SP, O_SLRU = O_PIM + NP * NGRP * SP,
                 O_SCONV = O_SLRU + NS * DLRU, O_SRE = O_SCONV + NS * 3 * DLRU, O_SIM = O_SRE + NS * NGRP * SP, O_END = O_SIM + NS * NGRP * SP;
static_assert(O_END == 40992768, "output size");

struct Args { const float* in[39]; float* out; unsigned char* ws; int ph_lo, ph_hi, li, pad; };
enum { I_XP = 0, I_XS, I_SLRU, I_SCONV, I_SRE, I_SIM, I_F1PRE, I_F1POST, I_F1G, I_F1U, I_F1D, I_MPRE, I_MPOST, I_WIN, I_CONVW, I_CONVB, I_WRG, I_BRG, I_WIG, I_BIG, I_LAM,
       I_ARE, I_AIM, I_LDT, I_BRE, I_BIM, I_CRE, I_CIM, I_DSK, I_WGLU, I_BGLU, I_WOA, I_WOB, I_WO, I_F2PRE, I_F2POST, I_F2G, I_F2U, I_F2D };

__device__ __forceinline__ void transpose_item(const float* W, int N, bf16* WT, int pitch, int k0, int n0, int drow, int dcol, LAS float* scr, int lane) {
    { f32x4 v[8]; const int rr = lane >> 3, c4 = (lane & 7) * 4;
#pragma unroll
      for (int i = 0; i < 8; ++i) v[i] = *(const GAS f32x4*)(W + (size_t)(k0 + 8 * i + rr) * N + n0 + c4);
#pragma unroll
      for (int i = 0; i < 8; ++i) { LAS float* d = scr + (8 * i + rr) * 33 + c4; d[0] = v[i].x; d[1] = v[i].y; d[2] = v[i].z; d[3] = v[i].w; } }
    LDS_WAIT(); asm volatile("" ::: "memory");
    const int c = lane & 7;
#pragma unroll
    for (int j = 0; j < 4; ++j) { const int n = (lane >> 3) + 8 * j; const LAS float* s = scr + (8 * c) * 33 + n;
        v4u o; o.x = pk2(s[0 * 33], s[1 * 33]); o.y = pk2(s[2 * 33], s[3 * 33]); o.z = pk2(s[4 * 33], s[5 * 33]); o.w = pk2(s[6 * 33], s[7 * 33]);
        *(GAS v4u*)(WT + (size_t)(drow + n) * pitch + dcol + k0 + 8 * c) = o; }
    LDS_WAIT(); asm volatile("" ::: "memory");
}
__device__ __forceinline__ void tr_plain(const float* W, int K, int N, bf16* WT, int pitch, int dcol, int item, LAS float* scr, int lane) {
    const int nkb = K / 64, nb = item / nkb, kb = item - nb * nkb;
    transpose_item(W, N, WT, pitch, 64 * kb, 32 * nb, 32 * nb, dcol, scr, lane);
}
__device__ __forceinline__ void tr_gu(const float* W, bf16* WT, int up, int item, LAS float* scr, int lane) {
    const int nkb = D / 64, nb = item / nkb, kb = item - nb * nkb, n0 = 32 * nb;
    transpose_item(W, DFF, WT, D, 64 * kb, n0, 256 * (n0 >> 7) + up * 128 + (n0 & 127), 0, scr, lane);
}
#if defined(CONV64)
constexpr int CNW = 64;
#else
constexpr int CNW = 32;
#endif
constexpr int CONV_SCR = 64 * (CNW + 1) * 4, CONV_SCR_STRIDE = CONV_SCR > 16384 ? CONV_SCR : 16384;
constexpr int IT_GU = (D / 64) * (DFF / CNW), IT_DN = (DFF / 64) * (D / CNW), IT_IN = (D / 64) * (DIN / CNW), IT_GLU = (DSSM / 64) * (DSSM / CNW), IT_OA = (DLRU / 64) * (D / CNW), IT_WO = (D / 64) * (D / CNW), IT_RG = 16 * 2 * 4;
constexpr int IT_TOTAL = 4 * IT_GU + 2 * IT_DN + IT_IN + IT_GLU + 2 * IT_OA + IT_WO + 2 * IT_RG;

template <int MODE> __device__ __forceinline__ void thin_rows(const Args& args, int gw, int ngw, int lane);

constexpr int ITB_GU1 = 0, ITB_DN1 = ITB_GU1 + 2 * IT_GU, ITB_IN = ITB_DN1 + IT_DN, ITB_GLU = ITB_IN + IT_IN, ITB_OA = ITB_GLU + IT_GLU, ITB_OB = ITB_OA + IT_OA, ITB_WO = ITB_OB + IT_OA,
              ITB_GU2 = ITB_WO + IT_WO, ITB_DN2 = ITB_GU2 + 2 * IT_GU, ITB_RG = ITB_DN2 + IT_DN, ITB_END = ITB_RG + 2 * IT_RG;
static_assert(ITB_END == IT_TOTAL, "item numbering");
__device__ __forceinline__ void convert_item(const Args& args, int it, LAS float* scr, int lane) {
    unsigned char* ws = args.ws; int r = it;
    if (r < IT_GU) { tr_gu(args.in[I_F1G], (bf16*)(ws + WS_WGU1), 0, r, scr, lane); return; } r -= IT_GU;
    if (r < IT_GU) { tr_gu(args.in[I_F1U], (bf16*)(ws + WS_WGU1), 1, r, scr, lane); return; } r -= IT_GU;
    if (r < IT_DN) { tr_plain(args.in[I_F1D], DFF, D, (bf16*)(ws + WS_WD1), DFF, 0, r, scr, lane); return; } r -= IT_DN;
    if (r < IT_IN) { tr_plain(args.in[I_WIN], D, DIN, (bf16*)(ws + WS_WIN), D, 0, r, scr, lane); return; } r -= IT_IN;
    if (r < IT_GLU) { tr_plain(args.in[I_WGLU], DSSM, DSSM, (bf16*)(ws + WS_WGLU), DSSM, 0, r, scr, lane); return; } r -= IT_GLU;
    if (r < IT_OA) { tr_plain(args.in[I_WOA], DLRU, D, (bf16*)(ws + WS_WOUT), D, 0, r, scr, lane); return; } r -= IT_OA;
    if (r < IT_OA) { tr_plain(args.in[I_WOB], DSSM, D, (bf16*)(ws + WS_WOUT), D, DLRU, r, scr, lane); return; } r -= IT_OA;
    if (r < IT_WO) { tr_plain(args.in[I_WO], D, D, (bf16*)(ws + WS_WO), D, 0, r, scr, lane); return; } r -= IT_WO;
    if (r < IT_GU) { tr_gu(args.in[I_F2G], (bf16*)(ws + WS_WGU2), 0, r, scr, lane); return; } r -= IT_GU;
    if (r < IT_GU) { tr_gu(args.in[I_F2U], (bf16*)(ws + WS_WGU2), 1, r, scr, lane); return; } r -= IT_GU;
    if (r < IT_DN) { tr_plain(args.in[I_F2D], DFF, D, (bf16*)(ws + WS_WD2), DFF, 0, r, scr, lane); return; } r -= IT_DN;
    { const int ig = r >= IT_RG ? 1 : 0; const int q = r - ig * IT_RG, h = q >> 3, sub = q & 7, kb = sub >> 2, nb = sub & 3;
      const float* W = (ig ? args.in[I_WIG] : args.in[I_WRG]) + (size_t)h * 128 * 128;
      transpose_item(W, 128, (bf16*)(ws + WS_WG) + (size_t)h * 256 * 128, 128, 64 * kb, 32 * nb, ig * 128 + 32 * nb, 0, scr, lane); }
}
struct ItemD { const float* src; bf16* dst; const float* gk; int N, pitch, k0, n0, drow, dcol; };
__device__ __forceinline__ ItemD item_desc(const Args& args, int it) {
    unsigned char* ws = args.ws; int r = it; bool hit = false;
    const float* ones = (const float*)(ws + WS_ONES);
    const float* src = nullptr; bf16* dst = nullptr; const float* gk = ones; int K = 64, N = 128, pitch = 128, dcol = 0, gu = 0, up = 0;
#define ITEM_CASE(CNT, SRC, DST, K_, N_, PITCH, DCOL, GU, UP, GK) { if (!hit && r < (CNT)) { hit = true; src = (SRC); dst = (bf16*)(DST); K = (K_); N = (N_); pitch = (PITCH); dcol = (DCOL); gu = (GU); up = (UP); gk = (GK); } else if (!hit) r -= (CNT); }
    ITEM_CASE(IT_GU, args.in[I_F1G], ws + WS_WGU1, D, DFF, D, 0, 1, 0, args.in[I_F1PRE])
    ITEM_CASE(IT_GU, args.in[I_F1U], ws + WS_WGU1, D, DFF, D, 0, 1, 1, args.in[I_F1PRE])
    ITEM_CASE(IT_DN, args.in[I_F1D], ws + WS_WD1, DFF, D, DFF, 0, 0, 0, ones)
    ITEM_CASE(IT_IN, args.in[I_WIN], ws + WS_WIN, D, DIN, D, 0, 0, 0, args.in[I_MPRE])
    ITEM_CASE(IT_GLU, args.in[I_WGLU], ws + WS_WGLU, DSSM, DSSM, DSSM, 0, 0, 0, ones)
    ITEM_CASE(IT_OA, args.in[I_WOA], ws + WS_WOUT, DLRU, D, D, 0, 0, 0, ones)
    ITEM_CASE(IT_OA, args.in[I_WOB], ws + WS_WOUT, DSSM, D, D, DLRU, 0, 0, ones)
    ITEM_CASE(IT_WO, args.in[I_WO], ws + WS_WO, D, D, D, 0, 0, 0, ones)
    ITEM_CASE(IT_GU, args.in[I_F2G], ws + WS_WGU2, D, DFF, D, 0, 1, 0, args.in[I_F2PRE])
    ITEM_CASE(IT_GU, args.in[I_F2U], ws + WS_WGU2, D, DFF, D, 0, 1, 1, args.in[I_F2PRE])
    ITEM_CASE(IT_DN, args.in[I_F2D], ws + WS_WD2, DFF, D, DFF, 0, 0, 0, ones)
#undef ITEM_CASE
    ItemD d;
    if (hit) { const int nkb = K / 64, nb = r / nkb, kb = r - nb * nkb, n0 = CNW * nb;
        d.src = src; d.dst = dst; d.gk = gk; d.N = N; d.pitch = pitch; d.k0 = 64 * kb; d.n0 = n0; d.dcol = dcol;
        d.drow = gu ? 256 * (n0 >> 7) + up * 128 + (n0 & 127) : n0;
    } else { const int ig = r >= IT_RG ? 1 : 0; const int q = r - ig * IT_RG, h = q >> 3, sub = q & 7, kb = sub >> 2, nb = sub & 3;
        d.src = (ig ? args.in[I_WIG] : args.in[I_WRG]) + (size_t)h * 128 * 128; d.dst = (bf16*)(ws + WS_WG) + (size_t)h * 256 * 128; d.gk = ones; d.N = 128; d.pitch = 128; d.k0 = 64 * kb; d.n0 = 32 * nb; d.drow = ig * 128 + 32 * nb; d.dcol = 0; }
    return d;
}
#if defined(CONV64)
constexpr int CNL = 16;
__device__ __forceinline__ void item_load(const ItemD& d, int lane, f32x4 (&v)[CNL], float (&gs)[CNL]) {
    const int rr = lane >> 4, c4 = (lane & 15) * 4;
#pragma unroll
    for (int i = 0; i < CNL; ++i) gs[i] = d.gk[d.k0 + 4 * i + rr];
#pragma unroll
    for (int i = 0; i < CNL; ++i) v[i] = STREAM_LD((const GAS f32x4*)(d.src + (size_t)(d.k0 + 4 * i + rr) * d.N + d.n0 + c4));
}
__device__ __forceinline__ void item_finish(const ItemD& d, const f32x4 (&v)[CNL], const float (&gs)[CNL], LAS float* scr, int lane) {
    { const int rr = lane >> 4, c4 = (lane & 15) * 4;
#pragma unroll
      for (int i = 0; i < CNL; ++i) { LAS float* q = scr + (4 * i + rr) * 65 + c4; q[0] = v[i].x * gs[i]; q[1] = v[i].y * gs[i]; q[2] = v[i].z * gs[i]; q[3] = v[i].w * gs[i]; } }
    LDS_WAIT(); asm volatile("" ::: "memory");
    const int c = lane & 7;
#pragma unroll
    for (int j = 0; j < 8; ++j) { const int n = (lane >> 3) + 8 * j; const LAS float* s = scr + (8 * c) * 65 + n;
        v4u o; o.x = pk2(s[0 * 65], s[1 * 65]); o.y = pk2(s[2 * 65], s[3 * 65]); o.z = pk2(s[4 * 65], s[5 * 65]); o.w = pk2(s[6 * 65], s[7 * 65]);
        CONV_ST(o, (GAS v4u*)(d.dst + (size_t)(d.drow + n) * d.pitch + d.dcol + d.k0 + 8 * c)); }
    LDS_WAIT(); asm volatile("" ::: "memory");
}
__device__ __forceinline__ void convert_run(const Args& args, int b, int e, LAS float* scr, int lane) {
    for (int it = b; it < e; ++it) { const ItemD d = item_desc(args, it); f32x4 v[CNL]; float g[CNL]; item_load(d, lane, v, g); item_finish(d, v, g, scr, lane); }
}
#else
__device__ __forceinline__ void item_load(const ItemD& d, int lane, f32x4 (&v)[8], float (&gs)[8]) {
    const int rr = lane >> 3, c4 = (lane & 7) * 4;
#pragma unroll
    for (int i = 0; i < 8; ++i) gs[i] = d.gk[d.k0 + 8 * i + rr];
#pragma unroll
    for (int i = 0; i < 8; ++i) v[i] = STREAM_LD((const GAS f32x4*)(d.src + (size_t)(d.k0 + 8 * i + rr) * d.N + d.n0 + c4));
}
__device__ __forceinline__ void item_finish(const ItemD& d, const f32x4 (&v)[8], const float (&gs)[8], LAS float* scr, int lane) {
    { const int rr = lane >> 3, c4 = (lane & 7) * 4;
#pragma unroll
      for (int i = 0; i < 8; ++i) { LAS float* q = scr + (8 * i + rr) * 33 + c4; q[0] = v[i].x * gs[i]; q[1] = v[i].y * gs[i]; q[2] = v[i].z * gs[i]; q[3] = v[i].w * gs[i]; } }
    LDS_WAIT(); asm volatile("" ::: "memory");
    const int c = lane & 7;
#pragma unroll
    for (int j = 0; j < 4; ++j) { const int n = (lane >> 3) + 8 * j; const LAS float* s = scr + (8 * c) * 33 + n;
        v4u o; o.x = pk2(s[0 * 33], s[1 * 33]); o.y = pk2(s[2 * 33], s[3 * 33]); o.z = pk2(s[4 * 33], s[5 * 33]); o.w = pk2(s[6 * 33], s[7 * 33]);
        CONV_ST(o, (GAS v4u*)(d.dst + (size_t)(d.drow + n) * d.pitch + d.dcol + d.k0 + 8 * c)); }
    LDS_WAIT(); asm volatile("" ::: "memory");
}
__device__ __forceinline__ void convert_run(const Args& args, int b, int e, LAS float* scr, int lane) {
    if (b >= e) return;
    ItemD dA = item_desc(args, b), dB = dA; f32x4 vA[8], vB[8]; float gA[8], gB[8]; item_load(dA, lane, vA, gA);
    for (int it = b;; it += 2) {
        if (it + 1 < e) { dB = item_desc(args, it + 1); item_load(dB, lane, vB, gB); item_finish(dA, vA, gA, scr, lane); } else { item_finish(dA, vA, gA, scr, lane); break; }
        if (it + 2 < e) { dA = item_desc(args, it + 2); item_load(dA, lane, vA, gA); item_finish(dB, vB, gB, scr, lane); } else { item_finish(dB, vB, gB, scr, lane); break; }
    }
}
#endif
#ifndef MK_QCHUNK
#define MK_QCHUNK (512 / CNW)
#endif
constexpr int CW_Q = 60000, Q_CHUNK = MK_QCHUNK;
#ifndef MK_GU2_N4
#define MK_GU2_N4 (96256 / CNW)
#endif
#ifndef MK_GU2_N5
#define MK_GU2_N5 (384000 / CNW)
#endif
constexpr int GU2_N4 = MK_GU2_N4, GU2_N5 = MK_GU2_N5;
#if defined(QREBAL)
constexpr int Q14_FIRST = ITB_GU2 + 2 * IT_GU - GU2_N4, Q14_N = GU2_N4;
constexpr int Q5_FIRST = ITB_WO, Q5_N = IT_WO + GU2_N5;
constexpr int Q6_FIRST = ITB_OA, Q6_N = 2 * IT_OA;
constexpr int Q7_FIRST = ITB_GU2 + GU2_N5, Q7_N = 2 * IT_GU - GU2_N4 - GU2_N5;
#else
constexpr int Q14_FIRST = ITB_GU2, Q14_N = GU2_N4;
constexpr int Q5_FIRST = ITB_GU2 + GU2_N4, Q5_N = GU2_N5;
constexpr int Q6_FIRST = ITB_OA, Q6_N = 2 * IT_OA + IT_WO;
constexpr int Q7_FIRST = ITB_GU2 + GU2_N4 + GU2_N5, Q7_N = 2 * IT_GU - GU2_N4 - GU2_N5;
#endif
static_assert(ITB_WO + IT_WO == ITB_GU2, "W_O and W_GU2 are neighbours in the item numbering");
__device__ __forceinline__ void convert_queue(const Args& args, int qid, int first, int n, LAS unsigned char* lds, int wave, int lane) {
    LAS float* scr = (LAS float*)(lds + RING_OFF + wave * CONV_SCR_STRIDE);
    unsigned* ctr = (unsigned*)(args.ws + WS_CTL) + CW_Q + 64 * qid;
    for (;;) {
        int base = 0;
        if (lane == 0) base = (int)__hip_atomic_fetch_add(ctr, (unsigned)Q_CHUNK, __ATOMIC_RELAXED, __HIP_MEMORY_SCOPE_AGENT);
        base = __builtin_amdgcn_readfirstlane(base);
        if (base >= n) break;
        const int e = (base + Q_CHUNK < n) ? base + Q_CHUNK : n;
        convert_run(args, first + base, first + e, scr, lane);
    }
}

__device__ __forceinline__ void p0_prologue(const Args& args, LAS unsigned char* lds, int wave, int lane, int gw, int ngw) {
    unsigned char* ws = args.ws;
    LAS float* scr = (LAS float*)(lds + RING_OFF + wave * CONV_SCR_STRIDE);
#if defined(NO_TAIL_CONVERT)
    for (int it = gw; it < IT_TOTAL; it += ngw) convert_run(args, it, it + 1, scr, lane);
#else
#ifndef MK_P0CHUNK
#define MK_P0CHUNK (704 / CNW)
#endif
    constexpr int P0_CHUNK = MK_P0CHUNK;
    for (int base = gw * P0_CHUNK; base < 2 * IT_GU; base += ngw * P0_CHUNK)
        convert_run(args, ITB_GU1 + base, ITB_GU1 + ((base + P0_CHUNK < 2 * IT_GU) ? base + P0_CHUNK : 2 * IT_GU), scr, lane);
    for (int it = gw; it < 2 * IT_RG; it += ngw) convert_item(args, ITB_RG + it, scr, lane);
#endif
    for (int i = gw * 64 + lane; i < DFF; i += ngw * 64) ((float*)(ws + WS_ONES))[i] = 1.0f;
    {
        const int gt = gw * 64 + lane;
        if (gt < NGRP * SP) {
            const int g = gt >> 6, p = gt & 63;
            const double dt = exp((double)args.in[I_LDT][g]);
            const double ar = (double)args.in[I_ARE][gt], ai = (double)args.in[I_AIM][gt];
            const double mag = exp(ar * dt);
            double th = ai * dt; th -= 6.283185307179586476925 * rint(th * 0.15915494309189533577);
            const double x = 0.25 * th, x2 = x * x;
            double s = x * (1.0 + x2 * (-1.0 / 6 + x2 * (1.0 / 120 + x2 * (-1.0 / 5040 + x2 * (1.0 / 362880 + x2 * (-1.0 / 39916800 + x2 * (1.0 / 6227020800.0)))))));
            double c = 1.0 + x2 * (-0.5 + x2 * (1.0 / 24 + x2 * (-1.0 / 720 + x2 * (1.0 / 40320 + x2 * (-1.0 / 3628800 + x2 * (1.0 / 479001600.0 + x2 * (-1.0 / 87178291200.0)))))));
            { const double s2 = 2.0 * s * c, c2 = 1.0 - 2.0 * s * s; s = s2; c = c2; }
            { const double s2 = 2.0 * s * c, c2 = 1.0 - 2.0 * s * s; s = s2; c = c2; }
            const double abr = mag * c, abi = mag * s;
            const double den = ar * ar + ai * ai, nr = abr - 1.0, ni = abi;
            const double cre = (nr * ar + ni * ai) / den, cim = (ni * ar - nr * ai) / den;
            float* AB = (float*)(ws + WS_ABAR); AB[2 * gt] = (float)abr; AB[2 * gt + 1] = (float)abi;
            bf16* BB = (bf16*)(ws + WS_BB); bf16* CC = (bf16*)(ws + WS_CC);
            const float* bre = args.in[I_BRE] + (size_t)gt * SCG; const float* bim = args.in[I_BIM] + (size_t)gt * SCG;
#pragma unroll 4
            for (int ch = 0; ch < SCG; ++ch) {
                const double br = (double)bre[ch], bi = (double)bim[ch];
                const float vre = (float)(cre * br - cim * bi), vim = (float)(cre * bi + cim * br);
#pragma unroll
                for (int ri = 0; ri < 2; ++ri) { const int col = 2 * p + ri, j = col >> 4, ln = (col & 15) + 16 * (ch >> 3);
                    BB[((size_t)(g * 8 + j) * 64 + ln) * 8 + (ch & 7)] = (bf16)f2bf(ri ? vim : vre); }
                const float c_re = args.in[I_CRE][((size_t)g * SCG + ch) * SP + p], c_im = args.in[I_CIM][((size_t)g * SCG + ch) * SP + p];
#pragma unroll
                for (int ri = 0; ri < 2; ++ri) { const int k = 2 * p + ri, kk = k >> 5, ln = ch + 16 * ((k & 31) >> 3);
                    CC[((size_t)(g * 4 + kk) * 64 + ln) * 8 + (k & 7)] = (bf16)f2bf(ri ? -c_im : c_re); }
            }
        }
    }
    thin_rows<0>(args, gw, ngw, lane);
}

template <int MODE> __device__ __forceinline__ void thin_rows(const Args& args, int gw, int ngw, int lane) {
    const float* gA = MODE == 1 ? args.in[I_F1POST] : (MODE == 2 ? args.in[I_MPOST] : args.in[I_F2POST]);
    const float sc = MODE == 2 ? 1.0f : 0.5f;
    float* Y = args.out + O_Y; const bf16* Fb = (const bf16*)(args.ws + WS_F); bf16* XN = (bf16*)(args.ws + WS_XN); bf16* XR = (bf16*)(args.ws + WS_XR);
    float* RS = (float*)(args.ws + WS_RSTD) + (size_t)(MODE <= 2 ? MODE : 0) * M;
    const int bxl = gw / NWAVES, wvl = gw % NWAVES, Gl = ngw / NWAVES;
    for (int i = wvl; i * Gl + bxl < M; i += NWAVES) { const int m = i * Gl + bxl;
        f32x4 v[16];
        if (MODE == 0) {
            const float* xin = m < MP ? args.in[I_XP] + (size_t)m * D : args.in[I_XS] + (size_t)(m - MP) * D;
            const GAS f32x4* xr = (const GAS f32x4*)xin + lane;
#pragma unroll
            for (int j = 0; j < 16; ++j) v[j] = STREAM_LD(xr + 64 * j);
        } else {
            const GAS v2u* xr = (const GAS v2u*)((MODE == 1 ? XN : XR) + (size_t)m * D) + lane;
#pragma unroll
            for (int j = 0; j < 16; ++j) { const v2u w = (MODE == 2) ? xr[64 * j] : DEAD_LD(xr + 64 * j); v[j] = (f32x4){bf_lo(w.x), bf_hi(w.x), bf_lo(w.y), bf_hi(w.y)}; }
        }
        if (MODE >= 1) {
            f32x4 f[16]; float s = 0.f;
            if (m < MP) {
                const GAS v2u* fr = (const GAS v2u*)(Fb + (size_t)m * D) + lane;
#pragma unroll
                for (int j = 0; j < 16; ++j) { const v2u w = fr[64 * j]; f[j] = (f32x4){bf_lo(w.x), bf_hi(w.x), bf_lo(w.y), bf_hi(w.y)}; }
            } else {
#if defined(SLAB_F32)
                for (int q = 0; q < 4; ++q) { const GAS f32x4* sr = (const GAS f32x4*)((const float*)(args.ws + WS_SLAB) + q * SLAB_FLOATS + (size_t)(m - MP) * D) + lane;
#pragma unroll
                    for (int j = 0; j < 16; ++j) f[j] = q == 0 ? sr[64 * j] : f[j] + sr[64 * j]; }
#else
                for (int q = 0; q < 4; ++q) { const GAS v2u* sr = (const GAS v2u*)((const bf16*)(args.ws + WS_SLAB) + q * SLAB_FLOATS + (size_t)(m - MP) * D) + lane;
#pragma unroll
                    for (int j = 0; j < 16; ++j) { const v2u w = sr[64 * j]; const f32x4 t = (f32x4){bf_lo(w.x), bf_hi(w.x), bf_lo(w.y), bf_hi(w.y)}; f[j] = q == 0 ? t : f[j] + t; } }
#endif
            }
#pragma unroll
            for (int j = 0; j < 16; ++j) s += (f[j].x * f[j].x + f[j].y * f[j].y) + (f[j].z * f[j].z + f[j].w * f[j].w);
            const float rstd = sc / sqrtf(wave_sum(s) * (1.f / D) + EPS);
            const GAS f32x4* gr = (const GAS f32x4*)gA + lane;
#pragma unroll
            for (int j = 0; j < 16; ++j) { const f32x4 g = gr[64 * j]; v[j] = v[j] + f[j] * rstd * g; }
            if (MODE == 3) { GAS f32x4* yo = (GAS f32x4*)(Y + (size_t)m * D) + lane;
#pragma unroll
                for (int j = 0; j < 16; ++j) STREAM_ST(v[j], yo + 64 * j);
            }
        }
        if (MODE <= 2) {
            GAS v2u* xo = (GAS v2u*)((MODE == 0 ? XN : XR) + (size_t)m * D) + lane;
            float s = 0.f;
#pragma unroll
            for (int j = 0; j < 16; ++j) { v2u w; w.x = pk2(v[j].x, v[j].y); w.y = pk2(v[j].z, v[j].w); if (MODE == 0) P0_ST(w, xo + 64 * j); else RES_ST(w, xo + 64 * j);
                if (MODE != 0) v[j] = (f32x4){bf_lo(w.x), bf_hi(w.x), bf_lo(w.y), bf_hi(w.y)};
                s += (v[j].x * v[j].x + v[j].y * v[j].y) + (v[j].z * v[j].z + v[j].w * v[j].w); }
            const float rstd = 1.0f / sqrtf(wave_sum(s) * (1.f / D) + EPS);
            if (lane == 0) RS[m] = rstd;
        }
    }
}

#if defined(LRU64)
constexpr int LCH = 64, L_WSL = 0, L_XCB = 34816, L_XCF = 52224, L_LA = 68864, L_LB = 85504, L_LH = 102144, L_END = 118784;
constexpr int LP = 65;
#else
constexpr int LCH = 32, L_WSL = 0, L_XCB = 17408, L_XCF = 34816, L_LA = 43264, L_LB = 51712, L_LH = 60160, L_END = 68608;
constexpr int LP = 33;
#endif
static_assert(L_END <= RING_BYTES, "RG-LRU LDS tables");
#define LBAR() do { asm volatile("s_waitcnt lgkmcnt(0)" ::: "memory"); __builtin_amdgcn_s_barrier(); asm volatile("" ::: "memory"); } while (0)
__device__ __forceinline__ f32x4 xa_ld4(const float* XA, size_t row, int ch) {
#if defined(XA_BF16)
    const v2u w = *(const GAS v2u*)((const bf16*)XA + row * DLRU + ch); return (f32x4){bf_lo(w.x), bf_hi(w.x), bf_lo(w.y), bf_hi(w.y)};
#else
    return *(const GAS f32x4*)(XA + row * DLRU + ch);
#endif
}
#if defined(LRU64)
template <bool SAMPLE> __device__ __forceinline__ void lru_load_tile(const Args& args, const float* XA, const bf16* GA, int chain, int k, int tg, int cg, int chb, int h, int tid, f32x4 (&v)[7], v2u (&gaw)[2]) {
    const size_t rbase = SAMPLE ? (size_t)MP + 64 * chain : (size_t)chain * TP + 64 * k;
#pragma unroll
    for (int i = 0; i < 7; ++i) {
        if (SAMPLE) { const int ts = 4 * (tg & 1) - 3 + i, sl = tg >> 1;
            v[i] = (ts >= 0) ? xa_ld4(XA, rbase + 8 * sl + ts, chb + 4 * cg)
                             : *(const GAS f32x4*)(args.in[I_SCONV] + ((size_t)(8 * chain + sl) * 3 + (3 + ts)) * DLRU + chb + 4 * cg);
        } else { const int tt = 4 * tg - 3 + i;
            v[i] = (k > 0 || tt >= 0) ? xa_ld4(XA, rbase + tt, chb + 4 * cg) : (f32x4){0.f, 0.f, 0.f, 0.f}; }
    }
    const bf16* gp = GA + (rbase + (tid >> 3)) * DLRU + chb + 64 * h + (tid & 7) * 8;
    gaw[0] = *(const GAS v2u*)gp; gaw[1] = *(const GAS v2u*)(gp + 4);
}
template <bool SAMPLE> __device__ __forceinline__ void lru_task(const Args& args, LAS unsigned char* lds, int tid, int wave, int lane, int chain, int head, int h, int nb = 1) {
    unsigned char* ws = args.ws;
    const float* XA = (const float*)(ws + WS_XA); const bf16* GA = (const bf16*)(ws + WS_GA); bf16* YAB = (bf16*)(ws + WS_YAB);
    const int chb = head * 128;
    const int cg = tid & 31, tg = tid >> 5;
    f32x4 v[7]; v2u gaw[2];
    lru_load_tile<SAMPLE>(args, XA, GA, chain, 0, tg, cg, chb, h, tid, v, gaw);
    { const bf16* WG = (const bf16*)(ws + WS_WG) + (size_t)head * 256 * 128;
      for (int i = tid; i < 2048; i += 512) { const int r = i >> 4, c16 = i & 15; const int srow = (r < 64) ? (64 * h + r) : (128 + 64 * h + (r - 64));
          *(LAS v4u*)(lds + L_WSL + r * 272 + c16 * 16) = *(const GAS v4u*)(WG + (size_t)srow * 128 + c16 * 8); } }
    const f32x4 cw0 = *(const f32x4*)(args.in[I_CONVW] + 0 * DLRU + chb + 4 * cg), cw1 = *(const f32x4*)(args.in[I_CONVW] + 1 * DLRU + chb + 4 * cg),
                cw2 = *(const f32x4*)(args.in[I_CONVW] + 2 * DLRU + chb + 4 * cg), cw3 = *(const f32x4*)(args.in[I_CONVW] + 3 * DLRU + chb + 4 * cg),
                cbv = *(const f32x4*)(args.in[I_CONVB] + chb + 4 * cg);
    const int tb = wave & 3, ct = wave >> 2, l15 = lane & 15, lq = lane >> 4;
    float brg[2], big[2], sp8[2];
#pragma unroll
    for (int j = 0; j < 2; ++j) { const int chg = chb + 64 * h + 16 * (ct + 2 * j) + l15;
        brg[j] = args.in[I_BRG][chg]; big[j] = args.in[I_BIG][chg]; const float lam = args.in[I_LAM][chg]; sp8[j] = -8.0f * log1pf(expf(-lam)); }
    float hcar = 0.f;
    float h0s[8];
#pragma unroll
    for (int s = 0; s < 8; ++s) h0s[s] = 0.f;
    const int ntile = SAMPLE ? nb : 32;
    for (int k = 0; k < ntile; ++k) {
        const int chk = SAMPLE ? chain + k : chain;
        const size_t rbase = SAMPLE ? (size_t)MP + 64 * chk : (size_t)chain * TP + 64 * k;
        if (SAMPLE && tid < 64) {
#pragma unroll
            for (int s = 0; s < 8; ++s) h0s[s] = args.in[I_SLRU][(size_t)(8 * chk + s) * DLRU + chb + 64 * h + tid];
        }
#pragma unroll
        for (int o = 0; o < 4; ++o) { const f32x4 xc = cbv + cw0 * v[o] + cw1 * v[o + 1] + cw2 * v[o + 2] + cw3 * v[o + 3];
            v2u w; w.x = pk2(xc.x, xc.y); w.y = pk2(xc.z, xc.w);
            *(LAS v2u*)(lds + L_XCB + (4 * tg + o) * 272 + cg * 8) = w;
            if ((cg >> 4) == h) { LAS float* xf = (LAS float*)(lds + L_XCF) + (4 * tg + o) * LP + 4 * (cg & 15); xf[0] = xc.x; xf[1] = xc.y; xf[2] = xc.z; xf[3] = xc.w; } }
        const v2u gcur0 = gaw[0], gcur1 = gaw[1];
        if (k + 1 < ntile) lru_load_tile<SAMPLE>(args, XA, GA, SAMPLE ? chk + 1 : chain, k + 1, tg, cg, chb, h, tid, v, gaw);
        LBAR();
        pg8::f32x4 accr[2], acci[2];
#pragma unroll
        for (int j = 0; j < 2; ++j) { accr[j] = (pg8::f32x4){0.f, 0.f, 0.f, 0.f}; acci[j] = (pg8::f32x4){0.f, 0.f, 0.f, 0.f}; }
#pragma unroll
        for (int kk = 0; kk < 4; ++kk) {
            const bf16x8 a = *(const LAS bf16x8*)(lds + L_XCB + (16 * tb + l15) * 272 + kk * 64 + lq * 16);
#pragma unroll
            for (int j = 0; j < 2; ++j) {
                const bf16x8 br = *(const LAS bf16x8*)(lds + L_WSL + (16 * (ct + 2 * j) + l15) * 272 + kk * 64 + lq * 16);
                const bf16x8 bi = *(const LAS bf16x8*)(lds + L_WSL + (64 + 16 * (ct + 2 * j) + l15) * 272 + kk * 64 + lq * 16);
                accr[j] = __builtin_amdgcn_mfma_f32_16x16x32_bf16(a, br, accr[j], 0, 0, 0);
                acci[j] = __builtin_amdgcn_mfma_f32_16x16x32_bf16(a, bi, acci[j], 0, 0, 0); }
        }
#pragma unroll
        for (int j = 0; j < 2; ++j)
#pragma unroll
        for (int r = 0; r < 4; ++r) { const int tt = 16 * tb + 4 * lq + r, cl = 16 * (ct + 2 * j) + l15;
            const float rg = fast_sigmoid(accr[j][r] + brg[j]), ig = fast_sigmoid(acci[j][r] + big[j]);
            const float la = sp8[j] * rg;
            const float a = __builtin_amdgcn_exp2f(la * 1.4426950408889634f);
            const float x2 = 2.0f * la;
            const float em = (x2 > -0.25f) ? -x2 * (1.0f + x2 * (0.5f + x2 * (1.0f / 6 + x2 * (1.0f / 24 + x2 * (1.0f / 120 + x2 * (1.0f / 720))))))
                                           : 1.0f - __builtin_amdgcn_exp2f(x2 * 1.4426950408889634f);
            const float xcv = ((const LAS float*)(lds + L_XCF))[tt * LP + cl];
            ((LAS float*)(lds + L_LA))[tt * LP + cl] = a;
            ((LAS float*)(lds + L_LB))[tt * LP + cl] = sqrtf(em) * ig * xcv; }
        LBAR();
        if (tid < 64) {
            const LAS float* la = (const LAS float*)(lds + L_LA) + tid; const LAS float* lb = (const LAS float*)(lds + L_LB) + tid; LAS float* lh = (LAS float*)(lds + L_LH) + tid;
            const int ch = chb + 64 * h + tid;
#pragma unroll
            for (int s = 0; s < 8; ++s) {
                if (SAMPLE) hcar = h0s[s];
#pragma unroll
                for (int t8 = 0; t8 < 8; ++t8) { const int tt = 8 * s + t8; hcar = la[tt * LP] * hcar + lb[tt * LP]; lh[tt * LP] = hcar; }
                if (SAMPLE) args.out[O_SLRU + (size_t)(8 * chk + s) * DLRU + ch] = hcar;
            }
            if (!SAMPLE && k == ntile - 1) args.out[O_PLRU + (size_t)chain * DLRU + ch] = hcar;
        }
        LBAR();
        { const int t = tid >> 3, c8 = (tid & 7) * 8; const LAS float* lh = (const LAS float*)(lds + L_LH) + t * LP + c8;
          v2u o0, o1; o0.x = pk2(lh[0] * bf_lo(gcur0.x), lh[1] * bf_hi(gcur0.x)); o0.y = pk2(lh[2] * bf_lo(gcur0.y), lh[3] * bf_hi(gcur0.y));
          o1.x = pk2(lh[4] * bf_lo(gcur1.x), lh[5] * bf_hi(gcur1.x)); o1.y = pk2(lh[6] * bf_lo(gcur1.y), lh[7] * bf_hi(gcur1.y));
          bf16* yp = YAB + (rbase + t) * D + chb + 64 * h + c8;
          MIX_ST(o0, (GAS v2u*)yp); MIX_ST(o1, (GAS v2u*)(yp + 4)); }
    }
    LBAR();
}
#else
template <bool SAMPLE> __device__ __forceinline__ void lru_load_tile(const Args& args, const float* XA, const bf16* GA, int chain, int k, int tg, int cg, int chb, int q, int tid, f32x4 (&v)[7], v2u& gaw) {
    const size_t rbase = SAMPLE ? (size_t)MP + 64 * chain : (size_t)chain * TP + 64 * k;
#pragma unroll
    for (int i = 0; i < 7; ++i) {
        if (SAMPLE) { const int ts = 4 * (tg & 1) - 3 + i, sl = tg >> 1;
            v[i] = (ts >= 0) ? xa_ld4(XA, rbase + 8 * sl + ts, chb + 4 * cg)
                             : *(const GAS f32x4*)(args.in[I_SCONV] + ((size_t)(8 * chain + sl) * 3 + (3 + ts)) * DLRU + chb + 4 * cg);
        } else { const int tt = 4 * tg - 3 + i;
            v[i] = (k > 0 || tt >= 0) ? xa_ld4(XA, rbase + tt, chb + 4 * cg) : (f32x4){0.f, 0.f, 0.f, 0.f}; }
    }
    gaw = *(const GAS v2u*)(GA + (rbase + (tid >> 3)) * DLRU + chb + 32 * q + (tid & 7) * 4);
}
template <bool SAMPLE> __device__ __forceinline__ void lru_task(const Args& args, LAS unsigned char* lds, int tid, int wave, int lane, int chain, int head, int q) {
    unsigned char* ws = args.ws;
    const float* XA = (const float*)(ws + WS_XA); const bf16* GA = (const bf16*)(ws + WS_GA); bf16* YAB = (bf16*)(ws + WS_YAB);
    const int chb = head * 128;
    const int cg = tid & 31, tg = tid >> 5;
    f32x4 v[7]; v2u gaw;
    lru_load_tile<SAMPLE>(args, XA, GA, chain, 0, tg, cg, chb, q, tid, v, gaw);
    { const bf16* WG = (const bf16*)(ws + WS_WG) + (size_t)head * 256 * 128;
      for (int i = tid; i < 1024; i += 512) { const int r = i >> 4, c16 = i & 15; const int srow = (r < 32) ? (32 * q + r) : (128 + 32 * q + (r - 32));
          *(LAS v4u*)(lds + L_WSL + r * 272 + c16 * 16) = *(const GAS v4u*)(WG + (size_t)srow * 128 + c16 * 8); } }
    const f32x4 cw0 = *(const f32x4*)(args.in[I_CONVW] + 0 * DLRU + chb + 4 * cg), cw1 = *(const f32x4*)(args.in[I_CONVW] + 1 * DLRU + chb + 4 * cg),
                cw2 = *(const f32x4*)(args.in[I_CONVW] + 2 * DLRU + chb + 4 * cg), cw3 = *(const f32x4*)(args.in[I_CONVW] + 3 * DLRU + chb + 4 * cg),
                cbv = *(const f32x4*)(args.in[I_CONVB] + chb + 4 * cg);
    const int tb = wave & 3, ct = wave >> 2, l15 = lane & 15, lq = lane >> 4;
    const int chg = chb + 32 * q + 16 * ct + l15;
    const float brg = args.in[I_BRG][chg], big = args.in[I_BIG][chg];
    const float lam = args.in[I_LAM][chg];
    const float sp8 = -8.0f * log1pf(expf(-lam));
    float hcar = 0.f;
    float h0s[8];
#pragma unroll
    for (int s = 0; s < 8; ++s) h0s[s] = 0.f;
    if (SAMPLE && tid < 32) {
#pragma unroll
        for (int s = 0; s < 8; ++s) h0s[s] = args.in[I_SLRU][(size_t)(8 * chain + s) * DLRU + chb + 32 * q + tid];
    }
    const int ntile = SAMPLE ? 1 : 32;
    for (int k = 0; k < ntile; ++k) {
        const size_t rbase = SAMPLE ? (size_t)MP + 64 * chain : (size_t)chain * TP + 64 * k;
#pragma unroll
        for (int o = 0; o < 4; ++o) { const f32x4 xc = cbv + cw0 * v[o] + cw1 * v[o + 1] + cw2 * v[o + 2] + cw3 * v[o + 3];
            v2u w; w.x = pk2(xc.x, xc.y); w.y = pk2(xc.z, xc.w);
            *(LAS v2u*)(lds + L_XCB + (4 * tg + o) * 272 + cg * 8) = w;
            if ((cg >> 3) == q) { LAS float* xf = (LAS float*)(lds + L_XCF) + (4 * tg + o) * LP + 4 * (cg & 7); xf[0] = xc.x; xf[1] = xc.y; xf[2] = xc.z; xf[3] = xc.w; } }
        const v2u gcur = gaw;
        if (k + 1 < ntile) lru_load_tile<SAMPLE>(args, XA, GA, chain, k + 1, tg, cg, chb, q, tid, v, gaw);
        LBAR();
        pg8::f32x4 accr = {0.f, 0.f, 0.f, 0.f}, acci = {0.f, 0.f, 0.f, 0.f};
#pragma unroll
        for (int kk = 0; kk < 4; ++kk) {
            const bf16x8 a = *(const LAS bf16x8*)(lds + L_XCB + (16 * tb + l15) * 272 + kk * 64 + lq * 16);
            const bf16x8 br = *(const LAS bf16x8*)(lds + L_WSL + (16 * ct + l15) * 272 + kk * 64 + lq * 16);
            const bf16x8 bi = *(const LAS bf16x8*)(lds + L_WSL + (32 + 16 * ct + l15) * 272 + kk * 64 + lq * 16);
            accr = __builtin_amdgcn_mfma_f32_16x16x32_bf16(a, br, accr, 0, 0, 0);
            acci = __builtin_amdgcn_mfma_f32_16x16x32_bf16(a, bi, acci, 0, 0, 0);
        }
#pragma unroll
        for (int r = 0; r < 4; ++r) { const int tt = 16 * tb + 4 * lq + r, cl = 16 * ct + l15;
            const float rg = fast_sigmoid(accr[r] + brg), ig = fast_sigmoid(acci[r] + big);
            const float la = sp8 * rg;
            const float a = __builtin_amdgcn_exp2f(la * 1.4426950408889634f);
            const float x2 = 2.0f * la;
            const float em = (x2 > -0.25f) ? -x2 * (1.0f + x2 * (0.5f + x2 * (1.0f / 6 + x2 * (1.0f / 24 + x2 * (1.0f / 120 + x2 * (1.0f / 720))))))
                                           : 1.0f - __builtin_amdgcn_exp2f(x2 * 1.4426950408889634f);
            const float xcv = ((const LAS float*)(lds + L_XCF))[tt * LP + cl];
            ((LAS float*)(lds + L_LA))[tt * LP + cl] = a;
            ((LAS float*)(lds + L_LB))[tt * LP + cl] = sqrtf(em) * ig * xcv; }
        LBAR();
        if (tid < 32) {
            const LAS float* la = (const LAS float*)(lds + L_LA) + tid; const LAS float* lb = (const LAS float*)(lds + L_LB) + tid; LAS float* lh = (LAS float*)(lds + L_LH) + tid;
            const int ch = chb + 32 * q + tid;
#pragma unroll
            for (int s = 0; s < 8; ++s) {
                if (SAMPLE) hcar = h0s[s];
#pragma unroll
                for (int t8 = 0; t8 < 8; ++t8) { const int tt = 8 * s + t8; hcar = la[tt * LP] * hcar + lb[tt * LP]; lh[tt * LP] = hcar; }
                if (SAMPLE) args.out[O_SLRU + (size_t)(8 * chain + s) * DLRU + ch] = hcar;
            }
            if (!SAMPLE && k == ntile - 1) args.out[O_PLRU + (size_t)chain * DLRU + ch] = hcar;
        }
        LBAR();
        { const int t = tid >> 3, c4 = (tid & 7) * 4; const LAS float* lh = (const LAS float*)(lds + L_LH) + t * LP + c4;
          v2u o; o.x = pk2(lh[0] * bf_lo(gcur.x), lh[1] * bf_hi(gcur.x)); o.y = pk2(lh[2] * bf_lo(gcur.y), lh[3] * bf_hi(gcur.y));
          MIX_ST(o, (GAS v2u*)(YAB + (rbase + t) * D + chb + 32 * q + c4)); }
    }
    LBAR();
}

#endif
constexpr int S5_WAVE_LDS = 12800, S5_BU = 0, S5_HS = 8448;
template <bool SAMPLE, bool FULL, bool STORE> __device__ __forceinline__ f32x2 s5_task(const Args& args, LAS unsigned char* wl, int lane, int chain, int g, int k_lo, int k_hi, float h0r, float h0i) {
    unsigned char* ws = args.ws;
    const bf16* XB = (const bf16*)(ws + WS_XB); bf16* G2 = (bf16*)(ws + WS_G2);
    const int l15 = lane & 15, lq = lane >> 4;
    const f32x2 ab = *(const GAS f32x2*)((const float*)(ws + WS_ABAR) + 2 * (g * SP + lane));
    bf16x8 bfrag[8], cfrag[4];
#pragma unroll
    for (int j = 0; j < 8; ++j) { bfrag[j] = (bf16x8){0, 0, 0, 0, 0, 0, 0, 0}; if (lane < 32) bfrag[j] = *(const GAS bf16x8*)((const bf16*)(ws + WS_BB) + ((size_t)(g * 8 + j) * 64 + lane) * 8); }
#pragma unroll
    for (int kk = 0; kk < 4; ++kk) cfrag[kk] = *(const GAS bf16x8*)((const bf16*)(ws + WS_CC) + ((size_t)(g * 4 + kk) * 64 + lane) * 8);
    const f32x4 dsk = *(const GAS f32x4*)(args.in[I_DSK] + g * SCG + 4 * lq);
    float hr = h0r, hi = h0i;
    bf16x8 a_nx = (bf16x8){0, 0, 0, 0, 0, 0, 0, 0}; v2u uw_nx;
    { const size_t r0 = SAMPLE ? (size_t)MP + 64 * chain : (size_t)chain * TP + 64 * k_lo;
      if (lane < 32) a_nx = *(const GAS bf16x8*)(XB + (r0 + l15) * DSSM + g * SCG + 8 * lq);
      uw_nx = *(const GAS v2u*)(XB + (r0 + l15) * DSSM + g * SCG + 4 * lq); }
    for (int k = k_lo; k < k_hi; ++k) {
        const size_t rbase = SAMPLE ? (size_t)MP + 64 * chain : (size_t)chain * TP + 64 * k;
#pragma unroll 1
        for (int tb = 0; tb < 4; ++tb) {
            const size_t row0 = rbase + 16 * tb;
            const bf16x8 a = a_nx; const v2u uw = uw_nx;
            if (!(k == k_hi - 1 && tb == 3)) {
                a_nx = (bf16x8){0, 0, 0, 0, 0, 0, 0, 0};
                if (lane < 32) a_nx = *(const GAS bf16x8*)(XB + (row0 + 16 + l15) * DSSM + g * SCG + 8 * lq);
                uw_nx = *(const GAS v2u*)(XB + (row0 + 16 + l15) * DSSM + g * SCG + 4 * lq); }
#pragma unroll
            for (int j = 0; j < 8; ++j) { const pg8::f32x4 c = __builtin_amdgcn_mfma_f32_16x16x32_bf16(a, bfrag[j], (pg8::f32x4){0.f, 0.f, 0.f, 0.f}, 0, 0, 0);
#pragma unroll
                for (int r = 0; r < 4; ++r) ((LAS float*)(wl + S5_BU))[(4 * lq + r) * 132 + 16 * j + l15] = c[r]; }
            LDS_WAIT();
            f32x2 bu[16];
#pragma unroll
            for (int t = 0; t < 16; ++t) bu[t] = *(const LAS f32x2*)(wl + S5_BU + (t * 132 + 2 * lane) * 4);
#pragma unroll
            for (int t = 0; t < 16; ++t) {
                if (SAMPLE && (t & 7) == 0) { const size_t si = ((size_t)(8 * chain + 2 * tb + (t >> 3)) * NGRP + g) * SP + lane; hr = args.in[I_SRE][si]; hi = args.in[I_SIM][si]; }
                const float nr = ab.x * hr - ab.y * hi + bu[t].x, ni = ab.x * hi + ab.y * hr + bu[t].y; hr = nr; hi = ni;
                *(LAS unsigned*)(wl + S5_HS + t * 272 + 4 * lane) = pk2(hr, hi);
                if (SAMPLE && (t & 7) == 7) { const size_t si = ((size_t)(8 * chain + 2 * tb + (t >> 3)) * NGRP + g) * SP + lane; args.out[O_SRE + si] = hr; args.out[O_SIM + si] = hi; }
            }
            LDS_WAIT();
            if (FULL) {
            pg8::f32x4 y = {0.f, 0.f, 0.f, 0.f};
#pragma unroll
            for (int kk = 0; kk < 4; ++kk) { const bf16x8 hb = *(const LAS bf16x8*)(wl + S5_HS + l15 * 272 + kk * 64 + lq * 16);
                y = __builtin_amdgcn_mfma_f32_16x16x32_bf16(cfrag[kk], hb, y, 0, 0, 0); }
            LDS_WAIT();
            const float y0 = y[0] + dsk.x * bf_lo(uw.x), y1 = y[1] + dsk.y * bf_hi(uw.x), y2 = y[2] + dsk.z * bf_lo(uw.y), y3 = y[3] + dsk.w * bf_hi(uw.y);
            v2u o; o.x = pk2(gelu_tanh_f(y0), gelu_tanh_f(y1)); o.y = pk2(gelu_tanh_f(y2), gelu_tanh_f(y3));
            MIX_ST(o, (GAS v2u*)(G2 + (row0 + l15) * DSSM + g * SCG + 4 * lq));
            }
        }
    }
    if (!SAMPLE && STORE) { const size_t si = ((size_t)chain * NGRP + g) * SP + lane; args.out[O_PRE + si] = hr; args.out[O_PIM + si] = hi; }
    return (f32x2){hr, hi};
}


constexpr int S5_EX = 8 * S5_WAVE_LDS;
#ifndef S5_P1FULL
#define S5_P1FULL false
#endif
__device__ __forceinline__ void s5_prompt_wg(const Args& args, LAS unsigned char* lds, int wave, int lane, int pair0) {
    LAS unsigned char* wl = lds + wave * S5_WAVE_LDS;
    const int pair = pair0 + (wave >> 2), seq = pair >> 7, g = pair & 127, chunk = wave & 3;
#if defined(S5_X3)
    { f32x2 h = {0.f, 0.f};
      if (chunk > 0) h = s5_task<false, S5_P1FULL, false>(args, wl, lane, seq, g, 0, 8 * chunk, 0.f, 0.f);
      if (chunk == 3) (void)s5_task<false, true, true>(args, wl, lane, seq, g, 24, 32, h.x, h.y);
      else (void)s5_task<false, true, false>(args, wl, lane, seq, g, 8 * chunk, 8 * chunk + 8, h.x, h.y);
      return; }
#endif
#if defined(S5_TWOCHUNK)
    {
      f32x2 e2 = {0.f, 0.f};
      if (chunk == 0) e2 = s5_task<false, false, false>(args, wl, lane, seq, g, 0, 16, 0.f, 0.f);
      *(LAS f32x2*)(lds + S5_EX + (wave * 64 + lane) * 8) = e2;
      LBAR();
      const f32x2 h1 = *(const LAS f32x2*)(lds + S5_EX + (((wave & ~3)) * 64 + lane) * 8);
      if (chunk == 0) (void)s5_task<false, true, false>(args, wl, lane, seq, g, 0, 16, 0.f, 0.f);
      if (chunk == 1) (void)s5_task<false, true, true>(args, wl, lane, seq, g, 16, 32, h1.x, h1.y);
      return; }
#endif
    f32x2 e = {0.f, 0.f};
    if (chunk < 3) e = s5_task<false, S5_P1FULL, false>(args, wl, lane, seq, g, 8 * chunk, 8 * chunk + 8, 0.f, 0.f);
#if defined(S5_EX_GLOBAL)
    float* exg = (float*)(args.ws + WS_HID + 184 * MiB) + (size_t)blockIdx.x * 1024;
    exg[(wave * 64 + lane) * 2] = e.x; exg[(wave * 64 + lane) * 2 + 1] = e.y;
    __threadfence(); __syncthreads();
#else
    *(LAS f32x2*)(lds + S5_EX + (wave * 64 + lane) * 8) = e;
    LBAR();
#endif
    const f32x2 ab = *(const GAS f32x2*)((const float*)(args.ws + WS_ABAR) + 2 * (g * SP + lane));
#define OPQ(x) asm volatile("" : "+v"(x))
    float pr = ab.x, pi = ab.y;
#pragma unroll 1
    for (int s = 0; s < 9; ++s) { float a2 = pr * pr, b2 = pi * pi, ab2 = pr * pi; OPQ(a2); OPQ(b2); OPQ(ab2); float nr = a2 - b2, ni = ab2 + ab2; OPQ(nr); OPQ(ni); pr = nr; pi = ni; }
    float hr = 0.f, hi = 0.f;
#pragma unroll 1
    for (int c = 0; c < chunk; ++c) { const f32x2 ec = *(const LAS f32x2*)(lds + S5_EX + (((wave & ~3) + c) * 64 + lane) * 8);
        float t1 = pr * hr, t2 = pi * hi, t3 = pr * hi, t4 = pi * hr; OPQ(t1); OPQ(t2); OPQ(t3); OPQ(t4);
        float nr = t1 - t2, ni = t3 + t4; OPQ(nr); OPQ(ni); nr += ec.x; ni += ec.y; OPQ(nr); OPQ(ni); hr = nr; hi = ni; }
#undef OPQ
    if (chunk == 3) (void)s5_task<false, true, true>(args, wl, lane, seq, g, 24, 32, hr, hi);
    else (void)s5_task<false, true, false>(args, wl, lane, seq, g, 8 * chunk, 8 * chunk + 8, hr, hi);
}
__device__ __forceinline__ void convert_beside_chains(const Args& args, int qid, int first, int n, LAS unsigned char* lds, int wave, int lane, volatile LAS unsigned* flag) {
    LAS float* scr = (LAS float*)(lds + RING_OFF + wave * CONV_SCR_STRIDE);
    unsigned* ctr = (unsigned*)(args.ws + WS_CTL) + CW_Q + 64 * qid;
    constexpr int QS = 4;
    for (;;) {
        if (*flag >= 4u) break;
        int base = 0;
        if (lane == 0) base = (int)__hip_atomic_fetch_add(ctr, (unsigned)QS, __ATOMIC_RELAXED, __HIP_MEMORY_SCOPE_AGENT);
        base = __builtin_amdgcn_readfirstlane(base);
        if (base >= n) break;
        const int e = (base + QS < n) ? base + QS : n;
        convert_run(args, first + base, first + e, scr, lane);
    }
}
__device__ __forceinline__ void p5_mixer(const Args& args, LAS unsigned char* lds, int tid, int wave, int lane, int bx, int G, int mode = 0) {
    volatile LAS unsigned* cflag = (volatile LAS unsigned*)(lds + RING_BYTES + 128);
#if defined(S5_CONV)
    if (tid == 0) *cflag = 0u;
    __syncthreads();
#endif
    { const float* XA = (const float*)(args.ws + WS_XA);
      const int nv = (NP + NS) * 3 * (DLRU / 4);
      for (int i = bx * 512 + tid; i < nv; i += G * 512) { const int c4 = i % (DLRU / 4), rj = i / (DLRU / 4), s = rj / 3, j = rj % 3;
          if (s < NP) *(GAS f32x4*)(args.out + O_PCONV + ((size_t)s * 3 + j) * DLRU + 4 * c4) = xa_ld4(XA, (size_t)s * TP + TP - 3 + j, 4 * c4);
          else { const int ss = s - NP; *(GAS f32x4*)(args.out + O_SCONV + ((size_t)ss * 3 + j) * DLRU + 4 * c4) = xa_ld4(XA, (size_t)MP + 8 * ss + 5 + j, 4 * c4); } } }
    LAS unsigned char* wl = lds + wave * S5_WAVE_LDS;
    const int NS5 = (G >= 128) ? NP * NGRP / NWAVES : 0;
#if defined(LRU64) && defined(S5_SPREAD)
    if (G >= 2 * NP * 32) {
        const int NW5 = NP * NGRP / 4;
        if (bx < NW5) {
#if defined(S5_CONV2) && !defined(NO_TAIL_CONVERT)
            if (wave < 4) {
                if (mode != 2 && mode != 3) { const int t = bx * 4 + wave; (void)s5_task<false, true, true>(args, wl, lane, t >> 7, t & 127, 0, 32, 0.f, 0.f); }
                if (mode == 0 || mode == 3) for (int t = bx * 4 + wave; t < 16 * NGRP; t += NW5 * 4) (void)s5_task<true, true, false>(args, wl, lane, t >> 7, t & 127, 0, 1, 0.f, 0.f);
            } else if (mode == 0) convert_queue(args, 5, Q5_FIRST, Q5_N, lds, wave, lane);
            __syncthreads();
#else
            if (wave < 4 && mode != 2 && mode != 3) { const int t = bx * 4 + wave;
#if defined(S5_PRIO)
                __builtin_amdgcn_s_setprio(3);
#endif
                (void)s5_task<false, true, true>(args, wl, lane, t >> 7, t & 127, 0, 32, 0.f, 0.f);
#if defined(S5_PRIO)
                __builtin_amdgcn_s_setprio(0);
#endif
#if defined(S5_CONV)
                if (lane == 0) __hip_atomic_fetch_add((LAS unsigned*)cflag, 1u, __ATOMIC_RELAXED, __HIP_MEMORY_SCOPE_WORKGROUP);
#endif
            }
#if defined(S5_CONV) && !defined(NO_TAIL_CONVERT)
            else if (wave >= 4 && mode == 0) convert_beside_chains(args, 5, Q5_FIRST, Q5_N, lds, wave, lane, cflag);
#endif
            __syncthreads();
            if (mode == 0 || mode == 3)
                for (int t = bx * NWAVES + wave; t < 16 * NGRP; t += NW5 * NWAVES) (void)s5_task<true, true, false>(args, wl, lane, t >> 7, t & 127, 0, 1, 0.f, 0.f);
#endif
        } else if (bx < NW5 + NP * 32) { const int t = bx - NW5; if (mode != 1 && mode != 3) lru_task<false>(args, lds, tid, wave, lane, t >> 5, (t >> 1) & 15, t & 1);
            if (mode == 0 || mode == 3) lru_task<true>(args, lds, tid, wave, lane, 4 * (t >> 5), (t >> 1) & 15, t & 1, 4); }
    } else {
        for (int t = bx * NWAVES + wave; t < NP * NGRP; t += G * NWAVES) (void)s5_task<false, true, true>(args, wl, lane, t >> 7, t & 127, 0, 32, 0.f, 0.f);
        __syncthreads();
        for (int t = bx; t < NP * 32; t += G) lru_task<false>(args, lds, tid, wave, lane, t >> 5, (t >> 1) & 15, t & 1);
        for (int t = bx; t < 16 * 32; t += G) lru_task<true>(args, lds, tid, wave, lane, t >> 5, (t >> 1) & 15, t & 1);
        for (int t = bx * NWAVES + wave; t < 16 * NGRP; t += G * NWAVES) (void)s5_task<true, true, false>(args, wl, lane, t >> 7, t & 127, 0, 1, 0.f, 0.f);
    }
#elif defined(LRU64)
    if (bx < NS5) {
        if (mode != 2) for (int t = bx * NWAVES + wave; t < NP * NGRP; t += NS5 * NWAVES) (void)s5_task<false, true, true>(args, wl, lane, t >> 7, t & 127, 0, 32, 0.f, 0.f);
    } else if (bx < NS5 + NP * 32 && G >= NS5 + NP * 32 + 8) {
        const int t = bx - NS5; if (mode != 1) lru_task<false>(args, lds, tid, wave, lane, t >> 5, (t >> 1) & 15, t & 1);
    } else if (mode == 0) {
        const bool wide = G >= NS5 + NP * 32 + 8; const int b4 = wide ? bx - NS5 - NP * 32 : bx - NS5, G4n = wide ? G - NS5 - NP * 32 : G - NS5;
        if (!wide) for (int t = b4; t < NP * 32; t += G4n) lru_task<false>(args, lds, tid, wave, lane, t >> 5, (t >> 1) & 15, t & 1);
        for (int t = b4; t < 16 * 32; t += G4n) lru_task<true>(args, lds, tid, wave, lane, t >> 5, (t >> 1) & 15, t & 1);
        for (int t = b4 * NWAVES + wave; t < 16 * NGRP; t += G4n * NWAVES) (void)s5_task<true, true, false>(args, wl, lane, t >> 7, t & 127, 0, 1, 0.f, 0.f);
        if (NS5 == 0) for (int t = bx * NWAVES + wave; t < NP * NGRP; t += G * NWAVES) (void)s5_task<false, true, true>(args, wl, lane, t >> 7, t & 127, 0, 32, 0.f, 0.f);
    }
#elif defined(S5_CHUNKED)
    { for (int t = bx; t < NP * 64; t += G) lru_task<false>(args, lds, tid, wave, lane, t >> 6, (t >> 2) & 15, t & 3);
      for (int t = bx; t < 16 * 64; t += G) lru_task<true>(args, lds, tid, wave, lane, t >> 6, (t >> 2) & 15, t & 3);
      for (int t = bx; t < NP * NGRP / 2; t += G) { s5_prompt_wg(args, lds, wave, lane, 2 * t); LBAR(); }
      for (int t = bx * NWAVES + wave; t < 16 * NGRP; t += G * NWAVES) (void)s5_task<true, true, false>(args, wl, lane, t >> 7, t & 127, 0, 1, 0.f, 0.f); }
#elif defined(P5_DEAL2)
    if (bx < NS5) {
        for (int t = bx * NWAVES + wave; t < NP * NGRP; t += NS5 * NWAVES) (void)s5_task<false, true, true>(args, wl, lane, t >> 7, t & 127, 0, 32, 0.f, 0.f);
        __syncthreads();
        const int G2n = G - NS5;
        for (int t = G2n + bx; t < NP * 64; t += NS5) lru_task<false>(args, lds, tid, wave, lane, t >> 6, (t >> 2) & 15, t & 3);
    } else {
        const int b2 = bx - NS5, G2n = G - NS5;
        if (b2 < NP * 64) lru_task<false>(args, lds, tid, wave, lane, b2 >> 6, (b2 >> 2) & 15, b2 & 3);
        for (int t = b2; t < 16 * 64; t += G2n) lru_task<true>(args, lds, tid, wave, lane, t >> 6, (t >> 2) & 15, t & 3);
        for (int t = b2 * NWAVES + wave; t < 16 * NGRP; t += G2n * NWAVES) (void)s5_task<true, true, false>(args, wl, lane, t >> 7, t & 127, 0, 1, 0.f, 0.f);
    }
#else
    if (bx < NS5) {
        for (int t = bx * NWAVES + wave; t < NP * NGRP; t += NS5 * NWAVES) (void)s5_task<false, true, true>(args, wl, lane, t >> 7, t & 127, 0, 32, 0.f, 0.f);
    } else {
        const int b2 = bx - NS5, G2n = G - NS5;
        for (int t = b2; t < NP * 64; t += G2n) lru_task<false>(args, lds, tid, wave, lane, t >> 6, (t >> 2) & 15, t & 3);
        const int nsk = (NP * 64 > G2n && 2 * G2n > NP * 64) ? NP * 64 - G2n : 0, b3 = b2 - nsk, G3n = G2n - nsk;
        if (b3 >= 0) {
            for (int t = b3; t < 16 * 64; t += G3n) lru_task<true>(args, lds, tid, wave, lane, t >> 6, (t >> 2) & 15, t & 3);
            for (int t = b3 * NWAVES + wave; t < 16 * NGRP; t += G3n * NWAVES) (void)s5_task<true, true, false>(args, wl, lane, t >> 7, t & 127, 0, 1, 0.f, 0.f);
        }
        if (NS5 == 0) for (int t = bx * NWAVES + wave; t < NP * NGRP; t += G * NWAVES) (void)s5_task<false, true, true>(args, wl, lane, t >> 7, t & 127, 0, 32, 0.f, 0.f);
    }
#endif
    __syncthreads();
}

__global__ void __launch_bounds__(NWAVES * 64, 2) hawk_fwd(Args args) {
    extern __shared__ __attribute__((aligned(16))) unsigned char lds_raw[];
    LAS unsigned char* lds = (LAS unsigned char*)lds_raw;
    volatile LAS unsigned* MISC = (volatile LAS unsigned*)(lds + MISC_OFF);
    const int tid = threadIdx.x, lane = tid & 63, wave = __builtin_amdgcn_readfirstlane(tid >> 6);
    const int G = gridDim.x, bx = blockIdx.x;
    const int gw = bx * NWAVES + wave, ngw = G * NWAVES;
    unsigned char* ws = args.ws;
    gu32* ctl = (gu32*)(ws + WS_CTL);
    for (int u = tid; u < (LDS_BYTES - LDSCTL_OFF) / 4; u += NWAVES * 64) ((LAS unsigned*)(lds + LDSCTL_OFF))[u] = 0u;
#if defined(XCHK) && XCHK
    for (int u = tid; u < RING_BYTES / 4; u += NWAVES * 64) ((LAS unsigned*)lds)[u] = 0xFFFFFFFFu;
#endif
    __syncthreads();
    XcdBarrier bar = xcd_barrier_post((unsigned*)(ctl + CW_BAR) + args.li * XCD_BAR_WORDS, MISC + 8);
    const int lo = args.ph_lo, hi = args.ph_hi;
#ifndef PHMASK
#define PHMASK 0x1fff
#endif
#define IN(k) ((((PHMASK) >> (k)) & 1) && lo <= (k) && (k) < hi)
#define BOTH(k) (IN(k) && IN((k) + 1))
#if defined(CLKPROBE)
#define SEAM(k) do { if ((k) == CLKPROBE) { const unsigned long long c1 = __builtin_amdgcn_s_memtime(), r1 = __builtin_amdgcn_s_memrealtime(); const unsigned long long dc = c1 - cp_t0, dr = r1 - cp_r0; cp_delay = dr ? (10000ull * dc) / dr : 0ull; } if (BOTH(k)) xcd_barrier(bar); } while (0)
#else
#if defined(SEAM_REP)
#define SEAM(k) do { if (BOTH(k)) { for (int _r = 0; _r < SEAM_REP; ++_r) xcd_barrier(bar); } } while (0)
#else
#define SEAM(k) do { if (BOTH(k)) xcd_barrier(bar); } while (0)
#endif
#endif
#if defined(CLKPROBE)
    unsigned long long cp_t0 = 0, cp_r0 = 0, cp_delay = 0;
#endif
    bf16* XN = (bf16*)(ws + WS_XN); bf16* HID = (bf16*)(ws + WS_HID); float* Fb = (float*)(ws + WS_F); bf16* YAB = (bf16*)(ws + WS_YAB);
#ifndef XS_ON
#define XS_ON 0
#endif
#define XS_CNT(ph) ((unsigned*)(ctl + CW_XS) + (ph) * 1024 + 64 * bar.x)
#define xs_nloc ((unsigned)MISC[8])

#if defined(XCHK) && XCHK
    if (lo == 0) {
        GAS v4u* w4 = (GAS v4u*)(ws + 2 * MiB); const size_t n4 = (WS_END - 2 * MiB) / 16; const v4u q = {0xFFFFFFFFu, 0xFFFFFFFFu, 0xFFFFFFFFu, 0xFFFFFFFFu};
        for (size_t i = (size_t)bx * 512 + tid; i < n4; i += (size_t)G * 512) w4[i] = q;
        GAS v4u* o4 = (GAS v4u*)args.out; const size_t m4 = O_END / 4;
        for (size_t i = (size_t)bx * 512 + tid; i < m4; i += (size_t)G * 512) o4[i] = q;
        if (hi > 1) xcd_barrier(bar);
    }
#endif
    if (IN(0)) { p0_prologue(args, lds, wave, lane, gw, ngw);
#if defined(REP_PHASE) && REP_PHASE == 0
        xcd_barrier(bar); p0_prologue(args, lds, wave, lane, gw, ngw);
#endif
        SEAM(0); }
    int cv = bx;
#if !defined(NO_VIRT_C)
    if (lo == 0 && hi > 1) {
        if (tid == 0) { unsigned ok = (G % 8 == 0) ? 1u : 0u;
            for (unsigned j = 0; j < 16; ++j) { const unsigned cn = xb_ld(&bar.bar[XB_XCNT(j)]); ok &= (cn == (j < 8 ? (unsigned)G / 8u : 0u)) ? 1u : 0u; }
            MISC[11] = ok; }
        __syncthreads();
        if (MISC[11] != 0u && MISC[10] < (unsigned)G / 8u && bar.x < 8u) cv = (int)(MISC[10] * 8u + bar.x);
    }
#endif
#if defined(CLKPROBE)
    if (IN(CLKPROBE)) { cp_t0 = __builtin_amdgcn_s_memtime(); cp_r0 = __builtin_amdgcn_s_memrealtime(); }
#endif
    if (IN(1)) { pg8::Gemm g{XN, (const bf16*)(ws + WS_WGU1), M, 2 * DFF, D, D};   pg8::StaticOrder S; S.init(M, 2 * DFF, D, G, cv); S.xs = pg8::XSync{XS_CNT(1), xs_nloc, XS_ON ? S.nwg / G : 0};
        pg8::EpiSwiglu E{HID, DFF, (const float*)(ws + WS_RSTD)};
        pg8::gemm_phase<pg8::EpiSwiglu, pg8::StaticOrder, PG8_ALIGN, PG8_SP2>(lds + RING_OFF, g, S, E);
#if defined(REP_PHASE) && REP_PHASE == 1
        xcd_barrier(bar); pg8::gemm_phase<pg8::EpiSwiglu, pg8::StaticOrder, PG8_ALIGN, PG8_SP2>(lds + RING_OFF, g, S, E);
#endif
#if !defined(NO_TAIL_CONVERT)
        convert_queue(args, 1, ITB_DN1, IT_DN + IT_IN, lds, wave, lane);
#endif
        SEAM(1); }
    if (IN(2)) { pg8::Gemm g{HID, (const bf16*)(ws + WS_WD1), M, D, DFF, DFF}; pg8::TailOrder S; S.init(D, DFF, G, cv); S.base.xs = pg8::XSync{XS_CNT(2), xs_nloc, XS_ON ? 3 : 0};
        pg8::EpiF32 E{(bf16*)(ws + WS_F), D, (float*)(ws + WS_SLAB), SLAB_FLOATS, MP};
        pg8::gemm_phase<pg8::EpiF32, pg8::TailOrder, PG8_ALIGN, PG8_SP2>(lds + RING_OFF, g, S, E);
#if defined(REP_PHASE) && REP_PHASE == 2
        xcd_barrier(bar); pg8::gemm_phase<pg8::EpiF32, pg8::TailOrder, PG8_ALIGN, PG8_SP2>(lds + RING_OFF, g, S, E);
#endif
        SEAM(2); }
    if (IN(3)) { thin_rows<1>(args, gw, ngw, lane);
#if defined(REP_PHASE) && REP_PHASE == 3
        xcd_barrier(bar); thin_rows<1>(args, gw, ngw, lane);
#endif
        SEAM(3); }
    if (IN(4)) { pg8::Gemm g{(const bf16*)(ws + WS_XR), (const bf16*)(ws + WS_WIN), M, DIN, D, D};   pg8::StaticOrder S; S.init(M, DIN, D, G, cv); S.xs = pg8::XSync{XS_CNT(4), xs_nloc, XS_ON ? S.nwg / G : 0};
        pg8::EpiWin E{(float*)(ws + WS_XA), (bf16*)(ws + WS_GA), (bf16*)(ws + WS_XB), (bf16*)(ws + WS_G), (const float*)(ws + WS_RSTD) + M};
        pg8::gemm_phase<pg8::EpiWin, pg8::StaticOrder, PG8_ALIGN, PG8_SP2>(lds + RING_OFF, g, S, E);
#if !defined(NO_TAIL_CONVERT)
        convert_queue(args, 4, ITB_GLU, IT_GLU, lds, wave, lane);
        convert_queue(args, 14, Q14_FIRST, Q14_N, lds, wave, lane);
#endif
        SEAM(4); }
    if (IN(5)) { p5_mixer(args, lds, tid, wave, lane, bx, G);
#if !defined(NO_TAIL_CONVERT)
        convert_queue(args, 5, Q5_FIRST, Q5_N, lds, wave, lane);
#endif
#if defined(REP_PHASE) && REP_PHASE == 5
#ifndef P5_REP_MODE
#define P5_REP_MODE 0
#endif
        xcd_barrier(bar); p5_mixer(args, lds, tid, wave, lane, bx, G, P5_REP_MODE);
#endif
        SEAM(5); }
    if (IN(6)) { pg8::Gemm g{(const bf16*)(ws + WS_G2), (const bf16*)(ws + WS_WGLU), M, DSSM, DSSM, DSSM}; pg8::StaticOrder S; S.init(M, DSSM, DSSM, G, cv); S.xs = pg8::XSync{XS_CNT(6), xs_nloc, XS_ON ? S.nwg / G : 0};
        pg8::EpiGlu E{(const bf16*)(ws + WS_G2), args.in[I_BGLU], YAB + DLRU};
        pg8::gemm_phase<pg8::EpiGlu, pg8::StaticOrder, PG8_ALIGN, PG8_SP2>(lds + RING_OFF, g, S, E);
#if defined(REP_PHASE) && REP_PHASE == 6
        xcd_barrier(bar); pg8::gemm_phase<pg8::EpiGlu, pg8::StaticOrder, PG8_ALIGN, PG8_SP2>(lds + RING_OFF, g, S, E);
#endif
#if !defined(NO_TAIL_CONVERT)
        convert_queue(args, 6, Q6_FIRST, Q6_N, lds, wave, lane);
#endif
        SEAM(6); }
    if (IN(7)) { pg8::Gemm g{YAB, (const bf16*)(ws + WS_WOUT), M, D, D, D}; pg8::SegOrder S; S.init(M, D, D, G, cv); S.xs = pg8::XSync{XS_CNT(7), xs_nloc, XS_ON ? S.nwg / G : 0};
        pg8::EpiOut E{(const bf16*)(ws + WS_G), XN};
        pg8::gemm_phase<pg8::EpiOut, pg8::SegOrder, PG8_ALIGN, PG8_SP2>(lds + RING_OFF, g, S, E);
#if defined(REP_PHASE) && REP_PHASE == 7
        xcd_barrier(bar); pg8::gemm_phase<pg8::EpiOut, pg8::SegOrder, PG8_ALIGN, PG8_SP2>(lds + RING_OFF, g, S, E);
#endif
#if !defined(NO_TAIL_CONVERT)
        convert_queue(args, 7, Q7_FIRST, Q7_N, lds, wave, lane);
#endif
        SEAM(7); }
    if (IN(8)) { pg8::Gemm g{XN, (const bf16*)(ws + WS_WO), M, D, D, D}; pg8::TailOrder S; S.init(D, D, G, cv); S.base.xs = pg8::XSync{XS_CNT(8), xs_nloc, XS_ON ? 3 : 0};
        pg8::EpiF32 E{(bf16*)(ws + WS_F), D, (float*)(ws + WS_SLAB), SLAB_FLOATS, MP};
        pg8::gemm_phase<pg8::EpiF32, pg8::TailOrder, PG8_ALIGN, PG8_SP2>(lds + RING_OFF, g, S, E);
#if defined(REP_PHASE) && REP_PHASE == 8
        xcd_barrier(bar); pg8::gemm_phase<pg8::EpiF32, pg8::TailOrder, PG8_ALIGN, PG8_SP2>(lds + RING_OFF, g, S, E);
#endif
        SEAM(8); }
    if (IN(9)) { thin_rows<2>(args, gw, ngw, lane); SEAM(9); }
    if (IN(10)) { pg8::Gemm g{(const bf16*)(ws + WS_XR), (const bf16*)(ws + WS_WGU2), M, 2 * DFF, D, D};   pg8::StaticOrder S; S.init(M, 2 * DFF, D, G, cv); S.xs = pg8::XSync{XS_CNT(10), xs_nloc, XS_ON ? S.nwg / G : 0};
        pg8::EpiSwiglu E{HID, DFF, (const float*)(ws + WS_RSTD) + 2 * M};
        pg8::gemm_phase<pg8::EpiSwiglu, pg8::StaticOrder, PG8_ALIGN, PG8_SP2>(lds + RING_OFF, g, S, E);
#if !defined(NO_TAIL_CONVERT)
        convert_queue(args, 10, ITB_DN2, IT_DN, lds, wave, lane);
#endif
        SEAM(10); }
    if (IN(11)) { pg8::Gemm g{HID, (const bf16*)(ws + WS_WD2), M, D, DFF, DFF}; pg8::TailOrder S; S.init(D, DFF, G, cv); S.base.xs = pg8::XSync{XS_CNT(11), xs_nloc, XS_ON ? 3 : 0};
        pg8::EpiF32 E{(bf16*)(ws + WS_F), D, (float*)(ws + WS_SLAB), SLAB_FLOATS, MP};
        pg8::gemm_phase<pg8::EpiF32, pg8::TailOrder, PG8_ALIGN, PG8_SP2>(lds + RING_OFF, g, S, E); SEAM(11); }
    if (IN(12)) { thin_rows<3>(args, gw, ngw, lane); }
#if defined(CLKPROBE)
    if (bx == 0 && tid == 0 && cp_delay != 0ull) { const unsigned long long s0 = __builtin_amdgcn_s_memrealtime(); while (__builtin_amdgcn_s_memrealtime() - s0 < cp_delay) __builtin_amdgcn_s_sleep(8); }
#endif
#undef IN
#undef BOTH
#undef SEAM
}

extern "C" void kernel_launch(void* const* d_in, const int* in_sizes, int n_in, void* d_out, int out_size, void* d_ws, size_t ws_size, hipStream_t stream) {
    static int grid = 0;
    if (grid == 0) {
        if (n_in != 39 || in_sizes[0] != MP * D || out_size != (int)O_END || ws_size < WS_END) { fprintf(stderr, "kernel_launch: unexpected shapes (n_in %d, in0 %d, out %d, ws %zu); nothing launched\n", n_in, n_in > 0 ? in_sizes[0] : -1, out_size, ws_size); grid = -1; return; }
        int dev = 0, cus = 0, per_cu = 0;
        if (hipGetDevice(&dev) != hipSuccess || hipDeviceGetAttribute(&cus, hipDeviceAttributeMultiprocessorCount, dev) != hipSuccess) { grid = -1; return; }
        if (hipFuncSetAttribute((const void*)hawk_fwd, hipFuncAttributeMaxDynamicSharedMemorySize, LDS_BYTES) != hipSuccess) { fprintf(stderr, "kernel_launch: hipFuncSetAttribute failed\n"); grid = -1; return; }
        if (hipOccupancyMaxActiveBlocksPerMultiprocessor(&per_cu, (const void*)hawk_fwd, NWAVES * 64, LDS_BYTES) != hipSuccess || per_cu < 1)
            fprintf(stderr, "kernel_launch: note: occupancy query reports %d workgroups per CU\n", per_cu);
        (void)hipGetLastError();
        grid = cus;
    }
    if (grid < 0) return;
    if (hipMemsetAsync((char*)d_ws + WS_CTL, 0, CTL_ZERO_BYTES, stream) != hipSuccess) return;
    Args a{};
    for (int i = 0; i < 39; ++i) a.in[i] = (const float*)d_in[i];
    a.out = (float*)d_out; a.ws = (unsigned char*)d_ws;
    static_assert(N_LAUNCHES == 1 || N_LAUNCHES == N_PHASES, "MK_N_LAUNCHES: 1 or one launch per phase");
    for (int li = 0; li < N_LAUNCHES; ++li) {
        a.ph_lo = (N_LAUNCHES == 1) ? 0 : li; a.ph_hi = (N_LAUNCHES == 1) ? N_PHASES : li + 1; a.li = li; a.pad = 0;
        hipLaunchKernelGGL(hawk_fwd, dim3(grid), dim3(NWAVES * 64), LDS_BYTES, stream, a);
        const hipError_t le = hipPeekAtLastError();
        if (le != hipSuccess) { fprintf(stderr, "kernel_launch: launch %d failed: %s\n", li, hipGetErrorName(le)); break; }
    }
}
```
